# Optimizing an MI355X kernel written in HIP

```python
import math
import jax, jax.numpy as jnp
from jax import lax
import numpy as np

D_MODEL = 2048
BATCH = 2
SEQ = 16384
DEPTH = 1

CHUNK = 64
N_PREV_CHUNKS = 8
BAND = (N_PREV_CHUNKS + 1) * CHUNK
ATTN_HEADS = 8
ATTN_HEAD_DIM = 128
ATTN_WIDTH = ATTN_HEADS * ATTN_HEAD_DIM
REL_CLIP = 128
SSM_WIDTH = D_MODEL // 2
SSM_GROUP = 16
SSM_GROUPS = SSM_WIDTH // SSM_GROUP
SSM_STATE = 64
DT_MIN = 0.001
DT_MAX = 0.1
IN_SPLITS = (ATTN_WIDTH, 2 * ATTN_WIDTH, 3 * ATTN_WIDTH, 3 * ATTN_WIDTH + SSM_WIDTH,
             3 * ATTN_WIDTH + SSM_WIDTH + D_MODEL)
IN_WIDTH = 3 * ATTN_WIDTH + SSM_WIDTH + 2 * D_MODEL
PEER_HEADS = 8
PEER_NKEYS = 128
PEER_EXPERTS = PEER_NKEYS * PEER_NKEYS
PEER_HALF = 128
PEER_QDIM = 2 * PEER_HALF
PEER_TOPK = 16
PEER_BLOCK = 128
PLE_DIM = 256
LN_EPS = 1e-5

kernel_name = "hybrid_chunk_attn_s5_peer_deepnorm"


def layer_norm(x, g, b):
    xf = x.astype(jnp.float32)
    mu = jnp.mean(xf, axis=-1, keepdims=True)
    var = jnp.mean(jnp.square(xf - mu), axis=-1, keepdims=True)
    y = (xf - mu) * lax.rsqrt(var + LN_EPS)
    return (y * g + b).astype(x.dtype)


def rms_norm(x, g):
    xf = x.astype(jnp.float32)
    y = xf * lax.rsqrt(jnp.mean(jnp.square(xf), axis=-1, keepdims=True) + LN_EPS)
    return (y * g).astype(x.dtype)


def chunk_attention(q, k, v, rel_bias):
    b, s, h, dh = q.shape
    nc = s // CHUNK
    pad = N_PREV_CHUNKS * CHUNK
    kp = jnp.pad(k, ((0, 0), (pad, 0), (0, 0), (0, 0)))
    vp = jnp.pad(v, ((0, 0), (pad, 0), (0, 0), (0, 0)))
    q_pos = jnp.arange(CHUNK)
    k_pos = jnp.arange(BAND)
    rel = (pad + q_pos)[:, None] - k_pos[None, :]
    rel_idx = jnp.clip(rel, -REL_CLIP, REL_CLIP) + REL_CLIP
    bias = rel_bias[:, rel_idx].astype(jnp.float32)
    scale = dh ** -0.5
    qc = q.reshape(b, nc, CHUNK, h, dh).transpose(1, 0, 2, 3, 4)

    def one_chunk(args):
        c, qb = args
        start = c * CHUNK
        kb = lax.dynamic_slice_in_dim(kp, start, BAND, axis=1)
        vb = lax.dynamic_slice_in_dim(vp, start, BAND, axis=1)
        sc = jnp.einsum('bqhd,bkhd->bhqk', qb, kb).astype(jnp.float32) * scale + bias
        valid = (start - pad + k_pos) >= 0
        sc = jnp.where(valid, sc, -1e30)
        w = jax.nn.softmax(sc, axis=-1).astype(vb.dtype)
        return jnp.einsum('bhqk,bkhd->bqhd', w, vb)

    out = lax.map(one_chunk, (jnp.arange(nc), qc))
    return out.transpose(1, 0, 2, 3, 4).reshape(b, s, h * dh)


def _complex_affine_combine(e1, e2):
    a1r, a1i, b1r, b1i = e1
    a2r, a2i, b2r, b2i = e2
    ar = a1r * a2r - a1i * a2i
    ai = a1r * a2i + a1i * a2r
    br = a2r * b1r - a2i * b1i + b2r
    bi = a2r * b1i + a2i * b1r + b2i
    return (ar, ai, br, bi)


def s5_scan(u, lam_re, lam_im, log_dt, b_re, b_im, c_re, c_im, d_skip):
    s = u.shape[1]
    lr = lam_re.astype(jnp.float32)
    li = lam_im.astype(jnp.float32)
    dt = jnp.exp(log_dt.astype(jnp.float32))[:, None]
    mag = jnp.exp(lr * dt)
    ab_re = mag * jnp.cos(li * dt)
    ab_im = mag * jnp.sin(li * dt)
    nr = ab_re - 1.0
    ni = ab_im
    den = lr * lr + li * li
    f_re = (nr * lr + ni * li) / den
    f_im = (ni * lr - nr * li) / den
    br = b_re.astype(jnp.float32)
    bi = b_im.astype(jnp.float32)
    bb_re = f_re[..., None] * br - f_im[..., None] * bi
    bb_im = f_re[..., None] * bi + f_im[..., None] * br
    uf = u.astype(jnp.float32)
    bu_re = jnp.einsum('bsgh,gph->bsgp', uf, bb_re)
    bu_im = jnp.einsum('bsgh,gph->bsgp', uf, bb_im)
    g, p_dim = ab_re.shape
    a_re = jnp.broadcast_to(ab_re, (1, s, g, p_dim))
    a_im = jnp.broadcast_to(ab_im, (1, s, g, p_dim))
    _, _, h_re, h_im = lax.associative_scan(
        _complex_affine_combine, (a_re, a_im, bu_re, bu_im), axis=1)
    y = (jnp.einsum('ghp,bsgp->bsgh', c_re.astype(jnp.float32), h_re)
         - jnp.einsum('ghp,bsgp->bsgh', c_im.astype(jnp.float32), h_im)
         + d_skip.astype(jnp.float32) * uf)
    return y.astype(u.dtype)


def mixer(h, w_in, rel_bias, lam_re, lam_im, log_dt, b_re, b_im, c_re, c_im, d_skip,
          w_ssm_glu, w_attn_up, w_ssm_up, w_out):
    b, s, _ = h.shape
    z = h @ w_in
    q, k, v, u, g_attn, g_ssm = jnp.split(z, IN_SPLITS, axis=-1)
    hd = (b, s, ATTN_HEADS, ATTN_HEAD_DIM)
    y_attn = chunk_attention(q.reshape(hd), k.reshape(hd), v.reshape(hd), rel_bias)
    y_ssm = s5_scan(u.reshape(b, s, SSM_GROUPS, SSM_GROUP), lam_re, lam_im, log_dt,
                    b_re, b_im, c_re, c_im, d_skip).reshape(b, s, SSM_WIDTH)
    y_ssm = jax.nn.gelu(y_ssm)
    y_ssm = y_ssm * jax.nn.sigmoid(y_ssm @ w_ssm_glu)
    merged = (jax.nn.sigmoid(g_attn) * (y_attn @ w_attn_up)
              + jax.nn.sigmoid(g_ssm) * (y_ssm @ w_ssm_up))
    return merged @ w_out


def peer_ffn(h, w_q, sub_keys, u_table, v_table):
    b, s, d = h.shape
    q = (h @ w_q).reshape(b, s, PEER_HEADS, 2, PEER_HALF)
    sc = jnp.einsum('bsrch,rckh->bsrck', q, sub_keys).astype(jnp.float32)
    v_half, i_half = lax.top_k(sc, PEER_TOPK)
    cand = v_half[..., 0, :, None] + v_half[..., 1, None, :]
    cand_idx = i_half[..., 0, :, None] * PEER_NKEYS + i_half[..., 1, None, :]
    cand = cand.reshape(b, s, PEER_HEADS, PEER_TOPK * PEER_TOPK)
    cand_idx = cand_idx.reshape(b, s, PEER_HEADS, PEER_TOPK * PEER_TOPK)
    top_sc, pos = lax.top_k(cand, PEER_TOPK)
    experts = jnp.take_along_axis(cand_idx, pos, axis=-1)
    gates = jax.nn.softmax(top_sc, axis=-1)
    nb = s // PEER_BLOCK
    hb = h.reshape(b, nb, PEER_BLOCK, d).transpose(1, 0, 2, 3)
    eb = experts.reshape(b, nb, PEER_BLOCK, PEER_HEADS, PEER_TOPK).transpose(1, 0, 2, 3, 4)
    gb = gates.reshape(b, nb, PEER_BLOCK, PEER_HEADS, PEER_TOPK).transpose(1, 0, 2, 3, 4)

    def apply_block(args):
        hk, ek, gk = args
        u = u_table[ek]
        act = jax.nn.gelu(jnp.einsum('btd,btrkd->btrk', hk, u).astype(jnp.float32))
        w = (gk * act).astype(hk.dtype)
        return jnp.einsum('btrk,btrkd->btd', w, v_table[ek])

    y = lax.map(apply_block, (hb, eb, gb))
    return y.transpose(1, 0, 2, 3).reshape(b, s, d)


def setup_inputs(seed: int = 0) -> dict:
    key = jax.random.key(seed)
    ks = jax.random.split(key, 32)
    f32 = jnp.float32
    beta = (8.0 * DEPTH) ** -0.25
    nrm = lambda k, shape, sc: jax.random.normal(k, shape, f32) * sc
    L = DEPTH
    lam_im0 = jnp.broadcast_to(math.pi * jnp.arange(SSM_STATE, dtype=f32), (L, SSM_GROUPS, SSM_STATE))
    return {
        "x": nrm(ks[0], (BATCH, SEQ, D_MODEL), 1.0),
        "p": nrm(ks[1], (DEPTH, BATCH, SEQ, PLE_DIM), 1.0),
        "ln_in_g": 1.0 + nrm(ks[2], (D_MODEL,), 0.02),
        "ln_in_b": nrm(ks[3], (D_MODEL,), 0.02),
        "w_in": nrm(ks[4], (L, D_MODEL, IN_WIDTH), D_MODEL ** -0.5),
        "attn_rel_bias": nrm(ks[5], (L, ATTN_HEADS, 2 * REL_CLIP + 1), 0.1),
        "ssm_lam_re": -0.5 + nrm(ks[6], (L, SSM_GROUPS, SSM_STATE), 0.01),
        "ssm_lam_im": lam_im0 + nrm(ks[7], (L, SSM_GROUPS, SSM_STATE), 0.01),
        "ssm_log_dt": jax.random.uniform(ks[8], (L, SSM_GROUPS), f32,
                                         math.log(DT_MIN), math.log(DT_MAX)),
        "ssm_b_re": nrm(ks[9], (L, SSM_GROUPS, SSM_STATE, SSM_GROUP), (2 * SSM_GROUP) ** -0.5),
        "ssm_b_im": nrm(ks[10], (L, SSM_GROUPS, SSM_STATE, SSM_GROUP), (2 * SSM_GROUP) ** -0.5),
        "ssm_c_re": nrm(ks[11], (L, SSM_GROUPS, SSM_GROUP, SSM_STATE), SSM_STATE ** -0.5),
        "ssm_c_im": nrm(ks[12], (L, SSM_GROUPS, SSM_GROUP, SSM_STATE), SSM_STATE ** -0.5),
        "ssm_d": nrm(ks[13], (L, SSM_GROUPS, SSM_GROUP), 1.0),
        "w_ssm_glu": nrm(ks[14], (L, SSM_WIDTH, SSM_WIDTH), SSM_WIDTH ** -0.5),
        "w_attn_up": nrm(ks[15], (L, ATTN_WIDTH, D_MODEL), ATTN_WIDTH ** -0.5),
        "w_ssm_up": nrm(ks[16], (L, SSM_WIDTH, D_MODEL), SSM_WIDTH ** -0.5),
        "w_mix_out": nrm(ks[17], (L, D_MODEL, D_MODEL), beta * D_MODEL ** -0.5),
        "ln1_g": 1.0 + nrm(ks[18], (L, D_MODEL), 0.02),
        "ln1_b": nrm(ks[19], (L, D_MODEL), 0.02),
        "w_peer_q": nrm(ks[20], (L, D_MODEL, PEER_HEADS * PEER_QDIM), D_MODEL ** -0.5),
        "peer_sub_keys": nrm(ks[21], (L, PEER_HEADS, 2, PEER_NKEYS, PEER_HALF), PEER_HALF ** -0.5),
        "peer_u": nrm(ks[22], (L, PEER_EXPERTS, D_MODEL), D_MODEL ** -0.5),
        "peer_v": nrm(ks[23], (L, PEER_EXPERTS, D_MODEL), beta * PEER_HEADS ** -0.5),
        "ple_w_in": nrm(ks[24], (L, PLE_DIM, D_MODEL), PLE_DIM ** -0.5),
        "ple_norm_g": 1.0 + nrm(ks[25], (L, D_MODEL), 0.02),
        "ple_w_gate": nrm(ks[26], (L, D_MODEL, D_MODEL), D_MODEL ** -0.5),
        "ln2_g": 1.0 + nrm(ks[27], (L, D_MODEL), 0.02),
        "ln2_b": nrm(ks[28], (L, D_MODEL), 0.02),
    }


def reference(x, p, ln_in_g, ln_in_b, w_in, attn_rel_bias, ssm_lam_re, ssm_lam_im, ssm_log_dt,
              ssm_b_re, ssm_b_im, ssm_c_re, ssm_c_im, ssm_d, w_ssm_glu, w_attn_up, w_ssm_up,
              w_mix_out, ln1_g, ln1_b, w_peer_q, peer_sub_keys, peer_u, peer_v, ple_w_in,
              ple_norm_g, ple_w_gate, ln2_g, ln2_b):
    alpha = (2.0 * DEPTH) ** 0.25
    h = layer_norm(x, ln_in_g, ln_in_b)
    for i in range(DEPTH):
        mix = mixer(h, w_in[i], attn_rel_bias[i], ssm_lam_re[i], ssm_lam_im[i], ssm_log_dt[i],
                    ssm_b_re[i], ssm_b_im[i], ssm_c_re[i], ssm_c_im[i], ssm_d[i],
                    w_ssm_glu[i], w_attn_up[i], w_ssm_up[i], w_mix_out[i])
        h = layer_norm(alpha * h + mix, ln1_g[i], ln1_b[i])
        ple = rms_norm(p[i] @ ple_w_in[i], ple_norm_g[i]) * jax.nn.sigmoid(h @ ple_w_gate[i])
        ffn = peer_ffn(h, w_peer_q[i], peer_sub_keys[i], peer_u[i], peer_v[i])
        h = layer_norm(alpha * h + ffn + ple, ln2_g[i], ln2_b[i])
    return h
```

```cpp
#include <hip/hip_runtime.h>
#include <hip/hip_bf16.h>
#include <hip/hip_cooperative_groups.h>
#include <cstdio>
namespace cg = cooperative_groups;

#ifndef MULTI
#define MULTI 0
#endif

typedef unsigned short u16;
using bf16x8 = __attribute__((ext_vector_type(8))) short;
using f32x4 = __attribute__((ext_vector_type(4))) float;

constexpr int T_ = 32768;
constexpr int S_ = 16384;
constexpr int D_ = 2048;
constexpr int SSM_L = 128;
constexpr int SSM_NC = S_ / SSM_L;
constexpr float ALPHA = 1.189207115002721f;
constexpr size_t MB = 1024ull * 1024ull;

constexpr size_t O_WIN = 0 * MB, O_WGLU = 32 * MB, O_WAU = 34 * MB, O_WSU = 38 * MB, O_WOUT = 42 * MB,
                 O_WPQ = 50 * MB, O_WPG = 58 * MB, O_WPIN = 66 * MB, O_SK = 67 * MB, O_BCAT = 67 * MB + 512 * 1024,
                 O_CCAT = 68 * MB, O_LAM = 68 * MB + 256 * 1024, O_UB = 70 * MB, O_VB = 134 * MB, O_SBUF = 198 * MB,
                 O_H = 206 * MB, O_Q = 334 * MB, O_K = 398 * MB, O_VT = 462 * MB, O_U2 = 526 * MB, O_G = 590 * MB,
                 O_YA = 846 * MB, O_YS = 910 * MB, O_PB = 974 * MB;
constexpr size_t O_YG = O_VT, O_MERGED = O_Q, O_PRE1 = O_G, O_PQ = O_Q, O_SG = O_VT, O_E = O_G,
                 O_HV = O_G + 128 * MB, O_HI = O_G + 160 * MB, O_EXP = O_G + 192 * MB, O_GATE = O_G + 208 * MB;

struct Params {
  const float *x, *p, *ln_in_g, *ln_in_b, *w_in, *rel_bias, *lam_re, *lam_im, *log_dt, *b_re, *b_im, *c_re, *c_im,
      *ssm_d, *w_glu, *w_au, *w_su, *w_out, *ln1_g, *ln1_b, *w_pq, *sub_keys, *peer_u, *peer_v, *ple_w_in, *ple_g,
      *ple_w_gate, *ln2_g, *ln2_b;
  float* out;
  char* ws;
};

__device__ __forceinline__ u16 f2bf(float f) {
  unsigned u = __float_as_uint(f);
  u += 0x7fffu + ((u >> 16) & 1u);
  return (u16)(u >> 16);
}
__device__ __forceinline__ float bf2f(u16 h) { return __uint_as_float(((unsigned)h) << 16); }
__device__ __forceinline__ unsigned pack2(float a, float b) { return (unsigned)f2bf(a) | ((unsigned)f2bf(b) << 16); }
__device__ __forceinline__ float lo2f(unsigned u) { return __uint_as_float(u << 16); }
__device__ __forceinline__ float hi2f(unsigned u) { return __uint_as_float(u & 0xffff0000u); }
__device__ __forceinline__ float sigmoidf_(float x) { return 1.f / (1.f + __expf(-x)); }
__device__ __forceinline__ float gelu_tanh(float x) {
  float u = 0.7978845608028654f * (x + 0.044715f * x * x * x);
  float t = 1.f - 2.f / (1.f + __expf(2.f * u));
  return 0.5f * x * (1.f + t);
}
__device__ __forceinline__ float wave_sum(float v) {
#pragma unroll
  for (int o = 32; o >= 1; o >>= 1) v += __shfl_xor(v, o);
  return v;
}
__device__ __forceinline__ void store_bf4(u16* dst, float a, float b, float c, float d) {
  uint2 v; v.x = pack2(a, b); v.y = pack2(c, d);
  *(uint2*)dst = v;
}

__device__ __forceinline__ void gemm_kloop(f32x4 (&acc)[4][4], const u16* __restrict__ A, int lda,
                                           const u16* __restrict__ Bt, int ldb, int K, u16* lds) {
  const int tid = threadIdx.x, lane = tid & 63, wid = tid >> 6, wm = wid >> 1, wn = wid & 1;
  const int lr = lane & 15, lq = lane >> 4;
  uint4 ra[4], rb[4];
  const int nk = K >> 6;
  const int srow = tid >> 3, skc = tid & 7;
  const u16* ga = A + (size_t)srow * lda + skc * 8;
  const u16* gb = Bt + (size_t)srow * ldb + skc * 8;
#pragma unroll
  for (int i = 0; i < 4; ++i) {
    ra[i] = *(const uint4*)(ga + (size_t)(32 * i) * lda);
    rb[i] = *(const uint4*)(gb + (size_t)(32 * i) * ldb);
  }
#pragma unroll
  for (int i = 0; i < 4; ++i) {
    *(uint4*)(lds + (srow + 32 * i) * 72 + skc * 8) = ra[i];
    *(uint4*)(lds + 128 * 72 + (srow + 32 * i) * 72 + skc * 8) = rb[i];
  }
  __syncthreads();
  for (int kt = 0; kt < nk; ++kt) {
    if (kt + 1 < nk) {
#pragma unroll
      for (int i = 0; i < 4; ++i) {
        ra[i] = *(const uint4*)(ga + (size_t)(32 * i) * lda + (kt + 1) * 64);
        rb[i] = *(const uint4*)(gb + (size_t)(32 * i) * ldb + (kt + 1) * 64);
      }
    }
    const u16* sa = lds + (kt & 1) * (2 * 128 * 72);
    const u16* sb = sa + 128 * 72;
#pragma unroll
    for (int ks = 0; ks < 2; ++ks) {
      bf16x8 af[4], bfr[4];
#pragma unroll
      for (int mi = 0; mi < 4; ++mi) af[mi] = *(const bf16x8*)(sa + (wm * 64 + mi * 16 + lr) * 72 + ks * 32 + lq * 8);
#pragma unroll
      for (int ni = 0; ni < 4; ++ni) bfr[ni] = *(const bf16x8*)(sb + (wn * 64 + ni * 16 + lr) * 72 + ks * 32 + lq * 8);
#pragma unroll
      for (int mi = 0; mi < 4; ++mi)
#pragma unroll
        for (int ni = 0; ni < 4; ++ni)
          acc[mi][ni] = __builtin_amdgcn_mfma_f32_16x16x32_bf16(bfr[ni], af[mi], acc[mi][ni], 0, 0, 0);
    }
    if (kt + 1 < nk) {
      u16* wa = lds + ((kt + 1) & 1) * (2 * 128 * 72);
#pragma unroll
      for (int i = 0; i < 4; ++i) {
        *(uint4*)(wa + (srow + 32 * i) * 72 + skc * 8) = ra[i];
        *(uint4*)(wa + 128 * 72 + (srow + 32 * i) * 72 + skc * 8) = rb[i];
      }
    }
    __syncthreads();
  }
}

#define ZERO_ACC(acc)                                   \
  _Pragma("unroll") for (int _a = 0; _a < 4; ++_a)      \
  _Pragma("unroll") for (int _b = 0; _b < 4; ++_b) acc[_a][_b] = f32x4{0.f, 0.f, 0.f, 0.f};

#define EPI_COORDS                                                             \
  const int lane = threadIdx.x & 63, wid = threadIdx.x >> 6, wm = wid >> 1, wn = wid & 1; \
  const int lr = lane & 15, lq = lane >> 4;

__device__ void tconv_tile(const float* __restrict__ W, int K, int N, u16* __restrict__ Wt, int tile, float* lds) {
  const int tid = threadIdx.x;
  const int ntn = N >> 6;
  const int kt = tile / ntn, nt = tile % ntn;
  const int c4 = (tid & 15) * 4;
#pragma unroll
  for (int i = 0; i < 4; ++i) {
    int r = (tid >> 4) + 16 * i;
    float4 v = *(const float4*)(W + (size_t)(kt * 64 + r) * N + nt * 64 + c4);
    lds[r * 65 + c4 + 0] = v.x; lds[r * 65 + c4 + 1] = v.y; lds[r * 65 + c4 + 2] = v.z; lds[r * 65 + c4 + 3] = v.w;
  }
  __syncthreads();
  const int n = tid >> 2, kseg = (tid & 3) * 16;
  unsigned o[8];
#pragma unroll
  for (int j = 0; j < 8; ++j) o[j] = pack2(lds[(kseg + 2 * j) * 65 + n], lds[(kseg + 2 * j + 1) * 65 + n]);
  u16* dst = Wt + (size_t)(nt * 64 + n) * K + kt * 64 + kseg;
  *(uint4*)dst = uint4{o[0], o[1], o[2], o[3]};
  *(uint4*)(dst + 8) = uint4{o[4], o[5], o[6], o[7]};
  __syncthreads();
}

__device__ void conv_linear(const float* __restrict__ src, u16* __restrict__ dst, size_t n8, size_t gtid, size_t nth) {
  for (size_t i = gtid; i < n8; i += nth) {
    float4 a = *(const float4*)(src + i * 8), b = *(const float4*)(src + i * 8 + 4);
    *(uint4*)(dst + i * 8) = uint4{pack2(a.x, a.y), pack2(a.z, a.w), pack2(b.x, b.y), pack2(b.z, b.w)};
  }
}

__device__ void ln_rows(const float* __restrict__ src, const float* __restrict__ g, const float* __restrict__ b,
                        u16* __restrict__ dst, int gw, int nw) {
  const int lane = threadIdx.x & 63;
  for (int row = gw; row < T_; row += nw) {
    const float* r = src + (size_t)row * D_;
    float4 v[8];
#pragma unroll
    for (int q = 0; q < 8; ++q) v[q] = *(const float4*)(r + q * 256 + lane * 4);
    float s = 0.f;
#pragma unroll
    for (int q = 0; q < 8; ++q) s += v[q].x + v[q].y + v[q].z + v[q].w;
    float mu = wave_sum(s) * (1.f / D_);
    float ss = 0.f;
#pragma unroll
    for (int q = 0; q < 8; ++q) {
      float a = v[q].x - mu, bb = v[q].y - mu, c = v[q].z - mu, d = v[q].w - mu;
      ss += a * a + bb * bb + c * c + d * d;
    }
    float rstd = rsqrtf(wave_sum(ss) * (1.f / D_) + 1e-5f);
#pragma unroll
    for (int q = 0; q < 8; ++q) {
      int col = q * 256 + lane * 4;
      float4 gg = *(const float4*)(g + col), bb = *(const float4*)(b + col);
      store_bf4(dst + (size_t)row * D_ + col, (v[q].x - mu) * rstd * gg.x + bb.x, (v[q].y - mu) * rstd * gg.y + bb.y,
                (v[q].z - mu) * rstd * gg.z + bb.z, (v[q].w - mu) * rstd * gg.w + bb.w);
    }
  }
}

__device__ __forceinline__ void dsincos(double x, double& s, double& c) {
  double q = rint(x * 0.63661977236758134308);
  double r = x - q * 1.57079632679489661923;
  double r2 = r * r;
  double sp = r * (1.0 + r2 * (-1.0 / 6 + r2 * (1.0 / 120 + r2 * (-1.0 / 5040 + r2 * (1.0 / 362880 + r2 * (-1.0 / 39916800 + r2 * (1.0 / 6227020800.0)))))));
  double cp = 1.0 + r2 * (-0.5 + r2 * (1.0 / 24 + r2 * (-1.0 / 720 + r2 * (1.0 / 40320 + r2 * (-1.0 / 3628800 + r2 * (1.0 / 479001600.0 + r2 * (-1.0 / 87178291200.0)))))));
  int qi = ((int)q) & 3;
  if (qi == 0) { s = sp; c = cp; }
  else if (qi == 1) { s = cp; c = -sp; }
  else if (qi == 2) { s = -sp; c = -cp; }
  else { s = -cp; c = sp; }
}

__device__ void ssm_consts(const Params& P, int i) {
  const int g = i >> 6, p = i & 63;
  double lr = P.lam_re[g * 64 + p], li = P.lam_im[g * 64 + p];
  double dt = exp((double)P.log_dt[g]);
  double mag = exp(lr * dt);
  double sn, cs;
  dsincos(li * dt, sn, cs);
  double ar = mag * cs, ai = mag * sn;
  double nr = ar - 1.0, ni = ai, den = lr * lr + li * li;
  double fr = (nr * lr + ni * li) / den, fi = (ni * lr - nr * li) / den;
  u16* bcat = (u16*)(P.ws + O_BCAT);
  u16* ccat = (u16*)(P.ws + O_CCAT);
  float* lam = (float*)(P.ws + O_LAM);
  for (int h = 0; h < 16; ++h) {
    double br = P.b_re[(g * 64 + p) * 16 + h], bi = P.b_im[(g * 64 + p) * 16 + h];
    bcat[(g * 128 + p) * 32 + h] = f2bf((float)(fr * br - fi * bi));
    bcat[(g * 128 + 64 + p) * 32 + h] = f2bf((float)(fr * bi + fi * br));
    bcat[(g * 128 + p) * 32 + 16 + h] = 0;
    bcat[(g * 128 + 64 + p) * 32 + 16 + h] = 0;
    ccat[(g * 16 + h) * 128 + p] = f2bf(P.c_re[(g * 16 + h) * 64 + p]);
    ccat[(g * 16 + h) * 128 + 64 + p] = f2bf(-P.c_im[(g * 16 + h) * 64 + p]);
  }
  double pr = ar, pi = ai;
  for (int k = 0; k < 7; ++k) {
    double t = pr * pr - pi * pi;
    pi = 2.0 * pr * pi;
    pr = t;
  }
  lam[0 * 4096 + i] = (float)ar;
  lam[1 * 4096 + i] = (float)ai;
  lam[2 * 4096 + i] = (float)pr;
  lam[3 * 4096 + i] = (float)pi;
}

__device__ void phase0(const Params& P, int bid, int nb, u16* lds) {
  const size_t gtid = (size_t)bid * 256 + threadIdx.x, nth = (size_t)nb * 256;
#define TCONV(wp, KK, NN, OFF) \
  for (int t = bid; t < ((KK) >> 6) * ((NN) >> 6); t += nb) tconv_tile(wp, KK, NN, (u16*)(P.ws + OFF), t, (float*)lds);
  TCONV(P.w_in, 2048, 8192, O_WIN)
  TCONV(P.w_glu, 1024, 1024, O_WGLU)
  TCONV(P.w_au, 1024, 2048, O_WAU)
  TCONV(P.w_su, 1024, 2048, O_WSU)
  TCONV(P.w_out, 2048, 2048, O_WOUT)
  TCONV(P.w_pq, 2048, 2048, O_WPQ)
  TCONV(P.ple_w_gate, 2048, 2048, O_WPG)
  TCONV(P.ple_w_in, 256, 2048, O_WPIN)
  conv_linear(P.peer_u, (u16*)(P.ws + O_UB), (size_t)16384 * 2048 / 8, gtid, nth);
  conv_linear(P.peer_v, (u16*)(P.ws + O_VB), (size_t)16384 * 2048 / 8, gtid, nth);
  conv_linear(P.sub_keys, (u16*)(P.ws + O_SK), (size_t)16 * 128 * 128 / 8, gtid, nth);
  conv_linear(P.p, (u16*)(P.ws + O_PB), (size_t)T_ * 256 / 8, gtid, nth);
  for (size_t i = gtid; i < 4096; i += nth) ssm_consts(P, (int)i);
  ln_rows(P.x, P.ln_in_g, P.ln_in_b, (u16*)(P.ws + O_H), bid * 4 + (threadIdx.x >> 6), nb * 4);
}

__device__ void phase1(const Params& P, int bid, int nb, u16* lds) {
  const u16* H = (const u16*)(P.ws + O_H);
  const u16* W = (const u16*)(P.ws + O_WIN);
  u16* Q = (u16*)(P.ws + O_Q);
  u16* Kb = (u16*)(P.ws + O_K);
  u16* Vt = (u16*)(P.ws + O_VT);
  u16* U2 = (u16*)(P.ws + O_U2);
  u16* G = (u16*)(P.ws + O_G);
  EPI_COORDS
  const int ntiles = 256 * 64;
  for (int t = bid; t < ntiles; t += nb) {
    const int mt = t >> 6, nt = t & 63;
    f32x4 acc[4][4];
    ZERO_ACC(acc)
    gemm_kloop(acc, H + (size_t)mt * 128 * D_, D_, W + (size_t)nt * 128 * D_, D_, D_, lds);
    const int region = nt >> 3;
#pragma unroll
    for (int mi = 0; mi < 4; ++mi) {
      const int m = mt * 128 + wm * 64 + mi * 16 + lr;
#pragma unroll
      for (int ni = 0; ni < 4; ++ni) {
        const int n = nt * 128 + wn * 64 + ni * 16 + lq * 4;
        f32x4 a = acc[mi][ni];
        if (region == 0) {
          const float sc = 0.08838834764831845f;
          store_bf4(Q + (size_t)m * 1024 + n, a[0] * sc, a[1] * sc, a[2] * sc, a[3] * sc);
        } else if (region == 1) {
          store_bf4(Kb + (size_t)m * 1024 + (n - 1024), a[0], a[1], a[2], a[3]);
        } else if (region == 2) {
          const int b = m >> 14, tt = m & (S_ - 1);
#pragma unroll
          for (int j = 0; j < 4; ++j) Vt[((size_t)(b * 1024 + (n - 2048 + j))) * S_ + tt] = f2bf(a[j]);
        } else if (region == 3) {
          store_bf4(U2 + (size_t)m * 1024 + (n - 3072), a[0], a[1], a[2], a[3]);
        } else {
          store_bf4(G + (size_t)m * 4096 + (n - 4096), sigmoidf_(a[0]), sigmoidf_(a[1]), sigmoidf_(a[2]), sigmoidf_(a[3]));
        }
      }
    }
  }
}

__device__ void attn_item(const Params& P, int item, u16* lds) {
  const int c = item & 255, hd = (item >> 8) & 7, b = item >> 11;
  const int tid = threadIdx.x, lane = tid & 63, w = tid >> 6, lr = lane & 15, lq = lane >> 4;
  u16* Ks = lds;
  u16* Vs = lds + 64 * 136;
  float* bs = (float*)(lds + 64 * 136 + 128 * 72);
  const u16* Q = (const u16*)(P.ws + O_Q);
  const u16* Kb = (const u16*)(P.ws + O_K);
  const u16* Vt = (const u16*)(P.ws + O_VT);
  u16* ya = (u16*)(P.ws + O_YA);
  __syncthreads();
  for (int i = tid; i < 257; i += 256) bs[i] = P.rel_bias[hd * 257 + i];
  bf16x8 qf[4];
  {
    const u16* qp = Q + (size_t)(b * S_ + c * 64 + w * 16 + lr) * 1024 + hd * 128 + lq * 8;
#pragma unroll
    for (int ks = 0; ks < 4; ++ks) qf[ks] = *(const bf16x8*)(qp + ks * 32);
  }
  f32x4 oacc[8];
#pragma unroll
  for (int d = 0; d < 8; ++d) oacc[d] = f32x4{0.f, 0.f, 0.f, 0.f};
  float m_run = -1e30f, lsum = 0.f;
  const int i0 = (c < 8) ? (8 - c) : 0;
  const int qi = w * 16 + lr;
  for (int i = i0; i <= 8; ++i) {
    const int kc = c - 8 + i;
    __syncthreads();
#pragma unroll
    for (int r = 0; r < 4; ++r) {
      int ch = tid + 256 * r;
      int row = ch >> 4, kk = ch & 15;
      *(uint4*)(Ks + row * 136 + kk * 8) = *(const uint4*)(Kb + (size_t)(b * S_ + kc * 64 + row) * 1024 + hd * 128 + kk * 8);
      int row2 = ch >> 3, k2 = ch & 7;
      *(uint4*)(Vs + row2 * 72 + k2 * 8) = *(const uint4*)(Vt + ((size_t)(b * 1024 + hd * 128 + row2)) * S_ + kc * 64 + k2 * 8);
    }
    __syncthreads();
    f32x4 sacc[4];
#pragma unroll
    for (int kt = 0; kt < 4; ++kt) {
      sacc[kt] = f32x4{0.f, 0.f, 0.f, 0.f};
#pragma unroll
      for (int ks = 0; ks < 4; ++ks) {
        bf16x8 kf = *(const bf16x8*)(Ks + (kt * 16 + lr) * 136 + ks * 32 + lq * 8);
        sacc[kt] = __builtin_amdgcn_mfma_f32_16x16x32_bf16(kf, qf[ks], sacc[kt], 0, 0, 0);
      }
    }
    float tmax = -1e30f;
#pragma unroll
    for (int kt = 0; kt < 4; ++kt)
#pragma unroll
      for (int j = 0; j < 4; ++j) {
        int kb = i * 64 + kt * 16 + lq * 4 + j;
        int rel = 512 + qi - kb;
        rel = min(max(rel, -128), 128) + 128;
        float s = sacc[kt][j] + bs[rel];
        sacc[kt][j] = s;
        tmax = fmaxf(tmax, s);
      }
    tmax = fmaxf(tmax, __shfl_xor(tmax, 16));
    tmax = fmaxf(tmax, __shfl_xor(tmax, 32));
    const float m_new = fmaxf(m_run, tmax);
    const float corr = __expf(m_run - m_new);
    m_run = m_new;
    float ps = 0.f;
#pragma unroll
    for (int kt = 0; kt < 4; ++kt)
#pragma unroll
      for (int j = 0; j < 4; ++j) {
        float pv = __expf(sacc[kt][j] - m_new);
        sacc[kt][j] = pv;
        ps += pv;
      }
    lsum = lsum * corr + ps;
#pragma unroll
    for (int d = 0; d < 8; ++d) {
      oacc[d][0] *= corr; oacc[d][1] *= corr; oacc[d][2] *= corr; oacc[d][3] *= corr;
    }
#pragma unroll
    for (int kk = 0; kk < 2; ++kk) {
      union { bf16x8 v; unsigned u[4]; } pf;
      pf.u[0] = pack2(sacc[2 * kk][0], sacc[2 * kk][1]);
      pf.u[1] = pack2(sacc[2 * kk][2], sacc[2 * kk][3]);
      pf.u[2] = pack2(sacc[2 * kk + 1][0], sacc[2 * kk + 1][1]);
      pf.u[3] = pack2(sacc[2 * kk + 1][2], sacc[2 * kk + 1][3]);
#pragma unroll
      for (int d = 0; d < 8; ++d) {
        union { bf16x8 v; uint2 h[2]; } vf;
        vf.h[0] = *(const uint2*)(Vs + (d * 16 + lr) * 72 + kk * 32 + lq * 4);
        vf.h[1] = *(const uint2*)(Vs + (d * 16 + lr) * 72 + kk * 32 + 16 + lq * 4);
        oacc[d] = __builtin_amdgcn_mfma_f32_16x16x32_bf16(vf.v, pf.v, oacc[d], 0, 0, 0);
      }
    }
  }
  lsum += __shfl_xor(lsum, 16);
  lsum += __shfl_xor(lsum, 32);
  const float inv = 1.f / lsum;
  u16* op = ya + (size_t)(b * S_ + c * 64 + w * 16 + lr) * 1024 + hd * 128 + lq * 4;
#pragma unroll
  for (int d = 0; d < 8; ++d) store_bf4(op + d * 16, oacc[d][0] * inv, oacc[d][1] * inv, oacc[d][2] * inv, oacc[d][3] * inv);
}

template <int PASS>
__device__ void ssm_item(const Params& P, int item, char* ldsw) {
  const int c = item & (SSM_NC - 1), seq = item >> 7, g = seq & 63, b = seq >> 6;
  const int lane = threadIdx.x & 63, lr = lane & 15, lq = lane >> 4;
  float* BuS = (float*)ldsw;
  u16* Hs = (u16*)(ldsw + 8192);
  const u16* bcat = (const u16*)(P.ws + O_BCAT);
  const u16* ccat = (const u16*)(P.ws + O_CCAT);
  const float* lam = (const float*)(P.ws + O_LAM);
  const u16* U2 = (const u16*)(P.ws + O_U2);
  float* Sbuf = (float*)(P.ws + O_SBUF);
  u16* ys = (u16*)(P.ws + O_YS);
  const float ar = lam[g * 64 + lane], ai = lam[4096 + g * 64 + lane];
  bf16x8 bfrag[8];
#pragma unroll
  for (int nt = 0; nt < 8; ++nt) bfrag[nt] = *(const bf16x8*)(bcat + (g * 128 + nt * 16 + lr) * 32 + lq * 8);
  float sr = 0.f, si = 0.f;
  bf16x8 cfrag[4];
  float dsk[4];
  if (PASS == 2) {
#pragma unroll
    for (int ks = 0; ks < 4; ++ks) cfrag[ks] = *(const bf16x8*)(ccat + (g * 16 + lr) * 128 + ks * 32 + lq * 8);
#pragma unroll
    for (int j = 0; j < 4; ++j) dsk[j] = P.ssm_d[g * 16 + lq * 4 + j];
    const float aLr = lam[2 * 4096 + g * 64 + lane], aLi = lam[3 * 4096 + g * 64 + lane];
    const float* Sb = Sbuf + (size_t)seq * SSM_NC * 128;
#pragma unroll 4
    for (int cc = 0; cc < c; ++cc) {
      float xr = Sb[cc * 128 + lane], xi = Sb[cc * 128 + 64 + lane];
      float nr = fmaf(aLr, sr, fmaf(-aLi, si, xr));
      float ni = fmaf(aLr, si, fmaf(aLi, sr, xi));
      sr = nr; si = ni;
    }
  }
  const size_t tok_base = (size_t)b * S_ + (size_t)c * SSM_L;
  for (int sub = 0; sub < SSM_L / 16; ++sub) {
    const size_t tok0 = tok_base + sub * 16;
    union { bf16x8 v; uint4 u; } uf;
    uf.u = uint4{0u, 0u, 0u, 0u};
    if (lq < 2) uf.u = *(const uint4*)(U2 + (tok0 + lr) * 1024 + g * 16 + lq * 8);
#pragma unroll
    for (int nt = 0; nt < 8; ++nt) {
      f32x4 d = __builtin_amdgcn_mfma_f32_16x16x32_bf16(bfrag[nt], uf.v, f32x4{0.f, 0.f, 0.f, 0.f}, 0, 0, 0);
      *(f32x4*)(BuS + lr * 128 + nt * 16 + lq * 4) = d;
    }
    asm volatile("s_waitcnt lgkmcnt(0)" ::: "memory");
#pragma unroll
    for (int t = 0; t < 16; ++t) {
      float bur = BuS[t * 128 + lane], bui = BuS[t * 128 + 64 + lane];
      float nr = fmaf(ar, sr, fmaf(-ai, si, bur));
      float ni = fmaf(ar, si, fmaf(ai, sr, bui));
      sr = nr; si = ni;
      if (PASS == 2) {
        Hs[t * 136 + lane] = f2bf(sr);
        Hs[t * 136 + 64 + lane] = f2bf(si);
      }
    }
    asm volatile("s_waitcnt lgkmcnt(0)" ::: "memory");
    if (PASS == 2) {
      f32x4 yacc = f32x4{0.f, 0.f, 0.f, 0.f};
#pragma unroll
      for (int ks = 0; ks < 4; ++ks) {
        bf16x8 hf = *(const bf16x8*)(Hs + lr * 136 + ks * 32 + lq * 8);
        yacc = __builtin_amdgcn_mfma_f32_16x16x32_bf16(cfrag[ks], hf, yacc, 0, 0, 0);
      }
      uint2 uu = *(const uint2*)(U2 + (tok0 + lr) * 1024 + g * 16 + lq * 4);
      float y0 = gelu_tanh(yacc[0] + dsk[0] * lo2f(uu.x));
      float y1 = gelu_tanh(yacc[1] + dsk[1] * hi2f(uu.x));
      float y2 = gelu_tanh(yacc[2] + dsk[2] * lo2f(uu.y));
      float y3 = gelu_tanh(yacc[3] + dsk[3] * hi2f(uu.y));
      store_bf4(ys + (tok0 + lr) * 1024 + g * 16 + lq * 4, y0, y1, y2, y3);
      asm volatile("s_waitcnt lgkmcnt(0)" ::: "memory");
    }
  }
  if (PASS == 1) {
    Sbuf[((size_t)seq * SSM_NC + c) * 128 + lane] = sr;
    Sbuf[((size_t)seq * SSM_NC + c) * 128 + 64 + lane] = si;
  }
}

__device__ void phase2(const Params& P, int bid, int nb, u16* lds) {
  for (int it = bid; it < 8192; it += nb) {
    if (it < 4096) {
      attn_item(P, it, lds);
    } else {
      __syncthreads();
      const int w = threadIdx.x >> 6;
      ssm_item<1>(P, (it - 4096) * 4 + w, (char*)lds + w * 12544);
    }
  }
}
__device__ void phase3(const Params& P, int bid, int nb, u16* lds) {
  const int w = threadIdx.x >> 6;
  for (int it = bid; it < 4096; it += nb) ssm_item<2>(P, it * 4 + w, (char*)lds + w * 12544);
}

__device__ void phase4(const Params& P, int bid, int nb, u16* lds) {
  const u16* ys = (const u16*)(P.ws + O_YS);
  const u16* W = (const u16*)(P.ws + O_WGLU);
  u16* yg = (u16*)(P.ws + O_YG);
  EPI_COORDS
  for (int t = bid; t < 256 * 8; t += nb) {
    const int mt = t >> 3, nt = t & 7;
    f32x4 acc[4][4];
    ZERO_ACC(acc)
    gemm_kloop(acc, ys + (size_t)mt * 128 * 1024, 1024, W + (size_t)nt * 128 * 1024, 1024, 1024, lds);
#pragma unroll
    for (int mi = 0; mi < 4; ++mi) {
      const int m = mt * 128 + wm * 64 + mi * 16 + lr;
#pragma unroll
      for (int ni = 0; ni < 4; ++ni) {
        const int n = nt * 128 + wn * 64 + ni * 16 + lq * 4;
        uint2 yy = *(const uint2*)(ys + (size_t)m * 1024 + n);
        f32x4 a = acc[mi][ni];
        store_bf4(yg + (size_t)m * 1024 + n, lo2f(yy.x) * sigmoidf_(a[0]), hi2f(yy.x) * sigmoidf_(a[1]),
                  lo2f(yy.y) * sigmoidf_(a[2]), hi2f(yy.y) * sigmoidf_(a[3]));
      }
    }
  }
}

__device__ void phase5(const Params& P, int bid, int nb, u16* lds) {
  const u16* ya = (const u16*)(P.ws + O_YA);
  const u16* yg = (const u16*)(P.ws + O_YG);
  const u16* Wa = (const u16*)(P.ws + O_WAU);
  const u16* Wsu = (const u16*)(P.ws + O_WSU);
  const u16* G = (const u16*)(P.ws + O_G);
  u16* mg = (u16*)(P.ws + O_MERGED);
  EPI_COORDS
  for (int t = bid; t < 256 * 16; t += nb) {
    const int mt = t >> 4, nt = t & 15;
    f32x4 acc[4][4];
    ZERO_ACC(acc)
    gemm_kloop(acc, ya + (size_t)mt * 128 * 1024, 1024, Wa + (size_t)nt * 128 * 1024, 1024, 1024, lds);
#pragma unroll
    for (int mi = 0; mi < 4; ++mi) {
      const int m = mt * 128 + wm * 64 + mi * 16 + lr;
#pragma unroll
      for (int ni = 0; ni < 4; ++ni) {
        const int n = nt * 128 + wn * 64 + ni * 16 + lq * 4;
        uint2 ga = *(const uint2*)(G + (size_t)m * 4096 + n);
        uint2 gs = *(const uint2*)(G + (size_t)m * 4096 + 2048 + n);
        acc[mi][ni][0] *= lo2f(ga.x) / fmaxf(lo2f(gs.x), 1e-30f);
        acc[mi][ni][1] *= hi2f(ga.x) / fmaxf(hi2f(gs.x), 1e-30f);
        acc[mi][ni][2] *= lo2f(ga.y) / fmaxf(lo2f(gs.y), 1e-30f);
        acc[mi][ni][3] *= hi2f(ga.y) / fmaxf(hi2f(gs.y), 1e-30f);
      }
    }
    gemm_kloop(acc, yg + (size_t)mt * 128 * 1024, 1024, Wsu + (size_t)nt * 128 * 1024, 1024, 1024, lds);
#pragma unroll
    for (int mi = 0; mi < 4; ++mi) {
      const int m = mt * 128 + wm * 64 + mi * 16 + lr;
#pragma unroll
      for (int ni = 0; ni < 4; ++ni) {
        const int n = nt * 128 + wn * 64 + ni * 16 + lq * 4;
        uint2 gs = *(const uint2*)(G + (size_t)m * 4096 + 2048 + n);
        f32x4 a = acc[mi][ni];
        store_bf4(mg + (size_t)m * D_ + n, a[0] * fmaxf(lo2f(gs.x), 1e-30f), a[1] * fmaxf(hi2f(gs.x), 1e-30f),
                  a[2] * fmaxf(lo2f(gs.y), 1e-30f), a[3] * fmaxf(hi2f(gs.y), 1e-30f));
      }
    }
  }
}

__device__ void phase6(const Params& P, int bid, int nb, u16* lds) {
  const u16* mg = (const u16*)(P.ws + O_MERGED);
  const u16* W = (const u16*)(P.ws + O_WOUT);
  const u16* H = (const u16*)(P.ws + O_H);
  float* pre1 = (float*)(P.ws + O_PRE1);
  EPI_COORDS
  for (int t = bid; t < 256 * 16; t += nb) {
    const int mt = t >> 4, nt = t & 15;
    f32x4 acc[4][4];
    ZERO_ACC(acc)
    gemm_kloop(acc, mg + (size_t)mt * 128 * D_, D_, W + (size_t)nt * 128 * D_, D_, D_, lds);
#pragma unroll
    for (int mi = 0; mi < 4; ++mi) {
      const int m = mt * 128 + wm * 64 + mi * 16 + lr;
#pragma unroll
      for (int ni = 0; ni < 4; ++ni) {
        const int n = nt * 128 + wn * 64 + ni * 16 + lq * 4;
        uint2 hh = *(const uint2*)(H + (size_t)m * D_ + n);
        f32x4 a = acc[mi][ni];
        float4 o;
        o.x = ALPHA * lo2f(hh.x) + a[0]; o.y = ALPHA * hi2f(hh.x) + a[1];
        o.z = ALPHA * lo2f(hh.y) + a[2]; o.w = ALPHA * hi2f(hh.y) + a[3];
        *(float4*)(pre1 + (size_t)m * D_ + n) = o;
      }
    }
  }
}

__device__ void phase8(const Params& P, int bid, int nb, u16* lds) {
  const u16* H = (const u16*)(P.ws + O_H);
  const u16* Pb = (const u16*)(P.ws + O_PB);
  u16* PQ = (u16*)(P.ws + O_PQ);
  u16* SG = (u16*)(P.ws + O_SG);
  u16* E = (u16*)(P.ws + O_E);
  EPI_COORDS
  for (int t = bid; t < 3 * 4096; t += nb) {
    const int which = t >> 12, tt = t & 4095, mt = tt >> 4, nt = tt & 15;
    f32x4 acc[4][4];
    ZERO_ACC(acc)
    u16* dst;
    if (which == 0) {
      gemm_kloop(acc, H + (size_t)mt * 128 * D_, D_, (const u16*)(P.ws + O_WPQ) + (size_t)nt * 128 * D_, D_, D_, lds);
      dst = PQ;
    } else if (which == 1) {
      gemm_kloop(acc, H + (size_t)mt * 128 * D_, D_, (const u16*)(P.ws + O_WPG) + (size_t)nt * 128 * D_, D_, D_, lds);
      dst = SG;
    } else {
      gemm_kloop(acc, Pb + (size_t)mt * 128 * 256, 256, (const u16*)(P.ws + O_WPIN) + (size_t)nt * 128 * 256, 256, 256, lds);
      dst = E;
    }
#pragma unroll
    for (int mi = 0; mi < 4; ++mi) {
      const int m = mt * 128 + wm * 64 + mi * 16 + lr;
#pragma unroll
      for (int ni = 0; ni < 4; ++ni) {
        const int n = nt * 128 + wn * 64 + ni * 16 + lq * 4;
        f32x4 a = acc[mi][ni];
        if (which == 1) { a[0] = sigmoidf_(a[0]); a[1] = sigmoidf_(a[1]); a[2] = sigmoidf_(a[2]); a[3] = sigmoidf_(a[3]); }
        store_bf4(dst + (size_t)m * D_ + n, a[0], a[1], a[2], a[3]);
      }
    }
  }
}

struct Top16 { float v[16]; int i[16]; };
__device__ __forceinline__ void top_init(Top16& t) {
#pragma unroll
  for (int k = 0; k < 16; ++k) { t.v[k] = -INFINITY; t.i[k] = 0; }
}
__device__ __forceinline__ void top_insert(Top16& t, float x, int id) {
  const bool c = x > t.v[15];
  t.v[15] = c ? x : t.v[15];
  t.i[15] = c ? id : t.i[15];
#pragma unroll
  for (int k = 15; k >= 1; --k) {
    const bool s = t.v[k] > t.v[k - 1];
    const float a = t.v[k - 1], b = t.v[k];
    const int ia = t.i[k - 1], ib = t.i[k];
    t.v[k - 1] = s ? b : a; t.v[k] = s ? a : b;
    t.i[k - 1] = s ? ib : ia; t.i[k] = s ? ia : ib;
  }
}

__device__ void phase9(const Params& P, int bid, int nb, u16* lds) {
  const u16* PQ = (const u16*)(P.ws + O_PQ);
  const u16* SK = (const u16*)(P.ws + O_SK);
  float* HV = (float*)(P.ws + O_HV);
  int* HI = (int*)(P.ws + O_HI);
  float* Sc = (float*)lds;
  EPI_COORDS
  const int tid = threadIdx.x;
  for (int t = bid; t < 256 * 16; t += nb) {
    const int mt = t >> 4, rc = t & 15;
    f32x4 acc[4][4];
    ZERO_ACC(acc)
    gemm_kloop(acc, PQ + (size_t)mt * 128 * D_ + rc * 128, D_, SK + (size_t)rc * 128 * 128, 128, 128, lds);
#pragma unroll
    for (int mi = 0; mi < 4; ++mi) {
      const int m = wm * 64 + mi * 16 + lr;
#pragma unroll
      for (int ni = 0; ni < 4; ++ni) {
        const int n = wn * 64 + ni * 16 + lq * 4;
#pragma unroll
        for (int j = 0; j < 4; ++j) Sc[m * 129 + n + j] = acc[mi][ni][j];
      }
    }
    __syncthreads();
    const int tok = tid & 127, hh = tid >> 7;
    Top16 tp;
    top_init(tp);
    for (int k = 0; k < 64; ++k) top_insert(tp, Sc[tok * 129 + hh * 64 + k], hh * 64 + k);
    __syncthreads();
    float* Lv = (float*)lds;
    int* Li = (int*)lds + 256 * 17;
#pragma unroll
    for (int k = 0; k < 16; ++k) { Lv[tid * 17 + k] = tp.v[k]; Li[tid * 17 + k] = tp.i[k]; }
    __syncthreads();
    if (tid < 128) {
      int ia = 0, ib = 0;
      const float* va = Lv + tid * 17; const float* vb = Lv + (tid + 128) * 17;
      const int* xa = Li + tid * 17; const int* xb = Li + (tid + 128) * 17;
      float* ov = HV + ((size_t)(mt * 128 + tid) * 16 + rc) * 16;
      int* oi = HI + ((size_t)(mt * 128 + tid) * 16 + rc) * 16;
      for (int k = 0; k < 16; ++k) {
        float a = va[ia], b = vb[ib];
        bool ta = a >= b;
        ov[k] = ta ? a : b;
        oi[k] = ta ? xa[ia] : xb[ib];
        ia += ta ? 1 : 0; ib += ta ? 0 : 1;
      }
    }
    __syncthreads();
  }
}

__device__ void phase10(const Params& P, int bid, int nb) {
  const float* HV = (const float*)(P.ws + O_HV);
  const int* HI = (const int*)(P.ws + O_HI);
  int* EX = (int*)(P.ws + O_EXP);
  float* GT = (float*)(P.ws + O_GATE);
  for (int i = bid * 256 + threadIdx.x; i < T_ * 8; i += nb * 256) {
    float v0[16], v1[16];
    int i0[16], i1[16];
#pragma unroll
    for (int q = 0; q < 4; ++q) {
      float4 a = *(const float4*)(HV + (size_t)i * 32 + q * 4);
      float4 b = *(const float4*)(HV + (size_t)i * 32 + 16 + q * 4);
      int4 c = *(const int4*)(HI + (size_t)i * 32 + q * 4);
      int4 d = *(const int4*)(HI + (size_t)i * 32 + 16 + q * 4);
      v0[q * 4] = a.x; v0[q * 4 + 1] = a.y; v0[q * 4 + 2] = a.z; v0[q * 4 + 3] = a.w;
      v1[q * 4] = b.x; v1[q * 4 + 1] = b.y; v1[q * 4 + 2] = b.z; v1[q * 4 + 3] = b.w;
      i0[q * 4] = c.x; i0[q * 4 + 1] = c.y; i0[q * 4 + 2] = c.z; i0[q * 4 + 3] = c.w;
      i1[q * 4] = d.x; i1[q * 4 + 1] = d.y; i1[q * 4 + 2] = d.z; i1[q * 4 + 3] = d.w;
    }
    Top16 tp;
    top_init(tp);
#pragma unroll
    for (int a = 0; a < 16; ++a)
#pragma unroll
      for (int b = 0; b < 16; ++b)
        if ((a + 1) * (b + 1) <= 16) top_insert(tp, v0[a] + v1[b], i0[a] * 128 + i1[b]);
    float sum = 0.f, e[16];
#pragma unroll
    for (int k = 0; k < 16; ++k) { e[k] = __expf(tp.v[k] - tp.v[0]); sum += e[k]; }
    const float inv = 1.f / sum;
#pragma unroll
    for (int q = 0; q < 4; ++q) {
      *(int4*)(EX + (size_t)i * 16 + q * 4) = int4{tp.i[q * 4], tp.i[q * 4 + 1], tp.i[q * 4 + 2], tp.i[q * 4 + 3]};
      *(float4*)(GT + (size_t)i * 16 + q * 4) = float4{e[q * 4] * inv, e[q * 4 + 1] * inv, e[q * 4 + 2] * inv, e[q * 4 + 3] * inv};
    }
  }
}

__device__ __forceinline__ void unpack8(uint4 u, float* f) {
  f[0] = lo2f(u.x); f[1] = hi2f(u.x); f[2] = lo2f(u.y); f[3] = hi2f(u.y);
  f[4] = lo2f(u.z); f[5] = hi2f(u.z); f[6] = lo2f(u.w); f[7] = hi2f(u.w);
}
__device__ void phase11(const Params& P, int bid, int nb) {
  const u16* H = (const u16*)(P.ws + O_H);
  const u16* UB = (const u16*)(P.ws + O_UB);
  const u16* VB = (const u16*)(P.ws + O_VB);
  const u16* SG = (const u16*)(P.ws + O_SG);
  const u16* E = (const u16*)(P.ws + O_E);
  const int* EX = (const int*)(P.ws + O_EXP);
  const float* GT = (const float*)(P.ws + O_GATE);
  const int lane = threadIdx.x & 63;
  for (int tok = bid * 4 + (threadIdx.x >> 6); tok < T_; tok += nb * 4) {
    float hf[32], y[32];
#pragma unroll
    for (int q = 0; q < 4; ++q) {
      uint4 u = *(const uint4*)(H + (size_t)tok * D_ + q * 512 + lane * 8);
      unpack8(u, hf + q * 8);
    }
#pragma unroll
    for (int k = 0; k < 32; ++k) y[k] = 0.f;
    const int ev0 = EX[(size_t)tok * 128 + lane], ev1 = EX[(size_t)tok * 128 + 64 + lane];
    const float gv0 = GT[(size_t)tok * 128 + lane], gv1 = GT[(size_t)tok * 128 + 64 + lane];
    for (int k2 = 0; k2 < 128; k2 += 2) {
      const int src = k2 & 63;
      const int ea = __shfl((k2 < 64) ? ev0 : ev1, src);
      const int eb = __shfl((k2 < 64) ? ev0 : ev1, src + 1);
      const float ga = __shfl((k2 < 64) ? gv0 : gv1, src);
      const float gb = __shfl((k2 < 64) ? gv0 : gv1, src + 1);
      uint4 ua[4], ub[4], va[4], vb[4];
#pragma unroll
      for (int q = 0; q < 4; ++q) {
        ua[q] = *(const uint4*)(UB + (size_t)ea * D_ + q * 512 + lane * 8);
        ub[q] = *(const uint4*)(UB + (size_t)eb * D_ + q * 512 + lane * 8);
        va[q] = *(const uint4*)(VB + (size_t)ea * D_ + q * 512 + lane * 8);
        vb[q] = *(const uint4*)(VB + (size_t)eb * D_ + q * 512 + lane * 8);
      }
      float da = 0.f, db = 0.f;
#pragma unroll
      for (int q = 0; q < 4; ++q) {
        float f[8];
        unpack8(ua[q], f);
#pragma unroll
        for (int j = 0; j < 8; ++j) da = fmaf(f[j], hf[q * 8 + j], da);
        unpack8(ub[q], f);
#pragma unroll
        for (int j = 0; j < 8; ++j) db = fmaf(f[j], hf[q * 8 + j], db);
      }
      da = wave_sum(da);
      db = wave_sum(db);
      const float wa = ga * gelu_tanh(da), wb = gb * gelu_tanh(db);
#pragma unroll
      for (int q = 0; q < 4; ++q) {
        float f[8];
        unpack8(va[q], f);
#pragma unroll
        for (int j = 0; j < 8; ++j) y[q * 8 + j] = fmaf(wa, f[j], y[q * 8 + j]);
        unpack8(vb[q], f);
#pragma unroll
        for (int j = 0; j < 8; ++j) y[q * 8 + j] = fmaf(wb, f[j], y[q * 8 + j]);
      }
    }
    float ef[32];
    float ss = 0.f;
#pragma unroll
    for (int q = 0; q < 4; ++q) {
      uint4 u = *(const uint4*)(E + (size_t)tok * D_ + q * 512 + lane * 8);
      unpack8(u, ef + q * 8);
    }
#pragma unroll
    for (int k = 0; k < 32; ++k) ss += ef[k] * ef[k];
    const float rr = rsqrtf(wave_sum(ss) * (1.f / D_) + 1e-5f);
    float s1 = 0.f;
#pragma unroll
    for (int q = 0; q < 4; ++q) {
      uint4 u = *(const uint4*)(SG + (size_t)tok * D_ + q * 512 + lane * 8);
      float sg[8];
      unpack8(u, sg);
      float4 g0 = *(const float4*)(P.ple_g + q * 512 + lane * 8), g1 = *(const float4*)(P.ple_g + q * 512 + lane * 8 + 4);
      const float gg[8] = {g0.x, g0.y, g0.z, g0.w, g1.x, g1.y, g1.z, g1.w};
#pragma unroll
      for (int j = 0; j < 8; ++j) {
        float v = ALPHA * hf[q * 8 + j] + y[q * 8 + j] + ef[q * 8 + j] * rr * gg[j] * sg[j];
        y[q * 8 + j] = v;
        s1 += v;
      }
    }
    const float mu = wave_sum(s1) * (1.f / D_);
    float s2 = 0.f;
#pragma unroll
    for (int k = 0; k < 32; ++k) { float d = y[k] - mu; s2 += d * d; }
    const float rstd = rsqrtf(wave_sum(s2) * (1.f / D_) + 1e-5f);
#pragma unroll
    for (int q = 0; q < 4; ++q) {
      const int col = q * 512 + lane * 8;
      float4 g0 = *(const float4*)(P.ln2_g + col), g1 = *(const float4*)(P.ln2_g + col + 4);
      float4 b0 = *(const float4*)(P.ln2_b + col), b1 = *(const float4*)(P.ln2_b + col + 4);
      float4 o0, o1;
      o0.x = (y[q * 8 + 0] - mu) * rstd * g0.x + b0.x; o0.y = (y[q * 8 + 1] - mu) * rstd * g0.y + b0.y;
      o0.z = (y[q * 8 + 2] - mu) * rstd * g0.z + b0.z; o0.w = (y[q * 8 + 3] - mu) * rstd * g0.w + b0.w;
      o1.x = (y[q * 8 + 4] - mu) * rstd * g1.x + b1.x; o1.y = (y[q * 8 + 5] - mu) * rstd * g1.y + b1.y;
      o1.z = (y[q * 8 + 6] - mu) * rstd * g1.z + b1.z; o1.w = (y[q * 8 + 7] - mu) * rstd * g1.w + b1.w;
      *(float4*)(P.out + (size_t)tok * D_ + col) = o0;
      *(float4*)(P.out + (size_t)tok * D_ + col + 4) = o1;
    }
  }
}

__device__ __forceinline__ void run_phase(const Params& P, int ph, int bid, int nb, u16* lds) {
  switch (ph) {
    case 0: phase0(P, bid, nb, lds); break;
    case 1: phase1(P, bid, nb, lds); break;
    case 2: phase2(P, bid, nb, lds); break;
    case 3: phase3(P, bid, nb, lds); break;
    case 4: phase4(P, bid, nb, lds); break;
    case 5: phase5(P, bid, nb, lds); break;
    case 6: phase6(P, bid, nb, lds); break;
    case 7: ln_rows((const float*)(P.ws + O_PRE1), P.ln1_g, P.ln1_b, (u16*)(P.ws + O_H), bid * 4 + (threadIdx.x >> 6), nb * 4); break;
    case 8: phase8(P, bid, nb, lds); break;
    case 9: phase9(P, bid, nb, lds); break;
    case 10: phase10(P, bid, nb); break;
    case 11: phase11(P, bid, nb); break;
  }
}
constexpr int NPHASE = 12;

#if MULTI
__global__ void __launch_bounds__(256, 2) phase_kernel(Params P, int ph) {
  __shared__ __attribute__((aligned(16))) u16 lds[36864];
  run_phase(P, ph, blockIdx.x, gridDim.x, lds);
}
#else
__global__ void __launch_bounds__(256, 2) mega_kernel(Params P) {
  __shared__ __attribute__((aligned(16))) u16 lds[36864];
  cg::grid_group grid = cg::this_grid();
  const int bid = blockIdx.x, nb = gridDim.x;
  phase0(P, bid, nb, lds); grid.sync();
  phase1(P, bid, nb, lds); grid.sync();
  phase2(P, bid, nb, lds); grid.sync();
  phase3(P, bid, nb, lds); grid.sync();
  phase4(P, bid, nb, lds); grid.sync();
  phase5(P, bid, nb, lds); grid.sync();
  phase6(P, bid, nb, lds); grid.sync();
  ln_rows((const float*)(P.ws + O_PRE1), P.ln1_g, P.ln1_b, (u16*)(P.ws + O_H), bid * 4 + (threadIdx.x >> 6), nb * 4);
  grid.sync();
  phase8(P, bid, nb, lds); grid.sync();
  phase9(P, bid, nb, lds); grid.sync();
  phase10(P, bid, nb); grid.sync();
  phase11(P, bid, nb);
}
#endif

extern "C" void kernel_launch(void* const* d_in, const int* in_sizes, int n_in, void* d_out, int out_size, void* d_ws,
                              size_t ws_size, hipStream_t stream) {
  Params p{};
  const float** pp = (const float**)&p;
  for (int i = 0; i < 29; ++i) pp[i] = (const float*)d_in[i];
  p.out = (float*)d_out;
  p.ws = (char*)d_ws;
  if (ws_size < 990 * MB) fprintf(stderr, "workspace too small: %zu\n", ws_size);
#if MULTI
  for (int ph = 0; ph < NPHASE; ++ph) phase_kernel<<<512, 256, 0, stream>>>(p, ph);
#else
  static int grid_blocks = 0;
  if (!grid_blocks) {
    int dev = 0, cus = 0, per_cu = 0;
    hipGetDevice(&dev);
    hipDeviceGetAttribute(&cus, hipDeviceAttributeMultiprocessorCount, dev);
    hipOccupancyMaxActiveBlocksPerMultiprocessor(&per_cu, mega_kernel, 256, 0);
    if (per_cu > 2) per_cu = 2;
    grid_blocks = cus * per_cu;
  }
  void* args[] = {&p};
  hipError_t e = hipLaunchCooperativeKernel((void*)mega_kernel, dim3(grid_blocks), dim3(256), args, 0, stream);
  if (e != hipSuccess) fprintf(stderr, "cooperative launch failed: %s (grid %d)\n", hipGetErrorString(e), grid_blocks);
#endif
}
```

```cpp
#include <hip/hip_runtime.h>
#include <hip/hip_bf16.h>
#include <hip/hip_cooperative_groups.h>
#include <cstdio>
namespace cg = cooperative_groups;

#ifndef MULTI
#define MULTI 0
#endif

typedef unsigned short u16;
using bf16x8 = __attribute__((ext_vector_type(8))) short;
using f32x4 = __attribute__((ext_vector_type(4))) float;

constexpr int T_ = 32768;
constexpr int S_ = 16384;
constexpr int D_ = 2048;
constexpr int SSM_L = 128;
constexpr int SSM_NC = S_ / SSM_L;
constexpr float ALPHA = 1.189207115002721f;
constexpr size_t MB = 1024ull * 1024ull;

constexpr size_t O_WIN = 0 * MB, O_WGLU = 32 * MB, O_WAU = 34 * MB, O_WSU = 38 * MB, O_WOUT = 42 * MB,
                 O_WPQ = 50 * MB, O_WPG = 58 * MB, O_WPIN = 66 * MB, O_SK = 67 * MB, O_BCAT = 67 * MB + 512 * 1024,
                 O_CCAT = 68 * MB, O_LAM = 68 * MB + 256 * 1024, O_UB = 70 * MB, O_VB = 134 * MB, O_SBUF = 198 * MB,
                 O_H = 206 * MB, O_Q = 334 * MB, O_K = 398 * MB, O_VT = 462 * MB, O_U2 = 526 * MB, O_G = 590 * MB,
                 O_YA = 846 * MB, O_YS = 910 * MB, O_PB = 974 * MB;
constexpr size_t O_YG = O_VT, O_MERGED = O_Q, O_PRE1 = O_G, O_PQ = O_Q, O_SG = O_VT, O_E = O_G,
                 O_HV = O_G + 128 * MB, O_HI = O_G + 160 * MB, O_EXP = O_G + 192 * MB, O_GATE = O_G + 208 * MB;

struct Params {
  const float *x, *p, *ln_in_g, *ln_in_b, *w_in, *rel_bias, *lam_re, *lam_im, *log_dt, *b_re, *b_im, *c_re, *c_im,
      *ssm_d, *w_glu, *w_au, *w_su, *w_out, *ln1_g, *ln1_b, *w_pq, *sub_keys, *peer_u, *peer_v, *ple_w_in, *ple_g,
      *ple_w_gate, *ln2_g, *ln2_b;
  float* out;
  char* ws;
};

__device__ __forceinline__ u16 f2bf(float f) {
  unsigned u = __float_as_uint(f);
  u += 0x7fffu + ((u >> 16) & 1u);
  return (u16)(u >> 16);
}
__device__ __forceinline__ float bf2f(u16 h) { return __uint_as_float(((unsigned)h) << 16); }
__device__ __forceinline__ unsigned pack2(float a, float b) { return (unsigned)f2bf(a) | ((unsigned)f2bf(b) << 16); }
__device__ __forceinline__ float lo2f(unsigned u) { return __uint_as_float(u << 16); }
__device__ __forceinline__ float hi2f(unsigned u) { return __uint_as_float(u & 0xffff0000u); }
__device__ __forceinline__ float sigmoidf_(float x) { return 1.f / (1.f + __expf(-x)); }
__device__ __forceinline__ float gelu_tanh(float x) {
  float u = 0.7978845608028654f * (x + 0.044715f * x * x * x);
  float t = 1.f - 2.f / (1.f + __expf(2.f * u));
  return 0.5f * x * (1.f + t);
}
__device__ __forceinline__ float wave_sum(float v) {
#pragma unroll
  for (int o = 32; o >= 1; o >>= 1) v += __shfl_xor(v, o);
  return v;
}
__device__ __forceinline__ void store_bf4(u16* dst, float a, float b, float c, float d) {
  uint2 v; v.x = pack2(a, b); v.y = pack2(c, d);
  *(uint2*)dst = v;
}

__device__ __forceinline__ void gemm_kloop(f32x4 (&acc)[4][4], const u16* __restrict__ A, int lda,
                                           const u16* __restrict__ Bt, int ldb, int K, u16* lds) {
  const int tid = threadIdx.x, lane = tid & 63, wid = tid >> 6, wm = wid >> 1, wn = wid & 1;
  const int lr = lane & 15, lq = lane >> 4;
  uint4 ra[4], rb[4];
  const int nk = K >> 6;
  const int srow = tid >> 3, skc = tid & 7;
  const u16* ga = A + (size_t)srow * lda + skc * 8;
  const u16* gb = Bt + (size_t)srow * ldb + skc * 8;
#pragma unroll
  for (int i = 0; i < 4; ++i) {
    ra[i] = *(const uint4*)(ga + (size_t)(32 * i) * lda);
    rb[i] = *(const uint4*)(gb + (size_t)(32 * i) * ldb);
  }
#pragma unroll
  for (int i = 0; i < 4; ++i) {
    *(uint4*)(lds + (srow + 32 * i) * 72 + skc * 8) = ra[i];
    *(uint4*)(lds + 128 * 72 + (srow + 32 * i) * 72 + skc * 8) = rb[i];
  }
  __syncthreads();
  for (int kt = 0; kt < nk; ++kt) {
    if (kt + 1 < nk) {
#pragma unroll
      for (int i = 0; i < 4; ++i) {
        ra[i] = *(const uint4*)(ga + (size_t)(32 * i) * lda + (kt + 1) * 64);
        rb[i] = *(const uint4*)(gb + (size_t)(32 * i) * ldb + (kt + 1) * 64);
      }
    }
    const u16* sa = lds + (kt & 1) * (2 * 128 * 72);
    const u16* sb = sa + 128 * 72;
#pragma unroll
    for (int ks = 0; ks < 2; ++ks) {
      bf16x8 af[4], bfr[4];
#pragma unroll
      for (int mi = 0; mi < 4; ++mi) af[mi] = *(const bf16x8*)(sa + (wm * 64 + mi * 16 + lr) * 72 + ks * 32 + lq * 8);
#pragma unroll
      for (int ni = 0; ni < 4; ++ni) bfr[ni] = *(const bf16x8*)(sb + (wn * 64 + ni * 16 + lr) * 72 + ks * 32 + lq * 8);
#pragma unroll
      for (int mi = 0; mi < 4; ++mi)
#pragma unroll
        for (int ni = 0; ni < 4; ++ni)
          acc[mi][ni] = __builtin_amdgcn_mfma_f32_16x16x32_bf16(bfr[ni], af[mi], acc[mi][ni], 0, 0, 0);
    }
    if (kt + 1 < nk) {
      u16* wa = lds + ((kt + 1) & 1) * (2 * 128 * 72);
#pragma unroll
      for (int i = 0; i < 4; ++i) {
        *(uint4*)(wa + (srow + 32 * i) * 72 + skc * 8) = ra[i];
        *(uint4*)(wa + 128 * 72 + (srow + 32 * i) * 72 + skc * 8) = rb[i];
      }
    }
    __syncthreads();
  }
}

#define ZERO_ACC(acc)                                   \
  _Pragma("unroll") for (int _a = 0; _a < 4; ++_a)      \
  _Pragma("unroll") for (int _b = 0; _b < 4; ++_b) acc[_a][_b] = f32x4{0.f, 0.f, 0.f, 0.f};

#define EPI_COORDS                                                             \
  const int lane = threadIdx.x & 63, wid = threadIdx.x >> 6, wm = wid >> 1, wn = wid & 1; \
  const int lr = lane & 15, lq = lane >> 4;

__device__ void tconv_tile(const float* __restrict__ W, int K, int N, u16* __restrict__ Wt, int tile, float* lds) {
  const int tid = threadIdx.x;
  const int ntn = N >> 6;
  const int kt = tile / ntn, nt = tile % ntn;
  const int c4 = (tid & 15) * 4;
#pragma unroll
  for (int i = 0; i < 4; ++i) {
    int r = (tid >> 4) + 16 * i;
    float4 v = *(const float4*)(W + (size_t)(kt * 64 + r) * N + nt * 64 + c4);
    lds[r * 65 + c4 + 0] = v.x; lds[r * 65 + c4 + 1] = v.y; lds[r * 65 + c4 + 2] = v.z; lds[r * 65 + c4 + 3] = v.w;
  }
  __syncthreads();
  const int n = tid >> 2, kseg = (tid & 3) * 16;
  unsigned o[8];
#pragma unroll
  for (int j = 0; j < 8; ++j) o[j] = pack2(lds[(kseg + 2 * j) * 65 + n], lds[(kseg + 2 * j + 1) * 65 + n]);
  u16* dst = Wt + (size_t)(nt * 64 + n) * K + kt * 64 + kseg;
  *(uint4*)dst = uint4{o[0], o[1], o[2], o[3]};
  *(uint4*)(dst + 8) = uint4{o[4], o[5], o[6], o[7]};
  __syncthreads();
}

__device__ void conv_linear(const float* __restrict__ src, u16* __restrict__ dst, size_t n8, size_t gtid, size_t nth) {
  for (size_t i = gtid; i < n8; i += nth) {
    float4 a = *(const float4*)(src + i * 8), b = *(const float4*)(src + i * 8 + 4);
    *(uint4*)(dst + i * 8) = uint4{pack2(a.x, a.y), pack2(a.z, a.w), pack2(b.x, b.y), pack2(b.z, b.w)};
  }
}

typedef float f32x2 __attribute__((ext_vector_type(2)));
constexpr size_t O_U8 = O_UB, O_V8 = O_UB + 32 * MB, O_RSU = O_VB, O_RSV = O_VB + 64 * 1024;
__device__ void conv_fp8_rows(const float* __restrict__ src, unsigned char* __restrict__ dst, float* __restrict__ rscale,
                              int gw, int nw) {
  const int lane = threadIdx.x & 63;
  for (int row = gw; row < 16384; row += nw) {
    const float* r = src + (size_t)row * D_;
    float4 v[8];
#pragma unroll
    for (int q = 0; q < 8; ++q) v[q] = *(const float4*)(r + q * 256 + lane * 4);
    float am = 0.f;
#pragma unroll
    for (int q = 0; q < 8; ++q) am = fmaxf(am, fmaxf(fmaxf(fabsf(v[q].x), fabsf(v[q].y)), fmaxf(fabsf(v[q].z), fabsf(v[q].w))));
#pragma unroll
    for (int o = 32; o >= 1; o >>= 1) am = fmaxf(am, __shfl_xor(am, o));
    const float sc = am > 0.f ? 416.f / am : 1.f;
#pragma unroll
    for (int q = 0; q < 8; ++q) {
      int w = 0;
      w = __builtin_amdgcn_cvt_pk_fp8_f32(v[q].x * sc, v[q].y * sc, w, false);
      w = __builtin_amdgcn_cvt_pk_fp8_f32(v[q].z * sc, v[q].w * sc, w, true);
      *(int*)(dst + (size_t)row * D_ + q * 256 + lane * 4) = w;
    }
    if (lane == 0) rscale[row] = am > 0.f ? am / 416.f : 1.f;
  }
}

__device__ void ln_rows(const float* __restrict__ src, const float* __restrict__ g, const float* __restrict__ b,
                        u16* __restrict__ dst, int gw, int nw) {
  const int lane = threadIdx.x & 63;
  for (int row = gw; row < T_; row += nw) {
    const float* r = src + (size_t)row * D_;
    float4 v[8];
#pragma unroll
    for (int q = 0; q < 8; ++q) v[q] = *(const float4*)(r + q * 256 + lane * 4);
    float s = 0.f;
#pragma unroll
    for (int q = 0; q < 8; ++q) s += v[q].x + v[q].y + v[q].z + v[q].w;
    float mu = wave_sum(s) * (1.f / D_);
    float ss = 0.f;
#pragma unroll
    for (int q = 0; q < 8; ++q) {
      float a = v[q].x - mu, bb = v[q].y - mu, c = v[q].z - mu, d = v[q].w - mu;
      ss += a * a + bb * bb + c * c + d * d;
    }
    float rstd = rsqrtf(wave_sum(ss) * (1.f / D_) + 1e-5f);
#pragma unroll
    for (int q = 0; q < 8; ++q) {
      int col = q * 256 + lane * 4;
      float4 gg = *(const float4*)(g + col), bb = *(const float4*)(b + col);
      store_bf4(dst + (size_t)row * D_ + col, (v[q].x - mu) * rstd * gg.x + bb.x, (v[q].y - mu) * rstd * gg.y + bb.y,
                (v[q].z - mu) * rstd * gg.z + bb.z, (v[q].w - mu) * rstd * gg.w + bb.w);
    }
  }
}

__device__ __forceinline__ void dsincos(double x, double& s, double& c) {
  double q = rint(x * 0.63661977236758134308);
  double r = x - q * 1.57079632679489661923;
  double r2 = r * r;
  double sp = r * (1.0 + r2 * (-1.0 / 6 + r2 * (1.0 / 120 + r2 * (-1.0 / 5040 + r2 * (1.0 / 362880 + r2 * (-1.0 / 39916800 + r2 * (1.0 / 6227020800.0)))))));
  double cp = 1.0 + r2 * (-0.5 + r2 * (1.0 / 24 + r2 * (-1.0 / 720 + r2 * (1.0 / 40320 + r2 * (-1.0 / 3628800 + r2 * (1.0 / 479001600.0 + r2 * (-1.0 / 87178291200.0)))))));
  int qi = ((int)q) & 3;
  if (qi == 0) { s = sp; c = cp; }
  else if (qi == 1) { s = cp; c = -sp; }
  else if (qi == 2) { s = -sp; c = -cp; }
  else { s = -cp; c = sp; }
}

__device__ void ssm_consts(const Params& P, int i) {
  const int g = i >> 6, p = i & 63;
  double lr = P.lam_re[g * 64 + p], li = P.lam_im[g * 64 + p];
  double dt = exp((double)P.log_dt[g]);
  double mag = exp(lr * dt);
  double sn, cs;
  dsincos(li * dt, sn, cs);
  double ar = mag * cs, ai = mag * sn;
  double nr = ar - 1.0, ni = ai, den = lr * lr + li * li;
  double fr = (nr * lr + ni * li) / den, fi = (ni * lr - nr * li) / den;
  u16* bcat = (u16*)(P.ws + O_BCAT);
  u16* ccat = (u16*)(P.ws + O_CCAT);
  float* lam = (float*)(P.ws + O_LAM);
  for (int h = 0; h < 16; ++h) {
    double br = P.b_re[(g * 64 + p) * 16 + h], bi = P.b_im[(g * 64 + p) * 16 + h];
    bcat[(g * 128 + p) * 32 + h] = f2bf((float)(fr * br - fi * bi));
    bcat[(g * 128 + 64 + p) * 32 + h] = f2bf((float)(fr * bi + fi * br));
    bcat[(g * 128 + p) * 32 + 16 + h] = 0;
    bcat[(g * 128 + 64 + p) * 32 + 16 + h] = 0;
    ccat[(g * 16 + h) * 128 + p] = f2bf(P.c_re[(g * 16 + h) * 64 + p]);
    ccat[(g * 16 + h) * 128 + 64 + p] = f2bf(-P.c_im[(g * 16 + h) * 64 + p]);
  }
  double pr = ar, pi = ai;
  for (int k = 0; k < 7; ++k) {
    double t = pr * pr - pi * pi;
    pi = 2.0 * pr * pi;
    pr = t;
  }
  lam[0 * 4096 + i] = (float)ar;
  lam[1 * 4096 + i] = (float)ai;
  lam[2 * 4096 + i] = (float)pr;
  lam[3 * 4096 + i] = (float)pi;
}

__device__ void phase0(const Params& P, int bid, int nb, u16* lds) {
  const size_t gtid = (size_t)bid * 256 + threadIdx.x, nth = (size_t)nb * 256;
#define TCONV(wp, KK, NN, OFF) \
  for (int t = bid; t < ((KK) >> 6) * ((NN) >> 6); t += nb) tconv_tile(wp, KK, NN, (u16*)(P.ws + OFF), t, (float*)lds);
  TCONV(P.w_in, 2048, 8192, O_WIN)
  TCONV(P.w_glu, 1024, 1024, O_WGLU)
  TCONV(P.w_au, 1024, 2048, O_WAU)
  TCONV(P.w_su, 1024, 2048, O_WSU)
  TCONV(P.w_out, 2048, 2048, O_WOUT)
  TCONV(P.w_pq, 2048, 2048, O_WPQ)
  TCONV(P.ple_w_gate, 2048, 2048, O_WPG)
  TCONV(P.ple_w_in, 256, 2048, O_WPIN)
  conv_fp8_rows(P.peer_u, (unsigned char*)(P.ws + O_U8), (float*)(P.ws + O_RSU), bid * 4 + (threadIdx.x >> 6), nb * 4);
  conv_fp8_rows(P.peer_v, (unsigned char*)(P.ws + O_V8), (float*)(P.ws + O_RSV), bid * 4 + (threadIdx.x >> 6), nb * 4);
  conv_linear(P.sub_keys, (u16*)(P.ws + O_SK), (size_t)16 * 128 * 128 / 8, gtid, nth);
  conv_linear(P.p, (u16*)(P.ws + O_PB), (size_t)T_ * 256 / 8, gtid, nth);
  for (size_t i = gtid; i < 4096; i += nth) ssm_consts(P, (int)i);
  ln_rows(P.x, P.ln_in_g, P.ln_in_b, (u16*)(P.ws + O_H), bid * 4 + (threadIdx.x >> 6), nb * 4);
}

__device__ void phase1(const Params& P, int bid, int nb, u16* lds) {
  const u16* H = (const u16*)(P.ws + O_H);
  const u16* W = (const u16*)(P.ws + O_WIN);
  u16* Q = (u16*)(P.ws + O_Q);
  u16* Kb = (u16*)(P.ws + O_K);
  u16* Vt = (u16*)(P.ws + O_VT);
  u16* U2 = (u16*)(P.ws + O_U2);
  u16* G = (u16*)(P.ws + O_G);
  EPI_COORDS
  const int ntiles = 256 * 64;
  for (int t = bid; t < ntiles; t += nb) {
    const int mt = t >> 6, nt = t & 63;
    f32x4 acc[4][4];
    ZERO_ACC(acc)
    gemm_kloop(acc, H + (size_t)mt * 128 * D_, D_, W + (size_t)nt * 128 * D_, D_, D_, lds);
    const int region = nt >> 3;
#pragma unroll
    for (int mi = 0; mi < 4; ++mi) {
      const int m = mt * 128 + wm * 64 + mi * 16 + lr;
#pragma unroll
      for (int ni = 0; ni < 4; ++ni) {
        const int n = nt * 128 + wn * 64 + ni * 16 + lq * 4;
        f32x4 a = acc[mi][ni];
        if (region == 0) {
          const float sc = 0.08838834764831845f;
          store_bf4(Q + (size_t)m * 1024 + n, a[0] * sc, a[1] * sc, a[2] * sc, a[3] * sc);
        } else if (region == 1) {
          store_bf4(Kb + (size_t)m * 1024 + (n - 1024), a[0], a[1], a[2], a[3]);
        } else if (region == 2) {
          const int b = m >> 14, tt = m & (S_ - 1);
#pragma unroll
          for (int j = 0; j < 4; ++j) Vt[((size_t)(b * 1024 + (n - 2048 + j))) * S_ + tt] = f2bf(a[j]);
        } else if (region == 3) {
          store_bf4(U2 + (size_t)m * 1024 + (n - 3072), a[0], a[1], a[2], a[3]);
        } else {
          store_bf4(G + (size_t)m * 4096 + (n - 4096), sigmoidf_(a[0]), sigmoidf_(a[1]), sigmoidf_(a[2]), sigmoidf_(a[3]));
        }
      }
    }
  }
}

__device__ void attn_item(const Params& P, int item, u16* lds) {
  const int c = item & 255, hd = (item >> 8) & 7, b = item >> 11;
  const int tid = threadIdx.x, lane = tid & 63, w = tid >> 6, lr = lane & 15, lq = lane >> 4;
  u16* Ks = lds;
  u16* Vs = lds + 64 * 136;
  float* bs = (float*)(lds + 64 * 136 + 128 * 72);
  const u16* Q = (const u16*)(P.ws + O_Q);
  const u16* Kb = (const u16*)(P.ws + O_K);
  const u16* Vt = (const u16*)(P.ws + O_VT);
  u16* ya = (u16*)(P.ws + O_YA);
  __syncthreads();
  for (int i = tid; i < 257; i += 256) bs[i] = P.rel_bias[hd * 257 + i];
  bf16x8 qf[4];
  {
    const u16* qp = Q + (size_t)(b * S_ + c * 64 + w * 16 + lr) * 1024 + hd * 128 + lq * 8;
#pragma unroll
    for (int ks = 0; ks < 4; ++ks) qf[ks] = *(const bf16x8*)(qp + ks * 32);
  }
  f32x4 oacc[8];
#pragma unroll
  for (int d = 0; d < 8; ++d) oacc[d] = f32x4{0.f, 0.f, 0.f, 0.f};
  float m_run = -1e30f, lsum = 0.f;
  const int i0 = (c < 8) ? (8 - c) : 0;
  const int qi = w * 16 + lr;
  for (int i = i0; i <= 8; ++i) {
    const int kc = c - 8 + i;
    __syncthreads();
#pragma unroll
    for (int r = 0; r < 4; ++r) {
      int ch = tid + 256 * r;
      int row = ch >> 4, kk = ch & 15;
      *(uint4*)(Ks + row * 136 + kk * 8) = *(const uint4*)(Kb + (size_t)(b * S_ + kc * 64 + row) * 1024 + hd * 128 + kk * 8);
      int row2 = ch >> 3, k2 = ch & 7;
      *(uint4*)(Vs + row2 * 72 + k2 * 8) = *(const uint4*)(Vt + ((size_t)(b * 1024 + hd * 128 + row2)) * S_ + kc * 64 + k2 * 8);
    }
    __syncthreads();
    f32x4 sacc[4];
#pragma unroll
    for (int kt = 0; kt < 4; ++kt) {
      sacc[kt] = f32x4{0.f, 0.f, 0.f, 0.f};
#pragma unroll
      for (int ks = 0; ks < 4; ++ks) {
        bf16x8 kf = *(const bf16x8*)(Ks + (kt * 16 + lr) * 136 + ks * 32 + lq * 8);
        sacc[kt] = __builtin_amdgcn_mfma_f32_16x16x32_bf16(kf, qf[ks], sacc[kt], 0, 0, 0);
      }
    }
    float tmax = -1e30f;
#pragma unroll
    for (int kt = 0; kt < 4; ++kt)
#pragma unroll
      for (int j = 0; j < 4; ++j) {
        int kb = i * 64 + kt * 16 + lq * 4 + j;
        int rel = 512 + qi - kb;
        rel = min(max(rel, -128), 128) + 128;
        float s = sacc[kt][j] + bs[rel];
        sacc[kt][j] = s;
        tmax = fmaxf(tmax, s);
      }
    tmax = fmaxf(tmax, __shfl_xor(tmax, 16));
    tmax = fmaxf(tmax, __shfl_xor(tmax, 32));
    const float m_new = fmaxf(m_run, tmax);
    const float corr = __expf(m_run - m_new);
    m_run = m_new;
    float ps = 0.f;
#pragma unroll
    for (int kt = 0; kt < 4; ++kt)
#pragma unroll
      for (int j = 0; j < 4; ++j) {
        float pv = __expf(sacc[kt][j] - m_new);
        sacc[kt][j] = pv;
        ps += pv;
      }
    lsum = lsum * corr + ps;
#pragma unroll
    for (int d = 0; d < 8; ++d) {
      oacc[d][0] *= corr; oacc[d][1] *= corr; oacc[d][2] *= corr; oacc[d][3] *= corr;
    }
#pragma unroll
    for (int kk = 0; kk < 2; ++kk) {
      union { bf16x8 v; unsigned u[4]; } pf;
      pf.u[0] = pack2(sacc[2 * kk][0], sacc[2 * kk][1]);
      pf.u[1] = pack2(sacc[2 * kk][2], sacc[2 * kk][3]);
      pf.u[2] = pack2(sacc[2 * kk + 1][0], sacc[2 * kk + 1][1]);
      pf.u[3] = pack2(sacc[2 * kk + 1][2], sacc[2 * kk + 1][3]);
#pragma unroll
      for (int d = 0; d < 8; ++d) {
        union { bf16x8 v; uint2 h[2]; } vf;
        vf.h[0] = *(const uint2*)(Vs + (d * 16 + lr) * 72 + kk * 32 + lq * 4);
        vf.h[1] = *(const uint2*)(Vs + (d * 16 + lr) * 72 + kk * 32 + 16 + lq * 4);
        oacc[d] = __builtin_amdgcn_mfma_f32_16x16x32_bf16(vf.v, pf.v, oacc[d], 0, 0, 0);
      }
    }
  }
  lsum += __shfl_xor(lsum, 16);
  lsum += __shfl_xor(lsum, 32);
  const float inv = 1.f / lsum;
  u16* op = ya + (size_t)(b * S_ + c * 64 + w * 16 + lr) * 1024 + hd * 128 + lq * 4;
#pragma unroll
  for (int d = 0; d < 8; ++d) store_bf4(op + d * 16, oacc[d][0] * inv, oacc[d][1] * inv, oacc[d][2] * inv, oacc[d][3] * inv);
}

template <int PASS>
__device__ void ssm_item(const Params& P, int item, char* ldsw) {
  const int c = item & (SSM_NC - 1), seq = item >> 7, g = seq & 63, b = seq >> 6;
  const int lane = threadIdx.x & 63, lr = lane & 15, lq = lane >> 4;
  float* BuS = (float*)ldsw;
  u16* Hs = (u16*)(ldsw + 8192);
  const u16* bcat = (const u16*)(P.ws + O_BCAT);
  const u16* ccat = (const u16*)(P.ws + O_CCAT);
  const float* lam = (const float*)(P.ws + O_LAM);
  const u16* U2 = (const u16*)(P.ws + O_U2);
  float* Sbuf = (float*)(P.ws + O_SBUF);
  u16* ys = (u16*)(P.ws + O_YS);
  const float ar = lam[g * 64 + lane], ai = lam[4096 + g * 64 + lane];
  bf16x8 bfrag[8];
#pragma unroll
  for (int nt = 0; nt < 8; ++nt) bfrag[nt] = *(const bf16x8*)(bcat + (g * 128 + nt * 16 + lr) * 32 + lq * 8);
  float sr = 0.f, si = 0.f;
  bf16x8 cfrag[4];
  float dsk[4];
  if (PASS == 2) {
#pragma unroll
    for (int ks = 0; ks < 4; ++ks) cfrag[ks] = *(const bf16x8*)(ccat + (g * 16 + lr) * 128 + ks * 32 + lq * 8);
#pragma unroll
    for (int j = 0; j < 4; ++j) dsk[j] = P.ssm_d[g * 16 + lq * 4 + j];
    const float aLr = lam[2 * 4096 + g * 64 + lane], aLi = lam[3 * 4096 + g * 64 + lane];
    const float* Sb = Sbuf + (size_t)seq * SSM_NC * 128;
#pragma unroll 4
    for (int cc = 0; cc < c; ++cc) {
      float xr = Sb[cc * 128 + lane], xi = Sb[cc * 128 + 64 + lane];
      float nr = fmaf(aLr, sr, fmaf(-aLi, si, xr));
      float ni = fmaf(aLr, si, fmaf(aLi, sr, xi));
      sr = nr; si = ni;
    }
  }
  const size_t tok_base = (size_t)b * S_ + (size_t)c * SSM_L;
  for (int sub = 0; sub < SSM_L / 16; ++sub) {
    const size_t tok0 = tok_base + sub * 16;
    union { bf16x8 v; uint4 u; } uf;
    uf.u = uint4{0u, 0u, 0u, 0u};
    if (lq < 2) uf.u = *(const uint4*)(U2 + (tok0 + lr) * 1024 + g * 16 + lq * 8);
#pragma unroll
    for (int nt = 0; nt < 8; ++nt) {
      f32x4 d = __builtin_amdgcn_mfma_f32_16x16x32_bf16(bfrag[nt], uf.v, f32x4{0.f, 0.f, 0.f, 0.f}, 0, 0, 0);
      *(f32x4*)(BuS + lr * 128 + nt * 16 + lq * 4) = d;
    }
    asm volatile("s_waitcnt lgkmcnt(0)" ::: "memory");
#pragma unroll
    for (int t = 0; t < 16; ++t) {
      float bur = BuS[t * 128 + lane], bui = BuS[t * 128 + 64 + lane];
      float nr = fmaf(ar, sr, fmaf(-ai, si, bur));
      float ni = fmaf(ar, si, fmaf(ai, sr, bui));
      sr = nr; si = ni;
      if (PASS == 2) {
        Hs[t * 136 + lane] = f2bf(sr);
        Hs[t * 136 + 64 + lane] = f2bf(si);
      }
    }
    asm volatile("s_waitcnt lgkmcnt(0)" ::: "memory");
    if (PASS == 2) {
      f32x4 yacc = f32x4{0.f, 0.f, 0.f, 0.f};
#pragma unroll
      for (int ks = 0; ks < 4; ++ks) {
        bf16x8 hf = *(const bf16x8*)(Hs + lr * 136 + ks * 32 + lq * 8);
        yacc = __builtin_amdgcn_mfma_f32_16x16x32_bf16(cfrag[ks], hf, yacc, 0, 0, 0);
      }
      uint2 uu = *(const uint2*)(U2 + (tok0 + lr) * 1024 + g * 16 + lq * 4);
      float y0 = gelu_tanh(yacc[0] + dsk[0] * lo2f(uu.x));
      float y1 = gelu_tanh(yacc[1] + dsk[1] * hi2f(uu.x));
      float y2 = gelu_tanh(yacc[2] + dsk[2] * lo2f(uu.y));
      float y3 = gelu_tanh(yacc[3] + dsk[3] * hi2f(uu.y));
      store_bf4(ys + (tok0 + lr) * 1024 + g * 16 + lq * 4, y0, y1, y2, y3);
      asm volatile("s_waitcnt lgkmcnt(0)" ::: "memory");
    }
  }
  if (PASS == 1) {
    Sbuf[((size_t)seq * SSM_NC + c) * 128 + lane] = sr;
    Sbuf[((size_t)seq * SSM_NC + c) * 128 + 64 + lane] = si;
  }
}

__device__ void phase2(const Params& P, int bid, int nb, u16* lds) {
  for (int it = bid; it < 8192; it += nb) {
    if (it < 4096) {
      attn_item(P, it, lds);
    } else {
      __syncthreads();
      const int w = threadIdx.x >> 6;
      ssm_item<1>(P, (it - 4096) * 4 + w, (char*)lds + w * 12544);
    }
  }
}
__device__ void phase3(const Params& P, int bid, int nb, u16* lds) {
  const int w = threadIdx.x >> 6;
  for (int it = bid; it < 4096; it += nb) ssm_item<2>(P, it * 4 + w, (char*)lds + w * 12544);
}

__device__ void phase4(const Params& P, int bid, int nb, u16* lds) {
  const u16* ys = (const u16*)(P.ws + O_YS);
  const u16* W = (const u16*)(P.ws + O_WGLU);
  u16* yg = (u16*)(P.ws + O_YG);
  EPI_COORDS
  for (int t = bid; t < 256 * 8; t += nb) {
    const int mt = t >> 3, nt = t & 7;
    f32x4 acc[4][4];
    ZERO_ACC(acc)
    gemm_kloop(acc, ys + (size_t)mt * 128 * 1024, 1024, W + (size_t)nt * 128 * 1024, 1024, 1024, lds);
#pragma unroll
    for (int mi = 0; mi < 4; ++mi) {
      const int m = mt * 128 + wm * 64 + mi * 16 + lr;
#pragma unroll
      for (int ni = 0; ni < 4; ++ni) {
        const int n = nt * 128 + wn * 64 + ni * 16 + lq * 4;
        uint2 yy = *(const uint2*)(ys + (size_t)m * 1024 + n);
        f32x4 a = acc[mi][ni];
        store_bf4(yg + (size_t)m * 1024 + n, lo2f(yy.x) * sigmoidf_(a[0]), hi2f(yy.x) * sigmoidf_(a[1]),
                  lo2f(yy.y) * sigmoidf_(a[2]), hi2f(yy.y) * sigmoidf_(a[3]));
      }
    }
  }
}

__device__ void phase5(const Params& P, int bid, int nb, u16* lds) {
  const u16* ya = (const u16*)(P.ws + O_YA);
  const u16* yg = (const u16*)(P.ws + O_YG);
  const u16* Wa = (const u16*)(P.ws + O_WAU);
  const u16* Wsu = (const u16*)(P.ws + O_WSU);
  const u16* G = (const u16*)(P.ws + O_G);
  u16* mg = (u16*)(P.ws + O_MERGED);
  EPI_COORDS
  for (int t = bid; t < 256 * 16; t += nb) {
    const int mt = t >> 4, nt = t & 15;
    f32x4 acc[4][4];
    ZERO_ACC(acc)
    gemm_kloop(acc, ya + (size_t)mt * 128 * 1024, 1024, Wa + (size_t)nt * 128 * 1024, 1024, 1024, lds);
#pragma unroll
    for (int mi = 0; mi < 4; ++mi) {
      const int m = mt * 128 + wm * 64 + mi * 16 + lr;
#pragma unroll
      for (int ni = 0; ni < 4; ++ni) {
        const int n = nt * 128 + wn * 64 + ni * 16 + lq * 4;
        uint2 ga = *(const uint2*)(G + (size_t)m * 4096 + n);
        uint2 gs = *(const uint2*)(G + (size_t)m * 4096 + 2048 + n);
        acc[mi][ni][0] *= lo2f(ga.x) / fmaxf(lo2f(gs.x), 1e-30f);
        acc[mi][ni][1] *= hi2f(ga.x) / fmaxf(hi2f(gs.x), 1e-30f);
        acc[mi][ni][2] *= lo2f(ga.y) / fmaxf(lo2f(gs.y), 1e-30f);
        acc[mi][ni][3] *= hi2f(ga.y) / fmaxf(hi2f(gs.y), 1e-30f);
      }
    }
    gemm_kloop(acc, yg + (size_t)mt * 128 * 1024, 1024, Wsu + (size_t)nt * 128 * 1024, 1024, 1024, lds);
#pragma unroll
    for (int mi = 0; mi < 4; ++mi) {
      const int m = mt * 128 + wm * 64 + mi * 16 + lr;
#pragma unroll
      for (int ni = 0; ni < 4; ++ni) {
        const int n = nt * 128 + wn * 64 + ni * 16 + lq * 4;
        uint2 gs = *(const uint2*)(G + (size_t)m * 4096 + 2048 + n);
        f32x4 a = acc[mi][ni];
        store_bf4(mg + (size_t)m * D_ + n, a[0] * fmaxf(lo2f(gs.x), 1e-30f), a[1] * fmaxf(hi2f(gs.x), 1e-30f),
                  a[2] * fmaxf(lo2f(gs.y), 1e-30f), a[3] * fmaxf(hi2f(gs.y), 1e-30f));
      }
    }
  }
}

__device__ void phase6(const Params& P, int bid, int nb, u16* lds) {
  const u16* mg = (const u16*)(P.ws + O_MERGED);
  const u16* W = (const u16*)(P.ws + O_WOUT);
  const u16* H = (const u16*)(P.ws + O_H);
  float* pre1 = (float*)(P.ws + O_PRE1);
  EPI_COORDS
  for (int t = bid; t < 256 * 16; t += nb) {
    const int mt = t >> 4, nt = t & 15;
    f32x4 acc[4][4];
    ZERO_ACC(acc)
    gemm_kloop(acc, mg + (size_t)mt * 128 * D_, D_, W + (size_t)nt * 128 * D_, D_, D_, lds);
#pragma unroll
    for (int mi = 0; mi < 4; ++mi) {
      const int m = mt * 128 + wm * 64 + mi * 16 + lr;
#pragma unroll
      for (int ni = 0; ni < 4; ++ni) {
        const int n = nt * 128 + wn * 64 + ni * 16 + lq * 4;
        uint2 hh = *(const uint2*)(H + (size_t)m * D_ + n);
        f32x4 a = acc[mi][ni];
        float4 o;
        o.x = ALPHA * lo2f(hh.x) + a[0]; o.y = ALPHA * hi2f(hh.x) + a[1];
        o.z = ALPHA * lo2f(hh.y) + a[2]; o.w = ALPHA * hi2f(hh.y) + a[3];
        *(float4*)(pre1 + (size_t)m * D_ + n) = o;
      }
    }
  }
}

__device__ void phase8(const Params& P, int bid, int nb, u16* lds) {
  const u16* H = (const u16*)(P.ws + O_H);
  const u16* Pb = (const u16*)(P.ws + O_PB);
  u16* PQ = (u16*)(P.ws + O_PQ);
  u16* SG = (u16*)(P.ws + O_SG);
  u16* E = (u16*)(P.ws + O_E);
  EPI_COORDS
  for (int t = bid; t < 3 * 4096; t += nb) {
    const int which = t >> 12, tt = t & 4095, mt = tt >> 4, nt = tt & 15;
    f32x4 acc[4][4];
    ZERO_ACC(acc)
    u16* dst;
    if (which == 0) {
      gemm_kloop(acc, H + (size_t)mt * 128 * D_, D_, (const u16*)(P.ws + O_WPQ) + (size_t)nt * 128 * D_, D_, D_, lds);
      dst = PQ;
    } else if (which == 1) {
      gemm_kloop(acc, H + (size_t)mt * 128 * D_, D_, (const u16*)(P.ws + O_WPG) + (size_t)nt * 128 * D_, D_, D_, lds);
      dst = SG;
    } else {
      gemm_kloop(acc, Pb + (size_t)mt * 128 * 256, 256, (const u16*)(P.ws + O_WPIN) + (size_t)nt * 128 * 256, 256, 256, lds);
      dst = E;
    }
#pragma unroll
    for (int mi = 0; mi < 4; ++mi) {
      const int m = mt * 128 + wm * 64 + mi * 16 + lr;
#pragma unroll
      for (int ni = 0; ni < 4; ++ni) {
        const int n = nt * 128 + wn * 64 + ni * 16 + lq * 4;
        f32x4 a = acc[mi][ni];
        if (which == 1) { a[0] = sigmoidf_(a[0]); a[1] = sigmoidf_(a[1]); a[2] = sigmoidf_(a[2]); a[3] = sigmoidf_(a[3]); }
        store_bf4(dst + (size_t)m * D_ + n, a[0], a[1], a[2], a[3]);
      }
    }
  }
}

struct Top16 { float v[16]; int i[16]; };
__device__ __forceinline__ void top_init(Top16& t) {
#pragma unroll
  for (int k = 0; k < 16; ++k) { t.v[k] = -INFINITY; t.i[k] = 0; }
}
__device__ __forceinline__ void top_insert(Top16& t, float x, int id) {
  const bool c = x > t.v[15];
  t.v[15] = c ? x : t.v[15];
  t.i[15] = c ? id : t.i[15];
#pragma unroll
  for (int k = 15; k >= 1; --k) {
    const bool s = t.v[k] > t.v[k - 1];
    const float a = t.v[k - 1], b = t.v[k];
    const int ia = t.i[k - 1], ib = t.i[k];
    t.v[k - 1] = s ? b : a; t.v[k] = s ? a : b;
    t.i[k - 1] = s ? ib : ia; t.i[k] = s ? ia : ib;
  }
}

__device__ void phase9(const Params& P, int bid, int nb, u16* lds) {
  const u16* PQ = (const u16*)(P.ws + O_PQ);
  const u16* SK = (const u16*)(P.ws + O_SK);
  float* HV = (float*)(P.ws + O_HV);
  int* HI = (int*)(P.ws + O_HI);
  float* Sc = (float*)lds;
  EPI_COORDS
  const int tid = threadIdx.x;
  for (int t = bid; t < 256 * 16; t += nb) {
    const int mt = t >> 4, rc = t & 15;
    f32x4 acc[4][4];
    ZERO_ACC(acc)
    gemm_kloop(acc, PQ + (size_t)mt * 128 * D_ + rc * 128, D_, SK + (size_t)rc * 128 * 128, 128, 128, lds);
#pragma unroll
    for (int mi = 0; mi < 4; ++mi) {
      const int m = wm * 64 + mi * 16 + lr;
#pragma unroll
      for (int ni = 0; ni < 4; ++ni) {
        const int n = wn * 64 + ni * 16 + lq * 4;
#pragma unroll
        for (int j = 0; j < 4; ++j) Sc[m * 129 + n + j] = acc[mi][ni][j];
      }
    }
    __syncthreads();
    const int tok = tid & 127, hh = tid >> 7;
    Top16 tp;
    top_init(tp);
    for (int k = 0; k < 64; ++k) top_insert(tp, Sc[tok * 129 + hh * 64 + k], hh * 64 + k);
    __syncthreads();
    float* Lv = (float*)lds;
    int* Li = (int*)lds + 256 * 17;
#pragma unroll
    for (int k = 0; k < 16; ++k) { Lv[tid * 17 + k] = tp.v[k]; Li[tid * 17 + k] = tp.i[k]; }
    __syncthreads();
    if (tid < 128) {
      int ia = 0, ib = 0;
      const float* va = Lv + tid * 17; const float* vb = Lv + (tid + 128) * 17;
      const int* xa = Li + tid * 17; const int* xb = Li + (tid + 128) * 17;
      float* ov = HV + ((size_t)(mt * 128 + tid) * 16 + rc) * 16;
      int* oi = HI + ((size_t)(mt * 128 + tid) * 16 + rc) * 16;
      for (int k = 0; k < 16; ++k) {
        float a = va[ia], b = vb[ib];
        bool ta = a >= b;
        ov[k] = ta ? a : b;
        oi[k] = ta ? xa[ia] : xb[ib];
        ia += ta ? 1 : 0; ib += ta ? 0 : 1;
      }
    }
    __syncthreads();
  }
}

__device__ void phase10(const Params& P, int bid, int nb) {
  const float* HV = (const float*)(P.ws + O_HV);
  const int* HI = (const int*)(P.ws + O_HI);
  int* EX = (int*)(P.ws + O_EXP);
  float* GT = (float*)(P.ws + O_GATE);
  for (int i = bid * 256 + threadIdx.x; i < T_ * 8; i += nb * 256) {
    float v0[16], v1[16];
    int i0[16], i1[16];
#pragma unroll
    for (int q = 0; q < 4; ++q) {
      float4 a = *(const float4*)(HV + (size_t)i * 32 + q * 4);
      float4 b = *(const float4*)(HV + (size_t)i * 32 + 16 + q * 4);
      int4 c = *(const int4*)(HI + (size_t)i * 32 + q * 4);
      int4 d = *(const int4*)(HI + (size_t)i * 32 + 16 + q * 4);
      v0[q * 4] = a.x; v0[q * 4 + 1] = a.y; v0[q * 4 + 2] = a.z; v0[q * 4 + 3] = a.w;
      v1[q * 4] = b.x; v1[q * 4 + 1] = b.y; v1[q * 4 + 2] = b.z; v1[q * 4 + 3] = b.w;
      i0[q * 4] = c.x; i0[q * 4 + 1] = c.y; i0[q * 4 + 2] = c.z; i0[q * 4 + 3] = c.w;
      i1[q * 4] = d.x; i1[q * 4 + 1] = d.y; i1[q * 4 + 2] = d.z; i1[q * 4 + 3] = d.w;
    }
    Top16 tp;
    top_init(tp);
#pragma unroll
    for (int a = 0; a < 16; ++a)
#pragma unroll
      for (int b = 0; b < 16; ++b)
        if ((a + 1) * (b + 1) <= 16) top_insert(tp, v0[a] + v1[b], i0[a] * 128 + i1[b]);
    float sum = 0.f, e[16];
#pragma unroll
    for (int k = 0; k < 16; ++k) { e[k] = __expf(tp.v[k] - tp.v[0]); sum += e[k]; }
    const float inv = 1.f / sum;
#pragma unroll
    for (int q = 0; q < 4; ++q) {
      *(int4*)(EX + (size_t)i * 16 + q * 4) = int4{tp.i[q * 4], tp.i[q * 4 + 1], tp.i[q * 4 + 2], tp.i[q * 4 + 3]};
      *(float4*)(GT + (size_t)i * 16 + q * 4) = float4{e[q * 4] * inv, e[q * 4 + 1] * inv, e[q * 4 + 2] * inv, e[q * 4 + 3] * inv};
    }
  }
}

__device__ __forceinline__ void unpack8(uint4 u, float* f) {
  f[0] = lo2f(u.x); f[1] = hi2f(u.x); f[2] = lo2f(u.y); f[3] = hi2f(u.y);
  f[4] = lo2f(u.z); f[5] = hi2f(u.z); f[6] = lo2f(u.w); f[7] = hi2f(u.w);
}
__device__ __forceinline__ void dec16(uint4 u, float* f) {
  f32x2 a;
  a = __builtin_amdgcn_cvt_pk_f32_fp8((int)u.x, false); f[0] = a.x; f[1] = a.y;
  a = __builtin_amdgcn_cvt_pk_f32_fp8((int)u.x, true);  f[2] = a.x; f[3] = a.y;
  a = __builtin_amdgcn_cvt_pk_f32_fp8((int)u.y, false); f[4] = a.x; f[5] = a.y;
  a = __builtin_amdgcn_cvt_pk_f32_fp8((int)u.y, true);  f[6] = a.x; f[7] = a.y;
  a = __builtin_amdgcn_cvt_pk_f32_fp8((int)u.z, false); f[8] = a.x; f[9] = a.y;
  a = __builtin_amdgcn_cvt_pk_f32_fp8((int)u.z, true);  f[10] = a.x; f[11] = a.y;
  a = __builtin_amdgcn_cvt_pk_f32_fp8((int)u.w, false); f[12] = a.x; f[13] = a.y;
  a = __builtin_amdgcn_cvt_pk_f32_fp8((int)u.w, true);  f[14] = a.x; f[15] = a.y;
}
__device__ __forceinline__ void load_row_bf16(const u16* row, int lane, float* f) {
#pragma unroll
  for (int q = 0; q < 2; ++q) {
    uint4 a = *(const uint4*)(row + q * 1024 + lane * 16);
    uint4 b = *(const uint4*)(row + q * 1024 + lane * 16 + 8);
    unpack8(a, f + q * 16);
    unpack8(b, f + q * 16 + 8);
  }
}
__device__ void phase11(const Params& P, int bid, int nb) {
  const u16* H = (const u16*)(P.ws + O_H);
  const unsigned char* U8 = (const unsigned char*)(P.ws + O_U8);
  const unsigned char* V8 = (const unsigned char*)(P.ws + O_V8);
  const float* RSU = (const float*)(P.ws + O_RSU);
  const float* RSV = (const float*)(P.ws + O_RSV);
  const u16* SG = (const u16*)(P.ws + O_SG);
  const u16* E = (const u16*)(P.ws + O_E);
  const int* EX = (const int*)(P.ws + O_EXP);
  const float* GT = (const float*)(P.ws + O_GATE);
  const int lane = threadIdx.x & 63;
  for (int tok = bid * 4 + (threadIdx.x >> 6); tok < T_; tok += nb * 4) {
    float hf[32], y[32];
    load_row_bf16(H + (size_t)tok * D_, lane, hf);
#pragma unroll
    for (int k = 0; k < 32; ++k) y[k] = 0.f;
    const int ev0 = EX[(size_t)tok * 128 + lane], ev1 = EX[(size_t)tok * 128 + 64 + lane];
    const float gv0 = GT[(size_t)tok * 128 + lane], gv1 = GT[(size_t)tok * 128 + 64 + lane];
    const float ru0 = RSU[ev0], ru1 = RSU[ev1], rv0 = RSV[ev0], rv1 = RSV[ev1];
    for (int k4 = 0; k4 < 128; k4 += 4) {
      const int src = k4 & 63;
      const bool lo = k4 < 64;
      int ee[4]; float gg[4], su[4], sv[4];
#pragma unroll
      for (int x = 0; x < 4; ++x) {
        ee[x] = __shfl(lo ? ev0 : ev1, src + x);
        gg[x] = __shfl(lo ? gv0 : gv1, src + x);
        su[x] = __shfl(lo ? ru0 : ru1, src + x);
        sv[x] = __shfl(lo ? rv0 : rv1, src + x);
      }
      uint4 uu[4][2], vv[4][2];
#pragma unroll
      for (int x = 0; x < 4; ++x)
#pragma unroll
        for (int q = 0; q < 2; ++q) {
          uu[x][q] = *(const uint4*)(U8 + (size_t)ee[x] * D_ + q * 1024 + lane * 16);
          vv[x][q] = *(const uint4*)(V8 + (size_t)ee[x] * D_ + q * 1024 + lane * 16);
        }
      float dd[4];
#pragma unroll
      for (int x = 0; x < 4; ++x) {
        float d = 0.f;
#pragma unroll
        for (int q = 0; q < 2; ++q) {
          float f[16];
          dec16(uu[x][q], f);
#pragma unroll
          for (int j = 0; j < 16; ++j) d = fmaf(f[j], hf[q * 16 + j], d);
        }
        dd[x] = d;
      }
#pragma unroll
      for (int o = 32; o >= 1; o >>= 1) {
#pragma unroll
        for (int x = 0; x < 4; ++x) dd[x] += __shfl_xor(dd[x], o);
      }
#pragma unroll
      for (int x = 0; x < 4; ++x) {
        const float w = gg[x] * gelu_tanh(dd[x] * su[x]) * sv[x];
#pragma unroll
        for (int q = 0; q < 2; ++q) {
          float f[16];
          dec16(vv[x][q], f);
#pragma unroll
          for (int j = 0; j < 16; ++j) y[q * 16 + j] = fmaf(w, f[j], y[q * 16 + j]);
        }
      }
    }
    float ef[32], sg[32];
    load_row_bf16(E + (size_t)tok * D_, lane, ef);
    load_row_bf16(SG + (size_t)tok * D_, lane, sg);
    float ss = 0.f;
#pragma unroll
    for (int k = 0; k < 32; ++k) ss += ef[k] * ef[k];
    const float rr = rsqrtf(wave_sum(ss) * (1.f / D_) + 1e-5f);
    float s1 = 0.f;
#pragma unroll
    for (int q = 0; q < 2; ++q)
#pragma unroll
      for (int j4 = 0; j4 < 4; ++j4) {
        float4 g = *(const float4*)(P.ple_g + q * 1024 + lane * 16 + j4 * 4);
        const float gq[4] = {g.x, g.y, g.z, g.w};
#pragma unroll
        for (int j = 0; j < 4; ++j) {
          const int k = q * 16 + j4 * 4 + j;
          float v = ALPHA * hf[k] + y[k] + ef[k] * rr * gq[j] * sg[k];
          y[k] = v;
          s1 += v;
        }
      }
    const float mu = wave_sum(s1) * (1.f / D_);
    float s2 = 0.f;
#pragma unroll
    for (int k = 0; k < 32; ++k) { float d = y[k] - mu; s2 += d * d; }
    const float rstd = rsqrtf(wave_sum(s2) * (1.f / D_) + 1e-5f);
#pragma unroll
    for (int q = 0; q < 2; ++q)
#pragma unroll
      for (int j4 = 0; j4 < 4; ++j4) {
        const int col = q * 1024 + lane * 16 + j4 * 4;
        const int k = q * 16 + j4 * 4;
        float4 g = *(const float4*)(P.ln2_g + col), b = *(const float4*)(P.ln2_b + col);
        float4 o;
        o.x = (y[k + 0] - mu) * rstd * g.x + b.x; o.y = (y[k + 1] - mu) * rstd * g.y + b.y;
        o.z = (y[k + 2] - mu) * rstd * g.z + b.z; o.w = (y[k + 3] - mu) * rstd * g.w + b.w;
        *(float4*)(P.out + (size_t)tok * D_ + col) = o;
      }
  }
}

__device__ __forceinline__ void run_phase(const Params& P, int ph, int bid, int nb, u16* lds) {
  switch (ph) {
    case 0: phase0(P, bid, nb, lds); break;
    case 1: phase1(P, bid, nb, lds); break;
    case 2: phase2(P, bid, nb, lds); break;
    case 3: phase3(P, bid, nb, lds); break;
    case 4: phase4(P, bid, nb, lds); break;
    case 5: phase5(P, bid, nb, lds); break;
    case 6: phase6(P, bid, nb, lds); break;
    case 7: ln_rows((const float*)(P.ws + O_PRE1), P.ln1_g, P.ln1_b, (u16*)(P.ws + O_H), bid * 4 + (threadIdx.x >> 6), nb * 4); break;
    case 8: phase8(P, bid, nb, lds); break;
    case 9: phase9(P, bid, nb, lds); break;
    case 10: phase10(P, bid, nb); break;
    case 11: phase11(P, bid, nb); break;
  }
}
constexpr int NPHASE = 12;

#if MULTI
__global__ void __launch_bounds__(256, 2) phase_kernel(Params P, int ph) {
  __shared__ __attribute__((aligned(16))) u16 lds[36864];
  run_phase(P, ph, blockIdx.x, gridDim.x, lds);
}
#else
__global__ void __launch_bounds__(256, 2) mega_kernel(Params P) {
  __shared__ __attribute__((aligned(16))) u16 lds[36864];
  cg::grid_group grid = cg::this_grid();
  const int bid = blockIdx.x, nb = gridDim.x;
  phase0(P, bid, nb, lds); grid.sync();
  phase1(P, bid, nb, lds); grid.sync();
  phase2(P, bid, nb, lds); grid.sync();
  phase3(P, bid, nb, lds); grid.sync();
  phase4(P, bid, nb, lds); grid.sync();
  phase5(P, bid, nb, lds); grid.sync();
  phase6(P, bid, nb, lds); grid.sync();
  ln_rows((const float*)(P.ws + O_PRE1), P.ln1_g, P.ln1_b, (u16*)(P.ws + O_H), bid * 4 + (threadIdx.x >> 6), nb * 4);
  grid.sync();
  phase8(P, bid, nb, lds); grid.sync();
  phase9(P, bid, nb, lds); grid.sync();
  phase10(P, bid, nb); grid.sync();
  phase11(P, bid, nb);
}
#endif

extern "C" void kernel_launch(void* const* d_in, const int* in_sizes, int n_in, void* d_out, int out_size, void* d_ws,
                              size_t ws_size, hipStream_t stream) {
  Params p{};
  const float** pp = (const float**)&p;
  for (int i = 0; i < 29; ++i) pp[i] = (const float*)d_in[i];
  p.out = (float*)d_out;
  p.ws = (char*)d_ws;
  if (ws_size < 990 * MB) fprintf(stderr, "workspace too small: %zu\n", ws_size);
#if MULTI
  for (int ph = 0; ph < NPHASE; ++ph) phase_kernel<<<512, 256, 0, stream>>>(p, ph);
#else
  static int grid_blocks = 0;
  if (!grid_blocks) {
    int dev = 0, cus = 0, per_cu = 0;
    hipGetDevice(&dev);
    hipDeviceGetAttribute(&cus, hipDeviceAttributeMultiprocessorCount, dev);
    hipOccupancyMaxActiveBlocksPerMultiprocessor(&per_cu, mega_kernel, 256, 0);
    if (per_cu > 2) per_cu = 2;
    grid_blocks = cus * per_cu;
  }
  void* args[] = {&p};
  hipError_t e = hipLaunchCooperativeKernel((void*)mega_kernel, dim3(grid_blocks), dim3(256), args, 0, stream);
  if (e != hipSuccess) fprintf(stderr, "cooperative launch failed: %s (grid %d)\n", hipGetErrorString(e), grid_blocks);
#endif
}
```

```cpp
#include <hip/hip_runtime.h>
#include <hip/hip_bf16.h>
#include <hip/hip_cooperative_groups.h>
#include <cstdio>
namespace cg = cooperative_groups;

#ifndef MULTI
#define MULTI 0
#endif

typedef unsigned short u16;
using bf16x8 = __attribute__((ext_vector_type(8))) short;
using f32x4 = __attribute__((ext_vector_type(4))) float;

constexpr int T_ = 32768;
constexpr int S_ = 16384;
constexpr int D_ = 2048;
constexpr int SSM_L = 128;
constexpr int SSM_NC = S_ / SSM_L;
constexpr float ALPHA = 1.189207115002721f;
constexpr size_t MB = 1024ull * 1024ull;

constexpr size_t O_WIN = 0 * MB, O_WGLU = 32 * MB, O_WAU = 34 * MB, O_WSU = 38 * MB, O_WOUT = 42 * MB,
                 O_WPQ = 50 * MB, O_WPG = 58 * MB, O_WPIN = 66 * MB, O_SK = 67 * MB, O_BCAT = 67 * MB + 512 * 1024,
                 O_CCAT = 68 * MB, O_LAM = 68 * MB + 256 * 1024, O_UB = 70 * MB, O_VB = 134 * MB, O_SBUF = 198 * MB,
                 O_H = 206 * MB, O_Q = 334 * MB, O_K = 398 * MB, O_VT = 462 * MB, O_U2 = 526 * MB, O_G = 590 * MB,
                 O_YA = 846 * MB, O_YS = 910 * MB, O_PB = 974 * MB;
constexpr size_t O_YG = O_VT, O_MERGED = O_Q, O_PRE1 = O_G, O_PQ = O_Q, O_SG = O_VT, O_E = O_G,
                 O_HV = O_G + 128 * MB, O_HI = O_G + 160 * MB, O_EXP = O_G + 192 * MB, O_GATE = O_G + 208 * MB;

struct Params {
  const float *x, *p, *ln_in_g, *ln_in_b, *w_in, *rel_bias, *lam_re, *lam_im, *log_dt, *b_re, *b_im, *c_re, *c_im,
      *ssm_d, *w_glu, *w_au, *w_su, *w_out, *ln1_g, *ln1_b, *w_pq, *sub_keys, *peer_u, *peer_v, *ple_w_in, *ple_g,
      *ple_w_gate, *ln2_g, *ln2_b;
  float* out;
  char* ws;
};

__device__ __forceinline__ u16 f2bf(float f) {
  unsigned u = __float_as_uint(f);
  u += 0x7fffu + ((u >> 16) & 1u);
  return (u16)(u >> 16);
}
__device__ __forceinline__ float bf2f(u16 h) { return __uint_as_float(((unsigned)h) << 16); }
__device__ __forceinline__ unsigned pack2(float a, float b) { return (unsigned)f2bf(a) | ((unsigned)f2bf(b) << 16); }
__device__ __forceinline__ float lo2f(unsigned u) { return __uint_as_float(u << 16); }
__device__ __forceinline__ float hi2f(unsigned u) { return __uint_as_float(u & 0xffff0000u); }
__device__ __forceinline__ float sigmoidf_(float x) { return 1.f / (1.f + __expf(-x)); }
__device__ __forceinline__ float gelu_tanh(float x) {
  float u = 0.7978845608028654f * (x + 0.044715f * x * x * x);
  float t = 1.f - 2.f / (1.f + __expf(2.f * u));
  return 0.5f * x * (1.f + t);
}
__device__ __forceinline__ float wave_sum(float v) {
#pragma unroll
  for (int o = 32; o >= 1; o >>= 1) v += __shfl_xor(v, o);
  return v;
}
__device__ __forceinline__ void store_bf4(u16* dst, float a, float b, float c, float d) {
  uint2 v; v.x = pack2(a, b); v.y = pack2(c, d);
  *(uint2*)dst = v;
}

__device__ __forceinline__ void gemm_kloop(f32x4 (&acc)[4][4], const u16* __restrict__ A, int lda,
                                           const u16* __restrict__ Bt, int ldb, int K, u16* lds) {
  const int tid = threadIdx.x, lane = tid & 63, wid = tid >> 6, wm = wid >> 1, wn = wid & 1;
  const int lr = lane & 15, lq = lane >> 4;
  const int nk = K >> 6;
  const int srow = tid >> 3, sc = (tid & 7) ^ (srow & 7);
  const u16* ga = A + (size_t)srow * lda + sc * 8;
  const u16* gb = Bt + (size_t)srow * ldb + sc * 8;
  u16* lw = lds + tid * 8;
#pragma unroll
  for (int i = 0; i < 4; ++i) {
    __builtin_amdgcn_global_load_lds((const unsigned*)(ga + (size_t)(32 * i) * lda), (unsigned*)(lw + i * 2048), 16, 0, 0);
    __builtin_amdgcn_global_load_lds((const unsigned*)(gb + (size_t)(32 * i) * ldb), (unsigned*)(lw + 8192 + i * 2048), 16, 0, 0);
  }
  __syncthreads();
  const int swz = lr & 7;
  for (int kt = 0; kt < nk; ++kt) {
    if (kt + 1 < nk) {
      u16* lw2 = lw + ((kt + 1) & 1) * 16384;
#pragma unroll
      for (int i = 0; i < 4; ++i) {
        __builtin_amdgcn_global_load_lds((const unsigned*)(ga + (size_t)(32 * i) * lda + (kt + 1) * 64), (unsigned*)(lw2 + i * 2048), 16, 0, 0);
        __builtin_amdgcn_global_load_lds((const unsigned*)(gb + (size_t)(32 * i) * ldb + (kt + 1) * 64), (unsigned*)(lw2 + 8192 + i * 2048), 16, 0, 0);
      }
    }
    const u16* sa = lds + (kt & 1) * 16384;
    const u16* sb = sa + 8192;
#pragma unroll
    for (int ks = 0; ks < 2; ++ks) {
      bf16x8 af[4], bfr[4];
      const int co = ((ks * 4 + lq) ^ swz) * 8;
#pragma unroll
      for (int mi = 0; mi < 4; ++mi) af[mi] = *(const bf16x8*)(sa + (wm * 64 + mi * 16 + lr) * 64 + co);
#pragma unroll
      for (int ni = 0; ni < 4; ++ni) bfr[ni] = *(const bf16x8*)(sb + (wn * 64 + ni * 16 + lr) * 64 + co);
#pragma unroll
      for (int mi = 0; mi < 4; ++mi)
#pragma unroll
        for (int ni = 0; ni < 4; ++ni)
          acc[mi][ni] = __builtin_amdgcn_mfma_f32_16x16x32_bf16(bfr[ni], af[mi], acc[mi][ni], 0, 0, 0);
    }
    __syncthreads();
  }
}

#define ZERO_ACC(acc)                                   \
  _Pragma("unroll") for (int _a = 0; _a < 4; ++_a)      \
  _Pragma("unroll") for (int _b = 0; _b < 4; ++_b) acc[_a][_b] = f32x4{0.f, 0.f, 0.f, 0.f};

#define EPI_COORDS                                                             \
  const int lane = threadIdx.x & 63, wid = threadIdx.x >> 6, wm = wid >> 1, wn = wid & 1; \
  const int lr = lane & 15, lq = lane >> 4;

__device__ void tconv_tile(const float* __restrict__ W, int K, int N, u16* __restrict__ Wt, int tile, float* lds) {
  const int tid = threadIdx.x;
  const int ntn = N >> 6;
  const int kt = tile / ntn, nt = tile % ntn;
  const int c4 = (tid & 15) * 4;
#pragma unroll
  for (int i = 0; i < 4; ++i) {
    int r = (tid >> 4) + 16 * i;
    float4 v = *(const float4*)(W + (size_t)(kt * 64 + r) * N + nt * 64 + c4);
    lds[r * 65 + c4 + 0] = v.x; lds[r * 65 + c4 + 1] = v.y; lds[r * 65 + c4 + 2] = v.z; lds[r * 65 + c4 + 3] = v.w;
  }
  __syncthreads();
  const int n = tid >> 2, kseg = (tid & 3) * 16;
  unsigned o[8];
#pragma unroll
  for (int j = 0; j < 8; ++j) o[j] = pack2(lds[(kseg + 2 * j) * 65 + n], lds[(kseg + 2 * j + 1) * 65 + n]);
  u16* dst = Wt + (size_t)(nt * 64 + n) * K + kt * 64 + kseg;
  *(uint4*)dst = uint4{o[0], o[1], o[2], o[3]};
  *(uint4*)(dst + 8) = uint4{o[4], o[5], o[6], o[7]};
  __syncthreads();
}

__device__ void conv_linear(const float* __restrict__ src, u16* __restrict__ dst, size_t n8, size_t gtid, size_t nth) {
  for (size_t i = gtid; i < n8; i += nth) {
    float4 a = *(const float4*)(src + i * 8), b = *(const float4*)(src + i * 8 + 4);
    *(uint4*)(dst + i * 8) = uint4{pack2(a.x, a.y), pack2(a.z, a.w), pack2(b.x, b.y), pack2(b.z, b.w)};
  }
}

typedef float f32x2 __attribute__((ext_vector_type(2)));
constexpr size_t O_U8 = O_UB, O_V8 = O_UB + 32 * MB, O_RSU = O_VB, O_RSV = O_VB + 64 * 1024;
__device__ void conv_fp8_rows(const float* __restrict__ src, unsigned char* __restrict__ dst, float* __restrict__ rscale,
                              int gw, int nw) {
  const int lane = threadIdx.x & 63;
  for (int row = gw; row < 16384; row += nw) {
    const float* r = src + (size_t)row * D_;
    float4 v[8];
#pragma unroll
    for (int q = 0; q < 8; ++q) v[q] = *(const float4*)(r + q * 256 + lane * 4);
    float am = 0.f;
#pragma unroll
    for (int q = 0; q < 8; ++q) am = fmaxf(am, fmaxf(fmaxf(fabsf(v[q].x), fabsf(v[q].y)), fmaxf(fabsf(v[q].z), fabsf(v[q].w))));
#pragma unroll
    for (int o = 32; o >= 1; o >>= 1) am = fmaxf(am, __shfl_xor(am, o));
    const float sc = am > 0.f ? 416.f / am : 1.f;
#pragma unroll
    for (int q = 0; q < 8; ++q) {
      int w = 0;
      w = __builtin_amdgcn_cvt_pk_fp8_f32(v[q].x * sc, v[q].y * sc, w, false);
      w = __builtin_amdgcn_cvt_pk_fp8_f32(v[q].z * sc, v[q].w * sc, w, true);
      *(int*)(dst + (size_t)row * D_ + q * 256 + lane * 4) = w;
    }
    if (lane == 0) rscale[row] = am > 0.f ? am / 416.f : 1.f;
  }
}

__device__ void ln_rows(const float* __restrict__ src, const float* __restrict__ g, const float* __restrict__ b,
                        u16* __restrict__ dst, int gw, int nw) {
  const int lane = threadIdx.x & 63;
  for (int row = gw; row < T_; row += nw) {
    const float* r = src + (size_t)row * D_;
    float4 v[8];
#pragma unroll
    for (int q = 0; q < 8; ++q) v[q] = *(const float4*)(r + q * 256 + lane * 4);
    float s = 0.f;
#pragma unroll
    for (int q = 0; q < 8; ++q) s += v[q].x + v[q].y + v[q].z + v[q].w;
    float mu = wave_sum(s) * (1.f / D_);
    float ss = 0.f;
#pragma unroll
    for (int q = 0; q < 8; ++q) {
      float a = v[q].x - mu, bb = v[q].y - mu, c = v[q].z - mu, d = v[q].w - mu;
      ss += a * a + bb * bb + c * c + d * d;
    }
    float rstd = rsqrtf(wave_sum(ss) * (1.f / D_) + 1e-5f);
#pragma unroll
    for (int q = 0; q < 8; ++q) {
      int col = q * 256 + lane * 4;
      float4 gg = *(const float4*)(g + col), bb = *(const float4*)(b + col);
      store_bf4(dst + (size_t)row * D_ + col, (v[q].x - mu) * rstd * gg.x + bb.x, (v[q].y - mu) * rstd * gg.y + bb.y,
                (v[q].z - mu) * rstd * gg.z + bb.z, (v[q].w - mu) * rstd * gg.w + bb.w);
    }
  }
}

__device__ __forceinline__ void dsincos(double x, double& s, double& c) {
  double q = rint(x * 0.63661977236758134308);
  double r = x - q * 1.57079632679489661923;
  double r2 = r * r;
  double sp = r * (1.0 + r2 * (-1.0 / 6 + r2 * (1.0 / 120 + r2 * (-1.0 / 5040 + r2 * (1.0 / 362880 + r2 * (-1.0 / 39916800 + r2 * (1.0 / 6227020800.0)))))));
  double cp = 1.0 + r2 * (-0.5 + r2 * (1.0 / 24 + r2 * (-1.0 / 720 + r2 * (1.0 / 40320 + r2 * (-1.0 / 3628800 + r2 * (1.0 / 479001600.0 + r2 * (-1.0 / 87178291200.0)))))));
  int qi = ((int)q) & 3;
  if (qi == 0) { s = sp; c = cp; }
  else if (qi == 1) { s = cp; c = -sp; }
  else if (qi == 2) { s = -sp; c = -cp; }
  else { s = -cp; c = sp; }
}

__device__ void ssm_consts(const Params& P, int i) {
  const int g = i >> 6, p = i & 63;
  double lr = P.lam_re[g * 64 + p], li = P.lam_im[g * 64 + p];
  double dt = exp((double)P.log_dt[g]);
  double mag = exp(lr * dt);
  double sn, cs;
  dsincos(li * dt, sn, cs);
  double ar = mag * cs, ai = mag * sn;
  double nr = ar - 1.0, ni = ai, den = lr * lr + li * li;
  double fr = (nr * lr + ni * li) / den, fi = (ni * lr - nr * li) / den;
  u16* bcat = (u16*)(P.ws + O_BCAT);
  u16* ccat = (u16*)(P.ws + O_CCAT);
  float* lam = (float*)(P.ws + O_LAM);
  for (int h = 0; h < 16; ++h) {
    double br = P.b_re[(g * 64 + p) * 16 + h], bi = P.b_im[(g * 64 + p) * 16 + h];
    bcat[(g * 128 + p) * 32 + h] = f2bf((float)(fr * br - fi * bi));
    bcat[(g * 128 + 64 + p) * 32 + h] = f2bf((float)(fr * bi + fi * br));
    bcat[(g * 128 + p) * 32 + 16 + h] = 0;
    bcat[(g * 128 + 64 + p) * 32 + 16 + h] = 0;
    ccat[(g * 16 + h) * 128 + p] = f2bf(P.c_re[(g * 16 + h) * 64 + p]);
    ccat[(g * 16 + h) * 128 + 64 + p] = f2bf(-P.c_im[(g * 16 + h) * 64 + p]);
  }
  double pr = ar, pi = ai;
  for (int k = 0; k < 7; ++k) {
    double t = pr * pr - pi * pi;
    pi = 2.0 * pr * pi;
    pr = t;
  }
  lam[0 * 4096 + i] = (float)ar;
  lam[1 * 4096 + i] = (float)ai;
  lam[2 * 4096 + i] = (float)pr;
  lam[3 * 4096 + i] = (float)pi;
}

__device__ void phase0(const Params& P, int bid, int nb, u16* lds) {
  const size_t gtid = (size_t)bid * 256 + threadIdx.x, nth = (size_t)nb * 256;
#define TCONV(wp, KK, NN, OFF) \
  for (int t = bid; t < ((KK) >> 6) * ((NN) >> 6); t += nb) tconv_tile(wp, KK, NN, (u16*)(P.ws + OFF), t, (float*)lds);
  TCONV(P.w_in, 2048, 8192, O_WIN)
  TCONV(P.w_glu, 1024, 1024, O_WGLU)
  TCONV(P.w_au, 1024, 2048, O_WAU)
  TCONV(P.w_su, 1024, 2048, O_WSU)
  TCONV(P.w_out, 2048, 2048, O_WOUT)
  TCONV(P.w_pq, 2048, 2048, O_WPQ)
  TCONV(P.ple_w_gate, 2048, 2048, O_WPG)
  TCONV(P.ple_w_in, 256, 2048, O_WPIN)
  conv_fp8_rows(P.peer_u, (unsigned char*)(P.ws + O_U8), (float*)(P.ws + O_RSU), bid * 4 + (threadIdx.x >> 6), nb * 4);
  conv_fp8_rows(P.peer_v, (unsigned char*)(P.ws + O_V8), (float*)(P.ws + O_RSV), bid * 4 + (threadIdx.x >> 6), nb * 4);
  conv_linear(P.sub_keys, (u16*)(P.ws + O_SK), (size_t)16 * 128 * 128 / 8, gtid, nth);
  conv_linear(P.p, (u16*)(P.ws + O_PB), (size_t)T_ * 256 / 8, gtid, nth);
  for (size_t i = gtid; i < 4096; i += nth) ssm_consts(P, (int)i);
  ln_rows(P.x, P.ln_in_g, P.ln_in_b, (u16*)(P.ws + O_H), bid * 4 + (threadIdx.x >> 6), nb * 4);
}

__device__ void phase1(const Params& P, int bid, int nb, u16* lds) {
  const u16* H = (const u16*)(P.ws + O_H);
  const u16* W = (const u16*)(P.ws + O_WIN);
  u16* Q = (u16*)(P.ws + O_Q);
  u16* Kb = (u16*)(P.ws + O_K);
  u16* Vt = (u16*)(P.ws + O_VT);
  u16* U2 = (u16*)(P.ws + O_U2);
  u16* G = (u16*)(P.ws + O_G);
  EPI_COORDS
  const int ntiles = 256 * 64;
  for (int t = bid; t < ntiles; t += nb) {
    const int mt = t >> 6, nt = t & 63;
    f32x4 acc[4][4];
    ZERO_ACC(acc)
    gemm_kloop(acc, H + (size_t)mt * 128 * D_, D_, W + (size_t)nt * 128 * D_, D_, D_, lds);
    const int region = nt >> 3;
#pragma unroll
    for (int mi = 0; mi < 4; ++mi) {
      const int m = mt * 128 + wm * 64 + mi * 16 + lr;
#pragma unroll
      for (int ni = 0; ni < 4; ++ni) {
        const int n = nt * 128 + wn * 64 + ni * 16 + lq * 4;
        f32x4 a = acc[mi][ni];
        if (region == 0) {
          const float sc = 0.08838834764831845f;
          store_bf4(Q + (size_t)m * 1024 + n, a[0] * sc, a[1] * sc, a[2] * sc, a[3] * sc);
        } else if (region == 1) {
          store_bf4(Kb + (size_t)m * 1024 + (n - 1024), a[0], a[1], a[2], a[3]);
        } else if (region == 2) {
          const int b = m >> 14, tt = m & (S_ - 1);
#pragma unroll
          for (int j = 0; j < 4; ++j) Vt[((size_t)(b * 1024 + (n - 2048 + j))) * S_ + tt] = f2bf(a[j]);
        } else if (region == 3) {
          store_bf4(U2 + (size_t)m * 1024 + (n - 3072), a[0], a[1], a[2], a[3]);
        } else {
          store_bf4(G + (size_t)m * 4096 + (n - 4096), sigmoidf_(a[0]), sigmoidf_(a[1]), sigmoidf_(a[2]), sigmoidf_(a[3]));
        }
      }
    }
  }
}

__device__ void attn_item(const Params& P, int item, u16* lds) {
  const int c = item & 255, hd = (item >> 8) & 7, b = item >> 11;
  const int tid = threadIdx.x, lane = tid & 63, w = tid >> 6, lr = lane & 15, lq = lane >> 4;
  u16* Ks = lds;
  u16* Vs = lds + 64 * 136;
  float* bs = (float*)(lds + 64 * 136 + 128 * 72);
  const u16* Q = (const u16*)(P.ws + O_Q);
  const u16* Kb = (const u16*)(P.ws + O_K);
  const u16* Vt = (const u16*)(P.ws + O_VT);
  u16* ya = (u16*)(P.ws + O_YA);
  __syncthreads();
  for (int i = tid; i < 257; i += 256) bs[i] = P.rel_bias[hd * 257 + i];
  bf16x8 qf[4];
  {
    const u16* qp = Q + (size_t)(b * S_ + c * 64 + w * 16 + lr) * 1024 + hd * 128 + lq * 8;
#pragma unroll
    for (int ks = 0; ks < 4; ++ks) qf[ks] = *(const bf16x8*)(qp + ks * 32);
  }
  f32x4 oacc[8];
#pragma unroll
  for (int d = 0; d < 8; ++d) oacc[d] = f32x4{0.f, 0.f, 0.f, 0.f};
  float m_run = -1e30f, lsum = 0.f;
  const int i0 = (c < 8) ? (8 - c) : 0;
  const int qi = w * 16 + lr;
  for (int i = i0; i <= 8; ++i) {
    const int kc = c - 8 + i;
    __syncthreads();
#pragma unroll
    for (int r = 0; r < 4; ++r) {
      int ch = tid + 256 * r;
      int row = ch >> 4, kk = ch & 15;
      *(uint4*)(Ks + row * 136 + kk * 8) = *(const uint4*)(Kb + (size_t)(b * S_ + kc * 64 + row) * 1024 + hd * 128 + kk * 8);
      int row2 = ch >> 3, k2 = ch & 7;
      *(uint4*)(Vs + row2 * 72 + k2 * 8) = *(const uint4*)(Vt + ((size_t)(b * 1024 + hd * 128 + row2)) * S_ + kc * 64 + k2 * 8);
    }
    __syncthreads();
    f32x4 sacc[4];
#pragma unroll
    for (int kt = 0; kt < 4; ++kt) {
      sacc[kt] = f32x4{0.f, 0.f, 0.f, 0.f};
#pragma unroll
      for (int ks = 0; ks < 4; ++ks) {
        bf16x8 kf = *(const bf16x8*)(Ks + (kt * 16 + lr) * 136 + ks * 32 + lq * 8);
        sacc[kt] = __builtin_amdgcn_mfma_f32_16x16x32_bf16(kf, qf[ks], sacc[kt], 0, 0, 0);
      }
    }
    float tmax = -1e30f;
#pragma unroll
    for (int kt = 0; kt < 4; ++kt)
#pragma unroll
      for (int j = 0; j < 4; ++j) {
        int kb = i * 64 + kt * 16 + lq * 4 + j;
        int rel = 512 + qi - kb;
        rel = min(max(rel, -128), 128) + 128;
        float s = sacc[kt][j] + bs[rel];
        sacc[kt][j] = s;
        tmax = fmaxf(tmax, s);
      }
    tmax = fmaxf(tmax, __shfl_xor(tmax, 16));
    tmax = fmaxf(tmax, __shfl_xor(tmax, 32));
    const float m_new = fmaxf(m_run, tmax);
    const float corr = __expf(m_run - m_new);
    m_run = m_new;
    float ps = 0.f;
#pragma unroll
    for (int kt = 0; kt < 4; ++kt)
#pragma unroll
      for (int j = 0; j < 4; ++j) {
        float pv = __expf(sacc[kt][j] - m_new);
        sacc[kt][j] = pv;
        ps += pv;
      }
    lsum = lsum * corr + ps;
#pragma unroll
    for (int d = 0; d < 8; ++d) {
      oacc[d][0] *= corr; oacc[d][1] *= corr; oacc[d][2] *= corr; oacc[d][3] *= corr;
    }
#pragma unroll
    for (int kk = 0; kk < 2; ++kk) {
      union { bf16x8 v; unsigned u[4]; } pf;
      pf.u[0] = pack2(sacc[2 * kk][0], sacc[2 * kk][1]);
      pf.u[1] = pack2(sacc[2 * kk][2], sacc[2 * kk][3]);
      pf.u[2] = pack2(sacc[2 * kk + 1][0], sacc[2 * kk + 1][1]);
      pf.u[3] = pack2(sacc[2 * kk + 1][2], sacc[2 * kk + 1][3]);
#pragma unroll
      for (int d = 0; d < 8; ++d) {
        union { bf16x8 v; uint2 h[2]; } vf;
        vf.h[0] = *(const uint2*)(Vs + (d * 16 + lr) * 72 + kk * 32 + lq * 4);
        vf.h[1] = *(const uint2*)(Vs + (d * 16 + lr) * 72 + kk * 32 + 16 + lq * 4);
        oacc[d] = __builtin_amdgcn_mfma_f32_16x16x32_bf16(vf.v, pf.v, oacc[d], 0, 0, 0);
      }
    }
  }
  lsum += __shfl_xor(lsum, 16);
  lsum += __shfl_xor(lsum, 32);
  const float inv = 1.f / lsum;
  u16* op = ya + (size_t)(b * S_ + c * 64 + w * 16 + lr) * 1024 + hd * 128 + lq * 4;
#pragma unroll
  for (int d = 0; d < 8; ++d) store_bf4(op + d * 16, oacc[d][0] * inv, oacc[d][1] * inv, oacc[d][2] * inv, oacc[d][3] * inv);
}

template <int PASS>
__device__ void ssm_item(const Params& P, int item, char* ldsw) {
  const int c = item & (SSM_NC - 1), seq = item >> 7, g = seq & 63, b = seq >> 6;
  const int lane = threadIdx.x & 63, lr = lane & 15, lq = lane >> 4;
  float* BuS = (float*)ldsw;
  u16* Hs = (u16*)(ldsw + 8192);
  const u16* bcat = (const u16*)(P.ws + O_BCAT);
  const u16* ccat = (const u16*)(P.ws + O_CCAT);
  const float* lam = (const float*)(P.ws + O_LAM);
  const u16* U2 = (const u16*)(P.ws + O_U2);
  float* Sbuf = (float*)(P.ws + O_SBUF);
  u16* ys = (u16*)(P.ws + O_YS);
  const float ar = lam[g * 64 + lane], ai = lam[4096 + g * 64 + lane];
  bf16x8 bfrag[8];
#pragma unroll
  for (int nt = 0; nt < 8; ++nt) bfrag[nt] = *(const bf16x8*)(bcat + (g * 128 + nt * 16 + lr) * 32 + lq * 8);
  float sr = 0.f, si = 0.f;
  bf16x8 cfrag[4];
  float dsk[4];
  if (PASS == 2) {
#pragma unroll
    for (int ks = 0; ks < 4; ++ks) cfrag[ks] = *(const bf16x8*)(ccat + (g * 16 + lr) * 128 + ks * 32 + lq * 8);
#pragma unroll
    for (int j = 0; j < 4; ++j) dsk[j] = P.ssm_d[g * 16 + lq * 4 + j];
    const float aLr = lam[2 * 4096 + g * 64 + lane], aLi = lam[3 * 4096 + g * 64 + lane];
    const float* Sb = Sbuf + (size_t)seq * SSM_NC * 128;
#pragma unroll 4
    for (int cc = 0; cc < c; ++cc) {
      float xr = Sb[cc * 128 + lane], xi = Sb[cc * 128 + 64 + lane];
      float nr = fmaf(aLr, sr, fmaf(-aLi, si, xr));
      float ni = fmaf(aLr, si, fmaf(aLi, sr, xi));
      sr = nr; si = ni;
    }
  }
  const size_t tok_base = (size_t)b * S_ + (size_t)c * SSM_L;
  for (int sub = 0; sub < SSM_L / 16; ++sub) {
    const size_t tok0 = tok_base + sub * 16;
    union { bf16x8 v; uint4 u; } uf;
    uf.u = uint4{0u, 0u, 0u, 0u};
    if (lq < 2) uf.u = *(const uint4*)(U2 + (tok0 + lr) * 1024 + g * 16 + lq * 8);
#pragma unroll
    for (int nt = 0; nt < 8; ++nt) {
      f32x4 d = __builtin_amdgcn_mfma_f32_16x16x32_bf16(bfrag[nt], uf.v, f32x4{0.f, 0.f, 0.f, 0.f}, 0, 0, 0);
      *(f32x4*)(BuS + lr * 128 + nt * 16 + lq * 4) = d;
    }
    asm volatile("s_waitcnt lgkmcnt(0)" ::: "memory");
#pragma unroll
    for (int t = 0; t < 16; ++t) {
      float bur = BuS[t * 128 + lane], bui = BuS[t * 128 + 64 + lane];
      float nr = fmaf(ar, sr, fmaf(-ai, si, bur));
      float ni = fmaf(ar, si, fmaf(ai, sr, bui));
      sr = nr; si = ni;
      if (PASS == 2) {
        Hs[t * 136 + lane] = f2bf(sr);
        Hs[t * 136 + 64 + lane] = f2bf(si);
      }
    }
    asm volatile("s_waitcnt lgkmcnt(0)" ::: "memory");
    if (PASS == 2) {
      f32x4 yacc = f32x4{0.f, 0.f, 0.f, 0.f};
#pragma unroll
      for (int ks = 0; ks < 4; ++ks) {
        bf16x8 hf = *(const bf16x8*)(Hs + lr * 136 + ks * 32 + lq * 8);
        yacc = __builtin_amdgcn_mfma_f32_16x16x32_bf16(cfrag[ks], hf, yacc, 0, 0, 0);
      }
      uint2 uu = *(const uint2*)(U2 + (tok0 + lr) * 1024 + g * 16 + lq * 4);
      float y0 = gelu_tanh(yacc[0] + dsk[0] * lo2f(uu.x));
      float y1 = gelu_tanh(yacc[1] + dsk[1] * hi2f(uu.x));
      float y2 = gelu_tanh(yacc[2] + dsk[2] * lo2f(uu.y));
      float y3 = gelu_tanh(yacc[3] + dsk[3] * hi2f(uu.y));
      store_bf4(ys + (tok0 + lr) * 1024 + g * 16 + lq * 4, y0, y1, y2, y3);
      asm volatile("s_waitcnt lgkmcnt(0)" ::: "memory");
    }
  }
  if (PASS == 1) {
    Sbuf[((size_t)seq * SSM_NC + c) * 128 + lane] = sr;
    Sbuf[((size_t)seq * SSM_NC + c) * 128 + 64 + lane] = si;
  }
}

__device__ void phase2(const Params& P, int bid, int nb, u16* lds) {
  for (int it = bid; it < 8192; it += nb) {
    if (it < 4096) {
      attn_item(P, it, lds);
    } else {
      __syncthreads();
      const int w = threadIdx.x >> 6;
      ssm_item<1>(P, (it - 4096) * 4 + w, (char*)lds + w * 12544);
    }
  }
}
__device__ void phase3(const Params& P, int bid, int nb, u16* lds) {
  const int w = threadIdx.x >> 6;
  for (int it = bid; it < 4096; it += nb) ssm_item<2>(P, it * 4 + w, (char*)lds + w * 12544);
}

__device__ void phase4(const Params& P, int bid, int nb, u16* lds) {
  const u16* ys = (const u16*)(P.ws + O_YS);
  const u16* W = (const u16*)(P.ws + O_WGLU);
  u16* yg = (u16*)(P.ws + O_YG);
  EPI_COORDS
  for (int t = bid; t < 256 * 8; t += nb) {
    const int mt = t >> 3, nt = t & 7;
    f32x4 acc[4][4];
    ZERO_ACC(acc)
    gemm_kloop(acc, ys + (size_t)mt * 128 * 1024, 1024, W + (size_t)nt * 128 * 1024, 1024, 1024, lds);
#pragma unroll
    for (int mi = 0; mi < 4; ++mi) {
      const int m = mt * 128 + wm * 64 + mi * 16 + lr;
#pragma unroll
      for (int ni = 0; ni < 4; ++ni) {
        const int n = nt * 128 + wn * 64 + ni * 16 + lq * 4;
        uint2 yy = *(const uint2*)(ys + (size_t)m * 1024 + n);
        f32x4 a = acc[mi][ni];
        store_bf4(yg + (size_t)m * 1024 + n, lo2f(yy.x) * sigmoidf_(a[0]), hi2f(yy.x) * sigmoidf_(a[1]),
                  lo2f(yy.y) * sigmoidf_(a[2]), hi2f(yy.y) * sigmoidf_(a[3]));
      }
    }
  }
}

__device__ void phase5(const Params& P, int bid, int nb, u16* lds) {
  const u16* ya = (const u16*)(P.ws + O_YA);
  const u16* yg = (const u16*)(P.ws + O_YG);
  const u16* Wa = (const u16*)(P.ws + O_WAU);
  const u16* Wsu = (const u16*)(P.ws + O_WSU);
  const u16* G = (const u16*)(P.ws + O_G);
  u16* mg = (u16*)(P.ws + O_MERGED);
  EPI_COORDS
  for (int t = bid; t < 256 * 16; t += nb) {
    const int mt = t >> 4, nt = t & 15;
    f32x4 acc[4][4];
    ZERO_ACC(acc)
    gemm_kloop(acc, ya + (size_t)mt * 128 * 1024, 1024, Wa + (size_t)nt * 128 * 1024, 1024, 1024, lds);
#pragma unroll
    for (int mi = 0; mi < 4; ++mi) {
      const int m = mt * 128 + wm * 64 + mi * 16 + lr;
#pragma unroll
      for (int ni = 0; ni < 4; ++ni) {
        const int n = nt * 128 + wn * 64 + ni * 16 + lq * 4;
        uint2 ga = *(const uint2*)(G + (size_t)m * 4096 + n);
        uint2 gs = *(const uint2*)(G + (size_t)m * 4096 + 2048 + n);
        acc[mi][ni][0] *= lo2f(ga.x) / fmaxf(lo2f(gs.x), 1e-30f);
        acc[mi][ni][1] *= hi2f(ga.x) / fmaxf(hi2f(gs.x), 1e-30f);
        acc[mi][ni][2] *= lo2f(ga.y) / fmaxf(lo2f(gs.y), 1e-30f);
        acc[mi][ni][3] *= hi2f(ga.y) / fmaxf(hi2f(gs.y), 1e-30f);
      }
    }
    gemm_kloop(acc, yg + (size_t)mt * 128 * 1024, 1024, Wsu + (size_t)nt * 128 * 1024, 1024, 1024, lds);
#pragma unroll
    for (int mi = 0; mi < 4; ++mi) {
      const int m = mt * 128 + wm * 64 + mi * 16 + lr;
#pragma unroll
      for (int ni = 0; ni < 4; ++ni) {
        const int n = nt * 128 + wn * 64 + ni * 16 + lq * 4;
        uint2 gs = *(const uint2*)(G + (size_t)m * 4096 + 2048 + n);
        f32x4 a = acc[mi][ni];
        store_bf4(mg + (size_t)m * D_ + n, a[0] * fmaxf(lo2f(gs.x), 1e-30f), a[1] * fmaxf(hi2f(gs.x), 1e-30f),
                  a[2] * fmaxf(lo2f(gs.y), 1e-30f), a[3] * fmaxf(hi2f(gs.y), 1e-30f));
      }
    }
  }
}

__device__ void phase6(const Params& P, int bid, int nb, u16* lds) {
  const u16* mg = (const u16*)(P.ws + O_MERGED);
  const u16* W = (const u16*)(P.ws + O_WOUT);
  const u16* H = (const u16*)(P.ws + O_H);
  float* pre1 = (float*)(P.ws + O_PRE1);
  EPI_COORDS
  for (int t = bid; t < 256 * 16; t += nb) {
    const int mt = t >> 4, nt = t & 15;
    f32x4 acc[4][4];
    ZERO_ACC(acc)
    gemm_kloop(acc, mg + (size_t)mt * 128 * D_, D_, W + (size_t)nt * 128 * D_, D_, D_, lds);
#pragma unroll
    for (int mi = 0; mi < 4; ++mi) {
      const int m = mt * 128 + wm * 64 + mi * 16 + lr;
#pragma unroll
      for (int ni = 0; ni < 4; ++ni) {
        const int n = nt * 128 + wn * 64 + ni * 16 + lq * 4;
        uint2 hh = *(const uint2*)(H + (size_t)m * D_ + n);
        f32x4 a = acc[mi][ni];
        float4 o;
        o.x = ALPHA * lo2f(hh.x) + a[0]; o.y = ALPHA * hi2f(hh.x) + a[1];
        o.z = ALPHA * lo2f(hh.y) + a[2]; o.w = ALPHA * hi2f(hh.y) + a[3];
        *(float4*)(pre1 + (size_t)m * D_ + n) = o;
      }
    }
  }
}

__device__ void phase8(const Params& P, int bid, int nb, u16* lds) {
  const u16* H = (const u16*)(P.ws + O_H);
  const u16* Pb = (const u16*)(P.ws + O_PB);
  u16* PQ = (u16*)(P.ws + O_PQ);
  u16* SG = (u16*)(P.ws + O_SG);
  u16* E = (u16*)(P.ws + O_E);
  EPI_COORDS
  for (int t = bid; t < 3 * 4096; t += nb) {
    const int which = t >> 12, tt = t & 4095, mt = tt >> 4, nt = tt & 15;
    f32x4 acc[4][4];
    ZERO_ACC(acc)
    u16* dst;
    if (which == 0) {
      gemm_kloop(acc, H + (size_t)mt * 128 * D_, D_, (const u16*)(P.ws + O_WPQ) + (size_t)nt * 128 * D_, D_, D_, lds);
      dst = PQ;
    } else if (which == 1) {
      gemm_kloop(acc, H + (size_t)mt * 128 * D_, D_, (const u16*)(P.ws + O_WPG) + (size_t)nt * 128 * D_, D_, D_, lds);
      dst = SG;
    } else {
      gemm_kloop(acc, Pb + (size_t)mt * 128 * 256, 256, (const u16*)(P.ws + O_WPIN) + (size_t)nt * 128 * 256, 256, 256, lds);
      dst = E;
    }
#pragma unroll
    for (int mi = 0; mi < 4; ++mi) {
      const int m = mt * 128 + wm * 64 + mi * 16 + lr;
#pragma unroll
      for (int ni = 0; ni < 4; ++ni) {
        const int n = nt * 128 + wn * 64 + ni * 16 + lq * 4;
        f32x4 a = acc[mi][ni];
        if (which == 1) { a[0] = sigmoidf_(a[0]); a[1] = sigmoidf_(a[1]); a[2] = sigmoidf_(a[2]); a[3] = sigmoidf_(a[3]); }
        store_bf4(dst + (size_t)m * D_ + n, a[0], a[1], a[2], a[3]);
      }
    }
  }
}

struct Top16 { float v[16]; int i[16]; };
__device__ __forceinline__ void top_init(Top16& t) {
#pragma unroll
  for (int k = 0; k < 16; ++k) { t.v[k] = -INFINITY; t.i[k] = 0; }
}
__device__ __forceinline__ void top_insert(Top16& t, float x, int id) {
  const bool c = x > t.v[15];
  t.v[15] = c ? x : t.v[15];
  t.i[15] = c ? id : t.i[15];
#pragma unroll
  for (int k = 15; k >= 1; --k) {
    const bool s = t.v[k] > t.v[k - 1];
    const float a = t.v[k - 1], b = t.v[k];
    const int ia = t.i[k - 1], ib = t.i[k];
    t.v[k - 1] = s ? b : a; t.v[k] = s ? a : b;
    t.i[k - 1] = s ? ib : ia; t.i[k] = s ? ia : ib;
  }
}

__device__ void phase9(const Params& P, int bid, int nb, u16* lds) {
  const u16* PQ = (const u16*)(P.ws + O_PQ);
  const u16* SK = (const u16*)(P.ws + O_SK);
  float* HV = (float*)(P.ws + O_HV);
  int* HI = (int*)(P.ws + O_HI);
  float* Sc = (float*)lds;
  EPI_COORDS
  const int tid = threadIdx.x;
  for (int t = bid; t < 256 * 16; t += nb) {
    const int mt = t >> 4, rc = t & 15;
    f32x4 acc[4][4];
    ZERO_ACC(acc)
    gemm_kloop(acc, PQ + (size_t)mt * 128 * D_ + rc * 128, D_, SK + (size_t)rc * 128 * 128, 128, 128, lds);
#pragma unroll
    for (int mi = 0; mi < 4; ++mi) {
      const int m = wm * 64 + mi * 16 + lr;
#pragma unroll
      for (int ni = 0; ni < 4; ++ni) {
        const int n = wn * 64 + ni * 16 + lq * 4;
#pragma unroll
        for (int j = 0; j < 4; ++j) Sc[m * 129 + n + j] = acc[mi][ni][j];
      }
    }
    __syncthreads();
    const int tok = tid & 127, hh = tid >> 7;
    Top16 tp;
    top_init(tp);
    for (int k = 0; k < 64; ++k) top_insert(tp, Sc[tok * 129 + hh * 64 + k], hh * 64 + k);
    __syncthreads();
    float* Lv = (float*)lds;
    int* Li = (int*)lds + 256 * 17;
#pragma unroll
    for (int k = 0; k < 16; ++k) { Lv[tid * 17 + k] = tp.v[k]; Li[tid * 17 + k] = tp.i[k]; }
    __syncthreads();
    if (tid < 128) {
      int ia = 0, ib = 0;
      const float* va = Lv + tid * 17; const float* vb = Lv + (tid + 128) * 17;
      const int* xa = Li + tid * 17; const int* xb = Li + (tid + 128) * 17;
      float* ov = HV + ((size_t)(mt * 128 + tid) * 16 + rc) * 16;
      int* oi = HI + ((size_t)(mt * 128 + tid) * 16 + rc) * 16;
      for (int k = 0; k < 16; ++k) {
        float a = va[ia], b = vb[ib];
        bool ta = a >= b;
        ov[k] = ta ? a : b;
        oi[k] = ta ? xa[ia] : xb[ib];
        ia += ta ? 1 : 0; ib += ta ? 0 : 1;
      }
    }
    __syncthreads();
  }
}

__device__ void phase10(const Params& P, int bid, int nb) {
  const float* HV = (const float*)(P.ws + O_HV);
  const int* HI = (const int*)(P.ws + O_HI);
  int* EX = (int*)(P.ws + O_EXP);
  float* GT = (float*)(P.ws + O_GATE);
  for (int i = bid * 256 + threadIdx.x; i < T_ * 8; i += nb * 256) {
    float v0[16], v1[16];
    int i0[16], i1[16];
#pragma unroll
    for (int q = 0; q < 4; ++q) {
      float4 a = *(const float4*)(HV + (size_t)i * 32 + q * 4);
      float4 b = *(const float4*)(HV + (size_t)i * 32 + 16 + q * 4);
      int4 c = *(const int4*)(HI + (size_t)i * 32 + q * 4);
      int4 d = *(const int4*)(HI + (size_t)i * 32 + 16 + q * 4);
      v0[q * 4] = a.x; v0[q * 4 + 1] = a.y; v0[q * 4 + 2] = a.z; v0[q * 4 + 3] = a.w;
      v1[q * 4] = b.x; v1[q * 4 + 1] = b.y; v1[q * 4 + 2] = b.z; v1[q * 4 + 3] = b.w;
      i0[q * 4] = c.x; i0[q * 4 + 1] = c.y; i0[q * 4 + 2] = c.z; i0[q * 4 + 3] = c.w;
      i1[q * 4] = d.x; i1[q * 4 + 1] = d.y; i1[q * 4 + 2] = d.z; i1[q * 4 + 3] = d.w;
    }
    Top16 tp;
    top_init(tp);
#pragma unroll
    for (int a = 0; a < 16; ++a)
#pragma unroll
      for (int b = 0; b < 16; ++b)
        if ((a + 1) * (b + 1) <= 16) top_insert(tp, v0[a] + v1[b], i0[a] * 128 + i1[b]);
    float sum = 0.f, e[16];
#pragma unroll
    for (int k = 0; k < 16; ++k) { e[k] = __expf(tp.v[k] - tp.v[0]); sum += e[k]; }
    const float inv = 1.f / sum;
#pragma unroll
    for (int q = 0; q < 4; ++q) {
      *(int4*)(EX + (size_t)i * 16 + q * 4) = int4{tp.i[q * 4], tp.i[q * 4 + 1], tp.i[q * 4 + 2], tp.i[q * 4 + 3]};
      *(float4*)(GT + (size_t)i * 16 + q * 4) = float4{e[q * 4] * inv, e[q * 4 + 1] * inv, e[q * 4 + 2] * inv, e[q * 4 + 3] * inv};
    }
  }
}

__device__ __forceinline__ void unpack8(uint4 u, float* f) {
  f[0] = lo2f(u.x); f[1] = hi2f(u.x); f[2] = lo2f(u.y); f[3] = hi2f(u.y);
  f[4] = lo2f(u.z); f[5] = hi2f(u.z); f[6] = lo2f(u.w); f[7] = hi2f(u.w);
}
__device__ __forceinline__ void dec16(uint4 u, float* f) {
  f32x2 a;
  a = __builtin_amdgcn_cvt_pk_f32_fp8((int)u.x, false); f[0] = a.x; f[1] = a.y;
  a = __builtin_amdgcn_cvt_pk_f32_fp8((int)u.x, true);  f[2] = a.x; f[3] = a.y;
  a = __builtin_amdgcn_cvt_pk_f32_fp8((int)u.y, false); f[4] = a.x; f[5] = a.y;
  a = __builtin_amdgcn_cvt_pk_f32_fp8((int)u.y, true);  f[6] = a.x; f[7] = a.y;
  a = __builtin_amdgcn_cvt_pk_f32_fp8((int)u.z, false); f[8] = a.x; f[9] = a.y;
  a = __builtin_amdgcn_cvt_pk_f32_fp8((int)u.z, true);  f[10] = a.x; f[11] = a.y;
  a = __builtin_amdgcn_cvt_pk_f32_fp8((int)u.w, false); f[12] = a.x; f[13] = a.y;
  a = __builtin_amdgcn_cvt_pk_f32_fp8((int)u.w, true);  f[14] = a.x; f[15] = a.y;
}
__device__ __forceinline__ void load_row_bf16(const u16* row, int lane, float* f) {
#pragma unroll
  for (int q = 0; q < 2; ++q) {
    uint4 a = *(const uint4*)(row + q * 1024 + lane * 16);
    uint4 b = *(const uint4*)(row + q * 1024 + lane * 16 + 8);
    unpack8(a, f + q * 16);
    unpack8(b, f + q * 16 + 8);
  }
}
__device__ void phase11(const Params& P, int bid, int nb) {
  const u16* H = (const u16*)(P.ws + O_H);
  const unsigned char* U8 = (const unsigned char*)(P.ws + O_U8);
  const unsigned char* V8 = (const unsigned char*)(P.ws + O_V8);
  const float* RSU = (const float*)(P.ws + O_RSU);
  const float* RSV = (const float*)(P.ws + O_RSV);
  const u16* SG = (const u16*)(P.ws + O_SG);
  const u16* E = (const u16*)(P.ws + O_E);
  const int* EX = (const int*)(P.ws + O_EXP);
  const float* GT = (const float*)(P.ws + O_GATE);
  const int lane = threadIdx.x & 63;
  for (int tok = bid * 4 + (threadIdx.x >> 6); tok < T_; tok += nb * 4) {
    float hf[32], y[32];
    load_row_bf16(H + (size_t)tok * D_, lane, hf);
#pragma unroll
    for (int k = 0; k < 32; ++k) y[k] = 0.f;
    const int ev0 = EX[(size_t)tok * 128 + lane], ev1 = EX[(size_t)tok * 128 + 64 + lane];
    const float gv0 = GT[(size_t)tok * 128 + lane], gv1 = GT[(size_t)tok * 128 + 64 + lane];
    const float ru0 = RSU[ev0], ru1 = RSU[ev1], rv0 = RSV[ev0], rv1 = RSV[ev1];
    for (int k4 = 0; k4 < 128; k4 += 4) {
      const int src = k4 & 63;
      const bool lo = k4 < 64;
      int ee[4]; float gg[4], su[4], sv[4];
#pragma unroll
      for (int x = 0; x < 4; ++x) {
        ee[x] = __shfl(lo ? ev0 : ev1, src + x);
        gg[x] = __shfl(lo ? gv0 : gv1, src + x);
        su[x] = __shfl(lo ? ru0 : ru1, src + x);
        sv[x] = __shfl(lo ? rv0 : rv1, src + x);
      }
      uint4 uu[4][2], vv[4][2];
#pragma unroll
      for (int x = 0; x < 4; ++x)
#pragma unroll
        for (int q = 0; q < 2; ++q) {
          uu[x][q] = *(const uint4*)(U8 + (size_t)ee[x] * D_ + q * 1024 + lane * 16);
          vv[x][q] = *(const uint4*)(V8 + (size_t)ee[x] * D_ + q * 1024 + lane * 16);
        }
      float dd[4];
#pragma unroll
      for (int x = 0; x < 4; ++x) {
        float d = 0.f;
#pragma unroll
        for (int q = 0; q < 2; ++q) {
          float f[16];
          dec16(uu[x][q], f);
#pragma unroll
          for (int j = 0; j < 16; ++j) d = fmaf(f[j], hf[q * 16 + j], d);
        }
        dd[x] = d;
      }
#pragma unroll
      for (int o = 32; o >= 1; o >>= 1) {
#pragma unroll
        for (int x = 0; x < 4; ++x) dd[x] += __shfl_xor(dd[x], o);
      }
#pragma unroll
      for (int x = 0; x < 4; ++x) {
        const float w = gg[x] * gelu_tanh(dd[x] * su[x]) * sv[x];
#pragma unroll
        for (int q = 0; q < 2; ++q) {
          float f[16];
          dec16(vv[x][q], f);
#pragma unroll
          for (int j = 0; j < 16; ++j) y[q * 16 + j] = fmaf(w, f[j], y[q * 16 + j]);
        }
      }
    }
    float ef[32], sg[32];
    load_row_bf16(E + (size_t)tok * D_, lane, ef);
    load_row_bf16(SG + (size_t)tok * D_, lane, sg);
    float ss = 0.f;
#pragma unroll
    for (int k = 0; k < 32; ++k) ss += ef[k] * ef[k];
    const float rr = rsqrtf(wave_sum(ss) * (1.f / D_) + 1e-5f);
    float s1 = 0.f;
#pragma unroll
    for (int q = 0; q < 2; ++q)
#pragma unroll
      for (int j4 = 0; j4 < 4; ++j4) {
        float4 g = *(const float4*)(P.ple_g + q * 1024 + lane * 16 + j4 * 4);
        const float gq[4] = {g.x, g.y, g.z, g.w};
#pragma unroll
        for (int j = 0; j < 4; ++j) {
          const int k = q * 16 + j4 * 4 + j;
          float v = ALPHA * hf[k] + y[k] + ef[k] * rr * gq[j] * sg[k];
          y[k] = v;
          s1 += v;
        }
      }
    const float mu = wave_sum(s1) * (1.f / D_);
    float s2 = 0.f;
#pragma unroll
    for (int k = 0; k < 32; ++k) { float d = y[k] - mu; s2 += d * d; }
    const float rstd = rsqrtf(wave_sum(s2) * (1.f / D_) + 1e-5f);
#pragma unroll
    for (int q = 0; q < 2; ++q)
#pragma unroll
      for (int j4 = 0; j4 < 4; ++j4) {
        const int col = q * 1024 + lane * 16 + j4 * 4;
        const int k = q * 16 + j4 * 4;
        float4 g = *(const float4*)(P.ln2_g + col), b = *(const float4*)(P.ln2_b + col);
        float4 o;
        o.x = (y[k + 0] - mu) * rstd * g.x + b.x; o.y = (y[k + 1] - mu) * rstd * g.y + b.y;
        o.z = (y[k + 2] - mu) * rstd * g.z + b.z; o.w = (y[k + 3] - mu) * rstd * g.w + b.w;
        *(float4*)(P.out + (size_t)tok * D_ + col) = o;
      }
  }
}

__device__ __forceinline__ void run_phase(const Params& P, int ph, int bid, int nb, u16* lds) {
  switch (ph) {
    case 0: phase0(P, bid, nb, lds); break;
    case 1: phase1(P, bid, nb, lds); break;
    case 2: phase2(P, bid, nb, lds); break;
    case 3: phase3(P, bid, nb, lds); break;
    case 4: phase4(P, bid, nb, lds); break;
    case 5: phase5(P, bid, nb, lds); break;
    case 6: phase6(P, bid, nb, lds); break;
    case 7: ln_rows((const float*)(P.ws + O_PRE1), P.ln1_g, P.ln1_b, (u16*)(P.ws + O_H), bid * 4 + (threadIdx.x >> 6), nb * 4); break;
    case 8: phase8(P, bid, nb, lds); break;
    case 9: phase9(P, bid, nb, lds); break;
    case 10: phase10(P, bid, nb); break;
    case 11: phase11(P, bid, nb); break;
  }
}
constexpr int NPHASE = 12;

#if MULTI
__global__ void __launch_bounds__(256, 2) phase_kernel(Params P, int ph) {
  __shared__ __attribute__((aligned(16))) u16 lds[36864];
  run_phase(P, ph, blockIdx.x, gridDim.x, lds);
}
#else
__global__ void __launch_bounds__(256, 2) mega_kernel(Params P) {
  __shared__ __attribute__((aligned(16))) u16 lds[36864];
  cg::grid_group grid = cg::this_grid();
  const int bid = blockIdx.x, nb = gridDim.x;
  phase0(P, bid, nb, lds); grid.sync();
  phase1(P, bid, nb, lds); grid.sync();
  phase2(P, bid, nb, lds); grid.sync();
  phase3(P, bid, nb, lds); grid.sync();
  phase4(P, bid, nb, lds); grid.sync();
  phase5(P, bid, nb, lds); grid.sync();
  phase6(P, bid, nb, lds); grid.sync();
  ln_rows((const float*)(P.ws + O_PRE1), P.ln1_g, P.ln1_b, (u16*)(P.ws + O_H), bid * 4 + (threadIdx.x >> 6), nb * 4);
  grid.sync();
  phase8(P, bid, nb, lds); grid.sync();
  phase9(P, bid, nb, lds); grid.sync();
  phase10(P, bid, nb); grid.sync();
  phase11(P, bid, nb);
}
#endif

extern "C" void kernel_launch(void* const* d_in, const int* in_sizes, int n_in, void* d_out, int out_size, void* d_ws,
                              size_t ws_size, hipStream_t stream) {
  Params p{};
  const float** pp = (const float**)&p;
  for (int i = 0; i < 29; ++i) pp[i] = (const float*)d_in[i];
  p.out = (float*)d_out;
  p.ws = (char*)d_ws;
  if (ws_size < 990 * MB) fprintf(stderr, "workspace too small: %zu\n", ws_size);
#if MULTI
  for (int ph = 0; ph < NPHASE; ++ph) phase_kernel<<<512, 256, 0, stream>>>(p, ph);
#else
  static int grid_blocks = 0;
  if (!grid_blocks) {
    int dev = 0, cus = 0, per_cu = 0;
    hipGetDevice(&dev);
    hipDeviceGetAttribute(&cus, hipDeviceAttributeMultiprocessorCount, dev);
    hipOccupancyMaxActiveBlocksPerMultiprocessor(&per_cu, mega_kernel, 256, 0);
    if (per_cu > 2) per_cu = 2;
    grid_blocks = cus * per_cu;
  }
  void* args[] = {&p};
  hipError_t e = hipLaunchCooperativeKernel((void*)mega_kernel, dim3(grid_blocks), dim3(256), args, 0, stream);
  if (e != hipSuccess) fprintf(stderr, "cooperative launch failed: %s (grid %d)\n", hipGetErrorString(e), grid_blocks);
#endif
}
```

```cpp
#include <hip/hip_runtime.h>
#include <hip/hip_bf16.h>
#include <hip/hip_cooperative_groups.h>
#include <cstdio>
namespace cg = cooperative_groups;

#ifndef MULTI
#define MULTI 0
#endif

typedef unsigned short u16;
using bf16x8 = __attribute__((ext_vector_type(8))) short;
using f32x4 = __attribute__((ext_vector_type(4))) float;

constexpr int T_ = 32768;
constexpr int S_ = 16384;
constexpr int D_ = 2048;
constexpr int SSM_L = 128;
constexpr int SSM_NC = S_ / SSM_L;
constexpr float ALPHA = 1.189207115002721f;
constexpr size_t MB = 1024ull * 1024ull;

constexpr size_t O_WIN = 0 * MB, O_WGLU = 32 * MB, O_WAU = 34 * MB, O_WSU = 38 * MB, O_WOUT = 42 * MB,
                 O_WPQ = 50 * MB, O_WPG = 58 * MB, O_WPIN = 66 * MB, O_SK = 67 * MB, O_BCAT = 67 * MB + 512 * 1024,
                 O_CCAT = 68 * MB, O_LAM = 68 * MB + 256 * 1024, O_UB = 70 * MB, O_VB = 134 * MB, O_SBUF = 198 * MB,
                 O_H = 206 * MB, O_Q = 334 * MB, O_K = 398 * MB, O_VT = 462 * MB, O_U2 = 526 * MB, O_G = 590 * MB,
                 O_YA = 846 * MB, O_YS = 910 * MB, O_PB = 974 * MB;
constexpr size_t O_YG = O_VT, O_MERGED = O_Q, O_PRE1 = O_G, O_PQ = O_Q, O_SG = O_VT, O_E = O_G,
                 O_HV = O_G + 128 * MB, O_HI = O_G + 160 * MB, O_EXP = O_G + 192 * MB, O_GATE = O_G + 208 * MB;

struct Params {
  const float *x, *p, *ln_in_g, *ln_in_b, *w_in, *rel_bias, *lam_re, *lam_im, *log_dt, *b_re, *b_im, *c_re, *c_im,
      *ssm_d, *w_glu, *w_au, *w_su, *w_out, *ln1_g, *ln1_b, *w_pq, *sub_keys, *peer_u, *peer_v, *ple_w_in, *ple_g,
      *ple_w_gate, *ln2_g, *ln2_b;
  float* out;
  char* ws;
};

__device__ __forceinline__ u16 f2bf(float f) {
  unsigned u = __float_as_uint(f);
  u += 0x7fffu + ((u >> 16) & 1u);
  return (u16)(u >> 16);
}
__device__ __forceinline__ float bf2f(u16 h) { return __uint_as_float(((unsigned)h) << 16); }
__device__ __forceinline__ unsigned pack2(float a, float b) { return (unsigned)f2bf(a) | ((unsigned)f2bf(b) << 16); }
__device__ __forceinline__ float lo2f(unsigned u) { return __uint_as_float(u << 16); }
__device__ __forceinline__ float hi2f(unsigned u) { return __uint_as_float(u & 0xffff0000u); }
__device__ __forceinline__ float sigmoidf_(float x) { return 1.f / (1.f + __expf(-x)); }
__device__ __forceinline__ float gelu_tanh(float x) {
  float u = 0.7978845608028654f * (x + 0.044715f * x * x * x);
  float t = 1.f - 2.f / (1.f + __expf(2.f * u));
  return 0.5f * x * (1.f + t);
}
__device__ __forceinline__ float wave_sum(float v) {
#pragma unroll
  for (int o = 32; o >= 1; o >>= 1) v += __shfl_xor(v, o);
  return v;
}
__device__ __forceinline__ void store_bf4(u16* dst, float a, float b, float c, float d) {
  uint2 v; v.x = pack2(a, b); v.y = pack2(c, d);
  *(uint2*)dst = v;
}

__device__ __forceinline__ void gemm_kloop(f32x4 (&acc)[4][4], const u16* __restrict__ A, int lda,
                                           const u16* __restrict__ Bt, int ldb, int K, u16* lds) {
  const int tid = threadIdx.x, lane = tid & 63, wid = tid >> 6, wm = wid >> 1, wn = wid & 1;
  const int lr = lane & 15, lq = lane >> 4;
  const int nk = K >> 6;
  const int srow = tid >> 3, sc = (tid & 7) ^ (srow & 7);
  const u16* ga = A + (size_t)srow * lda + sc * 8;
  const u16* gb = Bt + (size_t)srow * ldb + sc * 8;
  u16* lw = lds + tid * 8;
#pragma unroll
  for (int i = 0; i < 4; ++i) {
    __builtin_amdgcn_global_load_lds((const unsigned*)(ga + (size_t)(32 * i) * lda), (unsigned*)(lw + i * 2048), 16, 0, 0);
    __builtin_amdgcn_global_load_lds((const unsigned*)(gb + (size_t)(32 * i) * ldb), (unsigned*)(lw + 8192 + i * 2048), 16, 0, 0);
  }
  __syncthreads();
  const int swz = lr & 7;
  for (int kt = 0; kt < nk; ++kt) {
    if (kt + 1 < nk) {
      u16* lw2 = lw + ((kt + 1) & 1) * 16384;
#pragma unroll
      for (int i = 0; i < 4; ++i) {
        __builtin_amdgcn_global_load_lds((const unsigned*)(ga + (size_t)(32 * i) * lda + (kt + 1) * 64), (unsigned*)(lw2 + i * 2048), 16, 0, 0);
        __builtin_amdgcn_global_load_lds((const unsigned*)(gb + (size_t)(32 * i) * ldb + (kt + 1) * 64), (unsigned*)(lw2 + 8192 + i * 2048), 16, 0, 0);
      }
    }
    const u16* sa = lds + (kt & 1) * 16384;
    const u16* sb = sa + 8192;
#pragma unroll
    for (int ks = 0; ks < 2; ++ks) {
      bf16x8 af[4], bfr[4];
      const int co = ((ks * 4 + lq) ^ swz) * 8;
#pragma unroll
      for (int mi = 0; mi < 4; ++mi) af[mi] = *(const bf16x8*)(sa + (wm * 64 + mi * 16 + lr) * 64 + co);
#pragma unroll
      for (int ni = 0; ni < 4; ++ni) bfr[ni] = *(const bf16x8*)(sb + (wn * 64 + ni * 16 + lr) * 64 + co);
#pragma unroll
      for (int mi = 0; mi < 4; ++mi)
#pragma unroll
        for (int ni = 0; ni < 4; ++ni)
          acc[mi][ni] = __builtin_amdgcn_mfma_f32_16x16x32_bf16(bfr[ni], af[mi], acc[mi][ni], 0, 0, 0);
    }
    __syncthreads();
  }
}

#define ZERO_ACC(acc)                                   \
  _Pragma("unroll") for (int _a = 0; _a < 4; ++_a)      \
  _Pragma("unroll") for (int _b = 0; _b < 4; ++_b) acc[_a][_b] = f32x4{0.f, 0.f, 0.f, 0.f};

#define EPI_COORDS                                                             \
  const int lane = threadIdx.x & 63, wid = threadIdx.x >> 6, wm = wid >> 1, wn = wid & 1; \
  const int lr = lane & 15, lq = lane >> 4;

__device__ void tconv_tile(const float* __restrict__ W, int K, int N, u16* __restrict__ Wt, int tile, float* lds) {
  const int tid = threadIdx.x;
  const int ntn = N >> 6;
  const int kt = tile / ntn, nt = tile % ntn;
  const int c4 = (tid & 15) * 4;
#pragma unroll
  for (int i = 0; i < 4; ++i) {
    int r = (tid >> 4) + 16 * i;
    float4 v = *(const float4*)(W + (size_t)(kt * 64 + r) * N + nt * 64 + c4);
    lds[r * 65 + c4 + 0] = v.x; lds[r * 65 + c4 + 1] = v.y; lds[r * 65 + c4 + 2] = v.z; lds[r * 65 + c4 + 3] = v.w;
  }
  __syncthreads();
  const int n = tid >> 2, kseg = (tid & 3) * 16;
  unsigned o[8];
#pragma unroll
  for (int j = 0; j < 8; ++j) o[j] = pack2(lds[(kseg + 2 * j) * 65 + n], lds[(kseg + 2 * j + 1) * 65 + n]);
  u16* dst = Wt + (size_t)(nt * 64 + n) * K + kt * 64 + kseg;
  *(uint4*)dst = uint4{o[0], o[1], o[2], o[3]};
  *(uint4*)(dst + 8) = uint4{o[4], o[5], o[6], o[7]};
  __syncthreads();
}

__device__ void conv_linear(const float* __restrict__ src, u16* __restrict__ dst, size_t n8, size_t gtid, size_t nth) {
  for (size_t i = gtid; i < n8; i += nth) {
    float4 a = *(const float4*)(src + i * 8), b = *(const float4*)(src + i * 8 + 4);
    *(uint4*)(dst + i * 8) = uint4{pack2(a.x, a.y), pack2(a.z, a.w), pack2(b.x, b.y), pack2(b.z, b.w)};
  }
}

typedef float f32x2 __attribute__((ext_vector_type(2)));
constexpr size_t O_U8 = O_UB, O_V8 = O_UB + 32 * MB, O_RSU = O_VB, O_RSV = O_VB + 64 * 1024;
__device__ void conv_fp8_rows(const float* __restrict__ src, unsigned char* __restrict__ dst, float* __restrict__ rscale,
                              int gw, int nw) {
  const int lane = threadIdx.x & 63;
  for (int row = gw; row < 16384; row += nw) {
    const float* r = src + (size_t)row * D_;
    float4 v[8];
#pragma unroll
    for (int q = 0; q < 8; ++q) v[q] = *(const float4*)(r + q * 256 + lane * 4);
    float am = 0.f;
#pragma unroll
    for (int q = 0; q < 8; ++q) am = fmaxf(am, fmaxf(fmaxf(fabsf(v[q].x), fabsf(v[q].y)), fmaxf(fabsf(v[q].z), fabsf(v[q].w))));
#pragma unroll
    for (int o = 32; o >= 1; o >>= 1) am = fmaxf(am, __shfl_xor(am, o));
    const float sc = am > 0.f ? 416.f / am : 1.f;
#pragma unroll
    for (int q = 0; q < 8; ++q) {
      int w = 0;
      w = __builtin_amdgcn_cvt_pk_fp8_f32(v[q].x * sc, v[q].y * sc, w, false);
      w = __builtin_amdgcn_cvt_pk_fp8_f32(v[q].z * sc, v[q].w * sc, w, true);
      *(int*)(dst + (size_t)row * D_ + q * 256 + lane * 4) = w;
    }
    if (lane == 0) rscale[row] = am > 0.f ? am / 416.f : 1.f;
  }
}

__device__ void ln_rows(const float* __restrict__ src, const float* __restrict__ g, const float* __restrict__ b,
                        u16* __restrict__ dst, int gw, int nw) {
  const int lane = threadIdx.x & 63;
  for (int row = gw; row < T_; row += nw) {
    const float* r = src + (size_t)row * D_;
    float4 v[8];
#pragma unroll
    for (int q = 0; q < 8; ++q) v[q] = *(const float4*)(r + q * 256 + lane * 4);
    float s = 0.f;
#pragma unroll
    for (int q = 0; q < 8; ++q) s += v[q].x + v[q].y + v[q].z + v[q].w;
    float mu = wave_sum(s) * (1.f / D_);
    float ss = 0.f;
#pragma unroll
    for (int q = 0; q < 8; ++q) {
      float a = v[q].x - mu, bb = v[q].y - mu, c = v[q].z - mu, d = v[q].w - mu;
      ss += a * a + bb * bb + c * c + d * d;
    }
    float rstd = rsqrtf(wave_sum(ss) * (1.f / D_) + 1e-5f);
#pragma unroll
    for (int q = 0; q < 8; ++q) {
      int col = q * 256 + lane * 4;
      float4 gg = *(const float4*)(g + col), bb = *(const float4*)(b + col);
      store_bf4(dst + (size_t)row * D_ + col, (v[q].x - mu) * rstd * gg.x + bb.x, (v[q].y - mu) * rstd * gg.y + bb.y,
                (v[q].z - mu) * rstd * gg.z + bb.z, (v[q].w - mu) * rstd * gg.w + bb.w);
    }
  }
}

__device__ __forceinline__ void dsincos(double x, double& s, double& c) {
  double q = rint(x * 0.63661977236758134308);
  double r = x - q * 1.57079632679489661923;
  double r2 = r * r;
  double sp = r * (1.0 + r2 * (-1.0 / 6 + r2 * (1.0 / 120 + r2 * (-1.0 / 5040 + r2 * (1.0 / 362880 + r2 * (-1.0 / 39916800 + r2 * (1.0 / 6227020800.0)))))));
  double cp = 1.0 + r2 * (-0.5 + r2 * (1.0 / 24 + r2 * (-1.0 / 720 + r2 * (1.0 / 40320 + r2 * (-1.0 / 3628800 + r2 * (1.0 / 479001600.0 + r2 * (-1.0 / 87178291200.0)))))));
  int qi = ((int)q) & 3;
  if (qi == 0) { s = sp; c = cp; }
  else if (qi == 1) { s = cp; c = -sp; }
  else if (qi == 2) { s = -sp; c = -cp; }
  else { s = -cp; c = sp; }
}

__device__ void ssm_consts(const Params& P, int i) {
  const int g = i >> 6, p = i & 63;
  double lr = P.lam_re[g * 64 + p], li = P.lam_im[g * 64 + p];
  double dt = exp((double)P.log_dt[g]);
  double mag = exp(lr * dt);
  double sn, cs;
  dsincos(li * dt, sn, cs);
  double ar = mag * cs, ai = mag * sn;
  double nr = ar - 1.0, ni = ai, den = lr * lr + li * li;
  double fr = (nr * lr + ni * li) / den, fi = (ni * lr - nr * li) / den;
  u16* bcat = (u16*)(P.ws + O_BCAT);
  u16* ccat = (u16*)(P.ws + O_CCAT);
  float* lam = (float*)(P.ws + O_LAM);
  for (int h = 0; h < 16; ++h) {
    double br = P.b_re[(g * 64 + p) * 16 + h], bi = P.b_im[(g * 64 + p) * 16 + h];
    bcat[(g * 128 + p) * 32 + h] = f2bf((float)(fr * br - fi * bi));
    bcat[(g * 128 + 64 + p) * 32 + h] = f2bf((float)(fr * bi + fi * br));
    bcat[(g * 128 + p) * 32 + 16 + h] = 0;
    bcat[(g * 128 + 64 + p) * 32 + 16 + h] = 0;
    ccat[(g * 16 + h) * 128 + p] = f2bf(P.c_re[(g * 16 + h) * 64 + p]);
    ccat[(g * 16 + h) * 128 + 64 + p] = f2bf(-P.c_im[(g * 16 + h) * 64 + p]);
  }
  double pr = ar, pi = ai;
  for (int k = 0; k < 10; ++k) {
    double t = pr * pr - pi * pi;
    pi = 2.0 * pr * pi;
    pr = t;
  }
  lam[0 * 4096 + i] = (float)ar;
  lam[1 * 4096 + i] = (float)ai;
  lam[2 * 4096 + i] = (float)pr;
  lam[3 * 4096 + i] = (float)pi;
}

__device__ void phase0(const Params& P, int bid, int nb, u16* lds) {
  const size_t gtid = (size_t)bid * 256 + threadIdx.x, nth = (size_t)nb * 256;
#define TCONV(wp, KK, NN, OFF) \
  for (int t = bid; t < ((KK) >> 6) * ((NN) >> 6); t += nb) tconv_tile(wp, KK, NN, (u16*)(P.ws + OFF), t, (float*)lds);
  TCONV(P.w_in, 2048, 8192, O_WIN)
  TCONV(P.w_glu, 1024, 1024, O_WGLU)
  TCONV(P.w_au, 1024, 2048, O_WAU)
  TCONV(P.w_su, 1024, 2048, O_WSU)
  TCONV(P.w_out, 2048, 2048, O_WOUT)
  TCONV(P.w_pq, 2048, 2048, O_WPQ)
  TCONV(P.ple_w_gate, 2048, 2048, O_WPG)
  TCONV(P.ple_w_in, 256, 2048, O_WPIN)
  conv_fp8_rows(P.peer_u, (unsigned char*)(P.ws + O_U8), (float*)(P.ws + O_RSU), bid * 4 + (threadIdx.x >> 6), nb * 4);
  conv_fp8_rows(P.peer_v, (unsigned char*)(P.ws + O_V8), (float*)(P.ws + O_RSV), bid * 4 + (threadIdx.x >> 6), nb * 4);
  conv_linear(P.sub_keys, (u16*)(P.ws + O_SK), (size_t)16 * 128 * 128 / 8, gtid, nth);
  conv_linear(P.p, (u16*)(P.ws + O_PB), (size_t)T_ * 256 / 8, gtid, nth);
  for (size_t i = gtid; i < 4096; i += nth) ssm_consts(P, (int)i);
  ln_rows(P.x, P.ln_in_g, P.ln_in_b, (u16*)(P.ws + O_H), bid * 4 + (threadIdx.x >> 6), nb * 4);
}

__device__ void phase1(const Params& P, int bid, int nb, u16* lds) {
  const u16* H = (const u16*)(P.ws + O_H);
  const u16* W = (const u16*)(P.ws + O_WIN);
  u16* Q = (u16*)(P.ws + O_Q);
  u16* Kb = (u16*)(P.ws + O_K);
  u16* Vt = (u16*)(P.ws + O_VT);
  u16* U2 = (u16*)(P.ws + O_U2);
  u16* G = (u16*)(P.ws + O_G);
  EPI_COORDS
  const int ntiles = 256 * 64;
  for (int t = bid; t < ntiles; t += nb) {
    const int mt = t >> 6, nt = t & 63;
    f32x4 acc[4][4];
    ZERO_ACC(acc)
    gemm_kloop(acc, H + (size_t)mt * 128 * D_, D_, W + (size_t)nt * 128 * D_, D_, D_, lds);
    const int region = nt >> 3;
#pragma unroll
    for (int mi = 0; mi < 4; ++mi) {
      const int m = mt * 128 + wm * 64 + mi * 16 + lr;
#pragma unroll
      for (int ni = 0; ni < 4; ++ni) {
        const int n = nt * 128 + wn * 64 + ni * 16 + lq * 4;
        f32x4 a = acc[mi][ni];
        if (region == 0) {
          const float sc = 0.08838834764831845f;
          store_bf4(Q + (size_t)m * 1024 + n, a[0] * sc, a[1] * sc, a[2] * sc, a[3] * sc);
        } else if (region == 1) {
          store_bf4(Kb + (size_t)m * 1024 + (n - 1024), a[0], a[1], a[2], a[3]);
        } else if (region == 2) {
          const int b = m >> 14, tt = m & (S_ - 1);
#pragma unroll
          for (int j = 0; j < 4; ++j) Vt[((size_t)(b * 1024 + (n - 2048 + j))) * S_ + tt] = f2bf(a[j]);
        } else if (region == 3) {
          store_bf4(U2 + (size_t)m * 1024 + (n - 3072), a[0], a[1], a[2], a[3]);
        } else {
          store_bf4(G + (size_t)m * 4096 + (n - 4096), sigmoidf_(a[0]), sigmoidf_(a[1]), sigmoidf_(a[2]), sigmoidf_(a[3]));
        }
      }
    }
  }
}

__device__ void attn_item(const Params& P, int item, u16* lds) {
  const int c = item & 255, hd = (item >> 8) & 7, b = item >> 11;
  const int tid = threadIdx.x, lane = tid & 63, w = tid >> 6, lr = lane & 15, lq = lane >> 4;
  u16* Ks = lds;
  u16* Vs = lds + 64 * 136;
  float* bs = (float*)(lds + 64 * 136 + 128 * 72);
  const u16* Q = (const u16*)(P.ws + O_Q);
  const u16* Kb = (const u16*)(P.ws + O_K);
  const u16* Vt = (const u16*)(P.ws + O_VT);
  u16* ya = (u16*)(P.ws + O_YA);
  __syncthreads();
  for (int i = tid; i < 257; i += 256) bs[i] = P.rel_bias[hd * 257 + i];
  bf16x8 qf[4];
  {
    const u16* qp = Q + (size_t)(b * S_ + c * 64 + w * 16 + lr) * 1024 + hd * 128 + lq * 8;
#pragma unroll
    for (int ks = 0; ks < 4; ++ks) qf[ks] = *(const bf16x8*)(qp + ks * 32);
  }
  f32x4 oacc[8];
#pragma unroll
  for (int d = 0; d < 8; ++d) oacc[d] = f32x4{0.f, 0.f, 0.f, 0.f};
  float m_run = -1e30f, lsum = 0.f;
  const int i0 = (c < 8) ? (8 - c) : 0;
  const int qi = w * 16 + lr;
#define KV_ADDR_K(r, kc_) (Kb + (size_t)(b * S_ + (kc_) * 64 + ((tid + 256 * (r)) >> 4)) * 1024 + hd * 128 + ((tid + 256 * (r)) & 15) * 8)
#define KV_ADDR_V(r, kc_) (Vt + ((size_t)(b * 1024 + hd * 128 + ((tid + 256 * (r)) >> 3))) * S_ + (kc_) * 64 + ((tid + 256 * (r)) & 7) * 8)
#define KV_LOAD(kc_)                                                                   \
  kr0 = *(const uint4*)KV_ADDR_K(0, kc_); kr1 = *(const uint4*)KV_ADDR_K(1, kc_);     \
  kr2 = *(const uint4*)KV_ADDR_K(2, kc_); kr3 = *(const uint4*)KV_ADDR_K(3, kc_);     \
  vr0 = *(const uint4*)KV_ADDR_V(0, kc_); vr1 = *(const uint4*)KV_ADDR_V(1, kc_);     \
  vr2 = *(const uint4*)KV_ADDR_V(2, kc_); vr3 = *(const uint4*)KV_ADDR_V(3, kc_);
#define KS_W(r) (Ks + ((tid + 256 * (r)) >> 4) * 136 + ((tid + 256 * (r)) & 15) * 8)
#define VS_W(r) (Vs + ((tid + 256 * (r)) >> 3) * 72 + ((tid + 256 * (r)) & 7) * 8)
  uint4 kr0, kr1, kr2, kr3, vr0, vr1, vr2, vr3;
  KV_LOAD(c - 8 + i0)
  for (int i = i0; i <= 8; ++i) {
    __syncthreads();
    *(uint4*)KS_W(0) = kr0; *(uint4*)KS_W(1) = kr1; *(uint4*)KS_W(2) = kr2; *(uint4*)KS_W(3) = kr3;
    *(uint4*)VS_W(0) = vr0; *(uint4*)VS_W(1) = vr1; *(uint4*)VS_W(2) = vr2; *(uint4*)VS_W(3) = vr3;
    __syncthreads();
    if (i < 8) { KV_LOAD(c - 8 + i + 1) }
    f32x4 sacc[4];
#pragma unroll
    for (int kt = 0; kt < 4; ++kt) {
      sacc[kt] = f32x4{0.f, 0.f, 0.f, 0.f};
#pragma unroll
      for (int ks = 0; ks < 4; ++ks) {
        bf16x8 kf = *(const bf16x8*)(Ks + (kt * 16 + lr) * 136 + ks * 32 + lq * 8);
        sacc[kt] = __builtin_amdgcn_mfma_f32_16x16x32_bf16(kf, qf[ks], sacc[kt], 0, 0, 0);
      }
    }
    float tmax = -1e30f;
#pragma unroll
    for (int kt = 0; kt < 4; ++kt)
#pragma unroll
      for (int j = 0; j < 4; ++j) {
        int kb = i * 64 + kt * 16 + lq * 4 + j;
        int rel = 512 + qi - kb;
        rel = min(max(rel, -128), 128) + 128;
        float s = sacc[kt][j] + bs[rel];
        sacc[kt][j] = s;
        tmax = fmaxf(tmax, s);
      }
    tmax = fmaxf(tmax, __shfl_xor(tmax, 16));
    tmax = fmaxf(tmax, __shfl_xor(tmax, 32));
    const float m_new = fmaxf(m_run, tmax);
    const float corr = __expf(m_run - m_new);
    m_run = m_new;
    float ps = 0.f;
#pragma unroll
    for (int kt = 0; kt < 4; ++kt)
#pragma unroll
      for (int j = 0; j < 4; ++j) {
        float pv = __expf(sacc[kt][j] - m_new);
        sacc[kt][j] = pv;
        ps += pv;
      }
    lsum = lsum * corr + ps;
#pragma unroll
    for (int d = 0; d < 8; ++d) {
      oacc[d][0] *= corr; oacc[d][1] *= corr; oacc[d][2] *= corr; oacc[d][3] *= corr;
    }
#pragma unroll
    for (int kk = 0; kk < 2; ++kk) {
      union { bf16x8 v; unsigned u[4]; } pf;
      pf.u[0] = pack2(sacc[2 * kk][0], sacc[2 * kk][1]);
      pf.u[1] = pack2(sacc[2 * kk][2], sacc[2 * kk][3]);
      pf.u[2] = pack2(sacc[2 * kk + 1][0], sacc[2 * kk + 1][1]);
      pf.u[3] = pack2(sacc[2 * kk + 1][2], sacc[2 * kk + 1][3]);
#pragma unroll
      for (int d = 0; d < 8; ++d) {
        union { bf16x8 v; uint2 h[2]; } vf;
        vf.h[0] = *(const uint2*)(Vs + (d * 16 + lr) * 72 + kk * 32 + lq * 4);
        vf.h[1] = *(const uint2*)(Vs + (d * 16 + lr) * 72 + kk * 32 + 16 + lq * 4);
        oacc[d] = __builtin_amdgcn_mfma_f32_16x16x32_bf16(vf.v, pf.v, oacc[d], 0, 0, 0);
      }
    }
  }
  lsum += __shfl_xor(lsum, 16);
  lsum += __shfl_xor(lsum, 32);
  const float inv = 1.f / lsum;
  u16* op = ya + (size_t)(b * S_ + c * 64 + w * 16 + lr) * 1024 + hd * 128 + lq * 4;
#pragma unroll
  for (int d = 0; d < 8; ++d) store_bf4(op + d * 16, oacc[d][0] * inv, oacc[d][1] * inv, oacc[d][2] * inv, oacc[d][3] * inv);
}

template <int PASS>
__device__ void ssm_item(const Params& P, int item, char* ldsw) {
  const int sc = item & 15, seq = item >> 4, g = seq & 63, b = seq >> 6;
  const int lane = threadIdx.x & 63, lr = lane & 15, lq = lane >> 4;
  float* BuS = (float*)ldsw;
  u16* Hs = (u16*)(ldsw + 8192);
  const u16* bcat = (const u16*)(P.ws + O_BCAT);
  const u16* ccat = (const u16*)(P.ws + O_CCAT);
  const float* lam = (const float*)(P.ws + O_LAM);
  const u16* U2 = (const u16*)(P.ws + O_U2);
  float* Sbuf = (float*)(P.ws + O_SBUF);
  u16* ys = (u16*)(P.ws + O_YS);
  const float ar = lam[g * 64 + lane], ai = lam[4096 + g * 64 + lane];
  bf16x8 bfrag[8];
#pragma unroll
  for (int nt = 0; nt < 8; ++nt) bfrag[nt] = *(const bf16x8*)(bcat + (g * 128 + nt * 16 + lr) * 32 + lq * 8);
  float sr = 0.f, si = 0.f;
  bf16x8 cfrag[4];
  float dsk[4];
  if (PASS == 2) {
#pragma unroll
    for (int ks = 0; ks < 4; ++ks) cfrag[ks] = *(const bf16x8*)(ccat + (g * 16 + lr) * 128 + ks * 32 + lq * 8);
#pragma unroll
    for (int j = 0; j < 4; ++j) dsk[j] = P.ssm_d[g * 16 + lq * 4 + j];
    const float aLr = lam[2 * 4096 + g * 64 + lane], aLi = lam[3 * 4096 + g * 64 + lane];
    const float* Sb = Sbuf + (size_t)seq * 16 * 128;
#pragma unroll 4
    for (int cc = 0; cc < sc; ++cc) {
      float xr = Sb[cc * 128 + lane], xi = Sb[cc * 128 + 64 + lane];
      float nr = fmaf(aLr, sr, fmaf(-aLi, si, xr));
      float ni = fmaf(aLr, si, fmaf(aLi, sr, xi));
      sr = nr; si = ni;
    }
  }
#pragma unroll 1
  for (int ci = 0; ci < 8; ++ci) {
  const size_t tok_base = (size_t)b * S_ + (size_t)(sc * 8 + ci) * SSM_L;
  uint4 upre[SSM_L / 16];
  uint2 uepi[SSM_L / 16];
#pragma unroll
  for (int sub = 0; sub < SSM_L / 16; ++sub) {
    upre[sub] = uint4{0u, 0u, 0u, 0u};
    if (lq < 2) upre[sub] = *(const uint4*)(U2 + (tok_base + sub * 16 + lr) * 1024 + g * 16 + lq * 8);
    if (PASS == 2) uepi[sub] = *(const uint2*)(U2 + (tok_base + sub * 16 + lr) * 1024 + g * 16 + lq * 4);
  }
#pragma unroll
  for (int sub = 0; sub < SSM_L / 16; ++sub) {
    const size_t tok0 = tok_base + sub * 16;
    union { bf16x8 v; uint4 u; } uf;
    uf.u = upre[sub];
#pragma unroll
    for (int nt = 0; nt < 8; ++nt) {
      f32x4 d = __builtin_amdgcn_mfma_f32_16x16x32_bf16(bfrag[nt], uf.v, f32x4{0.f, 0.f, 0.f, 0.f}, 0, 0, 0);
      *(f32x4*)(BuS + lr * 128 + nt * 16 + lq * 4) = d;
    }
    asm volatile("s_waitcnt lgkmcnt(0)" ::: "memory");
#pragma unroll
    for (int t = 0; t < 16; ++t) {
      float bur = BuS[t * 128 + lane], bui = BuS[t * 128 + 64 + lane];
      float nr = fmaf(ar, sr, fmaf(-ai, si, bur));
      float ni = fmaf(ar, si, fmaf(ai, sr, bui));
      sr = nr; si = ni;
      if (PASS == 2) {
        Hs[t * 136 + lane] = f2bf(sr);
        Hs[t * 136 + 64 + lane] = f2bf(si);
      }
    }
    asm volatile("s_waitcnt lgkmcnt(0)" ::: "memory");
    if (PASS == 2) {
      f32x4 yacc = f32x4{0.f, 0.f, 0.f, 0.f};
#pragma unroll
      for (int ks = 0; ks < 4; ++ks) {
        bf16x8 hf = *(const bf16x8*)(Hs + lr * 136 + ks * 32 + lq * 8);
        yacc = __builtin_amdgcn_mfma_f32_16x16x32_bf16(cfrag[ks], hf, yacc, 0, 0, 0);
      }
      const uint2 uu = uepi[sub];
      float y0 = gelu_tanh(yacc[0] + dsk[0] * lo2f(uu.x));
      float y1 = gelu_tanh(yacc[1] + dsk[1] * hi2f(uu.x));
      float y2 = gelu_tanh(yacc[2] + dsk[2] * lo2f(uu.y));
      float y3 = gelu_tanh(yacc[3] + dsk[3] * hi2f(uu.y));
      store_bf4(ys + (tok0 + lr) * 1024 + g * 16 + lq * 4, y0, y1, y2, y3);
      asm volatile("s_waitcnt lgkmcnt(0)" ::: "memory");
    }
  }
  }
  if (PASS == 1) {
    Sbuf[((size_t)seq * 16 + sc) * 128 + lane] = sr;
    Sbuf[((size_t)seq * 16 + sc) * 128 + 64 + lane] = si;
  }
}

__device__ void phase2(const Params& P, int bid, int nb, u16* lds) {
  for (int it = bid; it < 4096 + 512; it += nb) {
    if (it < 4096) {
      attn_item(P, it, lds);
    } else {
      __syncthreads();
      const int w = threadIdx.x >> 6;
      ssm_item<1>(P, (it - 4096) * 4 + w, (char*)lds + w * 12544);
    }
  }
}
__device__ void phase3(const Params& P, int bid, int nb, u16* lds) {
  const int w = threadIdx.x >> 6;
  for (int it = bid; it < 512; it += nb) ssm_item<2>(P, it * 4 + w, (char*)lds + w * 12544);
}

__device__ void phase4(const Params& P, int bid, int nb, u16* lds) {
  const u16* ys = (const u16*)(P.ws + O_YS);
  const u16* W = (const u16*)(P.ws + O_WGLU);
  u16* yg = (u16*)(P.ws + O_YG);
  EPI_COORDS
  for (int t = bid; t < 256 * 8; t += nb) {
    const int mt = t >> 3, nt = t & 7;
    f32x4 acc[4][4];
    ZERO_ACC(acc)
    gemm_kloop(acc, ys + (size_t)mt * 128 * 1024, 1024, W + (size_t)nt * 128 * 1024, 1024, 1024, lds);
#pragma unroll
    for (int mi = 0; mi < 4; ++mi) {
      const int m = mt * 128 + wm * 64 + mi * 16 + lr;
#pragma unroll
      for (int ni = 0; ni < 4; ++ni) {
        const int n = nt * 128 + wn * 64 + ni * 16 + lq * 4;
        uint2 yy = *(const uint2*)(ys + (size_t)m * 1024 + n);
        f32x4 a = acc[mi][ni];
        store_bf4(yg + (size_t)m * 1024 + n, lo2f(yy.x) * sigmoidf_(a[0]), hi2f(yy.x) * sigmoidf_(a[1]),
                  lo2f(yy.y) * sigmoidf_(a[2]), hi2f(yy.y) * sigmoidf_(a[3]));
      }
    }
  }
}

__device__ void phase5(const Params& P, int bid, int nb, u16* lds) {
  const u16* ya = (const u16*)(P.ws + O_YA);
  const u16* yg = (const u16*)(P.ws + O_YG);
  const u16* Wa = (const u16*)(P.ws + O_WAU);
  const u16* Wsu = (const u16*)(P.ws + O_WSU);
  const u16* G = (const u16*)(P.ws + O_G);
  u16* mg = (u16*)(P.ws + O_MERGED);
  EPI_COORDS
  for (int t = bid; t < 256 * 16; t += nb) {
    const int mt = t >> 4, nt = t & 15;
    f32x4 acc[4][4];
    ZERO_ACC(acc)
    gemm_kloop(acc, ya + (size_t)mt * 128 * 1024, 1024, Wa + (size_t)nt * 128 * 1024, 1024, 1024, lds);
#pragma unroll
    for (int mi = 0; mi < 4; ++mi) {
      const int m = mt * 128 + wm * 64 + mi * 16 + lr;
#pragma unroll
      for (int ni = 0; ni < 4; ++ni) {
        const int n = nt * 128 + wn * 64 + ni * 16 + lq * 4;
        uint2 ga = *(const uint2*)(G + (size_t)m * 4096 + n);
        uint2 gs = *(const uint2*)(G + (size_t)m * 4096 + 2048 + n);
        acc[mi][ni][0] *= lo2f(ga.x) / fmaxf(lo2f(gs.x), 1e-30f);
        acc[mi][ni][1] *= hi2f(ga.x) / fmaxf(hi2f(gs.x), 1e-30f);
        acc[mi][ni][2] *= lo2f(ga.y) / fmaxf(lo2f(gs.y), 1e-30f);
        acc[mi][ni][3] *= hi2f(ga.y) / fmaxf(hi2f(gs.y), 1e-30f);
      }
    }
    gemm_kloop(acc, yg + (size_t)mt * 128 * 1024, 1024, Wsu + (size_t)nt * 128 * 1024, 1024, 1024, lds);
#pragma unroll
    for (int mi = 0; mi < 4; ++mi) {
      const int m = mt * 128 + wm * 64 + mi * 16 + lr;
#pragma unroll
      for (int ni = 0; ni < 4; ++ni) {
        const int n = nt * 128 + wn * 64 + ni * 16 + lq * 4;
        uint2 gs = *(const uint2*)(G + (size_t)m * 4096 + 2048 + n);
        f32x4 a = acc[mi][ni];
        store_bf4(mg + (size_t)m * D_ + n, a[0] * fmaxf(lo2f(gs.x), 1e-30f), a[1] * fmaxf(hi2f(gs.x), 1e-30f),
                  a[2] * fmaxf(lo2f(gs.y), 1e-30f), a[3] * fmaxf(hi2f(gs.y), 1e-30f));
      }
    }
  }
}

__device__ void phase6(const Params& P, int bid, int nb, u16* lds) {
  const u16* mg = (const u16*)(P.ws + O_MERGED);
  const u16* W = (const u16*)(P.ws + O_WOUT);
  const u16* H = (const u16*)(P.ws + O_H);
  float* pre1 = (float*)(P.ws + O_PRE1);
  EPI_COORDS
  for (int t = bid; t < 256 * 16; t += nb) {
    const int mt = t >> 4, nt = t & 15;
    f32x4 acc[4][4];
    ZERO_ACC(acc)
    gemm_kloop(acc, mg + (size_t)mt * 128 * D_, D_, W + (size_t)nt * 128 * D_, D_, D_, lds);
#pragma unroll
    for (int mi = 0; mi < 4; ++mi) {
      const int m = mt * 128 + wm * 64 + mi * 16 + lr;
#pragma unroll
      for (int ni = 0; ni < 4; ++ni) {
        const int n = nt * 128 + wn * 64 + ni * 16 + lq * 4;
        uint2 hh = *(const uint2*)(H + (size_t)m * D_ + n);
        f32x4 a = acc[mi][ni];
        float4 o;
        o.x = ALPHA * lo2f(hh.x) + a[0]; o.y = ALPHA * hi2f(hh.x) + a[1];
        o.z = ALPHA * lo2f(hh.y) + a[2]; o.w = ALPHA * hi2f(hh.y) + a[3];
        *(float4*)(pre1 + (size_t)m * D_ + n) = o;
      }
    }
  }
}

__device__ void phase8(const Params& P, int bid, int nb, u16* lds) {
  const u16* H = (const u16*)(P.ws + O_H);
  const u16* Pb = (const u16*)(P.ws + O_PB);
  u16* PQ = (u16*)(P.ws + O_PQ);
  u16* SG = (u16*)(P.ws + O_SG);
  u16* E = (u16*)(P.ws + O_E);
  EPI_COORDS
  for (int t = bid; t < 3 * 4096; t += nb) {
    const int which = t >> 12, tt = t & 4095, mt = tt >> 4, nt = tt & 15;
    f32x4 acc[4][4];
    ZERO_ACC(acc)
    u16* dst;
    if (which == 0) {
      gemm_kloop(acc, H + (size_t)mt * 128 * D_, D_, (const u16*)(P.ws + O_WPQ) + (size_t)nt * 128 * D_, D_, D_, lds);
      dst = PQ;
    } else if (which == 1) {
      gemm_kloop(acc, H + (size_t)mt * 128 * D_, D_, (const u16*)(P.ws + O_WPG) + (size_t)nt * 128 * D_, D_, D_, lds);
      dst = SG;
    } else {
      gemm_kloop(acc, Pb + (size_t)mt * 128 * 256, 256, (const u16*)(P.ws + O_WPIN) + (size_t)nt * 128 * 256, 256, 256, lds);
      dst = E;
    }
#pragma unroll
    for (int mi = 0; mi < 4; ++mi) {
      const int m = mt * 128 + wm * 64 + mi * 16 + lr;
#pragma unroll
      for (int ni = 0; ni < 4; ++ni) {
        const int n = nt * 128 + wn * 64 + ni * 16 + lq * 4;
        f32x4 a = acc[mi][ni];
        if (which == 1) { a[0] = sigmoidf_(a[0]); a[1] = sigmoidf_(a[1]); a[2] = sigmoidf_(a[2]); a[3] = sigmoidf_(a[3]); }
        store_bf4(dst + (size_t)m * D_ + n, a[0], a[1], a[2], a[3]);
      }
    }
  }
}

struct Top16 { float v[16]; int i[16]; };
__device__ __forceinline__ void top_init(Top16& t) {
#pragma unroll
  for (int k = 0; k < 16; ++k) { t.v[k] = -INFINITY; t.i[k] = 0; }
}
__device__ __forceinline__ void top_insert(Top16& t, float x, int id) {
  const bool c = x > t.v[15];
  t.v[15] = c ? x : t.v[15];
  t.i[15] = c ? id : t.i[15];
#pragma unroll
  for (int k = 15; k >= 1; --k) {
    const bool s = t.v[k] > t.v[k - 1];
    const float a = t.v[k - 1], b = t.v[k];
    const int ia = t.i[k - 1], ib = t.i[k];
    t.v[k - 1] = s ? b : a; t.v[k] = s ? a : b;
    t.i[k - 1] = s ? ib : ia; t.i[k] = s ? ia : ib;
  }
}

__device__ void phase9(const Params& P, int bid, int nb, u16* lds) {
  const u16* PQ = (const u16*)(P.ws + O_PQ);
  const u16* SK = (const u16*)(P.ws + O_SK);
  float* HV = (float*)(P.ws + O_HV);
  int* HI = (int*)(P.ws + O_HI);
  float* Sc = (float*)lds;
  EPI_COORDS
  const int tid = threadIdx.x;
  for (int t = bid; t < 256 * 16; t += nb) {
    const int mt = t >> 4, rc = t & 15;
    f32x4 acc[4][4];
    ZERO_ACC(acc)
    gemm_kloop(acc, PQ + (size_t)mt * 128 * D_ + rc * 128, D_, SK + (size_t)rc * 128 * 128, 128, 128, lds);
#pragma unroll
    for (int mi = 0; mi < 4; ++mi) {
      const int m = wm * 64 + mi * 16 + lr;
#pragma unroll
      for (int ni = 0; ni < 4; ++ni) {
        const int n = wn * 64 + ni * 16 + lq * 4;
#pragma unroll
        for (int j = 0; j < 4; ++j) Sc[m * 129 + n + j] = acc[mi][ni][j];
      }
    }
    __syncthreads();
    const int tok = tid & 127, hh = tid >> 7;
    float key[16];
#pragma unroll
    for (int j = 0; j < 16; ++j) key[j] = -INFINITY;
    {
      const float* sp = Sc + tok * 129 + hh * 64;
#pragma unroll 4
      for (int k = 0; k < 64; ++k) {
        const float x = sp[k];
        const float kk = __uint_as_float((__float_as_uint(x) & ~127u) | (unsigned)(127 - (hh * 64 + k)));
#pragma unroll
        for (int j = 15; j >= 1; --j) key[j] = __builtin_amdgcn_fmed3f(key[j - 1], key[j], kk);
        key[0] = fmaxf(key[0], kk);
      }
    }
    __syncthreads();
    float* Lv = (float*)lds;
#pragma unroll
    for (int k = 0; k < 16; ++k) Lv[tid * 17 + k] = key[k];
    __syncthreads();
    if (tid < 128) {
      int ia = 0, ib = 0;
      const float* va = Lv + tid * 17; const float* vb = Lv + (tid + 128) * 17;
      float* ov = HV + ((size_t)(mt * 16 + rc) * 128 + tid) * 16;
      int* oi = HI + ((size_t)(mt * 16 + rc) * 128 + tid) * 16;
      for (int k = 0; k < 16; ++k) {
        const float a = va[ia], b = vb[ib];
        const bool ta = a >= b;
        const unsigned bits = __float_as_uint(ta ? a : b);
        ov[k] = __uint_as_float(bits & ~127u);
        oi[k] = 127 - (int)(bits & 127u);
        ia += ta ? 1 : 0; ib += ta ? 0 : 1;
      }
    }
    __syncthreads();
  }
}

__device__ void phase10(const Params& P, int bid, int nb, u16* lds) {
  int* Lx = (int*)lds + threadIdx.x * 33;
  const float* HV = (const float*)(P.ws + O_HV);
  const int* HI = (const int*)(P.ws + O_HI);
  int* EX = (int*)(P.ws + O_EXP);
  float* GT = (float*)(P.ws + O_GATE);
  for (int i_ = bid * 256 + threadIdx.x; i_ < T_ * 8; i_ += nb * 256) {
    const int r_ = (i_ >> 7) & 7, mt_ = i_ >> 10, tl_ = i_ & 127;
    const int i = (mt_ * 128 + tl_) * 8 + r_;
    const size_t h0 = ((size_t)(mt_ * 16 + r_ * 2) * 128 + tl_) * 16, h1 = h0 + 128 * 16;
    float v0[16], v1[16];
    int i0[16], i1[16];
#pragma unroll
    for (int q = 0; q < 4; ++q) {
      float4 a = *(const float4*)(HV + h0 + q * 4);
      float4 b = *(const float4*)(HV + h1 + q * 4);
      int4 c = *(const int4*)(HI + h0 + q * 4);
      int4 d = *(const int4*)(HI + h1 + q * 4);
      v0[q * 4] = a.x; v0[q * 4 + 1] = a.y; v0[q * 4 + 2] = a.z; v0[q * 4 + 3] = a.w;
      v1[q * 4] = b.x; v1[q * 4 + 1] = b.y; v1[q * 4 + 2] = b.z; v1[q * 4 + 3] = b.w;
      i0[q * 4] = c.x; i0[q * 4 + 1] = c.y; i0[q * 4 + 2] = c.z; i0[q * 4 + 3] = c.w;
      i1[q * 4] = d.x; i1[q * 4 + 1] = d.y; i1[q * 4 + 2] = d.z; i1[q * 4 + 3] = d.w;
    }
    float t[16];
#pragma unroll
    for (int j = 0; j < 16; ++j) t[j] = -INFINITY;
#pragma unroll
    for (int a = 0; a < 16; ++a)
#pragma unroll
      for (int b = 0; b < 16; ++b)
        if ((a + 1) * (b + 1) <= 16) {
          const float sv = v0[a] + v1[b];
#pragma unroll
          for (int j = 15; j >= 1; --j) t[j] = __builtin_amdgcn_fmed3f(t[j - 1], t[j], sv);
          t[0] = fmaxf(t[0], sv);
        }
    const float mx = t[0], thr = t[15];
    float sum = 0.f;
#pragma unroll
    for (int k = 0; k < 16; ++k) sum += __expf(t[k] - mx);
    const float inv = 1.f / sum;
    int cnt = 0;
#pragma unroll
    for (int a = 0; a < 16; ++a)
#pragma unroll
      for (int b = 0; b < 16; ++b)
        if ((a + 1) * (b + 1) <= 16) {
          const float sv = v0[a] + v1[b];
          if (sv >= thr && cnt < 16) {
            Lx[cnt] = i0[a] * 128 + i1[b];
            Lx[16 + cnt] = __float_as_int(__expf(sv - mx) * inv);
            ++cnt;
          }
        }
    asm volatile("s_waitcnt lgkmcnt(0)" ::: "memory");
#pragma unroll
    for (int q = 0; q < 4; ++q) {
      *(int4*)(EX + (size_t)i * 16 + q * 4) = int4{Lx[q * 4], Lx[q * 4 + 1], Lx[q * 4 + 2], Lx[q * 4 + 3]};
      *(float4*)(GT + (size_t)i * 16 + q * 4) =
          float4{__int_as_float(Lx[16 + q * 4]), __int_as_float(Lx[16 + q * 4 + 1]), __int_as_float(Lx[16 + q * 4 + 2]),
                 __int_as_float(Lx[16 + q * 4 + 3])};
    }
    asm volatile("s_waitcnt lgkmcnt(0)" ::: "memory");
  }
}

__device__ __forceinline__ void unpack8(uint4 u, float* f) {
  f[0] = lo2f(u.x); f[1] = hi2f(u.x); f[2] = lo2f(u.y); f[3] = hi2f(u.y);
  f[4] = lo2f(u.z); f[5] = hi2f(u.z); f[6] = lo2f(u.w); f[7] = hi2f(u.w);
}
__device__ __forceinline__ void dec16(uint4 u, float* f) {
  f32x2 a;
  a = __builtin_amdgcn_cvt_pk_f32_fp8((int)u.x, false); f[0] = a.x; f[1] = a.y;
  a = __builtin_amdgcn_cvt_pk_f32_fp8((int)u.x, true);  f[2] = a.x; f[3] = a.y;
  a = __builtin_amdgcn_cvt_pk_f32_fp8((int)u.y, false); f[4] = a.x; f[5] = a.y;
  a = __builtin_amdgcn_cvt_pk_f32_fp8((int)u.y, true);  f[6] = a.x; f[7] = a.y;
  a = __builtin_amdgcn_cvt_pk_f32_fp8((int)u.z, false); f[8] = a.x; f[9] = a.y;
  a = __builtin_amdgcn_cvt_pk_f32_fp8((int)u.z, true);  f[10] = a.x; f[11] = a.y;
  a = __builtin_amdgcn_cvt_pk_f32_fp8((int)u.w, false); f[12] = a.x; f[13] = a.y;
  a = __builtin_amdgcn_cvt_pk_f32_fp8((int)u.w, true);  f[14] = a.x; f[15] = a.y;
}
__device__ __forceinline__ void load_row_bf16(const u16* row, int lane, float* f) {
#pragma unroll
  for (int q = 0; q < 2; ++q) {
    uint4 a = *(const uint4*)(row + q * 1024 + lane * 16);
    uint4 b = *(const uint4*)(row + q * 1024 + lane * 16 + 8);
    unpack8(a, f + q * 16);
    unpack8(b, f + q * 16 + 8);
  }
}
__device__ void phase11(const Params& P, int bid, int nb) {
  const u16* H = (const u16*)(P.ws + O_H);
  const unsigned char* U8 = (const unsigned char*)(P.ws + O_U8);
  const unsigned char* V8 = (const unsigned char*)(P.ws + O_V8);
  const float* RSU = (const float*)(P.ws + O_RSU);
  const float* RSV = (const float*)(P.ws + O_RSV);
  const u16* SG = (const u16*)(P.ws + O_SG);
  const u16* E = (const u16*)(P.ws + O_E);
  const int* EX = (const int*)(P.ws + O_EXP);
  const float* GT = (const float*)(P.ws + O_GATE);
  const int lane = threadIdx.x & 63;
  for (int tok = bid * 4 + (threadIdx.x >> 6); tok < T_; tok += nb * 4) {
    float hf[32], y[32];
    load_row_bf16(H + (size_t)tok * D_, lane, hf);
#pragma unroll
    for (int k = 0; k < 32; ++k) y[k] = 0.f;
    const int ev0 = EX[(size_t)tok * 128 + lane], ev1 = EX[(size_t)tok * 128 + 64 + lane];
    const float gv0 = GT[(size_t)tok * 128 + lane], gv1 = GT[(size_t)tok * 128 + 64 + lane];
    const float ru0 = RSU[ev0], ru1 = RSU[ev1], rv0 = RSV[ev0], rv1 = RSV[ev1];
    for (int k4 = 0; k4 < 128; k4 += 4) {
      const int src = k4 & 63;
      const bool lo = k4 < 64;
      int ee[4]; float gg[4], su[4], sv[4];
#pragma unroll
      for (int x = 0; x < 4; ++x) {
        ee[x] = __shfl(lo ? ev0 : ev1, src + x);
        gg[x] = __shfl(lo ? gv0 : gv1, src + x);
        su[x] = __shfl(lo ? ru0 : ru1, src + x);
        sv[x] = __shfl(lo ? rv0 : rv1, src + x);
      }
      uint4 uu[4][2], vv[4][2];
#pragma unroll
      for (int x = 0; x < 4; ++x)
#pragma unroll
        for (int q = 0; q < 2; ++q) {
          uu[x][q] = *(const uint4*)(U8 + (size_t)ee[x] * D_ + q * 1024 + lane * 16);
          vv[x][q] = *(const uint4*)(V8 + (size_t)ee[x] * D_ + q * 1024 + lane * 16);
        }
      float dd[4];
#pragma unroll
      for (int x = 0; x < 4; ++x) {
        float d = 0.f;
#pragma unroll
        for (int q = 0; q < 2; ++q) {
          float f[16];
          dec16(uu[x][q], f);
#pragma unroll
          for (int j = 0; j < 16; ++j) d = fmaf(f[j], hf[q * 16 + j], d);
        }
        dd[x] = d;
      }
#pragma unroll
      for (int o = 32; o >= 1; o >>= 1) {
#pragma unroll
        for (int x = 0; x < 4; ++x) dd[x] += __shfl_xor(dd[x], o);
      }
#pragma unroll
      for (int x = 0; x < 4; ++x) {
        const float w = gg[x] * gelu_tanh(dd[x] * su[x]) * sv[x];
#pragma unroll
        for (int q = 0; q < 2; ++q) {
          float f[16];
          dec16(vv[x][q], f);
#pragma unroll
          for (int j = 0; j < 16; ++j) y[q * 16 + j] = fmaf(w, f[j], y[q * 16 + j]);
        }
      }
    }
    float ef[32], sg[32];
    load_row_bf16(E + (size_t)tok * D_, lane, ef);
    load_row_bf16(SG + (size_t)tok * D_, lane, sg);
    float ss = 0.f;
#pragma unroll
    for (int k = 0; k < 32; ++k) ss += ef[k] * ef[k];
    const float rr = rsqrtf(wave_sum(ss) * (1.f / D_) + 1e-5f);
    float s1 = 0.f;
#pragma unroll
    for (int q = 0; q < 2; ++q)
#pragma unroll
      for (int j4 = 0; j4 < 4; ++j4) {
        float4 g = *(const float4*)(P.ple_g + q * 1024 + lane * 16 + j4 * 4);
        const float gq[4] = {g.x, g.y, g.z, g.w};
#pragma unroll
        for (int j = 0; j < 4; ++j) {
          const int k = q * 16 + j4 * 4 + j;
          float v = ALPHA * hf[k] + y[k] + ef[k] * rr * gq[j] * sg[k];
          y[k] = v;
          s1 += v;
        }
      }
    const float mu = wave_sum(s1) * (1.f / D_);
    float s2 = 0.f;
#pragma unroll
    for (int k = 0; k < 32; ++k) { float d = y[k] - mu; s2 += d * d; }
    const float rstd = rsqrtf(wave_sum(s2) * (1.f / D_) + 1e-5f);
#pragma unroll
    for (int q = 0; q < 2; ++q)
#pragma unroll
      for (int j4 = 0; j4 < 4; ++j4) {
        const int col = q * 1024 + lane * 16 + j4 * 4;
        const int k = q * 16 + j4 * 4;
        float4 g = *(const float4*)(P.ln2_g + col), b = *(const float4*)(P.ln2_b + col);
        float4 o;
        o.x = (y[k + 0] - mu) * rstd * g.x + b.x; o.y = (y[k + 1] - mu) * rstd * g.y + b.y;
        o.z = (y[k + 2] - mu) * rstd * g.z + b.z; o.w = (y[k + 3] - mu) * rstd * g.w + b.w;
        *(float4*)(P.out + (size_t)tok * D_ + col) = o;
      }
  }
}

__device__ __forceinline__ void run_phase(const Params& P, int ph, int bid, int nb, u16* lds) {
  switch (ph) {
    case 0: phase0(P, bid, nb, lds); break;
    case 1: phase1(P, bid, nb, lds); break;
    case 2: phase2(P, bid, nb, lds); break;
    case 3: phase3(P, bid, nb, lds); break;
    case 4: phase4(P, bid, nb, lds); break;
    case 5: phase5(P, bid, nb, lds); break;
    case 6: phase6(P, bid, nb, lds); break;
    case 7: ln_rows((const float*)(P.ws + O_PRE1), P.ln1_g, P.ln1_b, (u16*)(P.ws + O_H), bid * 4 + (threadIdx.x >> 6), nb * 4); break;
    case 8: phase8(P, bid, nb, lds); break;
    case 9: phase9(P, bid, nb, lds); break;
    case 10: phase10(P, bid, nb, lds); break;
    case 11: phase11(P, bid, nb); break;
  }
}
constexpr int NPHASE = 12;

#if MULTI
__global__ void __launch_bounds__(256, 2) phase_kernel(Params P, int ph) {
  __shared__ __attribute__((aligned(16))) u16 lds[36864];
  run_phase(P, ph, blockIdx.x, gridDim.x, lds);
}
#else
__global__ void __launch_bounds__(256, 2) mega_kernel(Params P) {
  __shared__ __attribute__((aligned(16))) u16 lds[36864];
  cg::grid_group grid = cg::this_grid();
  const int bid = blockIdx.x, nb = gridDim.x;
  phase0(P, bid, nb, lds); grid.sync();
  phase1(P, bid, nb, lds); grid.sync();
  phase2(P, bid, nb, lds); grid.sync();
  phase3(P, bid, nb, lds); grid.sync();
  phase4(P, bid, nb, lds); grid.sync();
  phase5(P, bid, nb, lds); grid.sync();
  phase6(P, bid, nb, lds); grid.sync();
  ln_rows((const float*)(P.ws + O_PRE1), P.ln1_g, P.ln1_b, (u16*)(P.ws + O_H), bid * 4 + (threadIdx.x >> 6), nb * 4);
  grid.sync();
  phase8(P, bid, nb, lds); grid.sync();
  phase9(P, bid, nb, lds); grid.sync();
  phase10(P, bid, nb, lds); grid.sync();
  phase11(P, bid, nb);
}
#endif

extern "C" void kernel_launch(void* const* d_in, const int* in_sizes, int n_in, void* d_out, int out_size, void* d_ws,
                              size_t ws_size, hipStream_t stream) {
  Params p{};
  const float** pp = (const float**)&p;
  for (int i = 0; i < 29; ++i) pp[i] = (const float*)d_in[i];
  p.out = (float*)d_out;
  p.ws = (char*)d_ws;
  if (ws_size < 990 * MB) fprintf(stderr, "workspace too small: %zu\n", ws_size);
#if MULTI
  for (int ph = 0; ph < NPHASE; ++ph) phase_kernel<<<512, 256, 0, stream>>>(p, ph);
#else
  static int grid_blocks = 0;
  if (!grid_blocks) {
    int dev = 0, cus = 0, per_cu = 0;
    hipGetDevice(&dev);
    hipDeviceGetAttribute(&cus, hipDeviceAttributeMultiprocessorCount, dev);
    hipOccupancyMaxActiveBlocksPerMultiprocessor(&per_cu, mega_kernel, 256, 0);
    if (per_cu > 2) per_cu = 2;
    grid_blocks = cus * per_cu;
  }
  void* args[] = {&p};
  hipError_t e = hipLaunchCooperativeKernel((void*)mega_kernel, dim3(grid_blocks), dim3(256), args, 0, stream);
  if (e != hipSuccess) fprintf(stderr, "cooperative launch failed: %s (grid %d)\n", hipGetErrorString(e), grid_blocks);
#endif
}
```

```cpp
#include <hip/hip_runtime.h>
#include <hip/hip_bf16.h>
#include <hip/hip_cooperative_groups.h>
#include <cstdio>
namespace cg = cooperative_groups;

#ifndef MULTI
#define MULTI 0
#endif

typedef unsigned short u16;
using bf16x8 = __attribute__((ext_vector_type(8))) short;
using f32x4 = __attribute__((ext_vector_type(4))) float;

constexpr int T_ = 32768;
constexpr int S_ = 16384;
constexpr int D_ = 2048;
constexpr int SSM_L = 128;
constexpr int SSM_NC = S_ / SSM_L;
constexpr float ALPHA = 1.189207115002721f;
constexpr size_t MB = 1024ull * 1024ull;

constexpr size_t O_WIN = 0 * MB, O_WGLU = 32 * MB, O_WAU = 34 * MB, O_WSU = 38 * MB, O_WOUT = 42 * MB,
                 O_WPQ = 50 * MB, O_WPG = 58 * MB, O_WPIN = 66 * MB, O_SK = 67 * MB, O_BCAT = 67 * MB + 512 * 1024,
                 O_CCAT = 68 * MB, O_LAM = 68 * MB + 256 * 1024, O_UB = 70 * MB, O_VB = 134 * MB, O_SBUF = 198 * MB,
                 O_H = 206 * MB, O_Q = 334 * MB, O_K = 398 * MB, O_VT = 462 * MB, O_U2 = 526 * MB, O_G = 590 * MB,
                 O_YA = 846 * MB, O_YS = 910 * MB, O_PB = 974 * MB;
constexpr size_t O_YG = O_VT, O_MERGED = O_Q, O_PRE1 = O_G, O_PQ = O_Q, O_SG = O_VT, O_E = O_G,
                 O_HV = O_G + 128 * MB, O_HI = O_G + 160 * MB, O_EXP = O_G + 192 * MB, O_GATE = O_G + 208 * MB;

struct Params {
  const float *x, *p, *ln_in_g, *ln_in_b, *w_in, *rel_bias, *lam_re, *lam_im, *log_dt, *b_re, *b_im, *c_re, *c_im,
      *ssm_d, *w_glu, *w_au, *w_su, *w_out, *ln1_g, *ln1_b, *w_pq, *sub_keys, *peer_u, *peer_v, *ple_w_in, *ple_g,
      *ple_w_gate, *ln2_g, *ln2_b;
  float* out;
  char* ws;
};

__device__ __forceinline__ u16 f2bf(float f) {
  unsigned u = __float_as_uint(f);
  u += 0x7fffu + ((u >> 16) & 1u);
  return (u16)(u >> 16);
}
__device__ __forceinline__ float bf2f(u16 h) { return __uint_as_float(((unsigned)h) << 16); }
__device__ __forceinline__ unsigned pack2(float a, float b) { return (unsigned)f2bf(a) | ((unsigned)f2bf(b) << 16); }
__device__ __forceinline__ float lo2f(unsigned u) { return __uint_as_float(u << 16); }
__device__ __forceinline__ float hi2f(unsigned u) { return __uint_as_float(u & 0xffff0000u); }
__device__ __forceinline__ float sigmoidf_(float x) { return __builtin_amdgcn_rcpf(1.f + __expf(-x)); }
__device__ __forceinline__ float gelu_tanh(float x) {
  float u = 0.7978845608028654f * (x + 0.044715f * x * x * x);
  float t = 1.f - 2.f * __builtin_amdgcn_rcpf(1.f + __expf(2.f * u));
  return 0.5f * x * (1.f + t);
}
__device__ __forceinline__ float wave_sum(float v) {
#pragma unroll
  for (int o = 32; o >= 1; o >>= 1) v += __shfl_xor(v, o);
  return v;
}
__device__ __forceinline__ void store_bf4(u16* dst, float a, float b, float c, float d) {
  uint2 v; v.x = pack2(a, b); v.y = pack2(c, d);
  *(uint2*)dst = v;
}

__device__ __forceinline__ void gemm_kloop(f32x4 (&acc)[4][4], const u16* __restrict__ A, int lda,
                                           const u16* __restrict__ Bt, int ldb, int K, u16* lds) {
  const int tid = threadIdx.x, lane = tid & 63, wid = tid >> 6, wm = wid >> 1, wn = wid & 1;
  const int lr = lane & 15, lq = lane >> 4;
  const int nk = K >> 6;
  const int srow = tid >> 3, sc = (tid & 7) ^ (srow & 7);
  const u16* ga = A + (size_t)srow * lda + sc * 8;
  const u16* gb = Bt + (size_t)srow * ldb + sc * 8;
  u16* lw = lds + tid * 8;
#pragma unroll
  for (int i = 0; i < 4; ++i) {
    __builtin_amdgcn_global_load_lds((const unsigned*)(ga + (size_t)(32 * i) * lda), (unsigned*)(lw + i * 2048), 16, 0, 0);
    __builtin_amdgcn_global_load_lds((const unsigned*)(gb + (size_t)(32 * i) * ldb), (unsigned*)(lw + 8192 + i * 2048), 16, 0, 0);
  }
  __syncthreads();
  const int swz = lr & 7;
  for (int kt = 0; kt < nk; ++kt) {
    if (kt + 1 < nk) {
      u16* lw2 = lw + ((kt + 1) & 1) * 16384;
#pragma unroll
      for (int i = 0; i < 4; ++i) {
        __builtin_amdgcn_global_load_lds((const unsigned*)(ga + (size_t)(32 * i) * lda + (kt + 1) * 64), (unsigned*)(lw2 + i * 2048), 16, 0, 0);
        __builtin_amdgcn_global_load_lds((const unsigned*)(gb + (size_t)(32 * i) * ldb + (kt + 1) * 64), (unsigned*)(lw2 + 8192 + i * 2048), 16, 0, 0);
      }
    }
    const u16* sa = lds + (kt & 1) * 16384;
    const u16* sb = sa + 8192;
#pragma unroll
    for (int ks = 0; ks < 2; ++ks) {
      bf16x8 af[4], bfr[4];
      const int co = ((ks * 4 + lq) ^ swz) * 8;
#pragma unroll
      for (int mi = 0; mi < 4; ++mi) af[mi] = *(const bf16x8*)(sa + (wm * 64 + mi * 16 + lr) * 64 + co);
#pragma unroll
      for (int ni = 0; ni < 4; ++ni) bfr[ni] = *(const bf16x8*)(sb + (wn * 64 + ni * 16 + lr) * 64 + co);
#pragma unroll
      for (int mi = 0; mi < 4; ++mi)
#pragma unroll
        for (int ni = 0; ni < 4; ++ni)
          acc[mi][ni] = __builtin_amdgcn_mfma_f32_16x16x32_bf16(bfr[ni], af[mi], acc[mi][ni], 0, 0, 0);
    }
    __syncthreads();
  }
}

#define ZERO_ACC(acc)                                   \
  _Pragma("unroll") for (int _a = 0; _a < 4; ++_a)      \
  _Pragma("unroll") for (int _b = 0; _b < 4; ++_b) acc[_a][_b] = f32x4{0.f, 0.f, 0.f, 0.f};

__device__ __forceinline__ void gemm_kloop2(f32x4 (&acc)[4][8], const u16* __restrict__ A, int lda,
                                            const u16* __restrict__ Bt, int ldb, int K, u16* lds) {
  const int tid = threadIdx.x, lane = tid & 63, wid = tid >> 6;
  const int lr = lane & 15, lq = lane >> 4;
  const int nk = K >> 5;
  const int srow = tid >> 2;
  const int sc = (tid & 3) ^ ((0x78 >> (2 * ((tid >> 4) & 3))) & 3);
  const u16* ga = A + (size_t)srow * lda + sc * 8;
  const u16* gb = Bt + (size_t)srow * ldb + sc * 8;
  u16* lw = lds + tid * 8;
#pragma unroll
  for (int i = 0; i < 4; ++i)
    __builtin_amdgcn_global_load_lds((const unsigned*)(ga + (size_t)(64 * i) * lda), (unsigned*)(lw + i * 2048), 16, 0, 0);
#pragma unroll
  for (int i = 0; i < 2; ++i)
    __builtin_amdgcn_global_load_lds((const unsigned*)(gb + (size_t)(64 * i) * ldb), (unsigned*)(lw + 8192 + i * 2048), 16, 0, 0);
  __syncthreads();
  const int co = (lq ^ ((0x78 >> (2 * ((lr >> 2) & 3))) & 3)) * 8;
  for (int kt = 0; kt < nk; ++kt) {
    if (kt + 1 < nk) {
      u16* lw2 = lw + ((kt + 1) & 1) * 12288;
#pragma unroll
      for (int i = 0; i < 4; ++i)
        __builtin_amdgcn_global_load_lds((const unsigned*)(ga + (size_t)(64 * i) * lda + (kt + 1) * 32), (unsigned*)(lw2 + i * 2048), 16, 0, 0);
#pragma unroll
      for (int i = 0; i < 2; ++i)
        __builtin_amdgcn_global_load_lds((const unsigned*)(gb + (size_t)(64 * i) * ldb + (kt + 1) * 32), (unsigned*)(lw2 + 8192 + i * 2048), 16, 0, 0);
    }
    const u16* sa = lds + (kt & 1) * 12288;
    const u16* sb = sa + 8192;
    bf16x8 af[4];
#pragma unroll
    for (int mi = 0; mi < 4; ++mi) af[mi] = *(const bf16x8*)(sa + (wid * 64 + mi * 16 + lr) * 32 + co);
#pragma unroll
    for (int nh = 0; nh < 2; ++nh) {
      bf16x8 bfr[4];
#pragma unroll
      for (int ni = 0; ni < 4; ++ni) bfr[ni] = *(const bf16x8*)(sb + ((nh * 4 + ni) * 16 + lr) * 32 + co);
#pragma unroll
      for (int mi = 0; mi < 4; ++mi)
#pragma unroll
        for (int ni = 0; ni < 4; ++ni)
          acc[mi][nh * 4 + ni] = __builtin_amdgcn_mfma_f32_16x16x32_bf16(bfr[ni], af[mi], acc[mi][nh * 4 + ni], 0, 0, 0);
    }
    __syncthreads();
  }
}

#define ZERO_ACC8(acc)                                  \
  _Pragma("unroll") for (int _a = 0; _a < 4; ++_a)      \
  _Pragma("unroll") for (int _b = 0; _b < 8; ++_b) acc[_a][_b] = f32x4{0.f, 0.f, 0.f, 0.f};

#define EPI_COORDS                                                             \
  const int lane = threadIdx.x & 63, wid = threadIdx.x >> 6, wm = wid >> 1, wn = wid & 1; \
  const int lr = lane & 15, lq = lane >> 4;

__device__ void tconv_tile(const float* __restrict__ W, int K, int N, u16* __restrict__ Wt, int tile, float* lds) {
  const int tid = threadIdx.x;
  const int ntn = N >> 6;
  const int kt = tile / ntn, nt = tile % ntn;
  const int c4 = (tid & 15) * 4;
#pragma unroll
  for (int i = 0; i < 4; ++i) {
    int r = (tid >> 4) + 16 * i;
    float4 v = *(const float4*)(W + (size_t)(kt * 64 + r) * N + nt * 64 + c4);
    lds[r * 65 + c4 + 0] = v.x; lds[r * 65 + c4 + 1] = v.y; lds[r * 65 + c4 + 2] = v.z; lds[r * 65 + c4 + 3] = v.w;
  }
  __syncthreads();
  const int n = tid >> 2, kseg = (tid & 3) * 16;
  unsigned o[8];
#pragma unroll
  for (int j = 0; j < 8; ++j) o[j] = pack2(lds[(kseg + 2 * j) * 65 + n], lds[(kseg + 2 * j + 1) * 65 + n]);
  u16* dst = Wt + (size_t)(nt * 64 + n) * K + kt * 64 + kseg;
  *(uint4*)dst = uint4{o[0], o[1], o[2], o[3]};
  *(uint4*)(dst + 8) = uint4{o[4], o[5], o[6], o[7]};
  __syncthreads();
}

__device__ void conv_linear(const float* __restrict__ src, u16* __restrict__ dst, size_t n8, size_t gtid, size_t nth) {
  for (size_t i = gtid; i < n8; i += nth) {
    float4 a = *(const float4*)(src + i * 8), b = *(const float4*)(src + i * 8 + 4);
    *(uint4*)(dst + i * 8) = uint4{pack2(a.x, a.y), pack2(a.z, a.w), pack2(b.x, b.y), pack2(b.z, b.w)};
  }
}

typedef float f32x2 __attribute__((ext_vector_type(2)));
constexpr size_t O_U8 = O_UB, O_V8 = O_UB + 32 * MB, O_RSU = O_VB, O_RSV = O_VB + 64 * 1024;
__device__ void conv_fp8_rows(const float* __restrict__ src, unsigned char* __restrict__ dst, float* __restrict__ rscale,
                              int gw, int nw) {
  const int lane = threadIdx.x & 63;
  for (int row = gw; row < 16384; row += nw) {
    const float* r = src + (size_t)row * D_;
    float4 v[8];
#pragma unroll
    for (int q = 0; q < 8; ++q) v[q] = *(const float4*)(r + q * 256 + lane * 4);
    float am = 0.f;
#pragma unroll
    for (int q = 0; q < 8; ++q) am = fmaxf(am, fmaxf(fmaxf(fabsf(v[q].x), fabsf(v[q].y)), fmaxf(fabsf(v[q].z), fabsf(v[q].w))));
#pragma unroll
    for (int o = 32; o >= 1; o >>= 1) am = fmaxf(am, __shfl_xor(am, o));
    const float sc = am > 0.f ? 416.f / am : 1.f;
#pragma unroll
    for (int q = 0; q < 8; ++q) {
      int w = 0;
      w = __builtin_amdgcn_cvt_pk_fp8_f32(v[q].x * sc, v[q].y * sc, w, false);
      w = __builtin_amdgcn_cvt_pk_fp8_f32(v[q].z * sc, v[q].w * sc, w, true);
      *(int*)(dst + (size_t)row * D_ + q * 256 + lane * 4) = w;
    }
    if (lane == 0) rscale[row] = am > 0.f ? am / 416.f : 1.f;
  }
}

__device__ void ln_rows(const float* __restrict__ src, const float* __restrict__ g, const float* __restrict__ b,
                        u16* __restrict__ dst, int gw, int nw) {
  const int lane = threadIdx.x & 63;
  for (int row = gw; row < T_; row += nw) {
    const float* r = src + (size_t)row * D_;
    float4 v[8];
#pragma unroll
    for (int q = 0; q < 8; ++q) v[q] = *(const float4*)(r + q * 256 + lane * 4);
    float s = 0.f;
#pragma unroll
    for (int q = 0; q < 8; ++q) s += v[q].x + v[q].y + v[q].z + v[q].w;
    float mu = wave_sum(s) * (1.f / D_);
    float ss = 0.f;
#pragma unroll
    for (int q = 0; q < 8; ++q) {
      float a = v[q].x - mu, bb = v[q].y - mu, c = v[q].z - mu, d = v[q].w - mu;
      ss += a * a + bb * bb + c * c + d * d;
    }
    float rstd = rsqrtf(wave_sum(ss) * (1.f / D_) + 1e-5f);
#pragma unroll
    for (int q = 0; q < 8; ++q) {
      int col = q * 256 + lane * 4;
      float4 gg = *(const float4*)(g + col), bb = *(const float4*)(b + col);
      store_bf4(dst + (size_t)row * D_ + col, (v[q].x - mu) * rstd * gg.x + bb.x, (v[q].y - mu) * rstd * gg.y + bb.y,
                (v[q].z - mu) * rstd * gg.z + bb.z, (v[q].w - mu) * rstd * gg.w + bb.w);
    }
  }
}

__device__ __forceinline__ void dsincos(double x, double& s, double& c) {
  double q = rint(x * 0.63661977236758134308);
  double r = x - q * 1.57079632679489661923;
  double r2 = r * r;
  double sp = r * (1.0 + r2 * (-1.0 / 6 + r2 * (1.0 / 120 + r2 * (-1.0 / 5040 + r2 * (1.0 / 362880 + r2 * (-1.0 / 39916800 + r2 * (1.0 / 6227020800.0)))))));
  double cp = 1.0 + r2 * (-0.5 + r2 * (1.0 / 24 + r2 * (-1.0 / 720 + r2 * (1.0 / 40320 + r2 * (-1.0 / 3628800 + r2 * (1.0 / 479001600.0 + r2 * (-1.0 / 87178291200.0)))))));
  int qi = ((int)q) & 3;
  if (qi == 0) { s = sp; c = cp; }
  else if (qi == 1) { s = cp; c = -sp; }
  else if (qi == 2) { s = -sp; c = -cp; }
  else { s = -cp; c = sp; }
}

__device__ void ssm_consts(const Params& P, int i) {
  const int g = i >> 6, p = i & 63;
  double lr = P.lam_re[g * 64 + p], li = P.lam_im[g * 64 + p];
  double dt = exp((double)P.log_dt[g]);
  double mag = exp(lr * dt);
  double sn, cs;
  dsincos(li * dt, sn, cs);
  double ar = mag * cs, ai = mag * sn;
  double nr = ar - 1.0, ni = ai, den = lr * lr + li * li;
  double fr = (nr * lr + ni * li) / den, fi = (ni * lr - nr * li) / den;
  u16* bcat = (u16*)(P.ws + O_BCAT);
  u16* ccat = (u16*)(P.ws + O_CCAT);
  float* lam = (float*)(P.ws + O_LAM);
  for (int h = 0; h < 16; ++h) {
    double br = P.b_re[(g * 64 + p) * 16 + h], bi = P.b_im[(g * 64 + p) * 16 + h];
    bcat[(g * 128 + p) * 32 + h] = f2bf((float)(fr * br - fi * bi));
    bcat[(g * 128 + 64 + p) * 32 + h] = f2bf((float)(fr * bi + fi * br));
    bcat[(g * 128 + p) * 32 + 16 + h] = 0;
    bcat[(g * 128 + 64 + p) * 32 + 16 + h] = 0;
    ccat[(g * 16 + h) * 128 + p] = f2bf(P.c_re[(g * 16 + h) * 64 + p]);
    ccat[(g * 16 + h) * 128 + 64 + p] = f2bf(-P.c_im[(g * 16 + h) * 64 + p]);
  }
  double pr = ar, pi = ai;
  for (int k = 0; k < 10; ++k) {
    double t = pr * pr - pi * pi;
    pi = 2.0 * pr * pi;
    pr = t;
  }
  lam[0 * 4096 + i] = (float)ar;
  lam[1 * 4096 + i] = (float)ai;
  lam[2 * 4096 + i] = (float)pr;
  lam[3 * 4096 + i] = (float)pi;
}

__device__ void phase0(const Params& P, int bid, int nb, u16* lds) {
  const size_t gtid = (size_t)bid * 256 + threadIdx.x, nth = (size_t)nb * 256;
#define TCONV(wp, KK, NN, OFF) \
  for (int t = bid; t < ((KK) >> 6) * ((NN) >> 6); t += nb) tconv_tile(wp, KK, NN, (u16*)(P.ws + OFF), t, (float*)lds);
  TCONV(P.w_in, 2048, 8192, O_WIN)
  TCONV(P.w_glu, 1024, 1024, O_WGLU)
  TCONV(P.w_au, 1024, 2048, O_WAU)
  TCONV(P.w_su, 1024, 2048, O_WSU)
  TCONV(P.w_out, 2048, 2048, O_WOUT)
  TCONV(P.w_pq, 2048, 2048, O_WPQ)
  TCONV(P.ple_w_gate, 2048, 2048, O_WPG)
  TCONV(P.ple_w_in, 256, 2048, O_WPIN)
  conv_fp8_rows(P.peer_u, (unsigned char*)(P.ws + O_U8), (float*)(P.ws + O_RSU), bid * 4 + (threadIdx.x >> 6), nb * 4);
  conv_fp8_rows(P.peer_v, (unsigned char*)(P.ws + O_V8), (float*)(P.ws + O_RSV), bid * 4 + (threadIdx.x >> 6), nb * 4);
  conv_linear(P.sub_keys, (u16*)(P.ws + O_SK), (size_t)16 * 128 * 128 / 8, gtid, nth);
  conv_linear(P.p, (u16*)(P.ws + O_PB), (size_t)T_ * 256 / 8, gtid, nth);
  for (size_t i = gtid; i < 4096; i += nth) ssm_consts(P, (int)i);
  ln_rows(P.x, P.ln_in_g, P.ln_in_b, (u16*)(P.ws + O_H), bid * 4 + (threadIdx.x >> 6), nb * 4);
}

__device__ void phase1(const Params& P, int bid, int nb, u16* lds) {
  const u16* H = (const u16*)(P.ws + O_H);
  const u16* W = (const u16*)(P.ws + O_WIN);
  u16* Q = (u16*)(P.ws + O_Q);
  u16* Kb = (u16*)(P.ws + O_K);
  u16* Vt = (u16*)(P.ws + O_VT);
  u16* U2 = (u16*)(P.ws + O_U2);
  u16* G = (u16*)(P.ws + O_G);
  EPI_COORDS
  const int ntiles = 128 * 64;
  for (int t = bid; t < ntiles; t += nb) {
    const int mt = t >> 6, nt = t & 63;
    f32x4 acc[4][8];
    ZERO_ACC8(acc)
    gemm_kloop2(acc, H + (size_t)mt * 256 * D_, D_, W + (size_t)nt * 128 * D_, D_, D_, lds);
    const int region = nt >> 3;
#pragma unroll
    for (int mi = 0; mi < 4; ++mi) {
      const int m = mt * 256 + wid * 64 + mi * 16 + lr;
#pragma unroll
      for (int ni = 0; ni < 8; ++ni) {
        const int n = nt * 128 + ni * 16 + lq * 4;
        f32x4 a = acc[mi][ni];
        if (region == 0) {
          const float sc = 0.08838834764831845f;
          store_bf4(Q + (size_t)m * 1024 + n, a[0] * sc, a[1] * sc, a[2] * sc, a[3] * sc);
        } else if (region == 1) {
          store_bf4(Kb + (size_t)m * 1024 + (n - 1024), a[0], a[1], a[2], a[3]);
        } else if (region == 2) {
          const int b = m >> 14, tt = m & (S_ - 1);
#pragma unroll
          for (int j = 0; j < 4; ++j) Vt[((size_t)(b * 1024 + (n - 2048 + j))) * S_ + tt] = f2bf(a[j]);
        } else if (region == 3) {
          store_bf4(U2 + (size_t)m * 1024 + (n - 3072), a[0], a[1], a[2], a[3]);
        } else {
          store_bf4(G + (size_t)m * 4096 + (n - 4096), sigmoidf_(a[0]), sigmoidf_(a[1]), sigmoidf_(a[2]), sigmoidf_(a[3]));
        }
      }
    }
  }
}

__device__ void attn_item(const Params& P, int item, u16* lds) {
  const int c = item & 255, hd = (item >> 8) & 7, b = item >> 11;
  const int tid = threadIdx.x, lane = tid & 63, w = tid >> 6, lr = lane & 15, lq = lane >> 4;
  u16* Ks = lds;
  u16* Vs = lds + 64 * 136;
  float* bs = (float*)(lds + 64 * 136 + 128 * 72);
  const u16* Q = (const u16*)(P.ws + O_Q);
  const u16* Kb = (const u16*)(P.ws + O_K);
  const u16* Vt = (const u16*)(P.ws + O_VT);
  u16* ya = (u16*)(P.ws + O_YA);
  __syncthreads();
  for (int i = tid; i < 257; i += 256) bs[i] = P.rel_bias[hd * 257 + i];
  bf16x8 qf[4];
  {
    const u16* qp = Q + (size_t)(b * S_ + c * 64 + w * 16 + lr) * 1024 + hd * 128 + lq * 8;
#pragma unroll
    for (int ks = 0; ks < 4; ++ks) qf[ks] = *(const bf16x8*)(qp + ks * 32);
  }
  f32x4 oacc[8];
#pragma unroll
  for (int d = 0; d < 8; ++d) oacc[d] = f32x4{0.f, 0.f, 0.f, 0.f};
  float m_run = -1e30f, lsum = 0.f;
  const int i0 = (c < 8) ? (8 - c) : 0;
  const int qi = w * 16 + lr;
#define KV_ADDR_K(r, kc_) (Kb + (size_t)(b * S_ + (kc_) * 64 + ((tid + 256 * (r)) >> 4)) * 1024 + hd * 128 + ((tid + 256 * (r)) & 15) * 8)
#define KV_ADDR_V(r, kc_) (Vt + ((size_t)(b * 1024 + hd * 128 + ((tid + 256 * (r)) >> 3))) * S_ + (kc_) * 64 + ((tid + 256 * (r)) & 7) * 8)
#define KV_LOAD(kc_)                                                                   \
  kr0 = *(const uint4*)KV_ADDR_K(0, kc_); kr1 = *(const uint4*)KV_ADDR_K(1, kc_);     \
  kr2 = *(const uint4*)KV_ADDR_K(2, kc_); kr3 = *(const uint4*)KV_ADDR_K(3, kc_);     \
  vr0 = *(const uint4*)KV_ADDR_V(0, kc_); vr1 = *(const uint4*)KV_ADDR_V(1, kc_);     \
  vr2 = *(const uint4*)KV_ADDR_V(2, kc_); vr3 = *(const uint4*)KV_ADDR_V(3, kc_);
#define KS_W(r) (Ks + ((tid + 256 * (r)) >> 4) * 136 + ((tid + 256 * (r)) & 15) * 8)
#define VS_W(r) (Vs + ((tid + 256 * (r)) >> 3) * 72 + ((tid + 256 * (r)) & 7) * 8)
  uint4 kr0, kr1, kr2, kr3, vr0, vr1, vr2, vr3;
  KV_LOAD(c - 8 + i0)
  for (int i = i0; i <= 8; ++i) {
    __syncthreads();
    *(uint4*)KS_W(0) = kr0; *(uint4*)KS_W(1) = kr1; *(uint4*)KS_W(2) = kr2; *(uint4*)KS_W(3) = kr3;
    *(uint4*)VS_W(0) = vr0; *(uint4*)VS_W(1) = vr1; *(uint4*)VS_W(2) = vr2; *(uint4*)VS_W(3) = vr3;
    __syncthreads();
    if (i < 8) { KV_LOAD(c - 8 + i + 1) }
    f32x4 sacc[4];
#pragma unroll
    for (int kt = 0; kt < 4; ++kt) {
      sacc[kt] = f32x4{0.f, 0.f, 0.f, 0.f};
#pragma unroll
      for (int ks = 0; ks < 4; ++ks) {
        bf16x8 kf = *(const bf16x8*)(Ks + (kt * 16 + lr) * 136 + ks * 32 + lq * 8);
        sacc[kt] = __builtin_amdgcn_mfma_f32_16x16x32_bf16(kf, qf[ks], sacc[kt], 0, 0, 0);
      }
    }
    float tmax = -1e30f;
#pragma unroll
    for (int kt = 0; kt < 4; ++kt)
#pragma unroll
      for (int j = 0; j < 4; ++j) {
        int kb = i * 64 + kt * 16 + lq * 4 + j;
        int rel = 512 + qi - kb;
        rel = min(max(rel, -128), 128) + 128;
        float s = sacc[kt][j] + bs[rel];
        sacc[kt][j] = s;
        tmax = fmaxf(tmax, s);
      }
    tmax = fmaxf(tmax, __shfl_xor(tmax, 16));
    tmax = fmaxf(tmax, __shfl_xor(tmax, 32));
    const float m_new = fmaxf(m_run, tmax);
    const float corr = __expf(m_run - m_new);
    m_run = m_new;
    float ps = 0.f;
#pragma unroll
    for (int kt = 0; kt < 4; ++kt)
#pragma unroll
      for (int j = 0; j < 4; ++j) {
        float pv = __expf(sacc[kt][j] - m_new);
        sacc[kt][j] = pv;
        ps += pv;
      }
    lsum = lsum * corr + ps;
#pragma unroll
    for (int d = 0; d < 8; ++d) {
      oacc[d][0] *= corr; oacc[d][1] *= corr; oacc[d][2] *= corr; oacc[d][3] *= corr;
    }
#pragma unroll
    for (int kk = 0; kk < 2; ++kk) {
      union { bf16x8 v; unsigned u[4]; } pf;
      pf.u[0] = pack2(sacc[2 * kk][0], sacc[2 * kk][1]);
      pf.u[1] = pack2(sacc[2 * kk][2], sacc[2 * kk][3]);
      pf.u[2] = pack2(sacc[2 * kk + 1][0], sacc[2 * kk + 1][1]);
      pf.u[3] = pack2(sacc[2 * kk + 1][2], sacc[2 * kk + 1][3]);
#pragma unroll
      for (int d = 0; d < 8; ++d) {
        union { bf16x8 v; uint2 h[2]; } vf;
        vf.h[0] = *(const uint2*)(Vs + (d * 16 + lr) * 72 + kk * 32 + lq * 4);
        vf.h[1] = *(const uint2*)(Vs + (d * 16 + lr) * 72 + kk * 32 + 16 + lq * 4);
        oacc[d] = __builtin_amdgcn_mfma_f32_16x16x32_bf16(vf.v, pf.v, oacc[d], 0, 0, 0);
      }
    }
  }
  lsum += __shfl_xor(lsum, 16);
  lsum += __shfl_xor(lsum, 32);
  const float inv = 1.f / lsum;
  u16* op = ya + (size_t)(b * S_ + c * 64 + w * 16 + lr) * 1024 + hd * 128 + lq * 4;
#pragma unroll
  for (int d = 0; d < 8; ++d) store_bf4(op + d * 16, oacc[d][0] * inv, oacc[d][1] * inv, oacc[d][2] * inv, oacc[d][3] * inv);
}

template <int PASS>
__device__ void ssm_item(const Params& P, int item, char* ldsw) {
  const int sc = item & 15, seq = item >> 4, g = seq & 63, b = seq >> 6;
  const int lane = threadIdx.x & 63, lr = lane & 15, lq = lane >> 4;
  float* BuS = (float*)ldsw;
  u16* Hs = (u16*)(ldsw + 8192);
  const u16* bcat = (const u16*)(P.ws + O_BCAT);
  const u16* ccat = (const u16*)(P.ws + O_CCAT);
  const float* lam = (const float*)(P.ws + O_LAM);
  const u16* U2 = (const u16*)(P.ws + O_U2);
  float* Sbuf = (float*)(P.ws + O_SBUF);
  u16* ys = (u16*)(P.ws + O_YS);
  const float ar = lam[g * 64 + lane], ai = lam[4096 + g * 64 + lane];
  bf16x8 bfrag[8];
#pragma unroll
  for (int nt = 0; nt < 8; ++nt) bfrag[nt] = *(const bf16x8*)(bcat + (g * 128 + nt * 16 + lr) * 32 + lq * 8);
  float sr = 0.f, si = 0.f;
  bf16x8 cfrag[4];
  float dsk[4];
  if (PASS == 2) {
#pragma unroll
    for (int ks = 0; ks < 4; ++ks) cfrag[ks] = *(const bf16x8*)(ccat + (g * 16 + lr) * 128 + ks * 32 + lq * 8);
#pragma unroll
    for (int j = 0; j < 4; ++j) dsk[j] = P.ssm_d[g * 16 + lq * 4 + j];
    const float aLr = lam[2 * 4096 + g * 64 + lane], aLi = lam[3 * 4096 + g * 64 + lane];
    const float* Sb = Sbuf + (size_t)seq * 16 * 128;
#pragma unroll 4
    for (int cc = 0; cc < sc; ++cc) {
      float xr = Sb[cc * 128 + lane], xi = Sb[cc * 128 + 64 + lane];
      float nr = fmaf(aLr, sr, fmaf(-aLi, si, xr));
      float ni = fmaf(aLr, si, fmaf(aLi, sr, xi));
      sr = nr; si = ni;
    }
  }
#pragma unroll 1
  for (int ci = 0; ci < 8; ++ci) {
  const size_t tok_base = (size_t)b * S_ + (size_t)(sc * 8 + ci) * SSM_L;
  uint4 upre[SSM_L / 16];
  uint2 uepi[SSM_L / 16];
#pragma unroll
  for (int sub = 0; sub < SSM_L / 16; ++sub) {
    upre[sub] = uint4{0u, 0u, 0u, 0u};
    if (lq < 2) upre[sub] = *(const uint4*)(U2 + (tok_base + sub * 16 + lr) * 1024 + g * 16 + lq * 8);
    if (PASS == 2) uepi[sub] = *(const uint2*)(U2 + (tok_base + sub * 16 + lr) * 1024 + g * 16 + lq * 4);
  }
#pragma unroll
  for (int sub = 0; sub < SSM_L / 16; ++sub) {
    const size_t tok0 = tok_base + sub * 16;
    union { bf16x8 v; uint4 u; } uf;
    uf.u = upre[sub];
#pragma unroll
    for (int nt = 0; nt < 8; ++nt) {
      f32x4 d = __builtin_amdgcn_mfma_f32_16x16x32_bf16(bfrag[nt], uf.v, f32x4{0.f, 0.f, 0.f, 0.f}, 0, 0, 0);
      *(f32x4*)(BuS + lr * 128 + nt * 16 + lq * 4) = d;
    }
    asm volatile("s_waitcnt lgkmcnt(0)" ::: "memory");
#pragma unroll
    for (int t = 0; t < 16; ++t) {
      float bur = BuS[t * 128 + lane], bui = BuS[t * 128 + 64 + lane];
      float nr = fmaf(ar, sr, fmaf(-ai, si, bur));
      float ni = fmaf(ar, si, fmaf(ai, sr, bui));
      sr = nr; si = ni;
      if (PASS == 2) {
        Hs[t * 136 + lane] = f2bf(sr);
        Hs[t * 136 + 64 + lane] = f2bf(si);
      }
    }
    asm volatile("s_waitcnt lgkmcnt(0)" ::: "memory");
    if (PASS == 2) {
      f32x4 yacc = f32x4{0.f, 0.f, 0.f, 0.f};
#pragma unroll
      for (int ks = 0; ks < 4; ++ks) {
        bf16x8 hf = *(const bf16x8*)(Hs + lr * 136 + ks * 32 + lq * 8);
        yacc = __builtin_amdgcn_mfma_f32_16x16x32_bf16(cfrag[ks], hf, yacc, 0, 0, 0);
      }
      const uint2 uu = uepi[sub];
      float y0 = gelu_tanh(yacc[0] + dsk[0] * lo2f(uu.x));
      float y1 = gelu_tanh(yacc[1] + dsk[1] * hi2f(uu.x));
      float y2 = gelu_tanh(yacc[2] + dsk[2] * lo2f(uu.y));
      float y3 = gelu_tanh(yacc[3] + dsk[3] * hi2f(uu.y));
      store_bf4(ys + (tok0 + lr) * 1024 + g * 16 + lq * 4, y0, y1, y2, y3);
      asm volatile("s_waitcnt lgkmcnt(0)" ::: "memory");
    }
  }
  }
  if (PASS == 1) {
    Sbuf[((size_t)seq * 16 + sc) * 128 + lane] = sr;
    Sbuf[((size_t)seq * 16 + sc) * 128 + 64 + lane] = si;
  }
}

__device__ void phase2(const Params& P, int bid, int nb, u16* lds) {
  for (int it = bid; it < 4096 + 512; it += nb) {
    if (it < 4096) {
      attn_item(P, it, lds);
    } else {
      __syncthreads();
      const int w = threadIdx.x >> 6;
      ssm_item<1>(P, (it - 4096) * 4 + w, (char*)lds + w * 12544);
    }
  }
}
__device__ void phase3(const Params& P, int bid, int nb, u16* lds) {
  const int w = threadIdx.x >> 6;
  for (int it = bid; it < 512; it += nb) ssm_item<2>(P, it * 4 + w, (char*)lds + w * 12544);
}

__device__ void phase4(const Params& P, int bid, int nb, u16* lds) {
  const u16* ys = (const u16*)(P.ws + O_YS);
  const u16* W = (const u16*)(P.ws + O_WGLU);
  u16* yg = (u16*)(P.ws + O_YG);
  EPI_COORDS
  for (int t = bid; t < 128 * 8; t += nb) {
    const int mt = t >> 3, nt = t & 7;
    f32x4 acc[4][8];
    ZERO_ACC8(acc)
    gemm_kloop2(acc, ys + (size_t)mt * 256 * 1024, 1024, W + (size_t)nt * 128 * 1024, 1024, 1024, lds);
#pragma unroll
    for (int mi = 0; mi < 4; ++mi) {
      const int m = mt * 256 + wid * 64 + mi * 16 + lr;
#pragma unroll
      for (int ni = 0; ni < 8; ++ni) {
        const int n = nt * 128 + ni * 16 + lq * 4;
        uint2 yy = *(const uint2*)(ys + (size_t)m * 1024 + n);
        f32x4 a = acc[mi][ni];
        store_bf4(yg + (size_t)m * 1024 + n, lo2f(yy.x) * sigmoidf_(a[0]), hi2f(yy.x) * sigmoidf_(a[1]),
                  lo2f(yy.y) * sigmoidf_(a[2]), hi2f(yy.y) * sigmoidf_(a[3]));
      }
    }
  }
}

__device__ void phase5(const Params& P, int bid, int nb, u16* lds) {
  const u16* ya = (const u16*)(P.ws + O_YA);
  const u16* yg = (const u16*)(P.ws + O_YG);
  const u16* Wa = (const u16*)(P.ws + O_WAU);
  const u16* Wsu = (const u16*)(P.ws + O_WSU);
  const u16* G = (const u16*)(P.ws + O_G);
  u16* mg = (u16*)(P.ws + O_MERGED);
  EPI_COORDS
  for (int t = bid; t < 128 * 16; t += nb) {
    const int mt = t >> 4, nt = t & 15;
#pragma unroll 1
    for (int part = 0; part < 2; ++part) {
      f32x4 acc[4][8];
      ZERO_ACC8(acc)
      gemm_kloop2(acc, (part ? yg : ya) + (size_t)mt * 256 * 1024, 1024, (part ? Wsu : Wa) + (size_t)nt * 128 * 1024, 1024,
                  1024, lds);
      const u16* Gp = G + part * 2048;
#pragma unroll
      for (int mi = 0; mi < 4; ++mi) {
        const int m = mt * 256 + wid * 64 + mi * 16 + lr;
#pragma unroll
        for (int ni = 0; ni < 8; ++ni) {
          const int n = nt * 128 + ni * 16 + lq * 4;
          const uint2 gg = *(const uint2*)(Gp + (size_t)m * 4096 + n);
          f32x4 a = acc[mi][ni];
          float o0 = a[0] * lo2f(gg.x), o1 = a[1] * hi2f(gg.x), o2 = a[2] * lo2f(gg.y), o3 = a[3] * hi2f(gg.y);
          if (part) {
            const uint2 pv = *(const uint2*)(mg + (size_t)m * D_ + n);
            o0 += lo2f(pv.x); o1 += hi2f(pv.x); o2 += lo2f(pv.y); o3 += hi2f(pv.y);
          }
          store_bf4(mg + (size_t)m * D_ + n, o0, o1, o2, o3);
        }
      }
    }
  }
}

__device__ void phase6(const Params& P, int bid, int nb, u16* lds) {
  const u16* mg = (const u16*)(P.ws + O_MERGED);
  const u16* W = (const u16*)(P.ws + O_WOUT);
  const u16* H = (const u16*)(P.ws + O_H);
  float* pre1 = (float*)(P.ws + O_PRE1);
  EPI_COORDS
  for (int t = bid; t < 128 * 16; t += nb) {
    const int mt = t >> 4, nt = t & 15;
    f32x4 acc[4][8];
    ZERO_ACC8(acc)
    gemm_kloop2(acc, mg + (size_t)mt * 256 * D_, D_, W + (size_t)nt * 128 * D_, D_, D_, lds);
#pragma unroll
    for (int mi = 0; mi < 4; ++mi) {
      const int m = mt * 256 + wid * 64 + mi * 16 + lr;
#pragma unroll
      for (int ni = 0; ni < 8; ++ni) {
        const int n = nt * 128 + ni * 16 + lq * 4;
        uint2 hh = *(const uint2*)(H + (size_t)m * D_ + n);
        f32x4 a = acc[mi][ni];
        float4 o;
        o.x = ALPHA * lo2f(hh.x) + a[0]; o.y = ALPHA * hi2f(hh.x) + a[1];
        o.z = ALPHA * lo2f(hh.y) + a[2]; o.w = ALPHA * hi2f(hh.y) + a[3];
        *(float4*)(pre1 + (size_t)m * D_ + n) = o;
      }
    }
  }
}

__device__ void phase8(const Params& P, int bid, int nb, u16* lds) {
  const u16* H = (const u16*)(P.ws + O_H);
  const u16* Pb = (const u16*)(P.ws + O_PB);
  u16* PQ = (u16*)(P.ws + O_PQ);
  u16* SG = (u16*)(P.ws + O_SG);
  u16* E = (u16*)(P.ws + O_E);
  EPI_COORDS
  for (int t = bid; t < 3 * 2048; t += nb) {
    const int which = t >> 11, tt = t & 2047, mt = tt >> 4, nt = tt & 15;
    f32x4 acc[4][8];
    ZERO_ACC8(acc)
    u16* dst;
    if (which == 0) {
      gemm_kloop2(acc, H + (size_t)mt * 256 * D_, D_, (const u16*)(P.ws + O_WPQ) + (size_t)nt * 128 * D_, D_, D_, lds);
      dst = PQ;
    } else if (which == 1) {
      gemm_kloop2(acc, H + (size_t)mt * 256 * D_, D_, (const u16*)(P.ws + O_WPG) + (size_t)nt * 128 * D_, D_, D_, lds);
      dst = SG;
    } else {
      gemm_kloop2(acc, Pb + (size_t)mt * 256 * 256, 256, (const u16*)(P.ws + O_WPIN) + (size_t)nt * 128 * 256, 256, 256, lds);
      dst = E;
    }
#pragma unroll
    for (int mi = 0; mi < 4; ++mi) {
      const int m = mt * 256 + wid * 64 + mi * 16 + lr;
#pragma unroll
      for (int ni = 0; ni < 8; ++ni) {
        const int n = nt * 128 + ni * 16 + lq * 4;
        f32x4 a = acc[mi][ni];
        if (which == 1) { a[0] = sigmoidf_(a[0]); a[1] = sigmoidf_(a[1]); a[2] = sigmoidf_(a[2]); a[3] = sigmoidf_(a[3]); }
        store_bf4(dst + (size_t)m * D_ + n, a[0], a[1], a[2], a[3]);
      }
    }
  }
}

struct Top16 { float v[16]; int i[16]; };
__device__ __forceinline__ void top_init(Top16& t) {
#pragma unroll
  for (int k = 0; k < 16; ++k) { t.v[k] = -INFINITY; t.i[k] = 0; }
}
__device__ __forceinline__ void top_insert(Top16& t, float x, int id) {
  const bool c = x > t.v[15];
  t.v[15] = c ? x : t.v[15];
  t.i[15] = c ? id : t.i[15];
#pragma unroll
  for (int k = 15; k >= 1; --k) {
    const bool s = t.v[k] > t.v[k - 1];
    const float a = t.v[k - 1], b = t.v[k];
    const int ia = t.i[k - 1], ib = t.i[k];
    t.v[k - 1] = s ? b : a; t.v[k] = s ? a : b;
    t.i[k - 1] = s ? ib : ia; t.i[k] = s ? ia : ib;
  }
}

__device__ void phase9(const Params& P, int bid, int nb, u16* lds) {
  const u16* PQ = (const u16*)(P.ws + O_PQ);
  const u16* SK = (const u16*)(P.ws + O_SK);
  float* HV = (float*)(P.ws + O_HV);
  int* HI = (int*)(P.ws + O_HI);
  float* Sc = (float*)lds;
  EPI_COORDS
  const int tid = threadIdx.x;
  for (int t = bid; t < 256 * 16; t += nb) {
    const int mt = t >> 4, rc = t & 15;
    f32x4 acc[4][4];
    ZERO_ACC(acc)
    gemm_kloop(acc, PQ + (size_t)mt * 128 * D_ + rc * 128, D_, SK + (size_t)rc * 128 * 128, 128, 128, lds);
#pragma unroll
    for (int mi = 0; mi < 4; ++mi) {
      const int m = wm * 64 + mi * 16 + lr;
#pragma unroll
      for (int ni = 0; ni < 4; ++ni) {
        const int n = wn * 64 + ni * 16 + lq * 4;
#pragma unroll
        for (int j = 0; j < 4; ++j) Sc[m * 129 + n + j] = acc[mi][ni][j];
      }
    }
    __syncthreads();
    const int tok = tid & 127, hh = tid >> 7;
    float key[16];
#pragma unroll
    for (int j = 0; j < 16; ++j) key[j] = -INFINITY;
    {
      const float* sp = Sc + tok * 129 + hh * 64;
#pragma unroll 4
      for (int k = 0; k < 64; ++k) {
        const float x = sp[k];
        const float kk = __uint_as_float((__float_as_uint(x) & ~127u) | (unsigned)(127 - (hh * 64 + k)));
#pragma unroll
        for (int j = 15; j >= 1; --j) key[j] = __builtin_amdgcn_fmed3f(key[j - 1], key[j], kk);
        key[0] = fmaxf(key[0], kk);
      }
    }
    __syncthreads();
    float* Lv = (float*)lds;
#pragma unroll
    for (int k = 0; k < 16; ++k) Lv[tid * 17 + k] = key[k];
    __syncthreads();
    if (tid < 128) {
      int ia = 0, ib = 0;
      const float* va = Lv + tid * 17; const float* vb = Lv + (tid + 128) * 17;
      float* ov = HV + ((size_t)(mt * 16 + rc) * 128 + tid) * 16;
      int* oi = HI + ((size_t)(mt * 16 + rc) * 128 + tid) * 16;
      for (int k = 0; k < 16; ++k) {
        const float a = va[ia], b = vb[ib];
        const bool ta = a >= b;
        const unsigned bits = __float_as_uint(ta ? a : b);
        ov[k] = __uint_as_float(bits & ~127u);
        oi[k] = 127 - (int)(bits & 127u);
        ia += ta ? 1 : 0; ib += ta ? 0 : 1;
      }
    }
    __syncthreads();
  }
}

__device__ void phase10(const Params& P, int bid, int nb, u16* lds) {
  int* Lx = (int*)lds + threadIdx.x * 33;
  const float* HV = (const float*)(P.ws + O_HV);
  const int* HI = (const int*)(P.ws + O_HI);
  int* EX = (int*)(P.ws + O_EXP);
  float* GT = (float*)(P.ws + O_GATE);
  for (int i_ = bid * 256 + threadIdx.x; i_ < T_ * 8; i_ += nb * 256) {
    const int r_ = (i_ >> 7) & 7, mt_ = i_ >> 10, tl_ = i_ & 127;
    const int i = (mt_ * 128 + tl_) * 8 + r_;
    const size_t h0 = ((size_t)(mt_ * 16 + r_ * 2) * 128 + tl_) * 16, h1 = h0 + 128 * 16;
    float v0[16], v1[16];
    int i0[16], i1[16];
#pragma unroll
    for (int q = 0; q < 4; ++q) {
      float4 a = *(const float4*)(HV + h0 + q * 4);
      float4 b = *(const float4*)(HV + h1 + q * 4);
      int4 c = *(const int4*)(HI + h0 + q * 4);
      int4 d = *(const int4*)(HI + h1 + q * 4);
      v0[q * 4] = a.x; v0[q * 4 + 1] = a.y; v0[q * 4 + 2] = a.z; v0[q * 4 + 3] = a.w;
      v1[q * 4] = b.x; v1[q * 4 + 1] = b.y; v1[q * 4 + 2] = b.z; v1[q * 4 + 3] = b.w;
      i0[q * 4] = c.x; i0[q * 4 + 1] = c.y; i0[q * 4 + 2] = c.z; i0[q * 4 + 3] = c.w;
      i1[q * 4] = d.x; i1[q * 4 + 1] = d.y; i1[q * 4 + 2] = d.z; i1[q * 4 + 3] = d.w;
    }
    float t[16];
#pragma unroll
    for (int j = 0; j < 16; ++j) t[j] = -INFINITY;
#pragma unroll
    for (int a = 0; a < 16; ++a)
#pragma unroll
      for (int b = 0; b < 16; ++b)
        if ((a + 1) * (b + 1) <= 16) {
          const float sv = v0[a] + v1[b];
#pragma unroll
          for (int j = 15; j >= 1; --j) t[j] = __builtin_amdgcn_fmed3f(t[j - 1], t[j], sv);
          t[0] = fmaxf(t[0], sv);
        }
    const float mx = t[0], thr = t[15];
    float sum = 0.f;
#pragma unroll
    for (int k = 0; k < 16; ++k) sum += __expf(t[k] - mx);
    const float inv = 1.f / sum;
    int cnt = 0;
#pragma unroll
    for (int a = 0; a < 16; ++a)
#pragma unroll
      for (int b = 0; b < 16; ++b)
        if ((a + 1) * (b + 1) <= 16) {
          const float sv = v0[a] + v1[b];
          if (sv >= thr && cnt < 16) {
            Lx[cnt] = i0[a] * 128 + i1[b];
            Lx[16 + cnt] = __float_as_int(__expf(sv - mx) * inv);
            ++cnt;
          }
        }
    asm volatile("s_waitcnt lgkmcnt(0)" ::: "memory");
#pragma unroll
    for (int q = 0; q < 4; ++q) {
      *(int4*)(EX + (size_t)i * 16 + q * 4) = int4{Lx[q * 4], Lx[q * 4 + 1], Lx[q * 4 + 2], Lx[q * 4 + 3]};
      *(float4*)(GT + (size_t)i * 16 + q * 4) =
          float4{__int_as_float(Lx[16 + q * 4]), __int_as_float(Lx[16 + q * 4 + 1]), __int_as_float(Lx[16 + q * 4 + 2]),
                 __int_as_float(Lx[16 + q * 4 + 3])};
    }
    asm volatile("s_waitcnt lgkmcnt(0)" ::: "memory");
  }
}

__device__ __forceinline__ void unpack8(uint4 u, float* f) {
  f[0] = lo2f(u.x); f[1] = hi2f(u.x); f[2] = lo2f(u.y); f[3] = hi2f(u.y);
  f[4] = lo2f(u.z); f[5] = hi2f(u.z); f[6] = lo2f(u.w); f[7] = hi2f(u.w);
}
__device__ __forceinline__ void dec16(uint4 u, float* f) {
  f32x2 a;
  a = __builtin_amdgcn_cvt_pk_f32_fp8((int)u.x, false); f[0] = a.x; f[1] = a.y;
  a = __builtin_amdgcn_cvt_pk_f32_fp8((int)u.x, true);  f[2] = a.x; f[3] = a.y;
  a = __builtin_amdgcn_cvt_pk_f32_fp8((int)u.y, false); f[4] = a.x; f[5] = a.y;
  a = __builtin_amdgcn_cvt_pk_f32_fp8((int)u.y, true);  f[6] = a.x; f[7] = a.y;
  a = __builtin_amdgcn_cvt_pk_f32_fp8((int)u.z, false); f[8] = a.x; f[9] = a.y;
  a = __builtin_amdgcn_cvt_pk_f32_fp8((int)u.z, true);  f[10] = a.x; f[11] = a.y;
  a = __builtin_amdgcn_cvt_pk_f32_fp8((int)u.w, false); f[12] = a.x; f[13] = a.y;
  a = __builtin_amdgcn_cvt_pk_f32_fp8((int)u.w, true);  f[14] = a.x; f[15] = a.y;
}
__device__ __forceinline__ void load_row_bf16(const u16* row, int lane, float* f) {
#pragma unroll
  for (int q = 0; q < 2; ++q) {
    uint4 a = *(const uint4*)(row + q * 1024 + lane * 16);
    uint4 b = *(const uint4*)(row + q * 1024 + lane * 16 + 8);
    unpack8(a, f + q * 16);
    unpack8(b, f + q * 16 + 8);
  }
}
__device__ void phase11(const Params& P, int bid, int nb) {
  const u16* H = (const u16*)(P.ws + O_H);
  const unsigned char* U8 = (const unsigned char*)(P.ws + O_U8);
  const unsigned char* V8 = (const unsigned char*)(P.ws + O_V8);
  const float* RSU = (const float*)(P.ws + O_RSU);
  const float* RSV = (const float*)(P.ws + O_RSV);
  const u16* SG = (const u16*)(P.ws + O_SG);
  const u16* E = (const u16*)(P.ws + O_E);
  const int* EX = (const int*)(P.ws + O_EXP);
  const float* GT = (const float*)(P.ws + O_GATE);
  const int lane = threadIdx.x & 63;
  for (int tok = bid * 4 + (threadIdx.x >> 6); tok < T_; tok += nb * 4) {
    float hf[32], y[32];
    load_row_bf16(H + (size_t)tok * D_, lane, hf);
#pragma unroll
    for (int k = 0; k < 32; ++k) y[k] = 0.f;
    const int ev0 = EX[(size_t)tok * 128 + lane], ev1 = EX[(size_t)tok * 128 + 64 + lane];
    const float gv0 = GT[(size_t)tok * 128 + lane], gv1 = GT[(size_t)tok * 128 + 64 + lane];
    const float ru0 = RSU[ev0], ru1 = RSU[ev1], rv0 = RSV[ev0], rv1 = RSV[ev1];
    for (int k4 = 0; k4 < 128; k4 += 4) {
      const int src = k4 & 63;
      const bool lo = k4 < 64;
      int ee[4]; float gg[4], su[4], sv[4];
#pragma unroll
      for (int x = 0; x < 4; ++x) {
        ee[x] = __shfl(lo ? ev0 : ev1, src + x);
        gg[x] = __shfl(lo ? gv0 : gv1, src + x);
        su[x] = __shfl(lo ? ru0 : ru1, src + x);
        sv[x] = __shfl(lo ? rv0 : rv1, src + x);
      }
      uint4 uu[4][2], vv[4][2];
#pragma unroll
      for (int x = 0; x < 4; ++x)
#pragma unroll
        for (int q = 0; q < 2; ++q) {
          uu[x][q] = *(const uint4*)(U8 + (size_t)ee[x] * D_ + q * 1024 + lane * 16);
          vv[x][q] = *(const uint4*)(V8 + (size_t)ee[x] * D_ + q * 1024 + lane * 16);
        }
      float dd[4];
#pragma unroll
      for (int x = 0; x < 4; ++x) {
        float d = 0.f;
#pragma unroll
        for (int q = 0; q < 2; ++q) {
          float f[16];
          dec16(uu[x][q], f);
#pragma unroll
          for (int j = 0; j < 16; ++j) d = fmaf(f[j], hf[q * 16 + j], d);
        }
        dd[x] = d;
      }
#pragma unroll
      for (int o = 32; o >= 1; o >>= 1) {
#pragma unroll
        for (int x = 0; x < 4; ++x) dd[x] += __shfl_xor(dd[x], o);
      }
#pragma unroll
      for (int x = 0; x < 4; ++x) {
        const float w = gg[x] * gelu_tanh(dd[x] * su[x]) * sv[x];
#pragma unroll
        for (int q = 0; q < 2; ++q) {
          float f[16];
          dec16(vv[x][q], f);
#pragma unroll
          for (int j = 0; j < 16; ++j) y[q * 16 + j] = fmaf(w, f[j], y[q * 16 + j]);
        }
      }
    }
    float ef[32], sg[32];
    load_row_bf16(E + (size_t)tok * D_, lane, ef);
    load_row_bf16(SG + (size_t)tok * D_, lane, sg);
    float ss = 0.f;
#pragma unroll
    for (int k = 0; k < 32; ++k) ss += ef[k] * ef[k];
    const float rr = rsqrtf(wave_sum(ss) * (1.f / D_) + 1e-5f);
    float s1 = 0.f;
#pragma unroll
    for (int q = 0; q < 2; ++q)
#pragma unroll
      for (int j4 = 0; j4 < 4; ++j4) {
        float4 g = *(const float4*)(P.ple_g + q * 1024 + lane * 16 + j4 * 4);
        const float gq[4] = {g.x, g.y, g.z, g.w};
#pragma unroll
        for (int j = 0; j < 4; ++j) {
          const int k = q * 16 + j4 * 4 + j;
          float v = ALPHA * hf[k] + y[k] + ef[k] * rr * gq[j] * sg[k];
          y[k] = v;
          s1 += v;
        }
      }
    const float mu = wave_sum(s1) * (1.f / D_);
    float s2 = 0.f;
#pragma unroll
    for (int k = 0; k < 32; ++k) { float d = y[k] - mu; s2 += d * d; }
    const float rstd = rsqrtf(wave_sum(s2) * (1.f / D_) + 1e-5f);
#pragma unroll
    for (int q = 0; q < 2; ++q)
#pragma unroll
      for (int j4 = 0; j4 < 4; ++j4) {
        const int col = q * 1024 + lane * 16 + j4 * 4;
        const int k = q * 16 + j4 * 4;
        float4 g = *(const float4*)(P.ln2_g + col), b = *(const float4*)(P.ln2_b + col);
        float4 o;
        o.x = (y[k + 0] - mu) * rstd * g.x + b.x; o.y = (y[k + 1] - mu) * rstd * g.y + b.y;
        o.z = (y[k + 2] - mu) * rstd * g.z + b.z; o.w = (y[k + 3] - mu) * rstd * g.w + b.w;
        *(float4*)(P.out + (size_t)tok * D_ + col) = o;
      }
  }
}

constexpr size_t O_BAR = 1000 * MB;
__device__ __forceinline__ void gbar(unsigned* ctr, unsigned& epoch, unsigned nb) {
  epoch += nb;
  asm volatile("s_waitcnt vmcnt(0)" ::: "memory");
  __syncthreads();
  if (threadIdx.x == 0) {
    __builtin_amdgcn_fence(__ATOMIC_RELEASE, "agent");
    asm volatile("s_waitcnt vmcnt(0)" ::: "memory");
    __hip_atomic_fetch_add(ctr, 1u, __ATOMIC_RELAXED, __HIP_MEMORY_SCOPE_AGENT);
    while (__hip_atomic_load(ctr, __ATOMIC_RELAXED, __HIP_MEMORY_SCOPE_AGENT) < epoch) __builtin_amdgcn_s_sleep(2);
    __builtin_amdgcn_fence(__ATOMIC_ACQUIRE, "agent");
    asm volatile("s_waitcnt vmcnt(0)" ::: "memory");
  }
  __syncthreads();
}

__device__ __forceinline__ void run_phase(const Params& P, int ph, int bid, int nb, u16* lds) {
  switch (ph) {
    case 0: phase0(P, bid, nb, lds); break;
    case 1: phase1(P, bid, nb, lds); break;
    case 2: phase2(P, bid, nb, lds); break;
    case 3: phase3(P, bid, nb, lds); break;
    case 4: phase4(P, bid, nb, lds); break;
    case 5: phase5(P, bid, nb, lds); break;
    case 6: phase6(P, bid, nb, lds); break;
    case 7: ln_rows((const float*)(P.ws + O_PRE1), P.ln1_g, P.ln1_b, (u16*)(P.ws + O_H), bid * 4 + (threadIdx.x >> 6), nb * 4); break;
    case 8: phase8(P, bid, nb, lds); break;
    case 9: phase9(P, bid, nb, lds); break;
    case 10: phase10(P, bid, nb, lds); break;
    case 11: phase11(P, bid, nb); break;
  }
}
constexpr int NPHASE = 12;

#if MULTI
__global__ void __launch_bounds__(256, 2) phase_kernel(Params P, int ph) {
  __shared__ __attribute__((aligned(16))) u16 lds[36864];
  run_phase(P, ph, blockIdx.x, gridDim.x, lds);
}
#else
__global__ void __launch_bounds__(256, 2) mega_kernel(Params P) {
  __shared__ __attribute__((aligned(16))) u16 lds[36864];
  cg::grid_group grid = cg::this_grid();
  const int bid = blockIdx.x, nb = gridDim.x;
  unsigned* ctr = (unsigned*)(P.ws + O_BAR);
  unsigned ep = 0;
  phase0(P, bid, nb, lds); grid.sync();
  phase1(P, bid, nb, lds); gbar(ctr, ep, nb);
  phase2(P, bid, nb, lds); gbar(ctr, ep, nb);
  phase3(P, bid, nb, lds); gbar(ctr, ep, nb);
  phase4(P, bid, nb, lds); gbar(ctr, ep, nb);
  phase5(P, bid, nb, lds); gbar(ctr, ep, nb);
  phase6(P, bid, nb, lds); gbar(ctr, ep, nb);
  ln_rows((const float*)(P.ws + O_PRE1), P.ln1_g, P.ln1_b, (u16*)(P.ws + O_H), bid * 4 + (threadIdx.x >> 6), nb * 4);
  gbar(ctr, ep, nb);
  phase8(P, bid, nb, lds); gbar(ctr, ep, nb);
  phase9(P, bid, nb, lds); gbar(ctr, ep, nb);
  phase10(P, bid, nb, lds); gbar(ctr, ep, nb);
  phase11(P, bid, nb);
}
#endif

extern "C" void kernel_launch(void* const* d_in, const int* in_sizes, int n_in, void* d_out, int out_size, void* d_ws,
                              size_t ws_size, hipStream_t stream) {
  Params p{};
  const float** pp = (const float**)&p;
  for (int i = 0; i < 29; ++i) pp[i] = (const float*)d_in[i];
  p.out = (float*)d_out;
  p.ws = (char*)d_ws;
  if (ws_size < 1001 * MB) fprintf(stderr, "workspace too small: %zu\n", ws_size);
#if MULTI
  for (int ph = 0; ph < NPHASE; ++ph) phase_kernel<<<512, 256, 0, stream>>>(p, ph);
#else
  static int grid_blocks = 0;
  if (!grid_blocks) {
    int dev = 0, cus = 0, per_cu = 0;
    hipGetDevice(&dev);
    hipDeviceGetAttribute(&cus, hipDeviceAttributeMultiprocessorCount, dev);
    hipOccupancyMaxActiveBlocksPerMultiprocessor(&per_cu, mega_kernel, 256, 0);
    if (per_cu > 2) per_cu = 2;
    grid_blocks = cus * per_cu;
  }
  (void)hipMemsetAsync((char*)d_ws + O_BAR, 0, 256, stream);
  void* args[] = {&p};
  hipError_t e = hipLaunchCooperativeKernel((void*)mega_kernel, dim3(grid_blocks), dim3(256), args, 0, stream);
  if (e != hipSuccess) fprintf(stderr, "cooperative launch failed: %s (grid %d)\n", hipGetErrorString(e), grid_blocks);
#endif
}
```

```cpp
#include <hip/hip_runtime.h>
#include <hip/hip_bf16.h>
#include <hip/hip_cooperative_groups.h>
#include <cstdio>
namespace cg = cooperative_groups;

#ifndef MULTI
#define MULTI 0
#endif

typedef unsigned short u16;
using bf16x8 = __attribute__((ext_vector_type(8))) short;
using f32x4 = __attribute__((ext_vector_type(4))) float;

constexpr int T_ = 32768;
constexpr int S_ = 16384;
constexpr int D_ = 2048;
constexpr int SSM_L = 128;
constexpr int SSM_NC = S_ / SSM_L;
constexpr float ALPHA = 1.189207115002721f;
constexpr size_t MB = 1024ull * 1024ull;

constexpr size_t O_WIN = 0 * MB, O_WGLU = 32 * MB, O_WAU = 34 * MB, O_WSU = 38 * MB, O_WOUT = 42 * MB,
                 O_WPQ = 50 * MB, O_WPG = 58 * MB, O_WPIN = 66 * MB, O_SK = 67 * MB, O_BCAT = 67 * MB + 512 * 1024,
                 O_CCAT = 68 * MB, O_LAM = 68 * MB + 256 * 1024, O_UB = 70 * MB, O_VB = 134 * MB, O_SBUF = 198 * MB,
                 O_H = 206 * MB, O_Q = 334 * MB, O_K = 398 * MB, O_VT = 462 * MB, O_U2 = 526 * MB, O_G = 590 * MB,
                 O_YA = 846 * MB, O_YS = 910 * MB, O_PB = 974 * MB;
constexpr size_t O_YG = O_VT, O_MERGED = O_Q, O_PRE1 = O_G, O_PQ = O_Q, O_SG = O_VT, O_E = O_G,
                 O_HV = O_G + 128 * MB, O_HI = O_G + 160 * MB, O_EXP = O_G + 192 * MB, O_GATE = O_G + 208 * MB;

struct Params {
  const float *x, *p, *ln_in_g, *ln_in_b, *w_in, *rel_bias, *lam_re, *lam_im, *log_dt, *b_re, *b_im, *c_re, *c_im,
      *ssm_d, *w_glu, *w_au, *w_su, *w_out, *ln1_g, *ln1_b, *w_pq, *sub_keys, *peer_u, *peer_v, *ple_w_in, *ple_g,
      *ple_w_gate, *ln2_g, *ln2_b;
  float* out;
  char* ws;
};

__device__ __forceinline__ int tidx() { int t = threadIdx.x; asm volatile("" : "+v"(t)); return t; }
__device__ __forceinline__ u16 f2bf(float f) {
  unsigned u = __float_as_uint(f);
  u += 0x7fffu + ((u >> 16) & 1u);
  return (u16)(u >> 16);
}
__device__ __forceinline__ float bf2f(u16 h) { return __uint_as_float(((unsigned)h) << 16); }
typedef __bf16 hwbf16x2 __attribute__((ext_vector_type(2)));
typedef float hwf32x2 __attribute__((ext_vector_type(2)));
__device__ __forceinline__ unsigned pack2(float a, float b) {
  hwf32x2 v = {a, b};
  hwbf16x2 r = __builtin_convertvector(v, hwbf16x2);
  return *(unsigned*)&r;
}
__device__ __forceinline__ float lo2f(unsigned u) { return __uint_as_float(u << 16); }
__device__ __forceinline__ float hi2f(unsigned u) { return __uint_as_float(u & 0xffff0000u); }
__device__ __forceinline__ float sigmoidf_(float x) { return __builtin_amdgcn_rcpf(1.f + __expf(-x)); }
__device__ __forceinline__ float gelu_tanh(float x) {
  float u = 0.7978845608028654f * (x + 0.044715f * x * x * x);
  float t = 1.f - 2.f * __builtin_amdgcn_rcpf(1.f + __expf(2.f * u));
  return 0.5f * x * (1.f + t);
}
__device__ __forceinline__ float wave_sum(float v) {
#pragma unroll
  for (int o = 32; o >= 1; o >>= 1) v += __shfl_xor(v, o);
  return v;
}
__device__ __forceinline__ void store_bf4(u16* dst, float a, float b, float c, float d) {
  uint2 v; v.x = pack2(a, b); v.y = pack2(c, d);
  *(uint2*)dst = v;
}

__device__ __forceinline__ void gemm_kloop(f32x4 (&acc)[4][4], const u16* __restrict__ A, int lda,
                                           const u16* __restrict__ Bt, int ldb, int K, u16* lds) {
  const int tid = tidx(), lane = tid & 63, wid = tid >> 6, wm = wid >> 1, wn = wid & 1;
  const int lr = lane & 15, lq = lane >> 4;
  const int nk = K >> 6;
  const int srow = tid >> 3, sc = (tid & 7) ^ (srow & 7);
  const u16* ga = A + (size_t)srow * lda + sc * 8;
  const u16* gb = Bt + (size_t)srow * ldb + sc * 8;
  u16* lw = lds + tid * 8;
#pragma unroll
  for (int i = 0; i < 4; ++i) {
    __builtin_amdgcn_global_load_lds((const unsigned*)(ga + (size_t)(32 * i) * lda), (unsigned*)(lw + i * 2048), 16, 0, 0);
    __builtin_amdgcn_global_load_lds((const unsigned*)(gb + (size_t)(32 * i) * ldb), (unsigned*)(lw + 8192 + i * 2048), 16, 0, 0);
  }
  __syncthreads();
  const int swz = lr & 7;
  for (int kt = 0; kt < nk; ++kt) {
    if (kt + 1 < nk) {
      u16* lw2 = lw + ((kt + 1) & 1) * 16384;
#pragma unroll
      for (int i = 0; i < 4; ++i) {
        __builtin_amdgcn_global_load_lds((const unsigned*)(ga + (size_t)(32 * i) * lda + (kt + 1) * 64), (unsigned*)(lw2 + i * 2048), 16, 0, 0);
        __builtin_amdgcn_global_load_lds((const unsigned*)(gb + (size_t)(32 * i) * ldb + (kt + 1) * 64), (unsigned*)(lw2 + 8192 + i * 2048), 16, 0, 0);
      }
    }
    const u16* sa = lds + (kt & 1) * 16384;
    const u16* sb = sa + 8192;
#pragma unroll
    for (int ks = 0; ks < 2; ++ks) {
      bf16x8 af[4], bfr[4];
      const int co = ((ks * 4 + lq) ^ swz) * 8;
#pragma unroll
      for (int mi = 0; mi < 4; ++mi) af[mi] = *(const bf16x8*)(sa + (wm * 64 + mi * 16 + lr) * 64 + co);
#pragma unroll
      for (int ni = 0; ni < 4; ++ni) bfr[ni] = *(const bf16x8*)(sb + (wn * 64 + ni * 16 + lr) * 64 + co);
#pragma unroll
      for (int mi = 0; mi < 4; ++mi)
#pragma unroll
        for (int ni = 0; ni < 4; ++ni)
          acc[mi][ni] = __builtin_amdgcn_mfma_f32_16x16x32_bf16(bfr[ni], af[mi], acc[mi][ni], 0, 0, 0);
    }
    __syncthreads();
  }
}

#define ZERO_ACC(acc)                                   \
  _Pragma("unroll") for (int _a = 0; _a < 4; ++_a)      \
  _Pragma("unroll") for (int _b = 0; _b < 4; ++_b) acc[_a][_b] = f32x4{0.f, 0.f, 0.f, 0.f};

__device__ __forceinline__ void gemm_kloop2(f32x4 (&acc)[4][8], const u16* __restrict__ A, int lda,
                                            const u16* __restrict__ Bt, int ldb, int K, u16* lds) {
  const int tid = tidx(), lane = tid & 63, wid = tid >> 6;
  const int lr = lane & 15, lq = lane >> 4;
  const int nk = K >> 5;
  const int srow = tid >> 2;
  const int sc = (tid & 3) ^ ((0x78 >> (2 * ((tid >> 4) & 3))) & 3);
  const u16* ga = A + (size_t)srow * lda + sc * 8;
  const u16* gb = Bt + (size_t)srow * ldb + sc * 8;
  u16* lw = lds + tid * 8;
#pragma unroll
  for (int i = 0; i < 4; ++i)
    __builtin_amdgcn_global_load_lds((const unsigned*)(ga + (size_t)(64 * i) * lda), (unsigned*)(lw + i * 2048), 16, 0, 0);
#pragma unroll
  for (int i = 0; i < 2; ++i)
    __builtin_amdgcn_global_load_lds((const unsigned*)(gb + (size_t)(64 * i) * ldb), (unsigned*)(lw + 8192 + i * 2048), 16, 0, 0);
  __syncthreads();
  const int co = (lq ^ ((0x78 >> (2 * ((lr >> 2) & 3))) & 3)) * 8;
  for (int kt = 0; kt < nk; ++kt) {
    if (kt + 1 < nk) {
      u16* lw2 = lw + ((kt + 1) & 1) * 12288;
#pragma unroll
      for (int i = 0; i < 4; ++i)
        __builtin_amdgcn_global_load_lds((const unsigned*)(ga + (size_t)(64 * i) * lda + (kt + 1) * 32), (unsigned*)(lw2 + i * 2048), 16, 0, 0);
#pragma unroll
      for (int i = 0; i < 2; ++i)
        __builtin_amdgcn_global_load_lds((const unsigned*)(gb + (size_t)(64 * i) * ldb + (kt + 1) * 32), (unsigned*)(lw2 + 8192 + i * 2048), 16, 0, 0);
    }
    const u16* sa = lds + (kt & 1) * 12288;
    const u16* sb = sa + 8192;
    bf16x8 af[4];
#pragma unroll
    for (int mi = 0; mi < 4; ++mi) af[mi] = *(const bf16x8*)(sa + (wid * 64 + mi * 16 + lr) * 32 + co);
#pragma unroll
    for (int nh = 0; nh < 2; ++nh) {
      bf16x8 bfr[4];
#pragma unroll
      for (int ni = 0; ni < 4; ++ni) bfr[ni] = *(const bf16x8*)(sb + ((nh * 4 + ni) * 16 + lr) * 32 + co);
#pragma unroll
      for (int mi = 0; mi < 4; ++mi)
#pragma unroll
        for (int ni = 0; ni < 4; ++ni)
          acc[mi][nh * 4 + ni] = __builtin_amdgcn_mfma_f32_16x16x32_bf16(bfr[ni], af[mi], acc[mi][nh * 4 + ni], 0, 0, 0);
    }
    __syncthreads();
  }
}

#define ZERO_ACC8(acc)                                  \
  _Pragma("unroll") for (int _a = 0; _a < 4; ++_a)      \
  _Pragma("unroll") for (int _b = 0; _b < 8; ++_b) acc[_a][_b] = f32x4{0.f, 0.f, 0.f, 0.f};

#define FOR_TILES_XCD(t, ntiles) \
  for (int _k = 0, t = (bid & 7) * (nb >> 3) + (bid >> 3); t < (ntiles); ++_k, t = ((_k * 8 + (bid & 7)) * (nb >> 3)) + (bid >> 3))

#define EPI_COORDS                                                             \
  const int lane = tidx() & 63, wid = tidx() >> 6, wm = wid >> 1, wn = wid & 1; \
  const int lr = lane & 15, lq = lane >> 4;

__device__ void tconv_tile(const float* __restrict__ W, int K, int N, u16* __restrict__ Wt, int tile, float* lds) {
  const int tid = tidx();
  const int ntn = N >> 6;
  const int kt = tile / ntn, nt = tile % ntn;
  const int c4 = (tid & 15) * 4;
#pragma unroll
  for (int i = 0; i < 4; ++i) {
    int r = (tid >> 4) + 16 * i;
    float4 v = *(const float4*)(W + (size_t)(kt * 64 + r) * N + nt * 64 + c4);
    lds[r * 65 + c4 + 0] = v.x; lds[r * 65 + c4 + 1] = v.y; lds[r * 65 + c4 + 2] = v.z; lds[r * 65 + c4 + 3] = v.w;
  }
  __syncthreads();
  const int n = tid >> 2, kseg = (tid & 3) * 16;
  unsigned o[8];
#pragma unroll
  for (int j = 0; j < 8; ++j) o[j] = pack2(lds[(kseg + 2 * j) * 65 + n], lds[(kseg + 2 * j + 1) * 65 + n]);
  u16* dst = Wt + (size_t)(nt * 64 + n) * K + kt * 64 + kseg;
  *(uint4*)dst = uint4{o[0], o[1], o[2], o[3]};
  *(uint4*)(dst + 8) = uint4{o[4], o[5], o[6], o[7]};
  __syncthreads();
}

__device__ void conv_linear(const float* __restrict__ src, u16* __restrict__ dst, size_t n8, size_t gtid, size_t nth) {
  for (size_t i = gtid; i < n8; i += nth) {
    float4 a = *(const float4*)(src + i * 8), b = *(const float4*)(src + i * 8 + 4);
    *(uint4*)(dst + i * 8) = uint4{pack2(a.x, a.y), pack2(a.z, a.w), pack2(b.x, b.y), pack2(b.z, b.w)};
  }
}

typedef float f32x2 __attribute__((ext_vector_type(2)));
constexpr size_t O_U8 = O_UB, O_V8 = O_UB + 32 * MB, O_RSU = O_VB, O_RSV = O_VB + 64 * 1024;
__device__ void conv_fp8_rows(const float* __restrict__ src, unsigned char* __restrict__ dst, float* __restrict__ rscale,
                              int gw, int nw) {
  const int lane = tidx() & 63;
  for (int row = gw; row < 16384; row += nw) {
    const float* r = src + (size_t)row * D_;
    float4 v[8];
#pragma unroll
    for (int q = 0; q < 8; ++q) v[q] = *(const float4*)(r + q * 256 + lane * 4);
    float am = 0.f;
#pragma unroll
    for (int q = 0; q < 8; ++q) am = fmaxf(am, fmaxf(fmaxf(fabsf(v[q].x), fabsf(v[q].y)), fmaxf(fabsf(v[q].z), fabsf(v[q].w))));
#pragma unroll
    for (int o = 32; o >= 1; o >>= 1) am = fmaxf(am, __shfl_xor(am, o));
    const float sc = am > 0.f ? 416.f / am : 1.f;
#pragma unroll
    for (int q = 0; q < 8; ++q) {
      int w = 0;
      w = __builtin_amdgcn_cvt_pk_fp8_f32(v[q].x * sc, v[q].y * sc, w, false);
      w = __builtin_amdgcn_cvt_pk_fp8_f32(v[q].z * sc, v[q].w * sc, w, true);
      *(int*)(dst + (size_t)row * D_ + q * 256 + lane * 4) = w;
    }
    if (lane == 0) rscale[row] = am > 0.f ? am / 416.f : 1.f;
  }
}

__device__ void ln_rows(const float* __restrict__ src, const float* __restrict__ g, const float* __restrict__ b,
                        u16* __restrict__ dst, int gw, int nw) {
  const int lane = tidx() & 63;
  for (int row = gw; row < T_; row += nw) {
    const float* r = src + (size_t)row * D_;
    float4 v[8];
#pragma unroll
    for (int q = 0; q < 8; ++q) v[q] = *(const float4*)(r + q * 256 + lane * 4);
    float s = 0.f;
#pragma unroll
    for (int q = 0; q < 8; ++q) s += v[q].x + v[q].y + v[q].z + v[q].w;
    float mu = wave_sum(s) * (1.f / D_);
    float ss = 0.f;
#pragma unroll
    for (int q = 0; q < 8; ++q) {
      float a = v[q].x - mu, bb = v[q].y - mu, c = v[q].z - mu, d = v[q].w - mu;
      ss += a * a + bb * bb + c * c + d * d;
    }
    float rstd = rsqrtf(wave_sum(ss) * (1.f / D_) + 1e-5f);
#pragma unroll
    for (int q = 0; q < 8; ++q) {
      int col = q * 256 + lane * 4;
      float4 gg = *(const float4*)(g + col), bb = *(const float4*)(b + col);
      store_bf4(dst + (size_t)row * D_ + col, (v[q].x - mu) * rstd * gg.x + bb.x, (v[q].y - mu) * rstd * gg.y + bb.y,
                (v[q].z - mu) * rstd * gg.z + bb.z, (v[q].w - mu) * rstd * gg.w + bb.w);
    }
  }
}

__device__ __forceinline__ void dsincos(double x, double& s, double& c) {
  double q = rint(x * 0.63661977236758134308);
  double r = x - q * 1.57079632679489661923;
  double r2 = r * r;
  double sp = r * (1.0 + r2 * (-1.0 / 6 + r2 * (1.0 / 120 + r2 * (-1.0 / 5040 + r2 * (1.0 / 362880 + r2 * (-1.0 / 39916800 + r2 * (1.0 / 6227020800.0)))))));
  double cp = 1.0 + r2 * (-0.5 + r2 * (1.0 / 24 + r2 * (-1.0 / 720 + r2 * (1.0 / 40320 + r2 * (-1.0 / 3628800 + r2 * (1.0 / 479001600.0 + r2 * (-1.0 / 87178291200.0)))))));
  int qi = ((int)q) & 3;
  if (qi == 0) { s = sp; c = cp; }
  else if (qi == 1) { s = cp; c = -sp; }
  else if (qi == 2) { s = -sp; c = -cp; }
  else { s = -cp; c = sp; }
}

__device__ void ssm_consts(const Params& P, int i) {
  const int g = i >> 6, p = i & 63;
  double lr = P.lam_re[g * 64 + p], li = P.lam_im[g * 64 + p];
  double dt = exp((double)P.log_dt[g]);
  double mag = exp(lr * dt);
  double sn, cs;
  dsincos(li * dt, sn, cs);
  double ar = mag * cs, ai = mag * sn;
  double nr = ar - 1.0, ni = ai, den = lr * lr + li * li;
  double fr = (nr * lr + ni * li) / den, fi = (ni * lr - nr * li) / den;
  u16* bcat = (u16*)(P.ws + O_BCAT);
  u16* ccat = (u16*)(P.ws + O_CCAT);
  float* lam = (float*)(P.ws + O_LAM);
  for (int h = 0; h < 16; ++h) {
    double br = P.b_re[(g * 64 + p) * 16 + h], bi = P.b_im[(g * 64 + p) * 16 + h];
    bcat[(g * 128 + p) * 32 + h] = f2bf((float)(fr * br - fi * bi));
    bcat[(g * 128 + 64 + p) * 32 + h] = f2bf((float)(fr * bi + fi * br));
    bcat[(g * 128 + p) * 32 + 16 + h] = 0;
    bcat[(g * 128 + 64 + p) * 32 + 16 + h] = 0;
    ccat[(g * 16 + h) * 128 + p] = f2bf(P.c_re[(g * 16 + h) * 64 + p]);
    ccat[(g * 16 + h) * 128 + 64 + p] = f2bf(-P.c_im[(g * 16 + h) * 64 + p]);
  }
  double pr = ar, pi = ai;
  for (int k = 0; k < 10; ++k) {
    double t = pr * pr - pi * pi;
    pi = 2.0 * pr * pi;
    pr = t;
  }
  lam[0 * 4096 + i] = (float)ar;
  lam[1 * 4096 + i] = (float)ai;
  lam[2 * 4096 + i] = (float)pr;
  lam[3 * 4096 + i] = (float)pi;
}

__device__ void phase0(const Params& P, int bid, int nb, u16* lds) {
  const size_t gtid = (size_t)bid * 256 + tidx(), nth = (size_t)nb * 256;
#define TCONV(wp, KK, NN, OFF) \
  for (int t = bid; t < ((KK) >> 6) * ((NN) >> 6); t += nb) tconv_tile(wp, KK, NN, (u16*)(P.ws + OFF), t, (float*)lds);
  TCONV(P.w_in, 2048, 8192, O_WIN)
  TCONV(P.w_glu, 1024, 1024, O_WGLU)
  TCONV(P.w_au, 1024, 2048, O_WAU)
  TCONV(P.w_su, 1024, 2048, O_WSU)
  TCONV(P.w_out, 2048, 2048, O_WOUT)
  TCONV(P.w_pq, 2048, 2048, O_WPQ)
  TCONV(P.ple_w_gate, 2048, 2048, O_WPG)
  TCONV(P.ple_w_in, 256, 2048, O_WPIN)
  conv_fp8_rows(P.peer_u, (unsigned char*)(P.ws + O_U8), (float*)(P.ws + O_RSU), bid * 4 + (tidx() >> 6), nb * 4);
  conv_fp8_rows(P.peer_v, (unsigned char*)(P.ws + O_V8), (float*)(P.ws + O_RSV), bid * 4 + (tidx() >> 6), nb * 4);
  conv_linear(P.sub_keys, (u16*)(P.ws + O_SK), (size_t)16 * 128 * 128 / 8, gtid, nth);
  conv_linear(P.p, (u16*)(P.ws + O_PB), (size_t)T_ * 256 / 8, gtid, nth);
  for (size_t i = gtid; i < 4096; i += nth) ssm_consts(P, (int)i);
  ln_rows(P.x, P.ln_in_g, P.ln_in_b, (u16*)(P.ws + O_H), bid * 4 + (tidx() >> 6), nb * 4);
}

__device__ void phase1(const Params& P, int bid, int nb, u16* lds) {
  const u16* H = (const u16*)(P.ws + O_H);
  const u16* W = (const u16*)(P.ws + O_WIN);
  u16* Q = (u16*)(P.ws + O_Q);
  u16* Kb = (u16*)(P.ws + O_K);
  u16* Vt = (u16*)(P.ws + O_VT);
  u16* U2 = (u16*)(P.ws + O_U2);
  u16* G = (u16*)(P.ws + O_G);
  EPI_COORDS
  const int ntiles = 128 * 64;
  for (int t = bid, rnd = 0; t < ntiles; t += nb, ++rnd) {
    const int mt = t >> 6, nt = (t & 7) + 8 * ((((t >> 3) & 7) + rnd) & 7);
    f32x4 acc[4][8];
    ZERO_ACC8(acc)
    gemm_kloop2(acc, H + (size_t)mt * 256 * D_, D_, W + (size_t)nt * 128 * D_, D_, D_, lds);
    const int region = nt >> 3;
#pragma unroll
    for (int mi = 0; mi < 4; ++mi) {
      const int m = mt * 256 + wid * 64 + mi * 16 + lr;
#pragma unroll
      for (int ni = 0; ni < 8; ++ni) {
        const int n = nt * 128 + ni * 16 + lq * 4;
        f32x4 a = acc[mi][ni];
        if (region == 0) {
          const float sc = 0.08838834764831845f;
          store_bf4(Q + (size_t)m * 1024 + n, a[0] * sc, a[1] * sc, a[2] * sc, a[3] * sc);
        } else if (region == 1) {
          store_bf4(Kb + (size_t)m * 1024 + (n - 1024), a[0], a[1], a[2], a[3]);
        } else if (region == 2) {
          const int b = m >> 14, tt = m & (S_ - 1);
#pragma unroll
          for (int j = 0; j < 4; ++j) Vt[((size_t)(b * 1024 + (n - 2048 + j))) * S_ + tt] = f2bf(a[j]);
        } else if (region == 3) {
          store_bf4(U2 + (size_t)m * 1024 + (n - 3072), a[0], a[1], a[2], a[3]);
        } else {
          store_bf4(G + (size_t)m * 4096 + (n - 4096), sigmoidf_(a[0]), sigmoidf_(a[1]), sigmoidf_(a[2]), sigmoidf_(a[3]));
        }
      }
    }
  }
}

__device__ void attn_item(const Params& P, int item, u16* lds) {
  const int c = item & 255, hd = (item >> 8) & 7, b = item >> 11;
  const int tid = tidx(), lane = tid & 63, w = tid >> 6, lr = lane & 15, lq = lane >> 4;
  u16* Ks = lds;
  u16* Vs = lds + 64 * 136;
  float* bs = (float*)(lds + 64 * 136 + 128 * 72);
  const u16* Q = (const u16*)(P.ws + O_Q);
  const u16* Kb = (const u16*)(P.ws + O_K);
  const u16* Vt = (const u16*)(P.ws + O_VT);
  u16* ya = (u16*)(P.ws + O_YA);
  __syncthreads();
  for (int i = tid; i < 257; i += 256) bs[i] = P.rel_bias[hd * 257 + i];
  bf16x8 qf[4];
  {
    const u16* qp = Q + (size_t)(b * S_ + c * 64 + w * 16 + lr) * 1024 + hd * 128 + lq * 8;
#pragma unroll
    for (int ks = 0; ks < 4; ++ks) qf[ks] = *(const bf16x8*)(qp + ks * 32);
  }
  f32x4 oacc[8];
#pragma unroll
  for (int d = 0; d < 8; ++d) oacc[d] = f32x4{0.f, 0.f, 0.f, 0.f};
  float m_run = -1e30f, lsum = 0.f;
  const int i0 = (c < 8) ? (8 - c) : 0;
  const int qi = w * 16 + lr;
#define KV_ADDR_K(r, kc_) (Kb + (size_t)(b * S_ + (kc_) * 64 + ((tid + 256 * (r)) >> 4)) * 1024 + hd * 128 + ((tid + 256 * (r)) & 15) * 8)
#define KV_ADDR_V(r, kc_) (Vt + ((size_t)(b * 1024 + hd * 128 + ((tid + 256 * (r)) >> 3))) * S_ + (kc_) * 64 + ((tid + 256 * (r)) & 7) * 8)
#define KV_LOAD(kc_)                                                                   \
  kr0 = *(const uint4*)KV_ADDR_K(0, kc_); kr1 = *(const uint4*)KV_ADDR_K(1, kc_);     \
  kr2 = *(const uint4*)KV_ADDR_K(2, kc_); kr3 = *(const uint4*)KV_ADDR_K(3, kc_);     \
  vr0 = *(const uint4*)KV_ADDR_V(0, kc_); vr1 = *(const uint4*)KV_ADDR_V(1, kc_);     \
  vr2 = *(const uint4*)KV_ADDR_V(2, kc_); vr3 = *(const uint4*)KV_ADDR_V(3, kc_);
#define KS_W(r) (Ks + ((tid + 256 * (r)) >> 4) * 136 + ((tid + 256 * (r)) & 15) * 8)
#define VS_W(r) (Vs + ((tid + 256 * (r)) >> 3) * 72 + ((tid + 256 * (r)) & 7) * 8)
  uint4 kr0, kr1, kr2, kr3, vr0, vr1, vr2, vr3;
  KV_LOAD(c - 8 + i0)
  for (int i = i0; i <= 8; ++i) {
    __syncthreads();
    *(uint4*)KS_W(0) = kr0; *(uint4*)KS_W(1) = kr1; *(uint4*)KS_W(2) = kr2; *(uint4*)KS_W(3) = kr3;
    *(uint4*)VS_W(0) = vr0; *(uint4*)VS_W(1) = vr1; *(uint4*)VS_W(2) = vr2; *(uint4*)VS_W(3) = vr3;
    __syncthreads();
    if (i < 8) { KV_LOAD(c - 8 + i + 1) }
    f32x4 sacc[4];
#pragma unroll
    for (int kt = 0; kt < 4; ++kt) {
      sacc[kt] = f32x4{0.f, 0.f, 0.f, 0.f};
#pragma unroll
      for (int ks = 0; ks < 4; ++ks) {
        bf16x8 kf = *(const bf16x8*)(Ks + (kt * 16 + lr) * 136 + ks * 32 + lq * 8);
        sacc[kt] = __builtin_amdgcn_mfma_f32_16x16x32_bf16(kf, qf[ks], sacc[kt], 0, 0, 0);
      }
    }
    float tmax = -1e30f;
#pragma unroll
    for (int kt = 0; kt < 4; ++kt)
#pragma unroll
      for (int j = 0; j < 4; ++j) {
        int kb = i * 64 + kt * 16 + lq * 4 + j;
        int rel = 512 + qi - kb;
        rel = min(max(rel, -128), 128) + 128;
        float s = sacc[kt][j] + bs[rel];
        sacc[kt][j] = s;
        tmax = fmaxf(tmax, s);
      }
    tmax = fmaxf(tmax, __shfl_xor(tmax, 16));
    tmax = fmaxf(tmax, __shfl_xor(tmax, 32));
    const float m_new = fmaxf(m_run, tmax);
    const float corr = __expf(m_run - m_new);
    m_run = m_new;
    float ps = 0.f;
#pragma unroll
    for (int kt = 0; kt < 4; ++kt)
#pragma unroll
      for (int j = 0; j < 4; ++j) {
        float pv = __expf(sacc[kt][j] - m_new);
        sacc[kt][j] = pv;
        ps += pv;
      }
    lsum = lsum * corr + ps;
#pragma unroll
    for (int d = 0; d < 8; ++d) {
      oacc[d][0] *= corr; oacc[d][1] *= corr; oacc[d][2] *= corr; oacc[d][3] *= corr;
    }
#pragma unroll
    for (int kk = 0; kk < 2; ++kk) {
      union { bf16x8 v; unsigned u[4]; } pf;
      pf.u[0] = pack2(sacc[2 * kk][0], sacc[2 * kk][1]);
      pf.u[1] = pack2(sacc[2 * kk][2], sacc[2 * kk][3]);
      pf.u[2] = pack2(sacc[2 * kk + 1][0], sacc[2 * kk + 1][1]);
      pf.u[3] = pack2(sacc[2 * kk + 1][2], sacc[2 * kk + 1][3]);
#pragma unroll
      for (int d = 0; d < 8; ++d) {
        union { bf16x8 v; uint2 h[2]; } vf;
        vf.h[0] = *(const uint2*)(Vs + (d * 16 + lr) * 72 + kk * 32 + lq * 4);
        vf.h[1] = *(const uint2*)(Vs + (d * 16 + lr) * 72 + kk * 32 + 16 + lq * 4);
        oacc[d] = __builtin_amdgcn_mfma_f32_16x16x32_bf16(vf.v, pf.v, oacc[d], 0, 0, 0);
      }
    }
  }
  lsum += __shfl_xor(lsum, 16);
  lsum += __shfl_xor(lsum, 32);
  const float inv = 1.f / lsum;
  u16* op = ya + (size_t)(b * S_ + c * 64 + w * 16 + lr) * 1024 + hd * 128 + lq * 4;
#pragma unroll
  for (int d = 0; d < 8; ++d) store_bf4(op + d * 16, oacc[d][0] * inv, oacc[d][1] * inv, oacc[d][2] * inv, oacc[d][3] * inv);
}

template <int PASS>
__device__ void ssm_item(const Params& P, int item, char* ldsw) {
  const int sc = item & 15, seq = item >> 4, g = seq & 63, b = seq >> 6;
  const int lane = tidx() & 63, lr = lane & 15, lq = lane >> 4;
  float* BuS = (float*)ldsw;
  u16* Hs = (u16*)(ldsw + 8192);
  const u16* bcat = (const u16*)(P.ws + O_BCAT);
  const u16* ccat = (const u16*)(P.ws + O_CCAT);
  const float* lam = (const float*)(P.ws + O_LAM);
  const u16* U2 = (const u16*)(P.ws + O_U2);
  float* Sbuf = (float*)(P.ws + O_SBUF);
  u16* ys = (u16*)(P.ws + O_YS);
  const float ar = lam[g * 64 + lane], ai = lam[4096 + g * 64 + lane];
  bf16x8 bfrag[8];
#pragma unroll
  for (int nt = 0; nt < 8; ++nt) bfrag[nt] = *(const bf16x8*)(bcat + (g * 128 + nt * 16 + lr) * 32 + lq * 8);
  float sr = 0.f, si = 0.f;
  bf16x8 cfrag[4];
  float dsk[4];
  if (PASS == 2) {
#pragma unroll
    for (int ks = 0; ks < 4; ++ks) cfrag[ks] = *(const bf16x8*)(ccat + (g * 16 + lr) * 128 + ks * 32 + lq * 8);
#pragma unroll
    for (int j = 0; j < 4; ++j) dsk[j] = P.ssm_d[g * 16 + lq * 4 + j];
    const float aLr = lam[2 * 4096 + g * 64 + lane], aLi = lam[3 * 4096 + g * 64 + lane];
    const float* Sb = Sbuf + (size_t)seq * 16 * 128;
#pragma unroll 4
    for (int cc = 0; cc < sc; ++cc) {
      float xr = Sb[cc * 128 + lane], xi = Sb[cc * 128 + 64 + lane];
      float nr = fmaf(aLr, sr, fmaf(-aLi, si, xr));
      float ni = fmaf(aLr, si, fmaf(aLi, sr, xi));
      sr = nr; si = ni;
    }
  }
#pragma unroll 1
  for (int ci = 0; ci < 8; ++ci) {
  const size_t tok_base = (size_t)b * S_ + (size_t)(sc * 8 + ci) * SSM_L;
  uint4 upre[SSM_L / 16];
  uint2 uepi[SSM_L / 16];
#pragma unroll
  for (int sub = 0; sub < SSM_L / 16; ++sub) {
    upre[sub] = uint4{0u, 0u, 0u, 0u};
    if (lq < 2) upre[sub] = *(const uint4*)(U2 + (tok_base + sub * 16 + lr) * 1024 + g * 16 + lq * 8);
    if (PASS == 2) uepi[sub] = *(const uint2*)(U2 + (tok_base + sub * 16 + lr) * 1024 + g * 16 + lq * 4);
  }
#pragma unroll
  for (int sub = 0; sub < SSM_L / 16; ++sub) {
    const size_t tok0 = tok_base + sub * 16;
    union { bf16x8 v; uint4 u; } uf;
    uf.u = upre[sub];
#pragma unroll
    for (int nt = 0; nt < 8; ++nt) {
      f32x4 d = __builtin_amdgcn_mfma_f32_16x16x32_bf16(bfrag[nt], uf.v, f32x4{0.f, 0.f, 0.f, 0.f}, 0, 0, 0);
      *(f32x4*)(BuS + lr * 128 + nt * 16 + lq * 4) = d;
    }
    asm volatile("s_waitcnt lgkmcnt(0)" ::: "memory");
#pragma unroll
    for (int t = 0; t < 16; ++t) {
      float bur = BuS[t * 128 + lane], bui = BuS[t * 128 + 64 + lane];
      float nr = fmaf(ar, sr, fmaf(-ai, si, bur));
      float ni = fmaf(ar, si, fmaf(ai, sr, bui));
      sr = nr; si = ni;
      if (PASS == 2) {
        Hs[t * 136 + lane] = f2bf(sr);
        Hs[t * 136 + 64 + lane] = f2bf(si);
      }
    }
    asm volatile("s_waitcnt lgkmcnt(0)" ::: "memory");
    if (PASS == 2) {
      f32x4 yacc = f32x4{0.f, 0.f, 0.f, 0.f};
#pragma unroll
      for (int ks = 0; ks < 4; ++ks) {
        bf16x8 hf = *(const bf16x8*)(Hs + lr * 136 + ks * 32 + lq * 8);
        yacc = __builtin_amdgcn_mfma_f32_16x16x32_bf16(cfrag[ks], hf, yacc, 0, 0, 0);
      }
      const uint2 uu = uepi[sub];
      float y0 = gelu_tanh(yacc[0] + dsk[0] * lo2f(uu.x));
      float y1 = gelu_tanh(yacc[1] + dsk[1] * hi2f(uu.x));
      float y2 = gelu_tanh(yacc[2] + dsk[2] * lo2f(uu.y));
      float y3 = gelu_tanh(yacc[3] + dsk[3] * hi2f(uu.y));
      store_bf4(ys + (tok0 + lr) * 1024 + g * 16 + lq * 4, y0, y1, y2, y3);
      asm volatile("s_waitcnt lgkmcnt(0)" ::: "memory");
    }
  }
  }
  if (PASS == 1) {
    Sbuf[((size_t)seq * 16 + sc) * 128 + lane] = sr;
    Sbuf[((size_t)seq * 16 + sc) * 128 + 64 + lane] = si;
  }
}

__device__ void phase2(const Params& P, int bid, int nb, u16* lds) {
  for (int it = bid; it < 4096 + 512; it += nb) {
    if (it < 4096) {
      attn_item(P, it, lds);
    } else {
      __syncthreads();
      const int w = tidx() >> 6;
      ssm_item<1>(P, (it - 4096) * 4 + w, (char*)lds + w * 12544);
    }
  }
}
__device__ void phase3(const Params& P, int bid, int nb, u16* lds) {
  const int w = tidx() >> 6;
  for (int it = bid; it < 512; it += nb) ssm_item<2>(P, it * 4 + w, (char*)lds + w * 12544);
}

__device__ void phase4(const Params& P, int bid, int nb, u16* lds) {
  const u16* ys = (const u16*)(P.ws + O_YS);
  const u16* W = (const u16*)(P.ws + O_WGLU);
  u16* yg = (u16*)(P.ws + O_YG);
  EPI_COORDS
  FOR_TILES_XCD(t, 128 * 8) {
    const int mt = t >> 3, nt = t & 7;
    f32x4 acc[4][8];
    ZERO_ACC8(acc)
    gemm_kloop2(acc, ys + (size_t)mt * 256 * 1024, 1024, W + (size_t)nt * 128 * 1024, 1024, 1024, lds);
#pragma unroll
    for (int mi = 0; mi < 4; ++mi) {
      const int m = mt * 256 + wid * 64 + mi * 16 + lr;
#pragma unroll
      for (int ni = 0; ni < 8; ++ni) {
        const int n = nt * 128 + ni * 16 + lq * 4;
        uint2 yy = *(const uint2*)(ys + (size_t)m * 1024 + n);
        f32x4 a = acc[mi][ni];
        store_bf4(yg + (size_t)m * 1024 + n, lo2f(yy.x) * sigmoidf_(a[0]), hi2f(yy.x) * sigmoidf_(a[1]),
                  lo2f(yy.y) * sigmoidf_(a[2]), hi2f(yy.y) * sigmoidf_(a[3]));
      }
    }
  }
}

__device__ void phase5(const Params& P, int bid, int nb, u16* lds) {
  const u16* ya = (const u16*)(P.ws + O_YA);
  const u16* yg = (const u16*)(P.ws + O_YG);
  const u16* Wa = (const u16*)(P.ws + O_WAU);
  const u16* Wsu = (const u16*)(P.ws + O_WSU);
  const u16* G = (const u16*)(P.ws + O_G);
  u16* mg = (u16*)(P.ws + O_MERGED);
  EPI_COORDS
  FOR_TILES_XCD(t, 128 * 16) {
    const int mt = t >> 4, nt = t & 15;
#pragma unroll 1
    for (int part = 0; part < 2; ++part) {
      f32x4 acc[4][8];
      ZERO_ACC8(acc)
      gemm_kloop2(acc, (part ? yg : ya) + (size_t)mt * 256 * 1024, 1024, (part ? Wsu : Wa) + (size_t)nt * 128 * 1024, 1024,
                  1024, lds);
      const u16* Gp = G + part * 2048;
#pragma unroll
      for (int mi = 0; mi < 4; ++mi) {
        const int m = mt * 256 + wid * 64 + mi * 16 + lr;
#pragma unroll
        for (int ni = 0; ni < 8; ++ni) {
          const int n = nt * 128 + ni * 16 + lq * 4;
          const uint2 gg = *(const uint2*)(Gp + (size_t)m * 4096 + n);
          f32x4 a = acc[mi][ni];
          float o0 = a[0] * lo2f(gg.x), o1 = a[1] * hi2f(gg.x), o2 = a[2] * lo2f(gg.y), o3 = a[3] * hi2f(gg.y);
          if (part) {
            const uint2 pv = *(const uint2*)(mg + (size_t)m * D_ + n);
            o0 += lo2f(pv.x); o1 += hi2f(pv.x); o2 += lo2f(pv.y); o3 += hi2f(pv.y);
          }
          store_bf4(mg + (size_t)m * D_ + n, o0, o1, o2, o3);
        }
      }
    }
  }
}

__device__ void phase6(const Params& P, int bid, int nb, u16* lds) {
  const u16* mg = (const u16*)(P.ws + O_MERGED);
  const u16* W = (const u16*)(P.ws + O_WOUT);
  const u16* H = (const u16*)(P.ws + O_H);
  float* pre1 = (float*)(P.ws + O_PRE1);
  EPI_COORDS
  FOR_TILES_XCD(t, 128 * 16) {
    const int mt = t >> 4, nt = t & 15;
    f32x4 acc[4][8];
    ZERO_ACC8(acc)
    gemm_kloop2(acc, mg + (size_t)mt * 256 * D_, D_, W + (size_t)nt * 128 * D_, D_, D_, lds);
#pragma unroll
    for (int mi = 0; mi < 4; ++mi) {
      const int m = mt * 256 + wid * 64 + mi * 16 + lr;
#pragma unroll
      for (int ni = 0; ni < 8; ++ni) {
        const int n = nt * 128 + ni * 16 + lq * 4;
        uint2 hh = *(const uint2*)(H + (size_t)m * D_ + n);
        f32x4 a = acc[mi][ni];
        float4 o;
        o.x = ALPHA * lo2f(hh.x) + a[0]; o.y = ALPHA * hi2f(hh.x) + a[1];
        o.z = ALPHA * lo2f(hh.y) + a[2]; o.w = ALPHA * hi2f(hh.y) + a[3];
        *(float4*)(pre1 + (size_t)m * D_ + n) = o;
      }
    }
  }
}

__device__ void phase8(const Params& P, int bid, int nb, u16* lds) {
  const u16* H = (const u16*)(P.ws + O_H);
  const u16* Pb = (const u16*)(P.ws + O_PB);
  u16* PQ = (u16*)(P.ws + O_PQ);
  u16* SG = (u16*)(P.ws + O_SG);
  u16* E = (u16*)(P.ws + O_E);
  EPI_COORDS
  FOR_TILES_XCD(t, 3 * 2048) {
    const int which = t >> 11, tt = t & 2047, mt = tt >> 4, nt = tt & 15;
    f32x4 acc[4][8];
    ZERO_ACC8(acc)
    u16* dst;
    if (which == 0) {
      gemm_kloop2(acc, H + (size_t)mt * 256 * D_, D_, (const u16*)(P.ws + O_WPQ) + (size_t)nt * 128 * D_, D_, D_, lds);
      dst = PQ;
    } else if (which == 1) {
      gemm_kloop2(acc, H + (size_t)mt * 256 * D_, D_, (const u16*)(P.ws + O_WPG) + (size_t)nt * 128 * D_, D_, D_, lds);
      dst = SG;
    } else {
      gemm_kloop2(acc, Pb + (size_t)mt * 256 * 256, 256, (const u16*)(P.ws + O_WPIN) + (size_t)nt * 128 * 256, 256, 256, lds);
      dst = E;
    }
#pragma unroll
    for (int mi = 0; mi < 4; ++mi) {
      const int m = mt * 256 + wid * 64 + mi * 16 + lr;
#pragma unroll
      for (int ni = 0; ni < 8; ++ni) {
        const int n = nt * 128 + ni * 16 + lq * 4;
        f32x4 a = acc[mi][ni];
        if (which == 1) { a[0] = sigmoidf_(a[0]); a[1] = sigmoidf_(a[1]); a[2] = sigmoidf_(a[2]); a[3] = sigmoidf_(a[3]); }
        store_bf4(dst + (size_t)m * D_ + n, a[0], a[1], a[2], a[3]);
      }
    }
  }
}

struct Top16 { float v[16]; int i[16]; };
__device__ __forceinline__ void top_init(Top16& t) {
#pragma unroll
  for (int k = 0; k < 16; ++k) { t.v[k] = -INFINITY; t.i[k] = 0; }
}
__device__ __forceinline__ void top_insert(Top16& t, float x, int id) {
  const bool c = x > t.v[15];
  t.v[15] = c ? x : t.v[15];
  t.i[15] = c ? id : t.i[15];
#pragma unroll
  for (int k = 15; k >= 1; --k) {
    const bool s = t.v[k] > t.v[k - 1];
    const float a = t.v[k - 1], b = t.v[k];
    const int ia = t.i[k - 1], ib = t.i[k];
    t.v[k - 1] = s ? b : a; t.v[k] = s ? a : b;
    t.i[k - 1] = s ? ib : ia; t.i[k] = s ? ia : ib;
  }
}

__device__ void phase9(const Params& P, int bid, int nb, u16* lds) {
  const u16* PQ = (const u16*)(P.ws + O_PQ);
  const u16* SK = (const u16*)(P.ws + O_SK);
  float* HV = (float*)(P.ws + O_HV);
  int* HI = (int*)(P.ws + O_HI);
  float* Sc = (float*)lds;
  EPI_COORDS
  const int tid = tidx();
  for (int t = bid; t < 256 * 16; t += nb) {
    const int mt = t >> 4, rc = t & 15;
    f32x4 acc[4][4];
    ZERO_ACC(acc)
    gemm_kloop(acc, PQ + (size_t)mt * 128 * D_ + rc * 128, D_, SK + (size_t)rc * 128 * 128, 128, 128, lds);
#pragma unroll
    for (int mi = 0; mi < 4; ++mi) {
      const int m = wm * 64 + mi * 16 + lr;
#pragma unroll
      for (int ni = 0; ni < 4; ++ni) {
        const int n = wn * 64 + ni * 16 + lq * 4;
#pragma unroll
        for (int j = 0; j < 4; ++j) Sc[m * 129 + n + j] = acc[mi][ni][j];
      }
    }
    __syncthreads();
    const int tok = tid & 127, hh = tid >> 7;
    float key[16];
#pragma unroll
    for (int j = 0; j < 16; ++j) key[j] = -INFINITY;
    {
      const float* sp = Sc + tok * 129 + hh * 64;
#pragma unroll 4
      for (int k = 0; k < 64; ++k) {
        const float x = sp[k];
        const float kk = __uint_as_float((__float_as_uint(x) & ~127u) | (unsigned)(127 - (hh * 64 + k)));
#pragma unroll
        for (int j = 15; j >= 1; --j) key[j] = __builtin_amdgcn_fmed3f(key[j - 1], key[j], kk);
        key[0] = fmaxf(key[0], kk);
      }
    }
    __syncthreads();
    float* Lv = (float*)lds;
#pragma unroll
    for (int k = 0; k < 16; ++k) Lv[tid * 17 + k] = key[k];
    __syncthreads();
    if (tid < 128) {
      int ia = 0, ib = 0;
      const float* va = Lv + tid * 17; const float* vb = Lv + (tid + 128) * 17;
      float* ov = HV + ((size_t)(mt * 16 + rc) * 128 + tid) * 16;
      int* oi = HI + ((size_t)(mt * 16 + rc) * 128 + tid) * 16;
      for (int k = 0; k < 16; ++k) {
        const float a = va[ia], b = vb[ib];
        const bool ta = a >= b;
        const unsigned bits = __float_as_uint(ta ? a : b);
        ov[k] = __uint_as_float(bits & ~127u);
        oi[k] = 127 - (int)(bits & 127u);
        ia += ta ? 1 : 0; ib += ta ? 0 : 1;
      }
    }
    __syncthreads();
  }
}

__device__ void phase10(const Params& P, int bid, int nb, u16* lds) {
  int* Lx = (int*)lds + tidx() * 33;
  const float* HV = (const float*)(P.ws + O_HV);
  const int* HI = (const int*)(P.ws + O_HI);
  int* EX = (int*)(P.ws + O_EXP);
  float* GT = (float*)(P.ws + O_GATE);
  for (int i_ = bid * 256 + tidx(); i_ < T_ * 8; i_ += nb * 256) {
    const int r_ = (i_ >> 7) & 7, mt_ = i_ >> 10, tl_ = i_ & 127;
    const int i = (mt_ * 128 + tl_) * 8 + r_;
    const size_t h0 = ((size_t)(mt_ * 16 + r_ * 2) * 128 + tl_) * 16, h1 = h0 + 128 * 16;
    float v0[16], v1[16];
    int i0[16], i1[16];
#pragma unroll
    for (int q = 0; q < 4; ++q) {
      float4 a = *(const float4*)(HV + h0 + q * 4);
      float4 b = *(const float4*)(HV + h1 + q * 4);
      int4 c = *(const int4*)(HI + h0 + q * 4);
      int4 d = *(const int4*)(HI + h1 + q * 4);
      v0[q * 4] = a.x; v0[q * 4 + 1] = a.y; v0[q * 4 + 2] = a.z; v0[q * 4 + 3] = a.w;
      v1[q * 4] = b.x; v1[q * 4 + 1] = b.y; v1[q * 4 + 2] = b.z; v1[q * 4 + 3] = b.w;
      i0[q * 4] = c.x; i0[q * 4 + 1] = c.y; i0[q * 4 + 2] = c.z; i0[q * 4 + 3] = c.w;
      i1[q * 4] = d.x; i1[q * 4 + 1] = d.y; i1[q * 4 + 2] = d.z; i1[q * 4 + 3] = d.w;
    }
    float t[16];
#pragma unroll
    for (int j = 0; j < 16; ++j) t[j] = -INFINITY;
#pragma unroll
    for (int a = 0; a < 16; ++a)
#pragma unroll
      for (int b = 0; b < 16; ++b)
        if ((a + 1) * (b + 1) <= 16) {
          const float sv = v0[a] + v1[b];
#pragma unroll
          for (int j = 15; j >= 1; --j) t[j] = __builtin_amdgcn_fmed3f(t[j - 1], t[j], sv);
          t[0] = fmaxf(t[0], sv);
        }
    const float mx = t[0], thr = t[15];
    float sum = 0.f;
#pragma unroll
    for (int k = 0; k < 16; ++k) sum += __expf(t[k] - mx);
    const float inv = 1.f / sum;
    int cnt = 0;
#pragma unroll
    for (int a = 0; a < 16; ++a)
#pragma unroll
      for (int b = 0; b < 16; ++b)
        if ((a + 1) * (b + 1) <= 16) {
          const float sv = v0[a] + v1[b];
          if (sv >= thr && cnt < 16) {
            Lx[cnt] = i0[a] * 128 + i1[b];
            Lx[16 + cnt] = __float_as_int(__expf(sv - mx) * inv);
            ++cnt;
          }
        }
    asm volatile("s_waitcnt lgkmcnt(0)" ::: "memory");
#pragma unroll
    for (int q = 0; q < 4; ++q) {
      *(int4*)(EX + (size_t)i * 16 + q * 4) = int4{Lx[q * 4], Lx[q * 4 + 1], Lx[q * 4 + 2], Lx[q * 4 + 3]};
      *(float4*)(GT + (size_t)i * 16 + q * 4) =
          float4{__int_as_float(Lx[16 + q * 4]), __int_as_float(Lx[16 + q * 4 + 1]), __int_as_float(Lx[16 + q * 4 + 2]),
                 __int_as_float(Lx[16 + q * 4 + 3])};
    }
    asm volatile("s_waitcnt lgkmcnt(0)" ::: "memory");
  }
}

__device__ __forceinline__ void unpack8(uint4 u, float* f) {
  f[0] = lo2f(u.x); f[1] = hi2f(u.x); f[2] = lo2f(u.y); f[3] = hi2f(u.y);
  f[4] = lo2f(u.z); f[5] = hi2f(u.z); f[6] = lo2f(u.w); f[7] = hi2f(u.w);
}
__device__ __forceinline__ void dec16(uint4 u, float* f) {
  f32x2 a;
  a = __builtin_amdgcn_cvt_pk_f32_fp8((int)u.x, false); f[0] = a.x; f[1] = a.y;
  a = __builtin_amdgcn_cvt_pk_f32_fp8((int)u.x, true);  f[2] = a.x; f[3] = a.y;
  a = __builtin_amdgcn_cvt_pk_f32_fp8((int)u.y, false); f[4] = a.x; f[5] = a.y;
  a = __builtin_amdgcn_cvt_pk_f32_fp8((int)u.y, true);  f[6] = a.x; f[7] = a.y;
  a = __builtin_amdgcn_cvt_pk_f32_fp8((int)u.z, false); f[8] = a.x; f[9] = a.y;
  a = __builtin_amdgcn_cvt_pk_f32_fp8((int)u.z, true);  f[10] = a.x; f[11] = a.y;
  a = __builtin_amdgcn_cvt_pk_f32_fp8((int)u.w, false); f[12] = a.x; f[13] = a.y;
  a = __builtin_amdgcn_cvt_pk_f32_fp8((int)u.w, true);  f[14] = a.x; f[15] = a.y;
}
__device__ __forceinline__ void load_row_bf16(const u16* row, int lane, float* f) {
#pragma unroll
  for (int q = 0; q < 2; ++q) {
    uint4 a = *(const uint4*)(row + q * 1024 + lane * 16);
    uint4 b = *(const uint4*)(row + q * 1024 + lane * 16 + 8);
    unpack8(a, f + q * 16);
    unpack8(b, f + q * 16 + 8);
  }
}
__device__ void phase11(const Params& P, int bid, int nb) {
  const u16* H = (const u16*)(P.ws + O_H);
  const unsigned char* U8 = (const unsigned char*)(P.ws + O_U8);
  const unsigned char* V8 = (const unsigned char*)(P.ws + O_V8);
  const float* RSU = (const float*)(P.ws + O_RSU);
  const float* RSV = (const float*)(P.ws + O_RSV);
  const u16* SG = (const u16*)(P.ws + O_SG);
  const u16* E = (const u16*)(P.ws + O_E);
  const int* EX = (const int*)(P.ws + O_EXP);
  const float* GT = (const float*)(P.ws + O_GATE);
  const int lane = tidx() & 63;
  int sweep = 0;
  for (int tok = bid * 4 + (tidx() >> 6); tok < T_; tok += nb * 4, sweep ^= 1) {
    float hf[32], y[32];
    load_row_bf16(H + (size_t)tok * D_, lane, hf);
#pragma unroll
    for (int k = 0; k < 32; ++k) y[k] = 0.f;
    int ev0 = EX[(size_t)tok * 128 + lane], ev1 = EX[(size_t)tok * 128 + 64 + lane];
    float gv0 = GT[(size_t)tok * 128 + lane], gv1 = GT[(size_t)tok * 128 + 64 + lane];
    {
      int k0 = (ev0 << 7) | lane, k1 = (ev1 << 7) | (64 + lane);
#pragma unroll
      for (int kk = 2; kk <= 128; kk <<= 1) {
#pragma unroll
        for (int j = kk >> 1; j >= 1; j >>= 1) {
          if (j == 64) {
            const int lo_ = min(k0, k1), hi_ = max(k0, k1);
            k0 = lo_; k1 = hi_;
          } else {
            const int p0 = __shfl_xor(k0, j), p1 = __shfl_xor(k1, j);
            const bool lower = (lane & j) == 0;
            const bool up0 = (kk == 128) ? true : ((lane & kk) == 0);
            const bool up1 = (kk == 128) ? true : (kk == 64 ? false : ((lane & kk) == 0));
            k0 = (lower == up0) ? min(k0, p0) : max(k0, p0);
            k1 = (lower == up1) ? min(k1, p1) : max(k1, p1);
          }
        }
      }
      const int s0 = k0 & 127, s1 = k1 & 127;
      const float ga0 = __shfl(gv0, s0 & 63), gb0 = __shfl(gv1, s0 & 63);
      const float ga1 = __shfl(gv0, s1 & 63), gb1 = __shfl(gv1, s1 & 63);
      gv0 = (s0 < 64) ? ga0 : gb0;
      gv1 = (s1 < 64) ? ga1 : gb1;
      ev0 = k0 >> 7;
      ev1 = k1 >> 7;
    }
    const float ru0 = RSU[ev0], ru1 = RSU[ev1], rv0 = RSV[ev0], rv1 = RSV[ev1];
    for (int k4_ = 0; k4_ < 128; k4_ += 4) {
      const int k4 = sweep ? (124 - k4_) : k4_;
      const int src = k4 & 63;
      const bool lo = k4 < 64;
      int ee[4]; float gg[4], su[4], sv[4];
#pragma unroll
      for (int x = 0; x < 4; ++x) {
        ee[x] = __shfl(lo ? ev0 : ev1, src + x);
        gg[x] = __shfl(lo ? gv0 : gv1, src + x);
        su[x] = __shfl(lo ? ru0 : ru1, src + x);
        sv[x] = __shfl(lo ? rv0 : rv1, src + x);
      }
      uint4 uu[4][2], vv[4][2];
#pragma unroll
      for (int x = 0; x < 4; ++x)
#pragma unroll
        for (int q = 0; q < 2; ++q) {
          uu[x][q] = *(const uint4*)(U8 + (size_t)ee[x] * D_ + q * 1024 + lane * 16);
          vv[x][q] = *(const uint4*)(V8 + (size_t)ee[x] * D_ + q * 1024 + lane * 16);
        }
      float dd[4];
#pragma unroll
      for (int x = 0; x < 4; ++x) {
        float d = 0.f;
#pragma unroll
        for (int q = 0; q < 2; ++q) {
          float f[16];
          dec16(uu[x][q], f);
#pragma unroll
          for (int j = 0; j < 16; ++j) d = fmaf(f[j], hf[q * 16 + j], d);
        }
        dd[x] = d;
      }
#pragma unroll
      for (int o = 32; o >= 1; o >>= 1) {
#pragma unroll
        for (int x = 0; x < 4; ++x) dd[x] += __shfl_xor(dd[x], o);
      }
#pragma unroll
      for (int x = 0; x < 4; ++x) {
        const float w = gg[x] * gelu_tanh(dd[x] * su[x]) * sv[x];
#pragma unroll
        for (int q = 0; q < 2; ++q) {
          float f[16];
          dec16(vv[x][q], f);
#pragma unroll
          for (int j = 0; j < 16; ++j) y[q * 16 + j] = fmaf(w, f[j], y[q * 16 + j]);
        }
      }
    }
    float ef[32], sg[32];
    load_row_bf16(E + (size_t)tok * D_, lane, ef);
    load_row_bf16(SG + (size_t)tok * D_, lane, sg);
    float ss = 0.f;
#pragma unroll
    for (int k = 0; k < 32; ++k) ss += ef[k] * ef[k];
    const float rr = rsqrtf(wave_sum(ss) * (1.f / D_) + 1e-5f);
    float s1 = 0.f;
#pragma unroll
    for (int q = 0; q < 2; ++q)
#pragma unroll
      for (int j4 = 0; j4 < 4; ++j4) {
        float4 g = *(const float4*)(P.ple_g + q * 1024 + lane * 16 + j4 * 4);
        const float gq[4] = {g.x, g.y, g.z, g.w};
#pragma unroll
        for (int j = 0; j < 4; ++j) {
          const int k = q * 16 + j4 * 4 + j;
          float v = ALPHA * hf[k] + y[k] + ef[k] * rr * gq[j] * sg[k];
          y[k] = v;
          s1 += v;
        }
      }
    const float mu = wave_sum(s1) * (1.f / D_);
    float s2 = 0.f;
#pragma unroll
    for (int k = 0; k < 32; ++k) { float d = y[k] - mu; s2 += d * d; }
    const float rstd = rsqrtf(wave_sum(s2) * (1.f / D_) + 1e-5f);
#pragma unroll
    for (int q = 0; q < 2; ++q)
#pragma unroll
      for (int j4 = 0; j4 < 4; ++j4) {
        const int col = q * 1024 + lane * 16 + j4 * 4;
        const int k = q * 16 + j4 * 4;
        float4 g = *(const float4*)(P.ln2_g + col), b = *(const float4*)(P.ln2_b + col);
        float4 o;
        o.x = (y[k + 0] - mu) * rstd * g.x + b.x; o.y = (y[k + 1] - mu) * rstd * g.y + b.y;
        o.z = (y[k + 2] - mu) * rstd * g.z + b.z; o.w = (y[k + 3] - mu) * rstd * g.w + b.w;
        *(float4*)(P.out + (size_t)tok * D_ + col) = o;
      }
  }
}

constexpr size_t O_BAR = 1000 * MB;
__device__ __forceinline__ void gbar(unsigned* ctr, unsigned& epoch, unsigned nb) {
  epoch += nb;
  asm volatile("s_waitcnt vmcnt(0)" ::: "memory");
  __syncthreads();
  if (tidx() == 0) {
    __builtin_amdgcn_fence(__ATOMIC_RELEASE, "agent");
    asm volatile("s_waitcnt vmcnt(0)" ::: "memory");
    __hip_atomic_fetch_add(ctr, 1u, __ATOMIC_RELAXED, __HIP_MEMORY_SCOPE_AGENT);
    while (__hip_atomic_load(ctr, __ATOMIC_RELAXED, __HIP_MEMORY_SCOPE_AGENT) < epoch) __builtin_amdgcn_s_sleep(2);
    __builtin_amdgcn_fence(__ATOMIC_ACQUIRE, "agent");
    asm volatile("s_waitcnt vmcnt(0)" ::: "memory");
  }
  __syncthreads();
}

__device__ __forceinline__ void run_phase(const Params& P, int ph, int bid, int nb, u16* lds) {
  switch (ph) {
    case 0: phase0(P, bid, nb, lds); break;
    case 1: phase1(P, bid, nb, lds); break;
    case 2: phase2(P, bid, nb, lds); break;
    case 3: phase3(P, bid, nb, lds); break;
    case 4: phase4(P, bid, nb, lds); break;
    case 5: phase5(P, bid, nb, lds); break;
    case 6: phase6(P, bid, nb, lds); break;
    case 7: ln_rows((const float*)(P.ws + O_PRE1), P.ln1_g, P.ln1_b, (u16*)(P.ws + O_H), bid * 4 + (tidx() >> 6), nb * 4); break;
    case 8: phase8(P, bid, nb, lds); break;
    case 9: phase9(P, bid, nb, lds); break;
    case 10: phase10(P, bid, nb, lds); break;
    case 11: phase11(P, bid, nb); break;
  }
}
constexpr int NPHASE = 12;

#if MULTI
__global__ void __launch_bounds__(256, 2) phase_kernel(Params P, int ph) {
  __shared__ __attribute__((aligned(16))) u16 lds[36864];
  run_phase(P, ph, blockIdx.x, gridDim.x, lds);
}
#else
__global__ void __launch_bounds__(256, 2) mega_kernel(Params P) {
  __shared__ __attribute__((aligned(16))) u16 lds[36864];
  cg::grid_group grid = cg::this_grid();
  const int bid = blockIdx.x, nb = gridDim.x;
  unsigned* ctr = (unsigned*)(P.ws + O_BAR);
  unsigned ep = 0;
  phase0(P, bid, nb, lds); grid.sync();
  phase1(P, bid, nb, lds); gbar(ctr, ep, nb);
  phase2(P, bid, nb, lds); gbar(ctr, ep, nb);
  phase3(P, bid, nb, lds); gbar(ctr, ep, nb);
  phase4(P, bid, nb, lds); gbar(ctr, ep, nb);
  phase5(P, bid, nb, lds); gbar(ctr, ep, nb);
  phase6(P, bid, nb, lds); gbar(ctr, ep, nb);
  ln_rows((const float*)(P.ws + O_PRE1), P.ln1_g, P.ln1_b, (u16*)(P.ws + O_H), bid * 4 + (tidx() >> 6), nb * 4);
  gbar(ctr, ep, nb);
  phase8(P, bid, nb, lds); gbar(ctr, ep, nb);
  phase9(P, bid, nb, lds); gbar(ctr, ep, nb);
  phase10(P, bid, nb, lds); gbar(ctr, ep, nb);
  phase11(P, bid, nb);
}
#endif

extern "C" void kernel_launch(void* const* d_in, const int* in_sizes, int n_in, void* d_out, int out_size, void* d_ws,
                              size_t ws_size, hipStream_t stream) {
  Params p{};
  const float** pp = (const float**)&p;
  for (int i = 0; i < 29; ++i) pp[i] = (const float*)d_in[i];
  p.out = (float*)d_out;
  p.ws = (char*)d_ws;
  if (ws_size < 1001 * MB) fprintf(stderr, "workspace too small: %zu\n", ws_size);
#if MULTI
  for (int ph = 0; ph < NPHASE; ++ph) phase_kernel<<<512, 256, 0, stream>>>(p, ph);
#else
  static int grid_blocks = 0;
  if (!grid_blocks) {
    int dev = 0, cus = 0, per_cu = 0;
    hipGetDevice(&dev);
    hipDeviceGetAttribute(&cus, hipDeviceAttributeMultiprocessorCount, dev);
    hipOccupancyMaxActiveBlocksPerMultiprocessor(&per_cu, mega_kernel, 256, 0);
    if (per_cu > 2) per_cu = 2;
    grid_blocks = cus * per_cu;
  }
  (void)hipMemsetAsync((char*)d_ws + O_BAR, 0, 256, stream);
  void* args[] = {&p};
  hipError_t e = hipLaunchCooperativeKernel((void*)mega_kernel, dim3(grid_blocks), dim3(256), args, 0, stream);
  if (e != hipSuccess) fprintf(stderr, "cooperative launch failed: %s (grid %d)\n", hipGetErrorString(e), grid_blocks);
#endif
}
```

```cpp
#include <hip/hip_runtime.h>
#include <hip/hip_bf16.h>
#include <hip/hip_cooperative_groups.h>
#include <cstdio>
namespace cg = cooperative_groups;

#ifndef MULTI
#define MULTI 0
#endif

typedef unsigned short u16;
using bf16x8 = __attribute__((ext_vector_type(8))) short;
using f32x4 = __attribute__((ext_vector_type(4))) float;

constexpr int T_ = 32768;
constexpr int S_ = 16384;
constexpr int D_ = 2048;
constexpr int SSM_L = 128;
constexpr int SSM_NC = S_ / SSM_L;
constexpr float ALPHA = 1.189207115002721f;
constexpr size_t MB = 1024ull * 1024ull;

constexpr size_t O_WIN = 0 * MB, O_WGLU = 32 * MB, O_WAU = 34 * MB, O_WSU = 38 * MB, O_WOUT = 42 * MB,
                 O_WPQ = 50 * MB, O_WPG = 58 * MB, O_WPIN = 66 * MB, O_SK = 67 * MB, O_BCAT = 67 * MB + 512 * 1024,
                 O_CCAT = 68 * MB, O_LAM = 68 * MB + 256 * 1024, O_UB = 70 * MB, O_VB = 134 * MB, O_SBUF = 198 * MB,
                 O_H = 206 * MB, O_Q = 334 * MB, O_K = 398 * MB, O_VT = 462 * MB, O_U2 = 526 * MB, O_G = 590 * MB,
                 O_YA = 846 * MB, O_YS = 910 * MB, O_PB = 974 * MB;
constexpr size_t O_YG = O_VT, O_MERGED = O_Q, O_PRE1 = O_G, O_PQ = O_Q, O_SG = O_VT, O_E = O_G,
                 O_HV = O_G + 128 * MB, O_HI = O_G + 160 * MB, O_EXP = O_G + 192 * MB, O_GATE = O_G + 208 * MB;

struct Params {
  const float *x, *p, *ln_in_g, *ln_in_b, *w_in, *rel_bias, *lam_re, *lam_im, *log_dt, *b_re, *b_im, *c_re, *c_im,
      *ssm_d, *w_glu, *w_au, *w_su, *w_out, *ln1_g, *ln1_b, *w_pq, *sub_keys, *peer_u, *peer_v, *ple_w_in, *ple_g,
      *ple_w_gate, *ln2_g, *ln2_b;
  float* out;
  char* ws;
};

__device__ __forceinline__ int tidx() { int t = threadIdx.x & 255; asm volatile("" : "+v"(t)); return t; }
__device__ __forceinline__ int rtid() { int t = threadIdx.x; asm volatile("" : "+v"(t)); return t; }
__device__ __forceinline__ u16 f2bf(float f) {
  unsigned u = __float_as_uint(f);
  u += 0x7fffu + ((u >> 16) & 1u);
  return (u16)(u >> 16);
}
__device__ __forceinline__ float bf2f(u16 h) { return __uint_as_float(((unsigned)h) << 16); }
typedef __bf16 hwbf16x2 __attribute__((ext_vector_type(2)));
typedef float hwf32x2 __attribute__((ext_vector_type(2)));
__device__ __forceinline__ unsigned pack2(float a, float b) {
  hwf32x2 v = {a, b};
  hwbf16x2 r = __builtin_convertvector(v, hwbf16x2);
  return *(unsigned*)&r;
}
__device__ __forceinline__ float lo2f(unsigned u) { return __uint_as_float(u << 16); }
__device__ __forceinline__ float hi2f(unsigned u) { return __uint_as_float(u & 0xffff0000u); }
__device__ __forceinline__ float sigmoidf_(float x) { return __builtin_amdgcn_rcpf(1.f + __expf(-x)); }
__device__ __forceinline__ float gelu_tanh(float x) {
  float u = 0.7978845608028654f * (x + 0.044715f * x * x * x);
  float t = 1.f - 2.f * __builtin_amdgcn_rcpf(1.f + __expf(2.f * u));
  return 0.5f * x * (1.f + t);
}
__device__ __forceinline__ float wave_sum(float v) {
#pragma unroll
  for (int o = 32; o >= 1; o >>= 1) v += __shfl_xor(v, o);
  return v;
}
__device__ __forceinline__ void store_bf4(u16* dst, float a, float b, float c, float d) {
  uint2 v; v.x = pack2(a, b); v.y = pack2(c, d);
  *(uint2*)dst = v;
}

__device__ __forceinline__ void gemm_kloop(f32x4 (&acc)[4][4], const u16* __restrict__ A, int lda,
                                           const u16* __restrict__ Bt, int ldb, int K, u16* lds) {
  const int tid = tidx(), lane = tid & 63, wid = tid >> 6, wm = wid >> 1, wn = wid & 1;
  const int lr = lane & 15, lq = lane >> 4;
  const int nk = K >> 6;
  const int srow = tid >> 3, sc = (tid & 7) ^ (srow & 7);
  const u16* ga = A + (size_t)srow * lda + sc * 8;
  const u16* gb = Bt + (size_t)srow * ldb + sc * 8;
  u16* lw = lds + tid * 8;
#pragma unroll
  for (int i = 0; i < 4; ++i) {
    __builtin_amdgcn_global_load_lds((const unsigned*)(ga + (size_t)(32 * i) * lda), (unsigned*)(lw + i * 2048), 16, 0, 0);
    __builtin_amdgcn_global_load_lds((const unsigned*)(gb + (size_t)(32 * i) * ldb), (unsigned*)(lw + 8192 + i * 2048), 16, 0, 0);
  }
  __syncthreads();
  const int swz = lr & 7;
  for (int kt = 0; kt < nk; ++kt) {
    if (kt + 1 < nk) {
      u16* lw2 = lw + ((kt + 1) & 1) * 16384;
#pragma unroll
      for (int i = 0; i < 4; ++i) {
        __builtin_amdgcn_global_load_lds((const unsigned*)(ga + (size_t)(32 * i) * lda + (kt + 1) * 64), (unsigned*)(lw2 + i * 2048), 16, 0, 0);
        __builtin_amdgcn_global_load_lds((const unsigned*)(gb + (size_t)(32 * i) * ldb + (kt + 1) * 64), (unsigned*)(lw2 + 8192 + i * 2048), 16, 0, 0);
      }
    }
    const u16* sa = lds + (kt & 1) * 16384;
    const u16* sb = sa + 8192;
#pragma unroll
    for (int ks = 0; ks < 2; ++ks) {
      bf16x8 af[4], bfr[4];
      const int co = ((ks * 4 + lq) ^ swz) * 8;
#pragma unroll
      for (int mi = 0; mi < 4; ++mi) af[mi] = *(const bf16x8*)(sa + (wm * 64 + mi * 16 + lr) * 64 + co);
#pragma unroll
      for (int ni = 0; ni < 4; ++ni) bfr[ni] = *(const bf16x8*)(sb + (wn * 64 + ni * 16 + lr) * 64 + co);
#pragma unroll
      for (int mi = 0; mi < 4; ++mi)
#pragma unroll
        for (int ni = 0; ni < 4; ++ni)
          acc[mi][ni] = __builtin_amdgcn_mfma_f32_16x16x32_bf16(bfr[ni], af[mi], acc[mi][ni], 0, 0, 0);
    }
    __syncthreads();
  }
}

#define ZERO_ACC(acc)                                   \
  _Pragma("unroll") for (int _a = 0; _a < 4; ++_a)      \
  _Pragma("unroll") for (int _b = 0; _b < 4; ++_b) acc[_a][_b] = f32x4{0.f, 0.f, 0.f, 0.f};

__device__ __forceinline__ void gemm_kloop2(f32x4 (&acc)[4][8], const u16* __restrict__ A, int lda,
                                            const u16* __restrict__ Bt, int ldb, int K, u16* lds) {
  const int tid = tidx(), lane = tid & 63, wid = tid >> 6;
  const int lr = lane & 15, lq = lane >> 4;
  const int nk = K >> 5;
  const int srow = tid >> 2;
  const int sc = (tid & 3) ^ ((0x78 >> (2 * ((tid >> 4) & 3))) & 3);
  const u16* ga = A + (size_t)srow * lda + sc * 8;
  const u16* gb = Bt + (size_t)srow * ldb + sc * 8;
  u16* lw = lds + tid * 8;
#pragma unroll
  for (int i = 0; i < 4; ++i)
    __builtin_amdgcn_global_load_lds((const unsigned*)(ga + (size_t)(64 * i) * lda), (unsigned*)(lw + i * 2048), 16, 0, 0);
#pragma unroll
  for (int i = 0; i < 2; ++i)
    __builtin_amdgcn_global_load_lds((const unsigned*)(gb + (size_t)(64 * i) * ldb), (unsigned*)(lw + 8192 + i * 2048), 16, 0, 0);
  __syncthreads();
  const int co = (lq ^ ((0x78 >> (2 * ((lr >> 2) & 3))) & 3)) * 8;
  for (int kt = 0; kt < nk; ++kt) {
    if (kt + 1 < nk) {
      u16* lw2 = lw + ((kt + 1) & 1) * 12288;
#pragma unroll
      for (int i = 0; i < 4; ++i)
        __builtin_amdgcn_global_load_lds((const unsigned*)(ga + (size_t)(64 * i) * lda + (kt + 1) * 32), (unsigned*)(lw2 + i * 2048), 16, 0, 0);
#pragma unroll
      for (int i = 0; i < 2; ++i)
        __builtin_amdgcn_global_load_lds((const unsigned*)(gb + (size_t)(64 * i) * ldb + (kt + 1) * 32), (unsigned*)(lw2 + 8192 + i * 2048), 16, 0, 0);
    }
    const u16* sa = lds + (kt & 1) * 12288;
    const u16* sb = sa + 8192;
    bf16x8 af[4];
#pragma unroll
    for (int mi = 0; mi < 4; ++mi) af[mi] = *(const bf16x8*)(sa + (wid * 64 + mi * 16 + lr) * 32 + co);
#pragma unroll
    for (int nh = 0; nh < 2; ++nh) {
      bf16x8 bfr[4];
#pragma unroll
      for (int ni = 0; ni < 4; ++ni) bfr[ni] = *(const bf16x8*)(sb + ((nh * 4 + ni) * 16 + lr) * 32 + co);
#pragma unroll
      for (int mi = 0; mi < 4; ++mi)
#pragma unroll
        for (int ni = 0; ni < 4; ++ni)
          acc[mi][nh * 4 + ni] = __builtin_amdgcn_mfma_f32_16x16x32_bf16(bfr[ni], af[mi], acc[mi][nh * 4 + ni], 0, 0, 0);
    }
    __syncthreads();
  }
}

__device__ __forceinline__ void gemm_kloop3(f32x4 (&acc)[4][8], const u16* __restrict__ A, int lda,
                                            const u16* __restrict__ Bt, int ldb, int K, u16* lds) {
  const int tid = rtid(), lane = tid & 63, wid = tid >> 6, wm = wid >> 1, wn = wid & 1;
  const int lr = lane & 15, lq = lane >> 4;
  const int nk = K >> 6;
  const int srow = tid >> 3, sc = (tid & 7) ^ (srow & 7);
  const u16* ga = A + (size_t)srow * lda + sc * 8;
  const u16* gb = Bt + (size_t)srow * ldb + sc * 8;
  u16* lw = lds + tid * 8;
#pragma unroll
  for (int i = 0; i < 4; ++i) {
    __builtin_amdgcn_global_load_lds((const unsigned*)(ga + (size_t)(64 * i) * lda), (unsigned*)(lw + i * 4096), 16, 0, 0);
    __builtin_amdgcn_global_load_lds((const unsigned*)(gb + (size_t)(64 * i) * ldb), (unsigned*)(lw + 16384 + i * 4096), 16, 0, 0);
  }
  __syncthreads();
  const int swz = lr & 7;
  for (int kt = 0; kt < nk; ++kt) {
    if (kt + 1 < nk) {
      u16* lw2 = lw + ((kt + 1) & 1) * 32768;
#pragma unroll
      for (int i = 0; i < 4; ++i) {
        __builtin_amdgcn_global_load_lds((const unsigned*)(ga + (size_t)(64 * i) * lda + (kt + 1) * 64), (unsigned*)(lw2 + i * 4096), 16, 0, 0);
        __builtin_amdgcn_global_load_lds((const unsigned*)(gb + (size_t)(64 * i) * ldb + (kt + 1) * 64), (unsigned*)(lw2 + 16384 + i * 4096), 16, 0, 0);
      }
    }
    const u16* sa = lds + (kt & 1) * 32768;
    const u16* sb = sa + 16384;
#pragma unroll
    for (int ks = 0; ks < 2; ++ks) {
      const int co = ((ks * 4 + lq) ^ swz) * 8;
      bf16x8 af[4];
#pragma unroll
      for (int mi = 0; mi < 4; ++mi) af[mi] = *(const bf16x8*)(sa + (wm * 64 + mi * 16 + lr) * 64 + co);
#pragma unroll
      for (int nh = 0; nh < 2; ++nh) {
        bf16x8 bfr[4];
#pragma unroll
        for (int ni = 0; ni < 4; ++ni) bfr[ni] = *(const bf16x8*)(sb + (wn * 128 + (nh * 4 + ni) * 16 + lr) * 64 + co);
#pragma unroll
        for (int mi = 0; mi < 4; ++mi)
#pragma unroll
          for (int ni = 0; ni < 4; ++ni)
            acc[mi][nh * 4 + ni] = __builtin_amdgcn_mfma_f32_16x16x32_bf16(bfr[ni], af[mi], acc[mi][nh * 4 + ni], 0, 0, 0);
      }
    }
    __syncthreads();
  }
}

#define EPI_COORDS3                                                             \
  const int lane = rtid() & 63, wid = rtid() >> 6, wm = wid >> 1, wn = wid & 1; \
  const int lr = lane & 15, lq = lane >> 4;

#define ZERO_ACC8(acc)                                  \
  _Pragma("unroll") for (int _a = 0; _a < 4; ++_a)      \
  _Pragma("unroll") for (int _b = 0; _b < 8; ++_b) acc[_a][_b] = f32x4{0.f, 0.f, 0.f, 0.f};

#define FOR_TILES_XCD(t, ntiles) \
  for (int _k = 0, t = (bid & 7) * (nb >> 3) + (bid >> 3); t < (ntiles); ++_k, t = ((_k * 8 + (bid & 7)) * (nb >> 3)) + (bid >> 3))

#define EPI_COORDS                                                             \
  const int lane = tidx() & 63, wid = tidx() >> 6, wm = wid >> 1, wn = wid & 1; \
  const int lr = lane & 15, lq = lane >> 4;

__device__ void tconv_tile(const float* __restrict__ W, int K, int N, u16* __restrict__ Wt, int tile, float* lds) {
  const int tid = tidx();
  const int ntn = N >> 6;
  const int kt = tile / ntn, nt = tile % ntn;
  const int c4 = (tid & 15) * 4;
#pragma unroll
  for (int i = 0; i < 4; ++i) {
    int r = (tid >> 4) + 16 * i;
    float4 v = *(const float4*)(W + (size_t)(kt * 64 + r) * N + nt * 64 + c4);
    lds[r * 65 + c4 + 0] = v.x; lds[r * 65 + c4 + 1] = v.y; lds[r * 65 + c4 + 2] = v.z; lds[r * 65 + c4 + 3] = v.w;
  }
  __syncthreads();
  const int n = tid >> 2, kseg = (tid & 3) * 16;
  unsigned o[8];
#pragma unroll
  for (int j = 0; j < 8; ++j) o[j] = pack2(lds[(kseg + 2 * j) * 65 + n], lds[(kseg + 2 * j + 1) * 65 + n]);
  u16* dst = Wt + (size_t)(nt * 64 + n) * K + kt * 64 + kseg;
  *(uint4*)dst = uint4{o[0], o[1], o[2], o[3]};
  *(uint4*)(dst + 8) = uint4{o[4], o[5], o[6], o[7]};
  __syncthreads();
}

__device__ void conv_linear(const float* __restrict__ src, u16* __restrict__ dst, size_t n8, size_t gtid, size_t nth) {
  for (size_t i = gtid; i < n8; i += nth) {
    float4 a = *(const float4*)(src + i * 8), b = *(const float4*)(src + i * 8 + 4);
    *(uint4*)(dst + i * 8) = uint4{pack2(a.x, a.y), pack2(a.z, a.w), pack2(b.x, b.y), pack2(b.z, b.w)};
  }
}

typedef float f32x2 __attribute__((ext_vector_type(2)));
constexpr size_t O_U8 = O_UB, O_V8 = O_UB + 32 * MB, O_RSU = O_VB, O_RSV = O_VB + 64 * 1024;
__device__ void conv_fp8_rows(const float* __restrict__ src, unsigned char* __restrict__ dst, float* __restrict__ rscale,
                              int gw, int nw) {
  const int lane = tidx() & 63;
  for (int row = gw; row < 16384; row += nw) {
    const float* r = src + (size_t)row * D_;
    float4 v[8];
#pragma unroll
    for (int q = 0; q < 8; ++q) v[q] = *(const float4*)(r + q * 256 + lane * 4);
    float am = 0.f;
#pragma unroll
    for (int q = 0; q < 8; ++q) am = fmaxf(am, fmaxf(fmaxf(fabsf(v[q].x), fabsf(v[q].y)), fmaxf(fabsf(v[q].z), fabsf(v[q].w))));
#pragma unroll
    for (int o = 32; o >= 1; o >>= 1) am = fmaxf(am, __shfl_xor(am, o));
    const float sc = am > 0.f ? 416.f / am : 1.f;
#pragma unroll
    for (int q = 0; q < 8; ++q) {
      int w = 0;
      w = __builtin_amdgcn_cvt_pk_fp8_f32(v[q].x * sc, v[q].y * sc, w, false);
      w = __builtin_amdgcn_cvt_pk_fp8_f32(v[q].z * sc, v[q].w * sc, w, true);
      *(int*)(dst + (size_t)row * D_ + q * 256 + lane * 4) = w;
    }
    if (lane == 0) rscale[row] = am > 0.f ? am / 416.f : 1.f;
  }
}

__device__ void ln_rows(const float* __restrict__ src, const float* __restrict__ g, const float* __restrict__ b,
                        u16* __restrict__ dst, int gw, int nw) {
  const int lane = tidx() & 63;
  for (int row = gw; row < T_; row += nw) {
    const float* r = src + (size_t)row * D_;
    float4 v[8];
#pragma unroll
    for (int q = 0; q < 8; ++q) v[q] = *(const float4*)(r + q * 256 + lane * 4);
    float s = 0.f;
#pragma unroll
    for (int q = 0; q < 8; ++q) s += v[q].x + v[q].y + v[q].z + v[q].w;
    float mu = wave_sum(s) * (1.f / D_);
    float ss = 0.f;
#pragma unroll
    for (int q = 0; q < 8; ++q) {
      float a = v[q].x - mu, bb = v[q].y - mu, c = v[q].z - mu, d = v[q].w - mu;
      ss += a * a + bb * bb + c * c + d * d;
    }
    float rstd = rsqrtf(wave_sum(ss) * (1.f / D_) + 1e-5f);
#pragma unroll
    for (int q = 0; q < 8; ++q) {
      int col = q * 256 + lane * 4;
      float4 gg = *(const float4*)(g + col), bb = *(const float4*)(b + col);
      store_bf4(dst + (size_t)row * D_ + col, (v[q].x - mu) * rstd * gg.x + bb.x, (v[q].y - mu) * rstd * gg.y + bb.y,
                (v[q].z - mu) * rstd * gg.z + bb.z, (v[q].w - mu) * rstd * gg.w + bb.w);
    }
  }
}

__device__ __forceinline__ void dsincos(double x, double& s, double& c) {
  double q = rint(x * 0.63661977236758134308);
  double r = x - q * 1.57079632679489661923;
  double r2 = r * r;
  double sp = r * (1.0 + r2 * (-1.0 / 6 + r2 * (1.0 / 120 + r2 * (-1.0 / 5040 + r2 * (1.0 / 362880 + r2 * (-1.0 / 39916800 + r2 * (1.0 / 6227020800.0)))))));
  double cp = 1.0 + r2 * (-0.5 + r2 * (1.0 / 24 + r2 * (-1.0 / 720 + r2 * (1.0 / 40320 + r2 * (-1.0 / 3628800 + r2 * (1.0 / 479001600.0 + r2 * (-1.0 / 87178291200.0)))))));
  int qi = ((int)q) & 3;
  if (qi == 0) { s = sp; c = cp; }
  else if (qi == 1) { s = cp; c = -sp; }
  else if (qi == 2) { s = -sp; c = -cp; }
  else { s = -cp; c = sp; }
}

__device__ void ssm_consts(const Params& P, int i) {
  const int g = i >> 6, p = i & 63;
  double lr = P.lam_re[g * 64 + p], li = P.lam_im[g * 64 + p];
  double dt = exp((double)P.log_dt[g]);
  double mag = exp(lr * dt);
  double sn, cs;
  dsincos(li * dt, sn, cs);
  double ar = mag * cs, ai = mag * sn;
  double nr = ar - 1.0, ni = ai, den = lr * lr + li * li;
  double fr = (nr * lr + ni * li) / den, fi = (ni * lr - nr * li) / den;
  u16* bcat = (u16*)(P.ws + O_BCAT);
  u16* ccat = (u16*)(P.ws + O_CCAT);
  float* lam = (float*)(P.ws + O_LAM);
  for (int h = 0; h < 16; ++h) {
    double br = P.b_re[(g * 64 + p) * 16 + h], bi = P.b_im[(g * 64 + p) * 16 + h];
    bcat[(g * 128 + p) * 32 + h] = f2bf((float)(fr * br - fi * bi));
    bcat[(g * 128 + 64 + p) * 32 + h] = f2bf((float)(fr * bi + fi * br));
    bcat[(g * 128 + p) * 32 + 16 + h] = 0;
    bcat[(g * 128 + 64 + p) * 32 + 16 + h] = 0;
    ccat[(g * 16 + h) * 128 + p] = f2bf(P.c_re[(g * 16 + h) * 64 + p]);
    ccat[(g * 16 + h) * 128 + 64 + p] = f2bf(-P.c_im[(g * 16 + h) * 64 + p]);
  }
  double pr = ar, pi = ai;
  for (int k = 0; k < 10; ++k) {
    double t = pr * pr - pi * pi;
    pi = 2.0 * pr * pi;
    pr = t;
  }
  lam[0 * 4096 + i] = (float)ar;
  lam[1 * 4096 + i] = (float)ai;
  lam[2 * 4096 + i] = (float)pr;
  lam[3 * 4096 + i] = (float)pi;
}

__device__ void phase0(const Params& P, int bid, int nb, u16* lds) {
  const size_t gtid = (size_t)bid * 256 + tidx(), nth = (size_t)nb * 256;
#define TCONV(wp, KK, NN, OFF) \
  for (int t = bid; t < ((KK) >> 6) * ((NN) >> 6); t += nb) tconv_tile(wp, KK, NN, (u16*)(P.ws + OFF), t, (float*)lds);
  TCONV(P.w_in, 2048, 8192, O_WIN)
  TCONV(P.w_glu, 1024, 1024, O_WGLU)
  TCONV(P.w_au, 1024, 2048, O_WAU)
  TCONV(P.w_su, 1024, 2048, O_WSU)
  TCONV(P.w_out, 2048, 2048, O_WOUT)
  TCONV(P.w_pq, 2048, 2048, O_WPQ)
  TCONV(P.ple_w_gate, 2048, 2048, O_WPG)
  TCONV(P.ple_w_in, 256, 2048, O_WPIN)
  conv_fp8_rows(P.peer_u, (unsigned char*)(P.ws + O_U8), (float*)(P.ws + O_RSU), bid * 4 + (tidx() >> 6), nb * 4);
  conv_fp8_rows(P.peer_v, (unsigned char*)(P.ws + O_V8), (float*)(P.ws + O_RSV), bid * 4 + (tidx() >> 6), nb * 4);
  conv_linear(P.sub_keys, (u16*)(P.ws + O_SK), (size_t)16 * 128 * 128 / 8, gtid, nth);
  conv_linear(P.p, (u16*)(P.ws + O_PB), (size_t)T_ * 256 / 8, gtid, nth);
  for (size_t i = gtid; i < 4096; i += nth) ssm_consts(P, (int)i);
  ln_rows(P.x, P.ln_in_g, P.ln_in_b, (u16*)(P.ws + O_H), bid * 4 + (tidx() >> 6), nb * 4);
}

__device__ void phase1(const Params& P, int bid, int nb, u16* lds) {
  const u16* H = (const u16*)(P.ws + O_H);
  const u16* W = (const u16*)(P.ws + O_WIN);
  u16* Q = (u16*)(P.ws + O_Q);
  u16* Kb = (u16*)(P.ws + O_K);
  u16* Vt = (u16*)(P.ws + O_VT);
  u16* U2 = (u16*)(P.ws + O_U2);
  u16* G = (u16*)(P.ws + O_G);
  EPI_COORDS3
  const int ntiles = 128 * 32;
  for (int t = bid; t < ntiles; t += nb) {
    const int mt = t >> 5, nt = t & 31;
    f32x4 acc[4][8];
    ZERO_ACC8(acc)
    gemm_kloop3(acc, H + (size_t)mt * 256 * D_, D_, W + (size_t)nt * 256 * D_, D_, D_, lds);
    const int region = (nt * 256 + wn * 128) >> 10;
#pragma unroll
    for (int mi = 0; mi < 4; ++mi) {
      const int m = mt * 256 + wm * 64 + mi * 16 + lr;
#pragma unroll
      for (int ni = 0; ni < 8; ++ni) {
        const int n = nt * 256 + wn * 128 + ni * 16 + lq * 4;
        f32x4 a = acc[mi][ni];
        if (region == 0) {
          const float sc = 0.08838834764831845f;
          store_bf4(Q + (size_t)m * 1024 + n, a[0] * sc, a[1] * sc, a[2] * sc, a[3] * sc);
        } else if (region == 1) {
          store_bf4(Kb + (size_t)m * 1024 + (n - 1024), a[0], a[1], a[2], a[3]);
        } else if (region == 2) {
          const int b = m >> 14, tt = m & (S_ - 1);
#pragma unroll
          for (int j = 0; j < 4; ++j) Vt[((size_t)(b * 1024 + (n - 2048 + j))) * S_ + tt] = f2bf(a[j]);
        } else if (region == 3) {
          store_bf4(U2 + (size_t)m * 1024 + (n - 3072), a[0], a[1], a[2], a[3]);
        } else {
          store_bf4(G + (size_t)m * 4096 + (n - 4096), sigmoidf_(a[0]), sigmoidf_(a[1]), sigmoidf_(a[2]), sigmoidf_(a[3]));
        }
      }
    }
  }
}

__device__ void attn_item(const Params& P, int item, u16* lds) {
  const int c = item >> 4, hd = item & 7, b = (item >> 3) & 1;
  const int tid = tidx(), lane = tid & 63, w = tid >> 6, lr = lane & 15, lq = lane >> 4;
  u16* Ks = lds;
  u16* Vs = lds + 64 * 136;
  float* bs = (float*)(lds + 64 * 136 + 128 * 72);
  const u16* Q = (const u16*)(P.ws + O_Q);
  const u16* Kb = (const u16*)(P.ws + O_K);
  const u16* Vt = (const u16*)(P.ws + O_VT);
  u16* ya = (u16*)(P.ws + O_YA);
  __syncthreads();
  for (int i = tid; i < 257; i += 256) bs[i] = P.rel_bias[hd * 257 + i];
  bf16x8 qf[4];
  {
    const u16* qp = Q + (size_t)(b * S_ + c * 64 + w * 16 + lr) * 1024 + hd * 128 + lq * 8;
#pragma unroll
    for (int ks = 0; ks < 4; ++ks) qf[ks] = *(const bf16x8*)(qp + ks * 32);
  }
  f32x4 oacc[8];
#pragma unroll
  for (int d = 0; d < 8; ++d) oacc[d] = f32x4{0.f, 0.f, 0.f, 0.f};
  float m_run = -1e30f, lsum = 0.f;
  const int i0 = (c < 8) ? (8 - c) : 0;
  const int qi = w * 16 + lr;
#define KV_ADDR_K(r, kc_) (Kb + (size_t)(b * S_ + (kc_) * 64 + ((tid + 256 * (r)) >> 4)) * 1024 + hd * 128 + ((tid + 256 * (r)) & 15) * 8)
#define KV_ADDR_V(r, kc_) (Vt + ((size_t)(b * 1024 + hd * 128 + ((tid + 256 * (r)) >> 3))) * S_ + (kc_) * 64 + ((tid + 256 * (r)) & 7) * 8)
#define KV_LOAD(kc_)                                                                   \
  kr0 = *(const uint4*)KV_ADDR_K(0, kc_); kr1 = *(const uint4*)KV_ADDR_K(1, kc_);     \
  kr2 = *(const uint4*)KV_ADDR_K(2, kc_); kr3 = *(const uint4*)KV_ADDR_K(3, kc_);     \
  vr0 = *(const uint4*)KV_ADDR_V(0, kc_); vr1 = *(const uint4*)KV_ADDR_V(1, kc_);     \
  vr2 = *(const uint4*)KV_ADDR_V(2, kc_); vr3 = *(const uint4*)KV_ADDR_V(3, kc_);
#define KS_W(r) (Ks + ((tid + 256 * (r)) >> 4) * 136 + ((tid + 256 * (r)) & 15) * 8)
#define VS_W(r) (Vs + ((tid + 256 * (r)) >> 3) * 72 + ((tid + 256 * (r)) & 7) * 8)
#define KV_LOADS(S, kc_)                                                                \
  S##k0 = *(const uint4*)KV_ADDR_K(0, kc_); S##k1 = *(const uint4*)KV_ADDR_K(1, kc_);   \
  S##k2 = *(const uint4*)KV_ADDR_K(2, kc_); S##k3 = *(const uint4*)KV_ADDR_K(3, kc_);   \
  S##v0 = *(const uint4*)KV_ADDR_V(0, kc_); S##v1 = *(const uint4*)KV_ADDR_V(1, kc_);   \
  S##v2 = *(const uint4*)KV_ADDR_V(2, kc_); S##v3 = *(const uint4*)KV_ADDR_V(3, kc_);
#define KV_WRITES(S)                                                                                   \
  *(uint4*)KS_W(0) = S##k0; *(uint4*)KS_W(1) = S##k1; *(uint4*)KS_W(2) = S##k2; *(uint4*)KS_W(3) = S##k3; \
  *(uint4*)VS_W(0) = S##v0; *(uint4*)VS_W(1) = S##v1; *(uint4*)VS_W(2) = S##v2; *(uint4*)VS_W(3) = S##v3;
  uint4 Ak0, Ak1, Ak2, Ak3, Av0, Av1, Av2, Av3, Bk0, Bk1, Bk2, Bk3, Bv0, Bv1, Bv2, Bv3;
  auto tile_compute = [&](const int i) {
    f32x4 sacc[4];
#pragma unroll
    for (int kt = 0; kt < 4; ++kt) {
      sacc[kt] = f32x4{0.f, 0.f, 0.f, 0.f};
#pragma unroll
      for (int ks = 0; ks < 4; ++ks) {
        bf16x8 kf = *(const bf16x8*)(Ks + (kt * 16 + lr) * 136 + ks * 32 + lq * 8);
        sacc[kt] = __builtin_amdgcn_mfma_f32_16x16x32_bf16(kf, qf[ks], sacc[kt], 0, 0, 0);
      }
    }
    float tmax = -1e30f;
#pragma unroll
    for (int kt = 0; kt < 4; ++kt)
#pragma unroll
      for (int j = 0; j < 4; ++j) {
        int kb = i * 64 + kt * 16 + lq * 4 + j;
        int rel = 512 + qi - kb;
        rel = min(max(rel, -128), 128) + 128;
        float s = sacc[kt][j] + bs[rel];
        sacc[kt][j] = s;
        tmax = fmaxf(tmax, s);
      }
    tmax = fmaxf(tmax, __shfl_xor(tmax, 16));
    tmax = fmaxf(tmax, __shfl_xor(tmax, 32));
    const float m_new = fmaxf(m_run, tmax);
    const float corr = __expf(m_run - m_new);
    m_run = m_new;
    float ps = 0.f;
#pragma unroll
    for (int kt = 0; kt < 4; ++kt)
#pragma unroll
      for (int j = 0; j < 4; ++j) {
        float pv = __expf(sacc[kt][j] - m_new);
        sacc[kt][j] = pv;
        ps += pv;
      }
    lsum = lsum * corr + ps;
#pragma unroll
    for (int d = 0; d < 8; ++d) {
      oacc[d][0] *= corr; oacc[d][1] *= corr; oacc[d][2] *= corr; oacc[d][3] *= corr;
    }
#pragma unroll
    for (int kk = 0; kk < 2; ++kk) {
      union { bf16x8 v; unsigned u[4]; } pf;
      pf.u[0] = pack2(sacc[2 * kk][0], sacc[2 * kk][1]);
      pf.u[1] = pack2(sacc[2 * kk][2], sacc[2 * kk][3]);
      pf.u[2] = pack2(sacc[2 * kk + 1][0], sacc[2 * kk + 1][1]);
      pf.u[3] = pack2(sacc[2 * kk + 1][2], sacc[2 * kk + 1][3]);
#pragma unroll
      for (int d = 0; d < 8; ++d) {
        union { bf16x8 v; uint2 h[2]; } vf;
        vf.h[0] = *(const uint2*)(Vs + (d * 16 + lr) * 72 + kk * 32 + lq * 4);
        vf.h[1] = *(const uint2*)(Vs + (d * 16 + lr) * 72 + kk * 32 + 16 + lq * 4);
        oacc[d] = __builtin_amdgcn_mfma_f32_16x16x32_bf16(vf.v, pf.v, oacc[d], 0, 0, 0);
      }
    }
  };
  KV_LOADS(A, c - 8 + i0)
  if (i0 + 1 <= 8) { KV_LOADS(B, c - 8 + i0 + 1) }
  for (int i = i0; i <= 8; i += 2) {
    __syncthreads();
    KV_WRITES(A)
    __syncthreads();
    if (i + 2 <= 8) { KV_LOADS(A, c - 8 + i + 2) }
    tile_compute(i);
    if (i + 1 > 8) break;
    __syncthreads();
    KV_WRITES(B)
    __syncthreads();
    if (i + 3 <= 8) { KV_LOADS(B, c - 8 + i + 3) }
    tile_compute(i + 1);
  }
  lsum += __shfl_xor(lsum, 16);
  lsum += __shfl_xor(lsum, 32);
  const float inv = 1.f / lsum;
  u16* op = ya + (size_t)(b * S_ + c * 64 + w * 16 + lr) * 1024 + hd * 128 + lq * 4;
#pragma unroll
  for (int d = 0; d < 8; ++d) store_bf4(op + d * 16, oacc[d][0] * inv, oacc[d][1] * inv, oacc[d][2] * inv, oacc[d][3] * inv);
}

template <int PASS>
__device__ void ssm_item(const Params& P, int item, char* ldsw) {
  const int sc = item & 15, seq = item >> 4, g = seq & 63, b = seq >> 6;
  const int lane = tidx() & 63, lr = lane & 15, lq = lane >> 4;
  float* BuS = (float*)ldsw;
  u16* Hs = (u16*)(ldsw + 8192);
  const u16* bcat = (const u16*)(P.ws + O_BCAT);
  const u16* ccat = (const u16*)(P.ws + O_CCAT);
  const float* lam = (const float*)(P.ws + O_LAM);
  const u16* U2 = (const u16*)(P.ws + O_U2);
  float* Sbuf = (float*)(P.ws + O_SBUF);
  u16* ys = (u16*)(P.ws + O_YS);
  const float ar = lam[g * 64 + lane], ai = lam[4096 + g * 64 + lane];
  bf16x8 bfrag[8];
#pragma unroll
  for (int nt = 0; nt < 8; ++nt) bfrag[nt] = *(const bf16x8*)(bcat + (g * 128 + nt * 16 + lr) * 32 + lq * 8);
  float sr = 0.f, si = 0.f;
  bf16x8 cfrag[4];
  float dsk[4];
  if (PASS == 2) {
#pragma unroll
    for (int ks = 0; ks < 4; ++ks) cfrag[ks] = *(const bf16x8*)(ccat + (g * 16 + lr) * 128 + ks * 32 + lq * 8);
#pragma unroll
    for (int j = 0; j < 4; ++j) dsk[j] = P.ssm_d[g * 16 + lq * 4 + j];
    const float aLr = lam[2 * 4096 + g * 64 + lane], aLi = lam[3 * 4096 + g * 64 + lane];
    const float* Sb = Sbuf + (size_t)seq * 16 * 128;
#pragma unroll 4
    for (int cc = 0; cc < sc; ++cc) {
      float xr = Sb[cc * 128 + lane], xi = Sb[cc * 128 + 64 + lane];
      float nr = fmaf(aLr, sr, fmaf(-aLi, si, xr));
      float ni = fmaf(aLr, si, fmaf(aLi, sr, xi));
      sr = nr; si = ni;
    }
  }
#pragma unroll 1
  for (int ci = 0; ci < 8; ++ci) {
  const size_t tok_base = (size_t)b * S_ + (size_t)(sc * 8 + ci) * SSM_L;
  uint4 upre[SSM_L / 16];
  uint2 uepi[SSM_L / 16];
#pragma unroll
  for (int sub = 0; sub < SSM_L / 16; ++sub) {
    upre[sub] = uint4{0u, 0u, 0u, 0u};
    if (lq < 2) upre[sub] = *(const uint4*)(U2 + (tok_base + sub * 16 + lr) * 1024 + g * 16 + lq * 8);
    if (PASS == 2) uepi[sub] = *(const uint2*)(U2 + (tok_base + sub * 16 + lr) * 1024 + g * 16 + lq * 4);
  }
#pragma unroll
  for (int sub = 0; sub < SSM_L / 16; ++sub) {
    const size_t tok0 = tok_base + sub * 16;
    union { bf16x8 v; uint4 u; } uf;
    uf.u = upre[sub];
#pragma unroll
    for (int nt = 0; nt < 8; ++nt) {
      f32x4 d = __builtin_amdgcn_mfma_f32_16x16x32_bf16(bfrag[nt], uf.v, f32x4{0.f, 0.f, 0.f, 0.f}, 0, 0, 0);
      *(f32x4*)(BuS + lr * 128 + nt * 16 + lq * 4) = d;
    }
    asm volatile("s_waitcnt lgkmcnt(0)" ::: "memory");
#pragma unroll
    for (int t = 0; t < 16; ++t) {
      float bur = BuS[t * 128 + lane], bui = BuS[t * 128 + 64 + lane];
      float nr = fmaf(ar, sr, fmaf(-ai, si, bur));
      float ni = fmaf(ar, si, fmaf(ai, sr, bui));
      sr = nr; si = ni;
      if (PASS == 2) {
        Hs[t * 136 + lane] = f2bf(sr);
        Hs[t * 136 + 64 + lane] = f2bf(si);
      }
    }
    asm volatile("s_waitcnt lgkmcnt(0)" ::: "memory");
    if (PASS == 2) {
      f32x4 yacc = f32x4{0.f, 0.f, 0.f, 0.f};
#pragma unroll
      for (int ks = 0; ks < 4; ++ks) {
        bf16x8 hf = *(const bf16x8*)(Hs + lr * 136 + ks * 32 + lq * 8);
        yacc = __builtin_amdgcn_mfma_f32_16x16x32_bf16(cfrag[ks], hf, yacc, 0, 0, 0);
      }
      const uint2 uu = uepi[sub];
      float y0 = gelu_tanh(yacc[0] + dsk[0] * lo2f(uu.x));
      float y1 = gelu_tanh(yacc[1] + dsk[1] * hi2f(uu.x));
      float y2 = gelu_tanh(yacc[2] + dsk[2] * lo2f(uu.y));
      float y3 = gelu_tanh(yacc[3] + dsk[3] * hi2f(uu.y));
      store_bf4(ys + (tok0 + lr) * 1024 + g * 16 + lq * 4, y0, y1, y2, y3);
      asm volatile("s_waitcnt lgkmcnt(0)" ::: "memory");
    }
  }
  }
  if (PASS == 1) {
    Sbuf[((size_t)seq * 16 + sc) * 128 + lane] = sr;
    Sbuf[((size_t)seq * 16 + sc) * 128 + 64 + lane] = si;
  }
}

__device__ void phase2(const Params& P, int bid, int nb, u16* lds) {
  for (int it = bid; it < 4096 + 512; it += nb) {
    if (it < 4096) {
      attn_item(P, it, lds);
    } else {
      __syncthreads();
      const int w = tidx() >> 6;
      ssm_item<1>(P, (it - 4096) * 4 + w, (char*)lds + w * 12544);
    }
  }
}
__device__ void phase3(const Params& P, int bid, int nb, u16* lds) {
  const int w = tidx() >> 6;
  for (int it = bid; it < 512; it += nb) ssm_item<2>(P, it * 4 + w, (char*)lds + w * 12544);
}

__device__ void phase4(const Params& P, int bid, int nb, u16* lds) {
  const u16* ys = (const u16*)(P.ws + O_YS);
  const u16* W = (const u16*)(P.ws + O_WGLU);
  u16* yg = (u16*)(P.ws + O_YG);
  EPI_COORDS3
  FOR_TILES_XCD(t, 128 * 4) {
    const int mt = t >> 2, nt = t & 3;
    f32x4 acc[4][8];
    ZERO_ACC8(acc)
    gemm_kloop3(acc, ys + (size_t)mt * 256 * 1024, 1024, W + (size_t)nt * 256 * 1024, 1024, 1024, lds);
#pragma unroll
    for (int mi = 0; mi < 4; ++mi) {
      const int m = mt * 256 + wm * 64 + mi * 16 + lr;
#pragma unroll
      for (int ni = 0; ni < 8; ++ni) {
        const int n = nt * 256 + wn * 128 + ni * 16 + lq * 4;
        uint2 yy = *(const uint2*)(ys + (size_t)m * 1024 + n);
        f32x4 a = acc[mi][ni];
        store_bf4(yg + (size_t)m * 1024 + n, lo2f(yy.x) * sigmoidf_(a[0]), hi2f(yy.x) * sigmoidf_(a[1]),
                  lo2f(yy.y) * sigmoidf_(a[2]), hi2f(yy.y) * sigmoidf_(a[3]));
      }
    }
  }
}

__device__ void phase5(const Params& P, int bid, int nb, u16* lds) {
  const u16* ya = (const u16*)(P.ws + O_YA);
  const u16* yg = (const u16*)(P.ws + O_YG);
  const u16* Wa = (const u16*)(P.ws + O_WAU);
  const u16* Wsu = (const u16*)(P.ws + O_WSU);
  const u16* G = (const u16*)(P.ws + O_G);
  u16* mg = (u16*)(P.ws + O_MERGED);
  EPI_COORDS3
  FOR_TILES_XCD(t, 128 * 8) {
    const int mt = t >> 3, nt = t & 7;
#pragma unroll 1
    for (int part = 0; part < 2; ++part) {
      f32x4 acc[4][8];
      ZERO_ACC8(acc)
      gemm_kloop3(acc, (part ? yg : ya) + (size_t)mt * 256 * 1024, 1024, (part ? Wsu : Wa) + (size_t)nt * 256 * 1024, 1024,
                  1024, lds);
      const u16* Gp = G + part * 2048;
#pragma unroll
      for (int mi = 0; mi < 4; ++mi) {
        const int m = mt * 256 + wm * 64 + mi * 16 + lr;
#pragma unroll
        for (int ni = 0; ni < 8; ++ni) {
          const int n = nt * 256 + wn * 128 + ni * 16 + lq * 4;
          const uint2 gg = *(const uint2*)(Gp + (size_t)m * 4096 + n);
          f32x4 a = acc[mi][ni];
          float o0 = a[0] * lo2f(gg.x), o1 = a[1] * hi2f(gg.x), o2 = a[2] * lo2f(gg.y), o3 = a[3] * hi2f(gg.y);
          if (part) {
            const uint2 pv = *(const uint2*)(mg + (size_t)m * D_ + n);
            o0 += lo2f(pv.x); o1 += hi2f(pv.x); o2 += lo2f(pv.y); o3 += hi2f(pv.y);
          }
          store_bf4(mg + (size_t)m * D_ + n, o0, o1, o2, o3);
        }
      }
    }
  }
}

__device__ void phase6(const Params& P, int bid, int nb, u16* lds) {
  const u16* mg = (const u16*)(P.ws + O_MERGED);
  const u16* W = (const u16*)(P.ws + O_WOUT);
  const u16* H = (const u16*)(P.ws + O_H);
  float* pre1 = (float*)(P.ws + O_PRE1);
  EPI_COORDS3
  FOR_TILES_XCD(t, 128 * 8) {
    const int mt = t >> 3, nt = t & 7;
    f32x4 acc[4][8];
    ZERO_ACC8(acc)
    gemm_kloop3(acc, mg + (size_t)mt * 256 * D_, D_, W + (size_t)nt * 256 * D_, D_, D_, lds);
#pragma unroll
    for (int mi = 0; mi < 4; ++mi) {
      const int m = mt * 256 + wm * 64 + mi * 16 + lr;
#pragma unroll
      for (int ni = 0; ni < 8; ++ni) {
        const int n = nt * 256 + wn * 128 + ni * 16 + lq * 4;
        uint2 hh = *(const uint2*)(H + (size_t)m * D_ + n);
        f32x4 a = acc[mi][ni];
        float4 o;
        o.x = ALPHA * lo2f(hh.x) + a[0]; o.y = ALPHA * hi2f(hh.x) + a[1];
        o.z = ALPHA * lo2f(hh.y) + a[2]; o.w = ALPHA * hi2f(hh.y) + a[3];
        *(float4*)(pre1 + (size_t)m * D_ + n) = o;
      }
    }
  }
}

__device__ void phase8(const Params& P, int bid, int nb, u16* lds) {
  const u16* H = (const u16*)(P.ws + O_H);
  const u16* Pb = (const u16*)(P.ws + O_PB);
  u16* PQ = (u16*)(P.ws + O_PQ);
  u16* SG = (u16*)(P.ws + O_SG);
  u16* E = (u16*)(P.ws + O_E);
  EPI_COORDS3
  FOR_TILES_XCD(t, 3 * 1024) {
    const int which = t >> 10, tt = t & 1023, mt = tt >> 3, nt = tt & 7;
    f32x4 acc[4][8];
    ZERO_ACC8(acc)
    u16* dst;
    if (which == 0) {
      gemm_kloop3(acc, H + (size_t)mt * 256 * D_, D_, (const u16*)(P.ws + O_WPQ) + (size_t)nt * 256 * D_, D_, D_, lds);
      dst = PQ;
    } else if (which == 1) {
      gemm_kloop3(acc, H + (size_t)mt * 256 * D_, D_, (const u16*)(P.ws + O_WPG) + (size_t)nt * 256 * D_, D_, D_, lds);
      dst = SG;
    } else {
      gemm_kloop3(acc, Pb + (size_t)mt * 256 * 256, 256, (const u16*)(P.ws + O_WPIN) + (size_t)nt * 256 * 256, 256, 256, lds);
      dst = E;
    }
#pragma unroll
    for (int mi = 0; mi < 4; ++mi) {
      const int m = mt * 256 + wm * 64 + mi * 16 + lr;
#pragma unroll
      for (int ni = 0; ni < 8; ++ni) {
        const int n = nt * 256 + wn * 128 + ni * 16 + lq * 4;
        f32x4 a = acc[mi][ni];
        if (which == 1) { a[0] = sigmoidf_(a[0]); a[1] = sigmoidf_(a[1]); a[2] = sigmoidf_(a[2]); a[3] = sigmoidf_(a[3]); }
        store_bf4(dst + (size_t)m * D_ + n, a[0], a[1], a[2], a[3]);
      }
    }
  }
}

struct Top16 { float v[16]; int i[16]; };
__device__ __forceinline__ void top_init(Top16& t) {
#pragma unroll
  for (int k = 0; k < 16; ++k) { t.v[k] = -INFINITY; t.i[k] = 0; }
}
__device__ __forceinline__ void top_insert(Top16& t, float x, int id) {
  const bool c = x > t.v[15];
  t.v[15] = c ? x : t.v[15];
  t.i[15] = c ? id : t.i[15];
#pragma unroll
  for (int k = 15; k >= 1; --k) {
    const bool s = t.v[k] > t.v[k - 1];
    const float a = t.v[k - 1], b = t.v[k];
    const int ia = t.i[k - 1], ib = t.i[k];
    t.v[k - 1] = s ? b : a; t.v[k] = s ? a : b;
    t.i[k - 1] = s ? ib : ia; t.i[k] = s ? ia : ib;
  }
}

__device__ void phase9(const Params& P, int bid, int nb, u16* lds) {
  const u16* PQ = (const u16*)(P.ws + O_PQ);
  const u16* SK = (const u16*)(P.ws + O_SK);
  float* HV = (float*)(P.ws + O_HV);
  int* HI = (int*)(P.ws + O_HI);
  float* Sc = (float*)lds;
  EPI_COORDS
  const int tid = tidx();
  for (int t = bid; t < 256 * 16; t += nb) {
    const int mt = t >> 4, rc = t & 15;
    f32x4 acc[4][4];
    ZERO_ACC(acc)
    gemm_kloop(acc, PQ + (size_t)mt * 128 * D_ + rc * 128, D_, SK + (size_t)rc * 128 * 128, 128, 128, lds);
#pragma unroll
    for (int mi = 0; mi < 4; ++mi) {
      const int m = wm * 64 + mi * 16 + lr;
#pragma unroll
      for (int ni = 0; ni < 4; ++ni) {
        const int n = wn * 64 + ni * 16 + lq * 4;
#pragma unroll
        for (int j = 0; j < 4; ++j) Sc[m * 129 + n + j] = acc[mi][ni][j];
      }
    }
    __syncthreads();
    const int tok = tid & 127, hh = tid >> 7;
    float key[16];
#pragma unroll
    for (int j = 0; j < 16; ++j) key[j] = -INFINITY;
    {
      const float* sp = Sc + tok * 129 + hh * 64;
#pragma unroll 4
      for (int k = 0; k < 64; ++k) {
        const float x = sp[k];
        const float kk = __uint_as_float((__float_as_uint(x) & ~127u) | (unsigned)(127 - (hh * 64 + k)));
#pragma unroll
        for (int j = 15; j >= 1; --j) key[j] = __builtin_amdgcn_fmed3f(key[j - 1], key[j], kk);
        key[0] = fmaxf(key[0], kk);
      }
    }
    __syncthreads();
    float* Lv = (float*)lds;
#pragma unroll
    for (int k = 0; k < 16; ++k) Lv[tid * 17 + k] = key[k];
    __syncthreads();
    if (tid < 128) {
      int ia = 0, ib = 0;
      const float* va = Lv + tid * 17; const float* vb = Lv + (tid + 128) * 17;
      float* ov = HV + ((size_t)(mt * 16 + rc) * 128 + tid) * 16;
      int* oi = HI + ((size_t)(mt * 16 + rc) * 128 + tid) * 16;
      for (int k = 0; k < 16; ++k) {
        const float a = va[ia], b = vb[ib];
        const bool ta = a >= b;
        const unsigned bits = __float_as_uint(ta ? a : b);
        ov[k] = __uint_as_float(bits & ~127u);
        oi[k] = 127 - (int)(bits & 127u);
        ia += ta ? 1 : 0; ib += ta ? 0 : 1;
      }
    }
    __syncthreads();
  }
}

__device__ void phase10(const Params& P, int bid, int nb, u16* lds) {
  int* Lx = (int*)lds + tidx() * 33;
  const float* HV = (const float*)(P.ws + O_HV);
  const int* HI = (const int*)(P.ws + O_HI);
  int* EX = (int*)(P.ws + O_EXP);
  float* GT = (float*)(P.ws + O_GATE);
  for (int i_ = bid * 256 + tidx(); i_ < T_ * 8; i_ += nb * 256) {
    const int r_ = (i_ >> 7) & 7, mt_ = i_ >> 10, tl_ = i_ & 127;
    const int i = (mt_ * 128 + tl_) * 8 + r_;
    const size_t h0 = ((size_t)(mt_ * 16 + r_ * 2) * 128 + tl_) * 16, h1 = h0 + 128 * 16;
    float v0[16], v1[16];
    int i0[16], i1[16];
#pragma unroll
    for (int q = 0; q < 4; ++q) {
      float4 a = *(const float4*)(HV + h0 + q * 4);
      float4 b = *(const float4*)(HV + h1 + q * 4);
      int4 c = *(const int4*)(HI + h0 + q * 4);
      int4 d = *(const int4*)(HI + h1 + q * 4);
      v0[q * 4] = a.x; v0[q * 4 + 1] = a.y; v0[q * 4 + 2] = a.z; v0[q * 4 + 3] = a.w;
      v1[q * 4] = b.x; v1[q * 4 + 1] = b.y; v1[q * 4 + 2] = b.z; v1[q * 4 + 3] = b.w;
      i0[q * 4] = c.x; i0[q * 4 + 1] = c.y; i0[q * 4 + 2] = c.z; i0[q * 4 + 3] = c.w;
      i1[q * 4] = d.x; i1[q * 4 + 1] = d.y; i1[q * 4 + 2] = d.z; i1[q * 4 + 3] = d.w;
    }
    float t[16];
#pragma unroll
    for (int j = 0; j < 16; ++j) t[j] = -INFINITY;
#pragma unroll
    for (int a = 0; a < 16; ++a)
#pragma unroll
      for (int b = 0; b < 16; ++b)
        if ((a + 1) * (b + 1) <= 16) {
          const float sv = v0[a] + v1[b];
#pragma unroll
          for (int j = 15; j >= 1; --j) t[j] = __builtin_amdgcn_fmed3f(t[j - 1], t[j], sv);
          t[0] = fmaxf(t[0], sv);
        }
    const float mx = t[0], thr = t[15];
    float sum = 0.f;
#pragma unroll
    for (int k = 0; k < 16; ++k) sum += __expf(t[k] - mx);
    const float inv = 1.f / sum;
    int cnt = 0;
#pragma unroll
    for (int a = 0; a < 16; ++a)
#pragma unroll
      for (int b = 0; b < 16; ++b)
        if ((a + 1) * (b + 1) <= 16) {
          const float sv = v0[a] + v1[b];
          if (sv >= thr && cnt < 16) {
            Lx[cnt] = i0[a] * 128 + i1[b];
            Lx[16 + cnt] = __float_as_int(__expf(sv - mx) * inv);
            ++cnt;
          }
        }
    asm volatile("s_waitcnt lgkmcnt(0)" ::: "memory");
#pragma unroll
    for (int q = 0; q < 4; ++q) {
      *(int4*)(EX + (size_t)i * 16 + q * 4) = int4{Lx[q * 4], Lx[q * 4 + 1], Lx[q * 4 + 2], Lx[q * 4 + 3]};
      *(float4*)(GT + (size_t)i * 16 + q * 4) =
          float4{__int_as_float(Lx[16 + q * 4]), __int_as_float(Lx[16 + q * 4 + 1]), __int_as_float(Lx[16 + q * 4 + 2]),
                 __int_as_float(Lx[16 + q * 4 + 3])};
    }
    asm volatile("s_waitcnt lgkmcnt(0)" ::: "memory");
  }
}

__device__ __forceinline__ void unpack8(uint4 u, float* f) {
  f[0] = lo2f(u.x); f[1] = hi2f(u.x); f[2] = lo2f(u.y); f[3] = hi2f(u.y);
  f[4] = lo2f(u.z); f[5] = hi2f(u.z); f[6] = lo2f(u.w); f[7] = hi2f(u.w);
}
__device__ __forceinline__ void dec16(uint4 u, float* f) {
  f32x2 a;
  a = __builtin_amdgcn_cvt_pk_f32_fp8((int)u.x, false); f[0] = a.x; f[1] = a.y;
  a = __builtin_amdgcn_cvt_pk_f32_fp8((int)u.x, true);  f[2] = a.x; f[3] = a.y;
  a = __builtin_amdgcn_cvt_pk_f32_fp8((int)u.y, false); f[4] = a.x; f[5] = a.y;
  a = __builtin_amdgcn_cvt_pk_f32_fp8((int)u.y, true);  f[6] = a.x; f[7] = a.y;
  a = __builtin_amdgcn_cvt_pk_f32_fp8((int)u.z, false); f[8] = a.x; f[9] = a.y;
  a = __builtin_amdgcn_cvt_pk_f32_fp8((int)u.z, true);  f[10] = a.x; f[11] = a.y;
  a = __builtin_amdgcn_cvt_pk_f32_fp8((int)u.w, false); f[12] = a.x; f[13] = a.y;
  a = __builtin_amdgcn_cvt_pk_f32_fp8((int)u.w, true);  f[14] = a.x; f[15] = a.y;
}
__device__ __forceinline__ void load_row_bf16(const u16* row, int lane, float* f) {
#pragma unroll
  for (int q = 0; q < 2; ++q) {
    uint4 a = *(const uint4*)(row + q * 1024 + lane * 16);
    uint4 b = *(const uint4*)(row + q * 1024 + lane * 16 + 8);
    unpack8(a, f + q * 16);
    unpack8(b, f + q * 16 + 8);
  }
}
__device__ void phase11(const Params& P, int bid, int nb) {
  const u16* H = (const u16*)(P.ws + O_H);
  const unsigned char* U8 = (const unsigned char*)(P.ws + O_U8);
  const unsigned char* V8 = (const unsigned char*)(P.ws + O_V8);
  const float* RSU = (const float*)(P.ws + O_RSU);
  const float* RSV = (const float*)(P.ws + O_RSV);
  const u16* SG = (const u16*)(P.ws + O_SG);
  const u16* E = (const u16*)(P.ws + O_E);
  const int* EX = (const int*)(P.ws + O_EXP);
  const float* GT = (const float*)(P.ws + O_GATE);
  const int lane = tidx() & 63;
  int sweep = 0;
  for (int tok = bid * 4 + (tidx() >> 6); tok < T_; tok += nb * 4, sweep ^= 1) {
    float hf[32], y[32];
    load_row_bf16(H + (size_t)tok * D_, lane, hf);
#pragma unroll
    for (int k = 0; k < 32; ++k) y[k] = 0.f;
    int ev0 = EX[(size_t)tok * 128 + lane], ev1 = EX[(size_t)tok * 128 + 64 + lane];
    float gv0 = GT[(size_t)tok * 128 + lane], gv1 = GT[(size_t)tok * 128 + 64 + lane];
    {
      int k0 = (ev0 << 7) | lane, k1 = (ev1 << 7) | (64 + lane);
#pragma unroll
      for (int kk = 2; kk <= 128; kk <<= 1) {
#pragma unroll
        for (int j = kk >> 1; j >= 1; j >>= 1) {
          if (j == 64) {
            const int lo_ = min(k0, k1), hi_ = max(k0, k1);
            k0 = lo_; k1 = hi_;
          } else {
            const int p0 = __shfl_xor(k0, j), p1 = __shfl_xor(k1, j);
            const bool lower = (lane & j) == 0;
            const bool up0 = (kk == 128) ? true : ((lane & kk) == 0);
            const bool up1 = (kk == 128) ? true : (kk == 64 ? false : ((lane & kk) == 0));
            k0 = (lower == up0) ? min(k0, p0) : max(k0, p0);
            k1 = (lower == up1) ? min(k1, p1) : max(k1, p1);
          }
        }
      }
      const int s0 = k0 & 127, s1 = k1 & 127;
      const float ga0 = __shfl(gv0, s0 & 63), gb0 = __shfl(gv1, s0 & 63);
      const float ga1 = __shfl(gv0, s1 & 63), gb1 = __shfl(gv1, s1 & 63);
      gv0 = (s0 < 64) ? ga0 : gb0;
      gv1 = (s1 < 64) ? ga1 : gb1;
      ev0 = k0 >> 7;
      ev1 = k1 >> 7;
    }
    const float ru0 = RSU[ev0], ru1 = RSU[ev1], rv0 = RSV[ev0], rv1 = RSV[ev1];
    for (int k4_ = 0; k4_ < 128; k4_ += 4) {
      const int k4 = sweep ? (124 - k4_) : k4_;
      const int src = k4 & 63;
      const bool lo = k4 < 64;
      int ee[4]; float gg[4], su[4], sv[4];
#pragma unroll
      for (int x = 0; x < 4; ++x) {
        ee[x] = __shfl(lo ? ev0 : ev1, src + x);
        gg[x] = __shfl(lo ? gv0 : gv1, src + x);
        su[x] = __shfl(lo ? ru0 : ru1, src + x);
        sv[x] = __shfl(lo ? rv0 : rv1, src + x);
      }
      uint4 uu[4][2], vv[4][2];
#pragma unroll
      for (int x = 0; x < 4; ++x)
#pragma unroll
        for (int q = 0; q < 2; ++q) {
          uu[x][q] = *(const uint4*)(U8 + (size_t)ee[x] * D_ + q * 1024 + lane * 16);
          vv[x][q] = *(const uint4*)(V8 + (size_t)ee[x] * D_ + q * 1024 + lane * 16);
        }
      float dd[4];
#pragma unroll
      for (int x = 0; x < 4; ++x) {
        float d = 0.f;
#pragma unroll
        for (int q = 0; q < 2; ++q) {
          float f[16];
          dec16(uu[x][q], f);
#pragma unroll
          for (int j = 0; j < 16; ++j) d = fmaf(f[j], hf[q * 16 + j], d);
        }
        dd[x] = d;
      }
#pragma unroll
      for (int o = 32; o >= 1; o >>= 1) {
#pragma unroll
        for (int x = 0; x < 4; ++x) dd[x] += __shfl_xor(dd[x], o);
      }
#pragma unroll
      for (int x = 0; x < 4; ++x) {
        const float w = gg[x] * gelu_tanh(dd[x] * su[x]) * sv[x];
#pragma unroll
        for (int q = 0; q < 2; ++q) {
          float f[16];
          dec16(vv[x][q], f);
#pragma unroll
          for (int j = 0; j < 16; ++j) y[q * 16 + j] = fmaf(w, f[j], y[q * 16 + j]);
        }
      }
    }
    float ef[32], sg[32];
    load_row_bf16(E + (size_t)tok * D_, lane, ef);
    load_row_bf16(SG + (size_t)tok * D_, lane, sg);
    float ss = 0.f;
#pragma unroll
    for (int k = 0; k < 32; ++k) ss += ef[k] * ef[k];
    const float rr = rsqrtf(wave_sum(ss) * (1.f / D_) + 1e-5f);
    float s1 = 0.f;
#pragma unroll
    for (int q = 0; q < 2; ++q)
#pragma unroll
      for (int j4 = 0; j4 < 4; ++j4) {
        float4 g = *(const float4*)(P.ple_g + q * 1024 + lane * 16 + j4 * 4);
        const float gq[4] = {g.x, g.y, g.z, g.w};
#pragma unroll
        for (int j = 0; j < 4; ++j) {
          const int k = q * 16 + j4 * 4 + j;
          float v = ALPHA * hf[k] + y[k] + ef[k] * rr * gq[j] * sg[k];
          y[k] = v;
          s1 += v;
        }
      }
    const float mu = wave_sum(s1) * (1.f / D_);
    float s2 = 0.f;
#pragma unroll
    for (int k = 0; k < 32; ++k) { float d = y[k] - mu; s2 += d * d; }
    const float rstd = rsqrtf(wave_sum(s2) * (1.f / D_) + 1e-5f);
#pragma unroll
    for (int q = 0; q < 2; ++q)
#pragma unroll
      for (int j4 = 0; j4 < 4; ++j4) {
        const int col = q * 1024 + lane * 16 + j4 * 4;
        const int k = q * 16 + j4 * 4;
        float4 g = *(const float4*)(P.ln2_g + col), b = *(const float4*)(P.ln2_b + col);
        float4 o;
        o.x = (y[k + 0] - mu) * rstd * g.x + b.x; o.y = (y[k + 1] - mu) * rstd * g.y + b.y;
        o.z = (y[k + 2] - mu) * rstd * g.z + b.z; o.w = (y[k + 3] - mu) * rstd * g.w + b.w;
        *(float4*)(P.out + (size_t)tok * D_ + col) = o;
      }
  }
}

constexpr size_t O_BAR = 1000 * MB;
__device__ __forceinline__ void gbar(unsigned* ctr, unsigned& epoch, unsigned nb) {
  epoch += nb;
  asm volatile("s_waitcnt vmcnt(0)" ::: "memory");
  __syncthreads();
  if (threadIdx.x == 0) {
    __builtin_amdgcn_fence(__ATOMIC_RELEASE, "agent");
    asm volatile("s_waitcnt vmcnt(0)" ::: "memory");
    __hip_atomic_fetch_add(ctr, 1u, __ATOMIC_RELAXED, __HIP_MEMORY_SCOPE_AGENT);
    while (__hip_atomic_load(ctr, __ATOMIC_RELAXED, __HIP_MEMORY_SCOPE_AGENT) < epoch) __builtin_amdgcn_s_sleep(2);
    __builtin_amdgcn_fence(__ATOMIC_ACQUIRE, "agent");
    asm volatile("s_waitcnt vmcnt(0)" ::: "memory");
  }
  __syncthreads();
}

constexpr int NPHASE = 12;

__global__ void __launch_bounds__(512, 2) mega_kernel(Params P) {
  extern __shared__ __attribute__((aligned(16))) u16 dlds[];
  cg::grid_group grid = cg::this_grid();
  const int rb = blockIdx.x, rnb = gridDim.x;
  const int half = threadIdx.x >> 8;
  const int bid = rb * 2 + half, nb = rnb * 2;
  u16* lds = dlds + half * 36864;
  unsigned* ctr = (unsigned*)(P.ws + O_BAR);
  unsigned ep = 0;
  phase0(P, bid, nb, lds); grid.sync();
  phase1(P, rb, rnb, dlds); gbar(ctr, ep, rnb);
  phase2(P, bid, nb, lds); gbar(ctr, ep, rnb);
  phase3(P, bid, nb, lds); gbar(ctr, ep, rnb);
  phase4(P, rb, rnb, dlds); gbar(ctr, ep, rnb);
  phase5(P, rb, rnb, dlds); gbar(ctr, ep, rnb);
  phase6(P, rb, rnb, dlds); gbar(ctr, ep, rnb);
  ln_rows((const float*)(P.ws + O_PRE1), P.ln1_g, P.ln1_b, (u16*)(P.ws + O_H), bid * 4 + (tidx() >> 6), nb * 4);
  gbar(ctr, ep, rnb);
  phase8(P, rb, rnb, dlds); gbar(ctr, ep, rnb);
  phase9(P, bid, nb, lds); gbar(ctr, ep, rnb);
  phase10(P, bid, nb, lds); gbar(ctr, ep, rnb);
  phase11(P, bid, nb);
}

extern "C" void kernel_launch(void* const* d_in, const int* in_sizes, int n_in, void* d_out, int out_size, void* d_ws,
                              size_t ws_size, hipStream_t stream) {
  Params p{};
  const float** pp = (const float**)&p;
  for (int i = 0; i < 29; ++i) pp[i] = (const float*)d_in[i];
  p.out = (float*)d_out;
  p.ws = (char*)d_ws;
  if (ws_size < 1001 * MB) fprintf(stderr, "workspace too small: %zu\n", ws_size);
  constexpr size_t kDynLds = 147456;
  static int grid_blocks = 0;
  if (!grid_blocks) {
    int dev = 0, cus = 0, per_cu = 0;
    (void)hipGetDevice(&dev);
    (void)hipDeviceGetAttribute(&cus, hipDeviceAttributeMultiprocessorCount, dev);
    (void)hipFuncSetAttribute((const void*)mega_kernel, hipFuncAttributeMaxDynamicSharedMemorySize, (int)kDynLds);
    (void)hipOccupancyMaxActiveBlocksPerMultiprocessor(&per_cu, mega_kernel, 512, kDynLds);
    if (per_cu > 1) per_cu = 1;
    grid_blocks = cus * per_cu;
  }
  (void)hipMemsetAsync((char*)d_ws + O_BAR, 0, 256, stream);
  void* args[] = {&p};
  hipError_t e = hipLaunchCooperativeKernel((void*)mega_kernel, dim3(grid_blocks), dim3(512), args, kDynLds, stream);
  if (e != hipSuccess) fprintf(stderr, "cooperative launch failed: %s (grid %d)\n", hipGetErrorString(e), grid_blocks);
}
```

```cpp
#include <hip/hip_runtime.h>
#include <hip/hip_bf16.h>
#include <hip/hip_cooperative_groups.h>
#include <cstdio>
namespace cg = cooperative_groups;

#ifndef MULTI
#define MULTI 0
#endif

typedef unsigned short u16;
using bf16x8 = __attribute__((ext_vector_type(8))) short;
using f32x4 = __attribute__((ext_vector_type(4))) float;

constexpr int T_ = 32768;
constexpr int S_ = 16384;
constexpr int D_ = 2048;
constexpr int SSM_L = 128;
constexpr int SSM_NC = S_ / SSM_L;
constexpr float ALPHA = 1.189207115002721f;
constexpr size_t MB = 1024ull * 1024ull;

constexpr size_t O_WIN = 0 * MB, O_WGLU = 32 * MB, O_WAU = 34 * MB, O_WSU = 38 * MB, O_WOUT = 42 * MB,
                 O_WPQ = 50 * MB, O_WPG = 58 * MB, O_WPIN = 66 * MB, O_SK = 67 * MB, O_BCAT = 67 * MB + 512 * 1024,
                 O_CCAT = 68 * MB, O_LAM = 68 * MB + 256 * 1024, O_UB = 70 * MB, O_VB = 134 * MB, O_SBUF = 198 * MB,
                 O_H = 206 * MB, O_Q = 334 * MB, O_K = 398 * MB, O_VT = 462 * MB, O_U2 = 526 * MB, O_G = 590 * MB,
                 O_YA = 846 * MB, O_YS = 910 * MB, O_PB = 974 * MB;
constexpr size_t O_YG = O_VT, O_MERGED = O_Q, O_PRE1 = O_G, O_PQ = O_Q, O_SG = O_VT, O_E = O_G,
                 O_HV = O_G + 128 * MB, O_HI = O_G + 160 * MB, O_EXP = O_G + 192 * MB, O_GATE = O_G + 208 * MB;

struct Params {
  const float *x, *p, *ln_in_g, *ln_in_b, *w_in, *rel_bias, *lam_re, *lam_im, *log_dt, *b_re, *b_im, *c_re, *c_im,
      *ssm_d, *w_glu, *w_au, *w_su, *w_out, *ln1_g, *ln1_b, *w_pq, *sub_keys, *peer_u, *peer_v, *ple_w_in, *ple_g,
      *ple_w_gate, *ln2_g, *ln2_b;
  float* out;
  char* ws;
};

__device__ __forceinline__ int tidx() { int t = threadIdx.x & 255; asm volatile("" : "+v"(t)); return t; }
__device__ __forceinline__ int rtid() { int t = threadIdx.x; asm volatile("" : "+v"(t)); return t; }
__device__ __forceinline__ u16 f2bf(float f) {
  unsigned u = __float_as_uint(f);
  u += 0x7fffu + ((u >> 16) & 1u);
  return (u16)(u >> 16);
}
__device__ __forceinline__ float bf2f(u16 h) { return __uint_as_float(((unsigned)h) << 16); }
typedef __bf16 hwbf16x2 __attribute__((ext_vector_type(2)));
typedef float hwf32x2 __attribute__((ext_vector_type(2)));
__device__ __forceinline__ unsigned pack2(float a, float b) {
  hwf32x2 v = {a, b};
  hwbf16x2 r = __builtin_convertvector(v, hwbf16x2);
  return *(unsigned*)&r;
}
__device__ __forceinline__ float lo2f(unsigned u) { return __uint_as_float(u << 16); }
__device__ __forceinline__ float hi2f(unsigned u) { return __uint_as_float(u & 0xffff0000u); }
__device__ __forceinline__ float sigmoidf_(float x) { return __builtin_amdgcn_rcpf(1.f + __expf(-x)); }
__device__ __forceinline__ float gelu_tanh(float x) {
  float u = 0.7978845608028654f * (x + 0.044715f * x * x * x);
  float t = 1.f - 2.f * __builtin_amdgcn_rcpf(1.f + __expf(2.f * u));
  return 0.5f * x * (1.f + t);
}
__device__ __forceinline__ float wave_sum(float v) {
#pragma unroll
  for (int o = 32; o >= 1; o >>= 1) v += __shfl_xor(v, o);
  return v;
}
__device__ __forceinline__ void store_bf4(u16* dst, float a, float b, float c, float d) {
  uint2 v; v.x = pack2(a, b); v.y = pack2(c, d);
  *(uint2*)dst = v;
}

__device__ __forceinline__ void gemm_kloop(f32x4 (&acc)[4][4], const u16* __restrict__ A, int lda,
                                           const u16* __restrict__ Bt, int ldb, int K, u16* lds) {
  const int tid = tidx(), lane = tid & 63, wid = tid >> 6, wm = wid >> 1, wn = wid & 1;
  const int lr = lane & 15, lq = lane >> 4;
  const int nk = K >> 6;
  const int srow = tid >> 3, sc = (tid & 7) ^ (srow & 7);
  const u16* ga = A + (size_t)srow * lda + sc * 8;
  const u16* gb = Bt + (size_t)srow * ldb + sc * 8;
  u16* lw = lds + tid * 8;
#pragma unroll
  for (int i = 0; i < 4; ++i) {
    __builtin_amdgcn_global_load_lds((const unsigned*)(ga + (size_t)(32 * i) * lda), (unsigned*)(lw + i * 2048), 16, 0, 0);
    __builtin_amdgcn_global_load_lds((const unsigned*)(gb + (size_t)(32 * i) * ldb), (unsigned*)(lw + 8192 + i * 2048), 16, 0, 0);
  }
  __syncthreads();
  const int swz = lr & 7;
  for (int kt = 0; kt < nk; ++kt) {
    if (kt + 1 < nk) {
      u16* lw2 = lw + ((kt + 1) & 1) * 16384;
#pragma unroll
      for (int i = 0; i < 4; ++i) {
        __builtin_amdgcn_global_load_lds((const unsigned*)(ga + (size_t)(32 * i) * lda + (kt + 1) * 64), (unsigned*)(lw2 + i * 2048), 16, 0, 0);
        __builtin_amdgcn_global_load_lds((const unsigned*)(gb + (size_t)(32 * i) * ldb + (kt + 1) * 64), (unsigned*)(lw2 + 8192 + i * 2048), 16, 0, 0);
      }
    }
    const u16* sa = lds + (kt & 1) * 16384;
    const u16* sb = sa + 8192;
#pragma unroll
    for (int ks = 0; ks < 2; ++ks) {
      bf16x8 af[4], bfr[4];
      const int co = ((ks * 4 + lq) ^ swz) * 8;
#pragma unroll
      for (int mi = 0; mi < 4; ++mi) af[mi] = *(const bf16x8*)(sa + (wm * 64 + mi * 16 + lr) * 64 + co);
#pragma unroll
      for (int ni = 0; ni < 4; ++ni) bfr[ni] = *(const bf16x8*)(sb + (wn * 64 + ni * 16 + lr) * 64 + co);
#pragma unroll
      for (int mi = 0; mi < 4; ++mi)
#pragma unroll
        for (int ni = 0; ni < 4; ++ni)
          acc[mi][ni] = __builtin_amdgcn_mfma_f32_16x16x32_bf16(bfr[ni], af[mi], acc[mi][ni], 0, 0, 0);
    }
    __syncthreads();
  }
}

#define ZERO_ACC(acc)                                   \
  _Pragma("unroll") for (int _a = 0; _a < 4; ++_a)      \
  _Pragma("unroll") for (int _b = 0; _b < 4; ++_b) acc[_a][_b] = f32x4{0.f, 0.f, 0.f, 0.f};

__device__ __forceinline__ void gemm_kloop2(f32x4 (&acc)[4][8], const u16* __restrict__ A, int lda,
                                            const u16* __restrict__ Bt, int ldb, int K, u16* lds) {
  const int tid = tidx(), lane = tid & 63, wid = tid >> 6;
  const int lr = lane & 15, lq = lane >> 4;
  const int nk = K >> 5;
  const int srow = tid >> 2;
  const int sc = (tid & 3) ^ ((0x78 >> (2 * ((tid >> 4) & 3))) & 3);
  const u16* ga = A + (size_t)srow * lda + sc * 8;
  const u16* gb = Bt + (size_t)srow * ldb + sc * 8;
  u16* lw = lds + tid * 8;
#pragma unroll
  for (int i = 0; i < 4; ++i)
    __builtin_amdgcn_global_load_lds((const unsigned*)(ga + (size_t)(64 * i) * lda), (unsigned*)(lw + i * 2048), 16, 0, 0);
#pragma unroll
  for (int i = 0; i < 2; ++i)
    __builtin_amdgcn_global_load_lds((const unsigned*)(gb + (size_t)(64 * i) * ldb), (unsigned*)(lw + 8192 + i * 2048), 16, 0, 0);
  __syncthreads();
  const int co = (lq ^ ((0x78 >> (2 * ((lr >> 2) & 3))) & 3)) * 8;
  for (int kt = 0; kt < nk; ++kt) {
    if (kt + 1 < nk) {
      u16* lw2 = lw + ((kt + 1) & 1) * 12288;
#pragma unroll
      for (int i = 0; i < 4; ++i)
        __builtin_amdgcn_global_load_lds((const unsigned*)(ga + (size_t)(64 * i) * lda + (kt + 1) * 32), (unsigned*)(lw2 + i * 2048), 16, 0, 0);
#pragma unroll
      for (int i = 0; i < 2; ++i)
        __builtin_amdgcn_global_load_lds((const unsigned*)(gb + (size_t)(64 * i) * ldb + (kt + 1) * 32), (unsigned*)(lw2 + 8192 + i * 2048), 16, 0, 0);
    }
    const u16* sa = lds + (kt & 1) * 12288;
    const u16* sb = sa + 8192;
    bf16x8 af[4];
#pragma unroll
    for (int mi = 0; mi < 4; ++mi) af[mi] = *(const bf16x8*)(sa + (wid * 64 + mi * 16 + lr) * 32 + co);
#pragma unroll
    for (int nh = 0; nh < 2; ++nh) {
      bf16x8 bfr[4];
#pragma unroll
      for (int ni = 0; ni < 4; ++ni) bfr[ni] = *(const bf16x8*)(sb + ((nh * 4 + ni) * 16 + lr) * 32 + co);
#pragma unroll
      for (int mi = 0; mi < 4; ++mi)
#pragma unroll
        for (int ni = 0; ni < 4; ++ni)
          acc[mi][nh * 4 + ni] = __builtin_amdgcn_mfma_f32_16x16x32_bf16(bfr[ni], af[mi], acc[mi][nh * 4 + ni], 0, 0, 0);
    }
    __syncthreads();
  }
}

__device__ __forceinline__ void gemm_kloop3(f32x4 (&acc)[4][8], const u16* __restrict__ A, int lda,
                                            const u16* __restrict__ Bt, int ldb, int K, u16* lds) {
  const int tid = rtid(), lane = tid & 63, wid = tid >> 6, wm = wid >> 1, wn = wid & 1;
  const int lr = lane & 15, lq = lane >> 4;
  const int nk = K >> 6;
  const int srow = tid >> 3, sc = (tid & 7) ^ (srow & 7);
  const u16* ga = A + (size_t)srow * lda + sc * 8;
  const u16* gb = Bt + (size_t)srow * ldb + sc * 8;
  u16* lw = lds + tid * 8;
#pragma unroll
  for (int i = 0; i < 4; ++i) {
    __builtin_amdgcn_global_load_lds((const unsigned*)(ga + (size_t)(64 * i) * lda), (unsigned*)(lw + i * 4096), 16, 0, 0);
    __builtin_amdgcn_global_load_lds((const unsigned*)(gb + (size_t)(64 * i) * ldb), (unsigned*)(lw + 16384 + i * 4096), 16, 0, 0);
  }
  __syncthreads();
  const int swz = lr & 7;
  for (int kt = 0; kt < nk; ++kt) {
    const int ko = min(kt + 1, nk - 1) * 64;
    u16* lw2 = lw + ((kt + 1) & 1) * 32768;
    const u16* sa = lds + (kt & 1) * 32768;
    const u16* sb = sa + 16384;
#pragma unroll
    for (int ks = 0; ks < 2; ++ks) {
      const int co = ((ks * 4 + lq) ^ swz) * 8;
      bf16x8 af[4];
#pragma unroll
      for (int mi = 0; mi < 4; ++mi) af[mi] = *(const bf16x8*)(sa + (wm * 64 + mi * 16 + lr) * 64 + co);
#pragma unroll
      for (int nh = 0; nh < 2; ++nh) {
        bf16x8 bfr[4];
#pragma unroll
        for (int ni = 0; ni < 4; ++ni) bfr[ni] = *(const bf16x8*)(sb + (wn * 128 + (nh * 4 + ni) * 16 + lr) * 64 + co);
        if (ks == 0) __builtin_amdgcn_sched_barrier(0);
#pragma unroll
        for (int mi = 0; mi < 4; ++mi) {
#pragma unroll
          for (int ni = 0; ni < 4; ++ni)
            acc[mi][nh * 4 + ni] = __builtin_amdgcn_mfma_f32_16x16x32_bf16(bfr[ni], af[mi], acc[mi][nh * 4 + ni], 0, 0, 0);
          if (ks == 0) {
            if (nh == 0)
              __builtin_amdgcn_global_load_lds((const unsigned*)(ga + (size_t)(64 * mi) * lda + ko), (unsigned*)(lw2 + mi * 4096), 16, 0, 0);
            else
              __builtin_amdgcn_global_load_lds((const unsigned*)(gb + (size_t)(64 * mi) * ldb + ko), (unsigned*)(lw2 + 16384 + mi * 4096), 16, 0, 0);
            __builtin_amdgcn_sched_barrier(0);
          }
        }
      }
    }
    __syncthreads();
  }
}

#define EPI_COORDS3                                                             \
  const int lane = rtid() & 63, wid = rtid() >> 6, wm = wid >> 1, wn = wid & 1; \
  const int lr = lane & 15, lq = lane >> 4;

#define ZERO_ACC8(acc)                                  \
  _Pragma("unroll") for (int _a = 0; _a < 4; ++_a)      \
  _Pragma("unroll") for (int _b = 0; _b < 8; ++_b) acc[_a][_b] = f32x4{0.f, 0.f, 0.f, 0.f};

#define FOR_TILES_XCD(t, ntiles) \
  for (int _k = 0, t = (bid & 7) * (nb >> 3) + (bid >> 3); t < (ntiles); ++_k, t = ((_k * 8 + (bid & 7)) * (nb >> 3)) + (bid >> 3))

#define EPI_COORDS                                                             \
  const int lane = tidx() & 63, wid = tidx() >> 6, wm = wid >> 1, wn = wid & 1; \
  const int lr = lane & 15, lq = lane >> 4;

__device__ void tconv_tile(const float* __restrict__ W, int K, int N, u16* __restrict__ Wt, int tile, float* lds) {
  const int tid = tidx();
  const int ntn = N >> 6;
  const int kt = tile / ntn, nt = tile % ntn;
  const int c4 = (tid & 15) * 4;
#pragma unroll
  for (int i = 0; i < 4; ++i) {
    int r = (tid >> 4) + 16 * i;
    float4 v = *(const float4*)(W + (size_t)(kt * 64 + r) * N + nt * 64 + c4);
    lds[r * 65 + c4 + 0] = v.x; lds[r * 65 + c4 + 1] = v.y; lds[r * 65 + c4 + 2] = v.z; lds[r * 65 + c4 + 3] = v.w;
  }
  __syncthreads();
  const int n = tid >> 2, kseg = (tid & 3) * 16;
  unsigned o[8];
#pragma unroll
  for (int j = 0; j < 8; ++j) o[j] = pack2(lds[(kseg + 2 * j) * 65 + n], lds[(kseg + 2 * j + 1) * 65 + n]);
  u16* dst = Wt + (size_t)(nt * 64 + n) * K + kt * 64 + kseg;
  *(uint4*)dst = uint4{o[0], o[1], o[2], o[3]};
  *(uint4*)(dst + 8) = uint4{o[4], o[5], o[6], o[7]};
  __syncthreads();
}

__device__ void conv_linear(const float* __restrict__ src, u16* __restrict__ dst, size_t n8, size_t gtid, size_t nth) {
  for (size_t i = gtid; i < n8; i += nth) {
    float4 a = *(const float4*)(src + i * 8), b = *(const float4*)(src + i * 8 + 4);
    *(uint4*)(dst + i * 8) = uint4{pack2(a.x, a.y), pack2(a.z, a.w), pack2(b.x, b.y), pack2(b.z, b.w)};
  }
}

typedef float f32x2 __attribute__((ext_vector_type(2)));
constexpr size_t O_U8 = O_UB, O_V8 = O_UB + 32 * MB, O_RSU = O_VB, O_RSV = O_VB + 64 * 1024;
__device__ void conv_fp8_rows(const float* __restrict__ src, unsigned char* __restrict__ dst, float* __restrict__ rscale,
                              int gw, int nw) {
  const int lane = tidx() & 63;
  for (int row = gw; row < 16384; row += nw) {
    const float* r = src + (size_t)row * D_;
    float4 v[8];
#pragma unroll
    for (int q = 0; q < 8; ++q) v[q] = *(const float4*)(r + q * 256 + lane * 4);
    float am = 0.f;
#pragma unroll
    for (int q = 0; q < 8; ++q) am = fmaxf(am, fmaxf(fmaxf(fabsf(v[q].x), fabsf(v[q].y)), fmaxf(fabsf(v[q].z), fabsf(v[q].w))));
#pragma unroll
    for (int o = 32; o >= 1; o >>= 1) am = fmaxf(am, __shfl_xor(am, o));
    const float sc = am > 0.f ? 416.f / am : 1.f;
#pragma unroll
    for (int q = 0; q < 8; ++q) {
      int w = 0;
      w = __builtin_amdgcn_cvt_pk_fp8_f32(v[q].x * sc, v[q].y * sc, w, false);
      w = __builtin_amdgcn_cvt_pk_fp8_f32(v[q].z * sc, v[q].w * sc, w, true);
      *(int*)(dst + (size_t)row * D_ + q * 256 + lane * 4) = w;
    }
    if (lane == 0) rscale[row] = am > 0.f ? am / 416.f : 1.f;
  }
}

__device__ void ln_rows(const float* __restrict__ src, const float* __restrict__ g, const float* __restrict__ b,
                        u16* __restrict__ dst, int gw, int nw) {
  const int lane = tidx() & 63;
  for (int row = gw; row < T_; row += nw) {
    const float* r = src + (size_t)row * D_;
    float4 v[8];
#pragma unroll
    for (int q = 0; q < 8; ++q) v[q] = *(const float4*)(r + q * 256 + lane * 4);
    float s = 0.f;
#pragma unroll
    for (int q = 0; q < 8; ++q) s += v[q].x + v[q].y + v[q].z + v[q].w;
    float mu = wave_sum(s) * (1.f / D_);
    float ss = 0.f;
#pragma unroll
    for (int q = 0; q < 8; ++q) {
      float a = v[q].x - mu, bb = v[q].y - mu, c = v[q].z - mu, d = v[q].w - mu;
      ss += a * a + bb * bb + c * c + d * d;
    }
    float rstd = rsqrtf(wave_sum(ss) * (1.f / D_) + 1e-5f);
#pragma unroll
    for (int q = 0; q < 8; ++q) {
      int col = q * 256 + lane * 4;
      float4 gg = *(const float4*)(g + col), bb = *(const float4*)(b + col);
      store_bf4(dst + (size_t)row * D_ + col, (v[q].x - mu) * rstd * gg.x + bb.x, (v[q].y - mu) * rstd * gg.y + bb.y,
                (v[q].z - mu) * rstd * gg.z + bb.z, (v[q].w - mu) * rstd * gg.w + bb.w);
    }
  }
}

__device__ __forceinline__ void dsincos(double x, double& s, double& c) {
  double q = rint(x * 0.63661977236758134308);
  double r = x - q * 1.57079632679489661923;
  double r2 = r * r;
  double sp = r * (1.0 + r2 * (-1.0 / 6 + r2 * (1.0 / 120 + r2 * (-1.0 / 5040 + r2 * (1.0 / 362880 + r2 * (-1.0 / 39916800 + r2 * (1.0 / 6227020800.0)))))));
  double cp = 1.0 + r2 * (-0.5 + r2 * (1.0 / 24 + r2 * (-1.0 / 720 + r2 * (1.0 / 40320 + r2 * (-1.0 / 3628800 + r2 * (1.0 / 479001600.0 + r2 * (-1.0 / 87178291200.0)))))));
  int qi = ((int)q) & 3;
  if (qi == 0) { s = sp; c = cp; }
  else if (qi == 1) { s = cp; c = -sp; }
  else if (qi == 2) { s = -sp; c = -cp; }
  else { s = -cp; c = sp; }
}

__device__ void ssm_consts(const Params& P, int i) {
  const int g = i >> 6, p = i & 63;
  double lr = P.lam_re[g * 64 + p], li = P.lam_im[g * 64 + p];
  double dt = exp((double)P.log_dt[g]);
  double mag = exp(lr * dt);
  double sn, cs;
  dsincos(li * dt, sn, cs);
  double ar = mag * cs, ai = mag * sn;
  double nr = ar - 1.0, ni = ai, den = lr * lr + li * li;
  double fr = (nr * lr + ni * li) / den, fi = (ni * lr - nr * li) / den;
  u16* bcat = (u16*)(P.ws + O_BCAT);
  u16* ccat = (u16*)(P.ws + O_CCAT);
  float* lam = (float*)(P.ws + O_LAM);
  for (int h = 0; h < 16; ++h) {
    double br = P.b_re[(g * 64 + p) * 16 + h], bi = P.b_im[(g * 64 + p) * 16 + h];
    bcat[(g * 128 + p) * 32 + h] = f2bf((float)(fr * br - fi * bi));
    bcat[(g * 128 + 64 + p) * 32 + h] = f2bf((float)(fr * bi + fi * br));
    bcat[(g * 128 + p) * 32 + 16 + h] = 0;
    bcat[(g * 128 + 64 + p) * 32 + 16 + h] = 0;
    ccat[(g * 16 + h) * 128 + p] = f2bf(P.c_re[(g * 16 + h) * 64 + p]);
    ccat[(g * 16 + h) * 128 + 64 + p] = f2bf(-P.c_im[(g * 16 + h) * 64 + p]);
  }
  double pr = ar, pi = ai;
  for (int k = 0; k < 10; ++k) {
    double t = pr * pr - pi * pi;
    pi = 2.0 * pr * pi;
    pr = t;
  }
  lam[0 * 4096 + i] = (float)ar;
  lam[1 * 4096 + i] = (float)ai;
  lam[2 * 4096 + i] = (float)pr;
  lam[3 * 4096 + i] = (float)pi;
}

__device__ void phase0(const Params& P, int bid, int nb, u16* lds) {
  const size_t gtid = (size_t)bid * 256 + tidx(), nth = (size_t)nb * 256;
#define TCONV(wp, KK, NN, OFF) \
  for (int t = bid; t < ((KK) >> 6) * ((NN) >> 6); t += nb) tconv_tile(wp, KK, NN, (u16*)(P.ws + OFF), t, (float*)lds);
  TCONV(P.w_in, 2048, 8192, O_WIN)
  TCONV(P.w_glu, 1024, 1024, O_WGLU)
  TCONV(P.w_au, 1024, 2048, O_WAU)
  TCONV(P.w_su, 1024, 2048, O_WSU)
  TCONV(P.w_out, 2048, 2048, O_WOUT)
  TCONV(P.w_pq, 2048, 2048, O_WPQ)
  TCONV(P.ple_w_gate, 2048, 2048, O_WPG)
  TCONV(P.ple_w_in, 256, 2048, O_WPIN)
  conv_fp8_rows(P.peer_u, (unsigned char*)(P.ws + O_U8), (float*)(P.ws + O_RSU), bid * 4 + (tidx() >> 6), nb * 4);
  conv_fp8_rows(P.peer_v, (unsigned char*)(P.ws + O_V8), (float*)(P.ws + O_RSV), bid * 4 + (tidx() >> 6), nb * 4);
  conv_linear(P.sub_keys, (u16*)(P.ws + O_SK), (size_t)16 * 128 * 128 / 8, gtid, nth);
  conv_linear(P.p, (u16*)(P.ws + O_PB), (size_t)T_ * 256 / 8, gtid, nth);
  for (size_t i = gtid; i < 4096; i += nth) ssm_consts(P, (int)i);
  ln_rows(P.x, P.ln_in_g, P.ln_in_b, (u16*)(P.ws + O_H), bid * 4 + (tidx() >> 6), nb * 4);
}

__device__ void phase1(const Params& P, int bid, int nb, u16* lds) {
  const u16* H = (const u16*)(P.ws + O_H);
  const u16* W = (const u16*)(P.ws + O_WIN);
  u16* Q = (u16*)(P.ws + O_Q);
  u16* Kb = (u16*)(P.ws + O_K);
  u16* Vt = (u16*)(P.ws + O_VT);
  u16* U2 = (u16*)(P.ws + O_U2);
  u16* G = (u16*)(P.ws + O_G);
  EPI_COORDS3
  const int ntiles = 128 * 32;
  for (int t = bid; t < ntiles; t += nb) {
    const int mt = t >> 5, nt = t & 31;
    f32x4 acc[4][8];
    ZERO_ACC8(acc)
    gemm_kloop3(acc, H + (size_t)mt * 256 * D_, D_, W + (size_t)nt * 256 * D_, D_, D_, lds);
    const int region = (nt * 256 + wn * 128) >> 10;
#pragma unroll
    for (int mi = 0; mi < 4; ++mi) {
      const int m = mt * 256 + wm * 64 + mi * 16 + lr;
#pragma unroll
      for (int ni = 0; ni < 8; ++ni) {
        const int n = nt * 256 + wn * 128 + ni * 16 + lq * 4;
        f32x4 a = acc[mi][ni];
        if (region == 0) {
          const float sc = 0.08838834764831845f;
          store_bf4(Q + (size_t)m * 1024 + n, a[0] * sc, a[1] * sc, a[2] * sc, a[3] * sc);
        } else if (region == 1) {
          store_bf4(Kb + (size_t)m * 1024 + (n - 1024), a[0], a[1], a[2], a[3]);
        } else if (region == 2) {
          const int b = m >> 14, tt = m & (S_ - 1);
#pragma unroll
          for (int j = 0; j < 4; ++j) Vt[((size_t)(b * 1024 + (n - 2048 + j))) * S_ + tt] = f2bf(a[j]);
        } else if (region == 3) {
          store_bf4(U2 + (size_t)m * 1024 + (n - 3072), a[0], a[1], a[2], a[3]);
        } else {
          store_bf4(G + (size_t)m * 4096 + (n - 4096), sigmoidf_(a[0]), sigmoidf_(a[1]), sigmoidf_(a[2]), sigmoidf_(a[3]));
        }
      }
    }
  }
}

__device__ void attn_item(const Params& P, int item, u16* lds) {
  const int c = item >> 4, hd = item & 7, b = (item >> 3) & 1;
  const int tid = tidx(), lane = tid & 63, w = tid >> 6, lr = lane & 15, lq = lane >> 4;
  u16* Ks = lds;
  u16* Vs = lds + 64 * 136;
  float* bs = (float*)(lds + 64 * 136 + 128 * 72);
  const u16* Q = (const u16*)(P.ws + O_Q);
  const u16* Kb = (const u16*)(P.ws + O_K);
  const u16* Vt = (const u16*)(P.ws + O_VT);
  u16* ya = (u16*)(P.ws + O_YA);
  __syncthreads();
  for (int i = tid; i < 257; i += 256) bs[i] = P.rel_bias[hd * 257 + i];
  bf16x8 qf[4];
  {
    const u16* qp = Q + (size_t)(b * S_ + c * 64 + w * 16 + lr) * 1024 + hd * 128 + lq * 8;
#pragma unroll
    for (int ks = 0; ks < 4; ++ks) qf[ks] = *(const bf16x8*)(qp + ks * 32);
  }
  f32x4 oacc[8];
#pragma unroll
  for (int d = 0; d < 8; ++d) oacc[d] = f32x4{0.f, 0.f, 0.f, 0.f};
  float m_run = -1e30f, lsum = 0.f;
  const int i0 = (c < 8) ? (8 - c) : 0;
  const int qi = w * 16 + lr;
#define KV_ADDR_K(r, kc_) (Kb + (size_t)(b * S_ + (kc_) * 64 + ((tid + 256 * (r)) >> 4)) * 1024 + hd * 128 + ((tid + 256 * (r)) & 15) * 8)
#define KV_ADDR_V(r, kc_) (Vt + ((size_t)(b * 1024 + hd * 128 + ((tid + 256 * (r)) >> 3))) * S_ + (kc_) * 64 + ((tid + 256 * (r)) & 7) * 8)
#define KV_LOAD(kc_)                                                                   \
  kr0 = *(const uint4*)KV_ADDR_K(0, kc_); kr1 = *(const uint4*)KV_ADDR_K(1, kc_);     \
  kr2 = *(const uint4*)KV_ADDR_K(2, kc_); kr3 = *(const uint4*)KV_ADDR_K(3, kc_);     \
  vr0 = *(const uint4*)KV_ADDR_V(0, kc_); vr1 = *(const uint4*)KV_ADDR_V(1, kc_);     \
  vr2 = *(const uint4*)KV_ADDR_V(2, kc_); vr3 = *(const uint4*)KV_ADDR_V(3, kc_);
#define KS_W(r) (Ks + ((tid + 256 * (r)) >> 4) * 136 + ((tid + 256 * (r)) & 15) * 8)
#define VS_W(r) (Vs + ((tid + 256 * (r)) >> 3) * 72 + ((tid + 256 * (r)) & 7) * 8)
#define KV_LOADS(S, kc_)                                                                \
  S##k0 = *(const uint4*)KV_ADDR_K(0, kc_); S##k1 = *(const uint4*)KV_ADDR_K(1, kc_);   \
  S##k2 = *(const uint4*)KV_ADDR_K(2, kc_); S##k3 = *(const uint4*)KV_ADDR_K(3, kc_);   \
  S##v0 = *(const uint4*)KV_ADDR_V(0, kc_); S##v1 = *(const uint4*)KV_ADDR_V(1, kc_);   \
  S##v2 = *(const uint4*)KV_ADDR_V(2, kc_); S##v3 = *(const uint4*)KV_ADDR_V(3, kc_);
#define KV_WRITES(S)                                                                                   \
  *(uint4*)KS_W(0) = S##k0; *(uint4*)KS_W(1) = S##k1; *(uint4*)KS_W(2) = S##k2; *(uint4*)KS_W(3) = S##k3; \
  *(uint4*)VS_W(0) = S##v0; *(uint4*)VS_W(1) = S##v1; *(uint4*)VS_W(2) = S##v2; *(uint4*)VS_W(3) = S##v3;
  uint4 Ak0, Ak1, Ak2, Ak3, Av0, Av1, Av2, Av3, Bk0, Bk1, Bk2, Bk3, Bv0, Bv1, Bv2, Bv3;
  auto tile_compute = [&](const int i) {
    f32x4 sacc[4];
#pragma unroll
    for (int kt = 0; kt < 4; ++kt) {
      sacc[kt] = f32x4{0.f, 0.f, 0.f, 0.f};
#pragma unroll
      for (int ks = 0; ks < 4; ++ks) {
        bf16x8 kf = *(const bf16x8*)(Ks + (kt * 16 + lr) * 136 + ks * 32 + lq * 8);
        sacc[kt] = __builtin_amdgcn_mfma_f32_16x16x32_bf16(kf, qf[ks], sacc[kt], 0, 0, 0);
      }
    }
    float tmax = -1e30f;
#pragma unroll
    for (int kt = 0; kt < 4; ++kt)
#pragma unroll
      for (int j = 0; j < 4; ++j) {
        int kb = i * 64 + kt * 16 + lq * 4 + j;
        int rel = 512 + qi - kb;
        rel = min(max(rel, -128), 128) + 128;
        float s = sacc[kt][j] + bs[rel];
        sacc[kt][j] = s;
        tmax = fmaxf(tmax, s);
      }
    tmax = fmaxf(tmax, __shfl_xor(tmax, 16));
    tmax = fmaxf(tmax, __shfl_xor(tmax, 32));
    const float m_new = fmaxf(m_run, tmax);
    const float corr = __expf(m_run - m_new);
    m_run = m_new;
    float ps = 0.f;
#pragma unroll
    for (int kt = 0; kt < 4; ++kt)
#pragma unroll
      for (int j = 0; j < 4; ++j) {
        float pv = __expf(sacc[kt][j] - m_new);
        sacc[kt][j] = pv;
        ps += pv;
      }
    lsum = lsum * corr + ps;
#pragma unroll
    for (int d = 0; d < 8; ++d) {
      oacc[d][0] *= corr; oacc[d][1] *= corr; oacc[d][2] *= corr; oacc[d][3] *= corr;
    }
#pragma unroll
    for (int kk = 0; kk < 2; ++kk) {
      union { bf16x8 v; unsigned u[4]; } pf;
      pf.u[0] = pack2(sacc[2 * kk][0], sacc[2 * kk][1]);
      pf.u[1] = pack2(sacc[2 * kk][2], sacc[2 * kk][3]);
      pf.u[2] = pack2(sacc[2 * kk + 1][0], sacc[2 * kk + 1][1]);
      pf.u[3] = pack2(sacc[2 * kk + 1][2], sacc[2 * kk + 1][3]);
#pragma unroll
      for (int d = 0; d < 8; ++d) {
        union { bf16x8 v; uint2 h[2]; } vf;
        vf.h[0] = *(const uint2*)(Vs + (d * 16 + lr) * 72 + kk * 32 + lq * 4);
        vf.h[1] = *(const uint2*)(Vs + (d * 16 + lr) * 72 + kk * 32 + 16 + lq * 4);
        oacc[d] = __builtin_amdgcn_mfma_f32_16x16x32_bf16(vf.v, pf.v, oacc[d], 0, 0, 0);
      }
    }
  };
  KV_LOADS(A, c - 8 + i0)
  if (i0 + 1 <= 8) { KV_LOADS(B, c - 8 + i0 + 1) }
  for (int i = i0; i <= 8; i += 2) {
    __syncthreads();
    KV_WRITES(A)
    __syncthreads();
    if (i + 2 <= 8) { KV_LOADS(A, c - 8 + i + 2) }
    tile_compute(i);
    if (i + 1 > 8) break;
    __syncthreads();
    KV_WRITES(B)
    __syncthreads();
    if (i + 3 <= 8) { KV_LOADS(B, c - 8 + i + 3) }
    tile_compute(i + 1);
  }
  lsum += __shfl_xor(lsum, 16);
  lsum += __shfl_xor(lsum, 32);
  const float inv = 1.f / lsum;
  u16* op = ya + (size_t)(b * S_ + c * 64 + w * 16 + lr) * 1024 + hd * 128 + lq * 4;
#pragma unroll
  for (int d = 0; d < 8; ++d) store_bf4(op + d * 16, oacc[d][0] * inv, oacc[d][1] * inv, oacc[d][2] * inv, oacc[d][3] * inv);
}

template <int PASS>
__device__ void ssm_item(const Params& P, int item, char* ldsw) {
  const int sc = item & 15, seq = item >> 4, g = seq & 63, b = seq >> 6;
  const int lane = tidx() & 63, lr = lane & 15, lq = lane >> 4;
  float* BuS = (float*)ldsw;
  u16* Hs = (u16*)(ldsw + 8448);
  const u16* bcat = (const u16*)(P.ws + O_BCAT);
  const u16* ccat = (const u16*)(P.ws + O_CCAT);
  const float* lam = (const float*)(P.ws + O_LAM);
  const u16* U2 = (const u16*)(P.ws + O_U2);
  float* Sbuf = (float*)(P.ws + O_SBUF);
  u16* ys = (u16*)(P.ws + O_YS);
  const float ar = lam[g * 64 + lane], ai = lam[4096 + g * 64 + lane];
  bf16x8 bfrag[8];
#pragma unroll
  for (int nt = 0; nt < 8; ++nt) bfrag[nt] = *(const bf16x8*)(bcat + (g * 128 + nt * 16 + lr) * 32 + lq * 8);
  float sr = 0.f, si = 0.f;
  bf16x8 cfrag[4];
  float dsk[4];
  if (PASS == 2) {
#pragma unroll
    for (int ks = 0; ks < 4; ++ks) cfrag[ks] = *(const bf16x8*)(ccat + (g * 16 + lr) * 128 + ks * 32 + lq * 8);
#pragma unroll
    for (int j = 0; j < 4; ++j) dsk[j] = P.ssm_d[g * 16 + lq * 4 + j];
    const float aLr = lam[2 * 4096 + g * 64 + lane], aLi = lam[3 * 4096 + g * 64 + lane];
    const float* Sb = Sbuf + (size_t)seq * 16 * 128;
#pragma unroll 4
    for (int cc = 0; cc < sc; ++cc) {
      float xr = Sb[cc * 128 + lane], xi = Sb[cc * 128 + 64 + lane];
      float nr = fmaf(aLr, sr, fmaf(-aLi, si, xr));
      float ni = fmaf(aLr, si, fmaf(aLi, sr, xi));
      sr = nr; si = ni;
    }
  }
#pragma unroll 1
  for (int ci = 0; ci < 8; ++ci) {
  const size_t tok_base = (size_t)b * S_ + (size_t)(sc * 8 + ci) * SSM_L;
  uint4 upre[SSM_L / 16];
  uint2 uepi[SSM_L / 16];
#pragma unroll
  for (int sub = 0; sub < SSM_L / 16; ++sub) {
    upre[sub] = uint4{0u, 0u, 0u, 0u};
    if (lq < 2) upre[sub] = *(const uint4*)(U2 + (tok_base + sub * 16 + lr) * 1024 + g * 16 + lq * 8);
    if (PASS == 2) uepi[sub] = *(const uint2*)(U2 + (tok_base + sub * 16 + lr) * 1024 + g * 16 + lq * 4);
  }
#pragma unroll
  for (int sub = 0; sub < SSM_L / 16; ++sub) {
    const size_t tok0 = tok_base + sub * 16;
    union { bf16x8 v; uint4 u; } uf;
    uf.u = upre[sub];
#pragma unroll
    for (int nt = 0; nt < 8; ++nt) {
      f32x4 d = __builtin_amdgcn_mfma_f32_16x16x32_bf16(bfrag[nt], uf.v, f32x4{0.f, 0.f, 0.f, 0.f}, 0, 0, 0);
      *(f32x4*)(BuS + lr * 132 + nt * 16 + lq * 4) = d;
    }
    asm volatile("s_waitcnt lgkmcnt(0)" ::: "memory");
    float bur[16], bui[16];
#pragma unroll
    for (int t = 0; t < 16; ++t) { bur[t] = BuS[t * 132 + lane]; bui[t] = BuS[t * 132 + 64 + lane]; }
    asm volatile("s_waitcnt lgkmcnt(0)" ::: "memory");
#pragma unroll
    for (int t = 0; t < 16; ++t) {
      float nr = fmaf(ar, sr, fmaf(-ai, si, bur[t]));
      float ni = fmaf(ar, si, fmaf(ai, sr, bui[t]));
      sr = nr; si = ni;
      if (PASS == 2) {
        const unsigned pk = pack2(sr, si);
        Hs[t * 136 + lane] = (u16)(pk & 0xffffu);
        Hs[t * 136 + 64 + lane] = (u16)(pk >> 16);
      }
    }
    asm volatile("s_waitcnt lgkmcnt(0)" ::: "memory");
    if (PASS == 2) {
      f32x4 yacc = f32x4{0.f, 0.f, 0.f, 0.f};
#pragma unroll
      for (int ks = 0; ks < 4; ++ks) {
        bf16x8 hf = *(const bf16x8*)(Hs + lr * 136 + ks * 32 + lq * 8);
        yacc = __builtin_amdgcn_mfma_f32_16x16x32_bf16(cfrag[ks], hf, yacc, 0, 0, 0);
      }
      const uint2 uu = uepi[sub];
      float y0 = gelu_tanh(yacc[0] + dsk[0] * lo2f(uu.x));
      float y1 = gelu_tanh(yacc[1] + dsk[1] * hi2f(uu.x));
      float y2 = gelu_tanh(yacc[2] + dsk[2] * lo2f(uu.y));
      float y3 = gelu_tanh(yacc[3] + dsk[3] * hi2f(uu.y));
      store_bf4(ys + (tok0 + lr) * 1024 + g * 16 + lq * 4, y0, y1, y2, y3);
      asm volatile("s_waitcnt lgkmcnt(0)" ::: "memory");
    }
  }
  }
  if (PASS == 1) {
    Sbuf[((size_t)seq * 16 + sc) * 128 + lane] = sr;
    Sbuf[((size_t)seq * 16 + sc) * 128 + 64 + lane] = si;
  }
}

__device__ void phase2(const Params& P, int bid, int nb, u16* lds) {
  for (int it = bid; it < 4096 + 512; it += nb) {
    if (it < 4096) {
      attn_item(P, it, lds);
    } else {
      __syncthreads();
      const int w = tidx() >> 6;
      ssm_item<1>(P, (it - 4096) * 4 + w, (char*)lds + w * 12800);
    }
  }
}
__device__ void phase3(const Params& P, int bid, int nb, u16* lds) {
  const int w = tidx() >> 6;
  for (int it = bid; it < 512; it += nb) ssm_item<2>(P, it * 4 + w, (char*)lds + w * 12800);
}

__device__ void phase4(const Params& P, int bid, int nb, u16* lds) {
  const u16* ys = (const u16*)(P.ws + O_YS);
  const u16* W = (const u16*)(P.ws + O_WGLU);
  u16* yg = (u16*)(P.ws + O_YG);
  EPI_COORDS3
  FOR_TILES_XCD(t, 128 * 4) {
    const int mt = t >> 2, nt = t & 3;
    f32x4 acc[4][8];
    ZERO_ACC8(acc)
    gemm_kloop3(acc, ys + (size_t)mt * 256 * 1024, 1024, W + (size_t)nt * 256 * 1024, 1024, 1024, lds);
#pragma unroll
    for (int mi = 0; mi < 4; ++mi) {
      const int m = mt * 256 + wm * 64 + mi * 16 + lr;
#pragma unroll
      for (int ni = 0; ni < 8; ++ni) {
        const int n = nt * 256 + wn * 128 + ni * 16 + lq * 4;
        uint2 yy = *(const uint2*)(ys + (size_t)m * 1024 + n);
        f32x4 a = acc[mi][ni];
        store_bf4(yg + (size_t)m * 1024 + n, lo2f(yy.x) * sigmoidf_(a[0]), hi2f(yy.x) * sigmoidf_(a[1]),
                  lo2f(yy.y) * sigmoidf_(a[2]), hi2f(yy.y) * sigmoidf_(a[3]));
      }
    }
  }
}

__device__ void phase5(const Params& P, int bid, int nb, u16* lds) {
  const u16* ya = (const u16*)(P.ws + O_YA);
  const u16* yg = (const u16*)(P.ws + O_YG);
  const u16* Wa = (const u16*)(P.ws + O_WAU);
  const u16* Wsu = (const u16*)(P.ws + O_WSU);
  const u16* G = (const u16*)(P.ws + O_G);
  u16* mg = (u16*)(P.ws + O_MERGED);
  EPI_COORDS3
  FOR_TILES_XCD(t, 128 * 8) {
    const int mt = t >> 3, nt = t & 7;
#pragma unroll 1
    for (int part = 0; part < 2; ++part) {
      f32x4 acc[4][8];
      ZERO_ACC8(acc)
      gemm_kloop3(acc, (part ? yg : ya) + (size_t)mt * 256 * 1024, 1024, (part ? Wsu : Wa) + (size_t)nt * 256 * 1024, 1024,
                  1024, lds);
      const u16* Gp = G + part * 2048;
#pragma unroll
      for (int mi = 0; mi < 4; ++mi) {
        const int m = mt * 256 + wm * 64 + mi * 16 + lr;
#pragma unroll
        for (int ni = 0; ni < 8; ++ni) {
          const int n = nt * 256 + wn * 128 + ni * 16 + lq * 4;
          const uint2 gg = *(const uint2*)(Gp + (size_t)m * 4096 + n);
          f32x4 a = acc[mi][ni];
          float o0 = a[0] * lo2f(gg.x), o1 = a[1] * hi2f(gg.x), o2 = a[2] * lo2f(gg.y), o3 = a[3] * hi2f(gg.y);
          if (part) {
            const uint2 pv = *(const uint2*)(mg + (size_t)m * D_ + n);
            o0 += lo2f(pv.x); o1 += hi2f(pv.x); o2 += lo2f(pv.y); o3 += hi2f(pv.y);
          }
          store_bf4(mg + (size_t)m * D_ + n, o0, o1, o2, o3);
        }
      }
    }
  }
}

__device__ void phase6(const Params& P, int bid, int nb, u16* lds) {
  const u16* mg = (const u16*)(P.ws + O_MERGED);
  const u16* W = (const u16*)(P.ws + O_WOUT);
  const u16* H = (const u16*)(P.ws + O_H);
  float* pre1 = (float*)(P.ws + O_PRE1);
  EPI_COORDS3
  FOR_TILES_XCD(t, 128 * 8) {
    const int mt = t >> 3, nt = t & 7;
    f32x4 acc[4][8];
    ZERO_ACC8(acc)
    gemm_kloop3(acc, mg + (size_t)mt * 256 * D_, D_, W + (size_t)nt * 256 * D_, D_, D_, lds);
#pragma unroll
    for (int mi = 0; mi < 4; ++mi) {
      const int m = mt * 256 + wm * 64 + mi * 16 + lr;
#pragma unroll
      for (int ni = 0; ni < 8; ++ni) {
        const int n = nt * 256 + wn * 128 + ni * 16 + lq * 4;
        uint2 hh = *(const uint2*)(H + (size_t)m * D_ + n);
        f32x4 a = acc[mi][ni];
        float4 o;
        o.x = ALPHA * lo2f(hh.x) + a[0]; o.y = ALPHA * hi2f(hh.x) + a[1];
        o.z = ALPHA * lo2f(hh.y) + a[2]; o.w = ALPHA * hi2f(hh.y) + a[3];
        *(float4*)(pre1 + (size_t)m * D_ + n) = o;
      }
    }
  }
}

__device__ void phase8(const Params& P, int bid, int nb, u16* lds) {
  const u16* H = (const u16*)(P.ws + O_H);
  const u16* Pb = (const u16*)(P.ws + O_PB);
  u16* PQ = (u16*)(P.ws + O_PQ);
  u16* SG = (u16*)(P.ws + O_SG);
  u16* E = (u16*)(P.ws + O_E);
  EPI_COORDS3
  FOR_TILES_XCD(t, 3 * 1024) {
    const int which = t >> 10, tt = t & 1023, mt = tt >> 3, nt = tt & 7;
    f32x4 acc[4][8];
    ZERO_ACC8(acc)
    u16* dst;
    if (which == 0) {
      gemm_kloop3(acc, H + (size_t)mt * 256 * D_, D_, (const u16*)(P.ws + O_WPQ) + (size_t)nt * 256 * D_, D_, D_, lds);
      dst = PQ;
    } else if (which == 1) {
      gemm_kloop3(acc, H + (size_t)mt * 256 * D_, D_, (const u16*)(P.ws + O_WPG) + (size_t)nt * 256 * D_, D_, D_, lds);
      dst = SG;
    } else {
      gemm_kloop3(acc, Pb + (size_t)mt * 256 * 256, 256, (const u16*)(P.ws + O_WPIN) + (size_t)nt * 256 * 256, 256, 256, lds);
      dst = E;
    }
#pragma unroll
    for (int mi = 0; mi < 4; ++mi) {
      const int m = mt * 256 + wm * 64 + mi * 16 + lr;
#pragma unroll
      for (int ni = 0; ni < 8; ++ni) {
        const int n = nt * 256 + wn * 128 + ni * 16 + lq * 4;
        f32x4 a = acc[mi][ni];
        if (which == 1) { a[0] = sigmoidf_(a[0]); a[1] = sigmoidf_(a[1]); a[2] = sigmoidf_(a[2]); a[3] = sigmoidf_(a[3]); }
        store_bf4(dst + (size_t)m * D_ + n, a[0], a[1], a[2], a[3]);
      }
    }
  }
}

struct Top16 { float v[16]; int i[16]; };
__device__ __forceinline__ void top_init(Top16& t) {
#pragma unroll
  for (int k = 0; k < 16; ++k) { t.v[k] = -INFINITY; t.i[k] = 0; }
}
__device__ __forceinline__ void top_insert(Top16& t, float x, int id) {
  const bool c = x > t.v[15];
  t.v[15] = c ? x : t.v[15];
  t.i[15] = c ? id : t.i[15];
#pragma unroll
  for (int k = 15; k >= 1; --k) {
    const bool s = t.v[k] > t.v[k - 1];
    const float a = t.v[k - 1], b = t.v[k];
    const int ia = t.i[k - 1], ib = t.i[k];
    t.v[k - 1] = s ? b : a; t.v[k] = s ? a : b;
    t.i[k - 1] = s ? ib : ia; t.i[k] = s ? ia : ib;
  }
}

__device__ void phase9(const Params& P, int bid, int nb, u16* lds) {
  const u16* PQ = (const u16*)(P.ws + O_PQ);
  const u16* SK = (const u16*)(P.ws + O_SK);
  float* HV = (float*)(P.ws + O_HV);
  int* HI = (int*)(P.ws + O_HI);
  float* Sc = (float*)lds;
  EPI_COORDS
  const int tid = tidx();
  for (int t = bid; t < 256 * 16; t += nb) {
    const int mt = t >> 4, rc = t & 15;
    f32x4 acc[4][4];
    ZERO_ACC(acc)
    gemm_kloop(acc, PQ + (size_t)mt * 128 * D_ + rc * 128, D_, SK + (size_t)rc * 128 * 128, 128, 128, lds);
#pragma unroll
    for (int mi = 0; mi < 4; ++mi) {
      const int m = wm * 64 + mi * 16 + lr;
#pragma unroll
      for (int ni = 0; ni < 4; ++ni) {
        const int n = wn * 64 + ni * 16 + lq * 4;
#pragma unroll
        for (int j = 0; j < 4; ++j) Sc[m * 129 + n + j] = acc[mi][ni][j];
      }
    }
    __syncthreads();
    const int tok = tid & 127, hh = tid >> 7;
    float key[16];
#pragma unroll
    for (int j = 0; j < 16; ++j) key[j] = -INFINITY;
    {
      const float* sp = Sc + tok * 129 + hh * 64;
#pragma unroll 4
      for (int k = 0; k < 64; ++k) {
        const float x = sp[k];
        const float kk = __uint_as_float((__float_as_uint(x) & ~127u) | (unsigned)(127 - (hh * 64 + k)));
#pragma unroll
        for (int j = 15; j >= 1; --j) key[j] = __builtin_amdgcn_fmed3f(key[j - 1], key[j], kk);
        key[0] = fmaxf(key[0], kk);
      }
    }
    __syncthreads();
    float* Lv = (float*)lds;
#pragma unroll
    for (int k = 0; k < 16; ++k) Lv[tid * 17 + k] = key[k];
    __syncthreads();
    if (tid < 128) {
      int ia = 0, ib = 0;
      const float* va = Lv + tid * 17; const float* vb = Lv + (tid + 128) * 17;
      float* ov = HV + ((size_t)(mt * 16 + rc) * 128 + tid) * 16;
      int* oi = HI + ((size_t)(mt * 16 + rc) * 128 + tid) * 16;
      for (int k = 0; k < 16; ++k) {
        const float a = va[ia], b = vb[ib];
        const bool ta = a >= b;
        const unsigned bits = __float_as_uint(ta ? a : b);
        ov[k] = __uint_as_float(bits & ~127u);
        oi[k] = 127 - (int)(bits & 127u);
        ia += ta ? 1 : 0; ib += ta ? 0 : 1;
      }
    }
    __syncthreads();
  }
}

__device__ void phase10(const Params& P, int bid, int nb, u16* lds) {
  int* Lx = (int*)lds + tidx() * 33;
  const float* HV = (const float*)(P.ws + O_HV);
  const int* HI = (const int*)(P.ws + O_HI);
  int* EX = (int*)(P.ws + O_EXP);
  float* GT = (float*)(P.ws + O_GATE);
  for (int i_ = bid * 256 + tidx(); i_ < T_ * 8; i_ += nb * 256) {
    const int r_ = (i_ >> 7) & 7, mt_ = i_ >> 10, tl_ = i_ & 127;
    const int i = (mt_ * 128 + tl_) * 8 + r_;
    const size_t h0 = ((size_t)(mt_ * 16 + r_ * 2) * 128 + tl_) * 16, h1 = h0 + 128 * 16;
    float v0[16], v1[16];
    int i0[16], i1[16];
#pragma unroll
    for (int q = 0; q < 4; ++q) {
      float4 a = *(const float4*)(HV + h0 + q * 4);
      float4 b = *(const float4*)(HV + h1 + q * 4);
      int4 c = *(const int4*)(HI + h0 + q * 4);
      int4 d = *(const int4*)(HI + h1 + q * 4);
      v0[q * 4] = a.x; v0[q * 4 + 1] = a.y; v0[q * 4 + 2] = a.z; v0[q * 4 + 3] = a.w;
      v1[q * 4] = b.x; v1[q * 4 + 1] = b.y; v1[q * 4 + 2] = b.z; v1[q * 4 + 3] = b.w;
      i0[q * 4] = c.x; i0[q * 4 + 1] = c.y; i0[q * 4 + 2] = c.z; i0[q * 4 + 3] = c.w;
      i1[q * 4] = d.x; i1[q * 4 + 1] = d.y; i1[q * 4 + 2] = d.z; i1[q * 4 + 3] = d.w;
    }
    float t[16];
#pragma unroll
    for (int j = 0; j < 16; ++j) t[j] = -INFINITY;
#pragma unroll
    for (int a = 0; a < 16; ++a)
#pragma unroll
      for (int b = 0; b < 16; ++b)
        if ((a + 1) * (b + 1) <= 16) {
          const float sv = v0[a] + v1[b];
#pragma unroll
          for (int j = 15; j >= 1; --j) t[j] = __builtin_amdgcn_fmed3f(t[j - 1], t[j], sv);
          t[0] = fmaxf(t[0], sv);
        }
    const float mx = t[0], thr = t[15];
    float sum = 0.f;
#pragma unroll
    for (int k = 0; k < 16; ++k) sum += __expf(t[k] - mx);
    const float inv = 1.f / sum;
    int cnt = 0;
#pragma unroll
    for (int a = 0; a < 16; ++a)
#pragma unroll
      for (int b = 0; b < 16; ++b)
        if ((a + 1) * (b + 1) <= 16) {
          const float sv = v0[a] + v1[b];
          if (sv >= thr && cnt < 16) {
            Lx[cnt] = i0[a] * 128 + i1[b];
            Lx[16 + cnt] = __float_as_int(__expf(sv - mx) * inv);
            ++cnt;
          }
        }
    asm volatile("s_waitcnt lgkmcnt(0)" ::: "memory");
#pragma unroll
    for (int q = 0; q < 4; ++q) {
      *(int4*)(EX + (size_t)i * 16 + q * 4) = int4{Lx[q * 4], Lx[q * 4 + 1], Lx[q * 4 + 2], Lx[q * 4 + 3]};
      *(float4*)(GT + (size_t)i * 16 + q * 4) =
          float4{__int_as_float(Lx[16 + q * 4]), __int_as_float(Lx[16 + q * 4 + 1]), __int_as_float(Lx[16 + q * 4 + 2]),
                 __int_as_float(Lx[16 + q * 4 + 3])};
    }
    asm volatile("s_waitcnt lgkmcnt(0)" ::: "memory");
  }
}

__device__ __forceinline__ void unpack8(uint4 u, float* f) {
  f[0] = lo2f(u.x); f[1] = hi2f(u.x); f[2] = lo2f(u.y); f[3] = hi2f(u.y);
  f[4] = lo2f(u.z); f[5] = hi2f(u.z); f[6] = lo2f(u.w); f[7] = hi2f(u.w);
}
__device__ __forceinline__ void dec16(uint4 u, float* f) {
  f32x2 a;
  a = __builtin_amdgcn_cvt_pk_f32_fp8((int)u.x, false); f[0] = a.x; f[1] = a.y;
  a = __builtin_amdgcn_cvt_pk_f32_fp8((int)u.x, true);  f[2] = a.x; f[3] = a.y;
  a = __builtin_amdgcn_cvt_pk_f32_fp8((int)u.y, false); f[4] = a.x; f[5] = a.y;
  a = __builtin_amdgcn_cvt_pk_f32_fp8((int)u.y, true);  f[6] = a.x; f[7] = a.y;
  a = __builtin_amdgcn_cvt_pk_f32_fp8((int)u.z, false); f[8] = a.x; f[9] = a.y;
  a = __builtin_amdgcn_cvt_pk_f32_fp8((int)u.z, true);  f[10] = a.x; f[11] = a.y;
  a = __builtin_amdgcn_cvt_pk_f32_fp8((int)u.w, false); f[12] = a.x; f[13] = a.y;
  a = __builtin_amdgcn_cvt_pk_f32_fp8((int)u.w, true);  f[14] = a.x; f[15] = a.y;
}
__device__ __forceinline__ void load_row_bf16(const u16* row, int lane, float* f) {
#pragma unroll
  for (int q = 0; q < 2; ++q) {
    uint4 a = *(const uint4*)(row + q * 1024 + lane * 16);
    uint4 b = *(const uint4*)(row + q * 1024 + lane * 16 + 8);
    unpack8(a, f + q * 16);
    unpack8(b, f + q * 16 + 8);
  }
}
__device__ void phase11(const Params& P, int bid, int nb) {
  const u16* H = (const u16*)(P.ws + O_H);
  const unsigned char* U8 = (const unsigned char*)(P.ws + O_U8);
  const unsigned char* V8 = (const unsigned char*)(P.ws + O_V8);
  const float* RSU = (const float*)(P.ws + O_RSU);
  const float* RSV = (const float*)(P.ws + O_RSV);
  const u16* SG = (const u16*)(P.ws + O_SG);
  const u16* E = (const u16*)(P.ws + O_E);
  const int* EX = (const int*)(P.ws + O_EXP);
  const float* GT = (const float*)(P.ws + O_GATE);
  const int lane = tidx() & 63;
  int sweep = 0;
  for (int tok = bid * 4 + (tidx() >> 6); tok < T_; tok += nb * 4, sweep ^= 1) {
    float hf[32], y[32];
    load_row_bf16(H + (size_t)tok * D_, lane, hf);
#pragma unroll
    for (int k = 0; k < 32; ++k) y[k] = 0.f;
    int ev0 = EX[(size_t)tok * 128 + lane], ev1 = EX[(size_t)tok * 128 + 64 + lane];
    float gv0 = GT[(size_t)tok * 128 + lane], gv1 = GT[(size_t)tok * 128 + 64 + lane];
    {
      int k0 = (ev0 << 7) | lane, k1 = (ev1 << 7) | (64 + lane);
#pragma unroll
      for (int kk = 2; kk <= 128; kk <<= 1) {
#pragma unroll
        for (int j = kk >> 1; j >= 1; j >>= 1) {
          if (j == 64) {
            const int lo_ = min(k0, k1), hi_ = max(k0, k1);
            k0 = lo_; k1 = hi_;
          } else {
            const int p0 = __shfl_xor(k0, j), p1 = __shfl_xor(k1, j);
            const bool lower = (lane & j) == 0;
            const bool up0 = (kk == 128) ? true : ((lane & kk) == 0);
            const bool up1 = (kk == 128) ? true : (kk == 64 ? false : ((lane & kk) == 0));
            k0 = (lower == up0) ? min(k0, p0) : max(k0, p0);
            k1 = (lower == up1) ? min(k1, p1) : max(k1, p1);
          }
        }
      }
      const int s0 = k0 & 127, s1 = k1 & 127;
      const float ga0 = __shfl(gv0, s0 & 63), gb0 = __shfl(gv1, s0 & 63);
      const float ga1 = __shfl(gv0, s1 & 63), gb1 = __shfl(gv1, s1 & 63);
      gv0 = (s0 < 64) ? ga0 : gb0;
      gv1 = (s1 < 64) ? ga1 : gb1;
      ev0 = k0 >> 7;
      ev1 = k1 >> 7;
    }
    const float ru0 = RSU[ev0], ru1 = RSU[ev1], rv0 = RSV[ev0], rv1 = RSV[ev1];
    for (int k4_ = 0; k4_ < 128; k4_ += 4) {
      const int k4 = sweep ? (124 - k4_) : k4_;
      const int src = k4 & 63;
      const bool lo = k4 < 64;
      int ee[4]; float gg[4], su[4], sv[4];
#pragma unroll
      for (int x = 0; x < 4; ++x) {
        ee[x] = __shfl(lo ? ev0 : ev1, src + x);
        gg[x] = __shfl(lo ? gv0 : gv1, src + x);
        su[x] = __shfl(lo ? ru0 : ru1, src + x);
        sv[x] = __shfl(lo ? rv0 : rv1, src + x);
      }
      uint4 uu[4][2], vv[4][2];
#pragma unroll
      for (int x = 0; x < 4; ++x)
#pragma unroll
        for (int q = 0; q < 2; ++q) {
          uu[x][q] = *(const uint4*)(U8 + (size_t)ee[x] * D_ + q * 1024 + lane * 16);
          vv[x][q] = *(const uint4*)(V8 + (size_t)ee[x] * D_ + q * 1024 + lane * 16);
        }
      float dd[4];
#pragma unroll
      for (int x = 0; x < 4; ++x) {
        float d = 0.f;
#pragma unroll
        for (int q = 0; q < 2; ++q) {
          float f[16];
          dec16(uu[x][q], f);
#pragma unroll
          for (int j = 0; j < 16; ++j) d = fmaf(f[j], hf[q * 16 + j], d);
        }
        dd[x] = d;
      }
#pragma unroll
      for (int o = 32; o >= 1; o >>= 1) {
#pragma unroll
        for (int x = 0; x < 4; ++x) dd[x] += __shfl_xor(dd[x], o);
      }
#pragma unroll
      for (int x = 0; x < 4; ++x) {
        const float w = gg[x] * gelu_tanh(dd[x] * su[x]) * sv[x];
#pragma unroll
        for (int q = 0; q < 2; ++q) {
          float f[16];
          dec16(vv[x][q], f);
#pragma unroll
          for (int j = 0; j < 16; ++j) y[q * 16 + j] = fmaf(w, f[j], y[q * 16 + j]);
        }
      }
    }
    float ef[32], sg[32];
    load_row_bf16(E + (size_t)tok * D_, lane, ef);
    load_row_bf16(SG + (size_t)tok * D_, lane, sg);
    float ss = 0.f;
#pragma unroll
    for (int k = 0; k < 32; ++k) ss += ef[k] * ef[k];
    const float rr = rsqrtf(wave_sum(ss) * (1.f / D_) + 1e-5f);
    float s1 = 0.f;
#pragma unroll
    for (int q = 0; q < 2; ++q)
#pragma unroll
      for (int j4 = 0; j4 < 4; ++j4) {
        float4 g = *(const float4*)(P.ple_g + q * 1024 + lane * 16 + j4 * 4);
        const float gq[4] = {g.x, g.y, g.z, g.w};
#pragma unroll
        for (int j = 0; j < 4; ++j) {
          const int k = q * 16 + j4 * 4 + j;
          float v = ALPHA * hf[k] + y[k] + ef[k] * rr * gq[j] * sg[k];
          y[k] = v;
          s1 += v;
        }
      }
    const float mu = wave_sum(s1) * (1.f / D_);
    float s2 = 0.f;
#pragma unroll
    for (int k = 0; k < 32; ++k) { float d = y[k] - mu; s2 += d * d; }
    const float rstd = rsqrtf(wave_sum(s2) * (1.f / D_) + 1e-5f);
#pragma unroll
    for (int q = 0; q < 2; ++q)
#pragma unroll
      for (int j4 = 0; j4 < 4; ++j4) {
        const int col = q * 1024 + lane * 16 + j4 * 4;
        const int k = q * 16 + j4 * 4;
        float4 g = *(const float4*)(P.ln2_g + col), b = *(const float4*)(P.ln2_b + col);
        float4 o;
        o.x = (y[k + 0] - mu) * rstd * g.x + b.x; o.y = (y[k + 1] - mu) * rstd * g.y + b.y;
        o.z = (y[k + 2] - mu) * rstd * g.z + b.z; o.w = (y[k + 3] - mu) * rstd * g.w + b.w;
        *(float4*)(P.out + (size_t)tok * D_ + col) = o;
      }
  }
}

constexpr size_t O_BAR = 1000 * MB;
__device__ __forceinline__ void gbar(unsigned* ctr, unsigned& epoch, unsigned nb) {
  epoch += nb;
  asm volatile("s_waitcnt vmcnt(0)" ::: "memory");
  __syncthreads();
  if (threadIdx.x == 0) {
    __builtin_amdgcn_fence(__ATOMIC_RELEASE, "agent");
    asm volatile("s_waitcnt vmcnt(0)" ::: "memory");
    __hip_atomic_fetch_add(ctr, 1u, __ATOMIC_RELAXED, __HIP_MEMORY_SCOPE_AGENT);
    while (__hip_atomic_load(ctr, __ATOMIC_RELAXED, __HIP_MEMORY_SCOPE_AGENT) < epoch) __builtin_amdgcn_s_sleep(2);
    __builtin_amdgcn_fence(__ATOMIC_ACQUIRE, "agent");
    asm volatile("s_waitcnt vmcnt(0)" ::: "memory");
  }
  __syncthreads();
}

constexpr int NPHASE = 12;

__global__ void __launch_bounds__(512, 2) mega_kernel(Params P) {
  extern __shared__ __attribute__((aligned(16))) u16 dlds[];
  cg::grid_group grid = cg::this_grid();
  const int rb = blockIdx.x, rnb = gridDim.x;
  const int half = threadIdx.x >> 8;
  const int bid = rb * 2 + half, nb = rnb * 2;
  u16* lds = dlds + half * 36864;
  unsigned* ctr = (unsigned*)(P.ws + O_BAR);
  unsigned ep = 0;
  phase0(P, bid, nb, lds); grid.sync();
  phase1(P, rb, rnb, dlds); gbar(ctr, ep, rnb);
  phase2(P, bid, nb, lds); gbar(ctr, ep, rnb);
  phase3(P, bid, nb, lds); gbar(ctr, ep, rnb);
  phase4(P, rb, rnb, dlds); gbar(ctr, ep, rnb);
  phase5(P, rb, rnb, dlds); gbar(ctr, ep, rnb);
  phase6(P, rb, rnb, dlds); gbar(ctr, ep, rnb);
  ln_rows((const float*)(P.ws + O_PRE1), P.ln1_g, P.ln1_b, (u16*)(P.ws + O_H), bid * 4 + (tidx() >> 6), nb * 4);
  gbar(ctr, ep, rnb);
  phase8(P, rb, rnb, dlds); gbar(ctr, ep, rnb);
  phase9(P, bid, nb, lds); gbar(ctr, ep, rnb);
  phase10(P, bid, nb, lds); gbar(ctr, ep, rnb);
  phase11(P, bid, nb);
}

extern "C" void kernel_launch(void* const* d_in, const int* in_sizes, int n_in, void* d_out, int out_size, void* d_ws,
                              size_t ws_size, hipStream_t stream) {
  Params p{};
  const float** pp = (const float**)&p;
  for (int i = 0; i < 29; ++i) pp[i] = (const float*)d_in[i];
  p.out = (float*)d_out;
  p.ws = (char*)d_ws;
  if (ws_size < 1001 * MB) fprintf(stderr, "workspace too small: %zu\n", ws_size);
  constexpr size_t kDynLds = 147456;
  static int grid_blocks = 0;
  if (!grid_blocks) {
    int dev = 0, cus = 0, per_cu = 0;
    (void)hipGetDevice(&dev);
    (void)hipDeviceGetAttribute(&cus, hipDeviceAttributeMultiprocessorCount, dev);
    (void)hipFuncSetAttribute((const void*)mega_kernel, hipFuncAttributeMaxDynamicSharedMemorySize, (int)kDynLds);
    (void)hipOccupancyMaxActiveBlocksPerMultiprocessor(&per_cu, mega_kernel, 512, kDynLds);
    if (per_cu > 1) per_cu = 1;
    grid_blocks = cus * per_cu;
  }
  (void)hipMemsetAsync((char*)d_ws + O_BAR, 0, 256, stream);
  void* args[] = {&p};
  hipError_t e = hipLaunchCooperativeKernel((void*)mega_kernel, dim3(grid_blocks), dim3(512), args, kDynLds, stream);
  if (e != hipSuccess) fprintf(stderr, "cooperative launch failed: %s (grid %d)\n", hipGetErrorString(e), grid_blocks);
}
```

```cpp
#include <hip/hip_runtime.h>
#include <hip/hip_bf16.h>
#include <hip/hip_cooperative_groups.h>
#include <cstdio>
namespace cg = cooperative_groups;

#ifndef MULTI
#define MULTI 0
#endif

typedef unsigned short u16;
using bf16x8 = __attribute__((ext_vector_type(8))) short;
using f32x4 = __attribute__((ext_vector_type(4))) float;

constexpr int T_ = 32768;
constexpr int S_ = 16384;
constexpr int D_ = 2048;
constexpr int SSM_L = 128;
constexpr int SSM_NC = S_ / SSM_L;
constexpr float ALPHA = 1.189207115002721f;
constexpr size_t MB = 1024ull * 1024ull;

constexpr size_t O_WIN = 0 * MB, O_WGLU = 32 * MB, O_WAU = 34 * MB, O_WSU = 38 * MB, O_WOUT = 42 * MB,
                 O_WPQ = 50 * MB, O_WPG = 58 * MB, O_WPIN = 66 * MB, O_SK = 67 * MB, O_BCAT = 67 * MB + 512 * 1024,
                 O_CCAT = 68 * MB, O_LAM = 68 * MB + 256 * 1024, O_UB = 70 * MB, O_VB = 134 * MB, O_SBUF = 198 * MB,
                 O_H = 206 * MB, O_Q = 334 * MB, O_K = 398 * MB, O_VT = 462 * MB, O_U2 = 526 * MB, O_G = 590 * MB,
                 O_YA = 846 * MB, O_YS = 910 * MB, O_PB = 974 * MB;
constexpr size_t O_YG = O_VT, O_MERGED = O_Q, O_PRE1 = O_G, O_PQ = O_Q, O_SG = O_VT, O_E = O_G,
                 O_HV = O_G + 128 * MB, O_HI = O_G + 160 * MB, O_EXP = O_G + 192 * MB, O_GATE = O_G + 208 * MB;

struct Params {
  const float *x, *p, *ln_in_g, *ln_in_b, *w_in, *rel_bias, *lam_re, *lam_im, *log_dt, *b_re, *b_im, *c_re, *c_im,
      *ssm_d, *w_glu, *w_au, *w_su, *w_out, *ln1_g, *ln1_b, *w_pq, *sub_keys, *peer_u, *peer_v, *ple_w_in, *ple_g,
      *ple_w_gate, *ln2_g, *ln2_b;
  float* out;
  char* ws;
};

__device__ __forceinline__ int tidx() { int t = threadIdx.x & 255; asm volatile("" : "+v"(t)); return t; }
__device__ __forceinline__ int rtid() { int t = threadIdx.x; asm volatile("" : "+v"(t)); return t; }
__device__ __forceinline__ u16 f2bf(float f) {
  unsigned u = __float_as_uint(f);
  u += 0x7fffu + ((u >> 16) & 1u);
  return (u16)(u >> 16);
}
__device__ __forceinline__ float bf2f(u16 h) { return __uint_as_float(((unsigned)h) << 16); }
typedef __bf16 hwbf16x2 __attribute__((ext_vector_type(2)));
typedef float hwf32x2 __attribute__((ext_vector_type(2)));
__device__ __forceinline__ unsigned pack2(float a, float b) {
  hwf32x2 v = {a, b};
  hwbf16x2 r = __builtin_convertvector(v, hwbf16x2);
  return *(unsigned*)&r;
}
__device__ __forceinline__ float lo2f(unsigned u) { return __uint_as_float(u << 16); }
__device__ __forceinline__ float hi2f(unsigned u) { return __uint_as_float(u & 0xffff0000u); }
__device__ __forceinline__ float sigmoidf_(float x) { return __builtin_amdgcn_rcpf(1.f + __expf(-x)); }
__device__ __forceinline__ float gelu_tanh(float x) {
  float u = 0.7978845608028654f * (x + 0.044715f * x * x * x);
  float t = 1.f - 2.f * __builtin_amdgcn_rcpf(1.f + __expf(2.f * u));
  return 0.5f * x * (1.f + t);
}
__device__ __forceinline__ float wave_sum(float v) {
#pragma unroll
  for (int o = 32; o >= 1; o >>= 1) v += __shfl_xor(v, o);
  return v;
}
__device__ __forceinline__ void store_bf4(u16* dst, float a, float b, float c, float d) {
  uint2 v; v.x = pack2(a, b); v.y = pack2(c, d);
  *(uint2*)dst = v;
}

__device__ __forceinline__ void gemm_kloop(f32x4 (&acc)[4][4], const u16* __restrict__ A, int lda,
                                           const u16* __restrict__ Bt, int ldb, int K, u16* lds) {
  const int tid = tidx(), lane = tid & 63, wid = tid >> 6, wm = wid >> 1, wn = wid & 1;
  const int lr = lane & 15, lq = lane >> 4;
  const int nk = K >> 6;
  const int srow = tid >> 3, sc = (tid & 7) ^ (srow & 7);
  const u16* ga = A + (size_t)srow * lda + sc * 8;
  const u16* gb = Bt + (size_t)srow * ldb + sc * 8;
  u16* lw = lds + tid * 8;
#pragma unroll
  for (int i = 0; i < 4; ++i) {
    __builtin_amdgcn_global_load_lds((const unsigned*)(ga + (size_t)(32 * i) * lda), (unsigned*)(lw + i * 2048), 16, 0, 0);
    __builtin_amdgcn_global_load_lds((const unsigned*)(gb + (size_t)(32 * i) * ldb), (unsigned*)(lw + 8192 + i * 2048), 16, 0, 0);
  }
  __syncthreads();
  const int swz = lr & 7;
  for (int kt = 0; kt < nk; ++kt) {
    if (kt + 1 < nk) {
      u16* lw2 = lw + ((kt + 1) & 1) * 16384;
#pragma unroll
      for (int i = 0; i < 4; ++i) {
        __builtin_amdgcn_global_load_lds((const unsigned*)(ga + (size_t)(32 * i) * lda + (kt + 1) * 64), (unsigned*)(lw2 + i * 2048), 16, 0, 0);
        __builtin_amdgcn_global_load_lds((const unsigned*)(gb + (size_t)(32 * i) * ldb + (kt + 1) * 64), (unsigned*)(lw2 + 8192 + i * 2048), 16, 0, 0);
      }
    }
    const u16* sa = lds + (kt & 1) * 16384;
    const u16* sb = sa + 8192;
#pragma unroll
    for (int ks = 0; ks < 2; ++ks) {
      bf16x8 af[4], bfr[4];
      const int co = ((ks * 4 + lq) ^ swz) * 8;
#pragma unroll
      for (int mi = 0; mi < 4; ++mi) af[mi] = *(const bf16x8*)(sa + (wm * 64 + mi * 16 + lr) * 64 + co);
#pragma unroll
      for (int ni = 0; ni < 4; ++ni) bfr[ni] = *(const bf16x8*)(sb + (wn * 64 + ni * 16 + lr) * 64 + co);
#pragma unroll
      for (int mi = 0; mi < 4; ++mi)
#pragma unroll
        for (int ni = 0; ni < 4; ++ni)
          acc[mi][ni] = __builtin_amdgcn_mfma_f32_16x16x32_bf16(bfr[ni], af[mi], acc[mi][ni], 0, 0, 0);
    }
    __syncthreads();
  }
}

#define ZERO_ACC(acc)                                   \
  _Pragma("unroll") for (int _a = 0; _a < 4; ++_a)      \
  _Pragma("unroll") for (int _b = 0; _b < 4; ++_b) acc[_a][_b] = f32x4{0.f, 0.f, 0.f, 0.f};

__device__ __forceinline__ void gemm_kloop2(f32x4 (&acc)[4][8], const u16* __restrict__ A, int lda,
                                            const u16* __restrict__ Bt, int ldb, int K, u16* lds) {
  const int tid = tidx(), lane = tid & 63, wid = tid >> 6;
  const int lr = lane & 15, lq = lane >> 4;
  const int nk = K >> 5;
  const int srow = tid >> 2;
  const int sc = (tid & 3) ^ ((0x78 >> (2 * ((tid >> 4) & 3))) & 3);
  const u16* ga = A + (size_t)srow * lda + sc * 8;
  const u16* gb = Bt + (size_t)srow * ldb + sc * 8;
  u16* lw = lds + tid * 8;
#pragma unroll
  for (int i = 0; i < 4; ++i)
    __builtin_amdgcn_global_load_lds((const unsigned*)(ga + (size_t)(64 * i) * lda), (unsigned*)(lw + i * 2048), 16, 0, 0);
#pragma unroll
  for (int i = 0; i < 2; ++i)
    __builtin_amdgcn_global_load_lds((const unsigned*)(gb + (size_t)(64 * i) * ldb), (unsigned*)(lw + 8192 + i * 2048), 16, 0, 0);
  __syncthreads();
  const int co = (lq ^ ((0x78 >> (2 * ((lr >> 2) & 3))) & 3)) * 8;
  for (int kt = 0; kt < nk; ++kt) {
    if (kt + 1 < nk) {
      u16* lw2 = lw + ((kt + 1) & 1) * 12288;
#pragma unroll
      for (int i = 0; i < 4; ++i)
        __builtin_amdgcn_global_load_lds((const unsigned*)(ga + (size_t)(64 * i) * lda + (kt + 1) * 32), (unsigned*)(lw2 + i * 2048), 16, 0, 0);
#pragma unroll
      for (int i = 0; i < 2; ++i)
        __builtin_amdgcn_global_load_lds((const unsigned*)(gb + (size_t)(64 * i) * ldb + (kt + 1) * 32), (unsigned*)(lw2 + 8192 + i * 2048), 16, 0, 0);
    }
    const u16* sa = lds + (kt & 1) * 12288;
    const u16* sb = sa + 8192;
    bf16x8 af[4];
#pragma unroll
    for (int mi = 0; mi < 4; ++mi) af[mi] = *(const bf16x8*)(sa + (wid * 64 + mi * 16 + lr) * 32 + co);
#pragma unroll
    for (int nh = 0; nh < 2; ++nh) {
      bf16x8 bfr[4];
#pragma unroll
      for (int ni = 0; ni < 4; ++ni) bfr[ni] = *(const bf16x8*)(sb + ((nh * 4 + ni) * 16 + lr) * 32 + co);
#pragma unroll
      for (int mi = 0; mi < 4; ++mi)
#pragma unroll
        for (int ni = 0; ni < 4; ++ni)
          acc[mi][nh * 4 + ni] = __builtin_amdgcn_mfma_f32_16x16x32_bf16(bfr[ni], af[mi], acc[mi][nh * 4 + ni], 0, 0, 0);
    }
    __syncthreads();
  }
}

__device__ __forceinline__ void gemm_kloop3(f32x4 (&acc)[4][8], const u16* __restrict__ A, int lda,
                                            const u16* __restrict__ Bt, int ldb, int K, u16* lds) {
  const int tid = rtid(), lane = tid & 63, wid = tid >> 6, wm = wid >> 1, wn = wid & 1;
  const int lr = lane & 15, lq = lane >> 4;
  const int nk = K >> 6;
  const int srow = tid >> 3, sc = (tid & 7) ^ (srow & 7);
  const u16* ga = A + (size_t)srow * lda + sc * 8;
  const u16* gb = Bt + (size_t)srow * ldb + sc * 8;
  u16* lw = lds + tid * 8;
#pragma unroll
  for (int i = 0; i < 4; ++i) {
    __builtin_amdgcn_global_load_lds((const unsigned*)(ga + (size_t)(64 * i) * lda), (unsigned*)(lw + i * 4096), 16, 0, 0);
    __builtin_amdgcn_global_load_lds((const unsigned*)(gb + (size_t)(64 * i) * ldb), (unsigned*)(lw + 16384 + i * 4096), 16, 0, 0);
  }
  __syncthreads();
  const int swz = lr & 7;
  for (int kt = 0; kt < nk; ++kt) {
    const int ko = min(kt + 1, nk - 1) * 64;
    u16* lw2 = lw + ((kt + 1) & 1) * 32768;
    const u16* sa = lds + (kt & 1) * 32768;
    const u16* sb = sa + 16384;
#pragma unroll
    for (int ks = 0; ks < 2; ++ks) {
      const int co = ((ks * 4 + lq) ^ swz) * 8;
      bf16x8 af[4];
#pragma unroll
      for (int mi = 0; mi < 4; ++mi) af[mi] = *(const bf16x8*)(sa + (wm * 64 + mi * 16 + lr) * 64 + co);
#pragma unroll
      for (int nh = 0; nh < 2; ++nh) {
        bf16x8 bfr[4];
#pragma unroll
        for (int ni = 0; ni < 4; ++ni) bfr[ni] = *(const bf16x8*)(sb + (wn * 128 + (nh * 4 + ni) * 16 + lr) * 64 + co);
        if (ks == 0) __builtin_amdgcn_sched_barrier(0);
#pragma unroll
        for (int mi = 0; mi < 4; ++mi) {
#pragma unroll
          for (int ni = 0; ni < 4; ++ni)
            acc[mi][nh * 4 + ni] = __builtin_amdgcn_mfma_f32_16x16x32_bf16(bfr[ni], af[mi], acc[mi][nh * 4 + ni], 0, 0, 0);
          if (ks == 0) {
            if (nh == 0)
              __builtin_amdgcn_global_load_lds((const unsigned*)(ga + (size_t)(64 * mi) * lda + ko), (unsigned*)(lw2 + mi * 4096), 16, 0, 0);
            else
              __builtin_amdgcn_global_load_lds((const unsigned*)(gb + (size_t)(64 * mi) * ldb + ko), (unsigned*)(lw2 + 16384 + mi * 4096), 16, 0, 0);
            __builtin_amdgcn_sched_barrier(0);
          }
        }
      }
    }
    __syncthreads();
  }
}

#define EPI_COORDS3                                                             \
  const int lane = rtid() & 63, wid = rtid() >> 6, wm = wid >> 1, wn = wid & 1; \
  const int lr = lane & 15, lq = lane >> 4;

#define ZERO_ACC8(acc)                                  \
  _Pragma("unroll") for (int _a = 0; _a < 4; ++_a)      \
  _Pragma("unroll") for (int _b = 0; _b < 8; ++_b) acc[_a][_b] = f32x4{0.f, 0.f, 0.f, 0.f};

#define FOR_TILES_XCD(t, ntiles) \
  for (int _k = 0, t = (bid & 7) * (nb >> 3) + (bid >> 3); t < (ntiles); ++_k, t = ((_k * 8 + (bid & 7)) * (nb >> 3)) + (bid >> 3))

#define EPI_COORDS                                                             \
  const int lane = tidx() & 63, wid = tidx() >> 6, wm = wid >> 1, wn = wid & 1; \
  const int lr = lane & 15, lq = lane >> 4;

__device__ void tconv_tile(const float* __restrict__ W, int K, int N, u16* __restrict__ Wt, int tile, float* lds) {
  const int tid = tidx();
  const int ntn = N >> 6;
  const int kt = tile / ntn, nt = tile % ntn;
  const int c4 = (tid & 15) * 4;
#pragma unroll
  for (int i = 0; i < 4; ++i) {
    int r = (tid >> 4) + 16 * i;
    float4 v = *(const float4*)(W + (size_t)(kt * 64 + r) * N + nt * 64 + c4);
    lds[r * 65 + c4 + 0] = v.x; lds[r * 65 + c4 + 1] = v.y; lds[r * 65 + c4 + 2] = v.z; lds[r * 65 + c4 + 3] = v.w;
  }
  __syncthreads();
  const int n = tid >> 2, kseg = (tid & 3) * 16;
  unsigned o[8];
#pragma unroll
  for (int j = 0; j < 8; ++j) o[j] = pack2(lds[(kseg + 2 * j) * 65 + n], lds[(kseg + 2 * j + 1) * 65 + n]);
  u16* dst = Wt + (size_t)(nt * 64 + n) * K + kt * 64 + kseg;
  *(uint4*)dst = uint4{o[0], o[1], o[2], o[3]};
  *(uint4*)(dst + 8) = uint4{o[4], o[5], o[6], o[7]};
  __syncthreads();
}

__device__ void conv_linear(const float* __restrict__ src, u16* __restrict__ dst, size_t n8, size_t gtid, size_t nth) {
  for (size_t i = gtid; i < n8; i += nth) {
    float4 a = *(const float4*)(src + i * 8), b = *(const float4*)(src + i * 8 + 4);
    *(uint4*)(dst + i * 8) = uint4{pack2(a.x, a.y), pack2(a.z, a.w), pack2(b.x, b.y), pack2(b.z, b.w)};
  }
}

typedef float f32x2 __attribute__((ext_vector_type(2)));
constexpr size_t O_U8 = O_UB, O_V8 = O_UB + 32 * MB, O_RSU = O_VB, O_RSV = O_VB + 64 * 1024;
__device__ void conv_fp8_rows(const float* __restrict__ src, unsigned char* __restrict__ dst, float* __restrict__ rscale,
                              int gw, int nw) {
  const int lane = tidx() & 63;
  for (int row = gw; row < 16384; row += nw) {
    const float* r = src + (size_t)row * D_;
    float4 v[8];
#pragma unroll
    for (int q = 0; q < 8; ++q) v[q] = *(const float4*)(r + q * 256 + lane * 4);
    float am = 0.f;
#pragma unroll
    for (int q = 0; q < 8; ++q) am = fmaxf(am, fmaxf(fmaxf(fabsf(v[q].x), fabsf(v[q].y)), fmaxf(fabsf(v[q].z), fabsf(v[q].w))));
#pragma unroll
    for (int o = 32; o >= 1; o >>= 1) am = fmaxf(am, __shfl_xor(am, o));
    const float sc = am > 0.f ? 416.f / am : 1.f;
#pragma unroll
    for (int q = 0; q < 8; ++q) {
      int w = 0;
      w = __builtin_amdgcn_cvt_pk_fp8_f32(v[q].x * sc, v[q].y * sc, w, false);
      w = __builtin_amdgcn_cvt_pk_fp8_f32(v[q].z * sc, v[q].w * sc, w, true);
      *(int*)(dst + (size_t)row * D_ + q * 256 + lane * 4) = w;
    }
    if (lane == 0) rscale[row] = am > 0.f ? am / 416.f : 1.f;
  }
}

__device__ void ln_rows(const float* __restrict__ src, const float* __restrict__ g, const float* __restrict__ b,
                        u16* __restrict__ dst, int gw, int nw) {
  const int lane = tidx() & 63;
  for (int row = gw; row < T_; row += nw) {
    const float* r = src + (size_t)row * D_;
    float4 v[8];
#pragma unroll
    for (int q = 0; q < 8; ++q) v[q] = *(const float4*)(r + q * 256 + lane * 4);
    float s = 0.f;
#pragma unroll
    for (int q = 0; q < 8; ++q) s += v[q].x + v[q].y + v[q].z + v[q].w;
    float mu = wave_sum(s) * (1.f / D_);
    float ss = 0.f;
#pragma unroll
    for (int q = 0; q < 8; ++q) {
      float a = v[q].x - mu, bb = v[q].y - mu, c = v[q].z - mu, d = v[q].w - mu;
      ss += a * a + bb * bb + c * c + d * d;
    }
    float rstd = rsqrtf(wave_sum(ss) * (1.f / D_) + 1e-5f);
#pragma unroll
    for (int q = 0; q < 8; ++q) {
      int col = q * 256 + lane * 4;
      float4 gg = *(const float4*)(g + col), bb = *(const float4*)(b + col);
      store_bf4(dst + (size_t)row * D_ + col, (v[q].x - mu) * rstd * gg.x + bb.x, (v[q].y - mu) * rstd * gg.y + bb.y,
                (v[q].z - mu) * rstd * gg.z + bb.z, (v[q].w - mu) * rstd * gg.w + bb.w);
    }
  }
}

__device__ __forceinline__ void dsincos(double x, double& s, double& c) {
  double q = rint(x * 0.63661977236758134308);
  double r = x - q * 1.57079632679489661923;
  double r2 = r * r;
  double sp = r * (1.0 + r2 * (-1.0 / 6 + r2 * (1.0 / 120 + r2 * (-1.0 / 5040 + r2 * (1.0 / 362880 + r2 * (-1.0 / 39916800 + r2 * (1.0 / 6227020800.0)))))));
  double cp = 1.0 + r2 * (-0.5 + r2 * (1.0 / 24 + r2 * (-1.0 / 720 + r2 * (1.0 / 40320 + r2 * (-1.0 / 3628800 + r2 * (1.0 / 479001600.0 + r2 * (-1.0 / 87178291200.0)))))));
  int qi = ((int)q) & 3;
  if (qi == 0) { s = sp; c = cp; }
  else if (qi == 1) { s = cp; c = -sp; }
  else if (qi == 2) { s = -sp; c = -cp; }
  else { s = -cp; c = sp; }
}

__device__ void ssm_consts(const Params& P, int i) {
  const int g = i >> 6, p = i & 63;
  double lr = P.lam_re[g * 64 + p], li = P.lam_im[g * 64 + p];
  double dt = exp((double)P.log_dt[g]);
  double mag = exp(lr * dt);
  double sn, cs;
  dsincos(li * dt, sn, cs);
  double ar = mag * cs, ai = mag * sn;
  double nr = ar - 1.0, ni = ai, den = lr * lr + li * li;
  double fr = (nr * lr + ni * li) / den, fi = (ni * lr - nr * li) / den;
  u16* bcat = (u16*)(P.ws + O_BCAT);
  u16* ccat = (u16*)(P.ws + O_CCAT);
  float* lam = (float*)(P.ws + O_LAM);
  for (int h = 0; h < 16; ++h) {
    double br = P.b_re[(g * 64 + p) * 16 + h], bi = P.b_im[(g * 64 + p) * 16 + h];
    bcat[(g * 128 + p) * 32 + h] = f2bf((float)(fr * br - fi * bi));
    bcat[(g * 128 + 64 + p) * 32 + h] = f2bf((float)(fr * bi + fi * br));
    bcat[(g * 128 + p) * 32 + 16 + h] = 0;
    bcat[(g * 128 + 64 + p) * 32 + 16 + h] = 0;
    ccat[(g * 16 + h) * 128 + p] = f2bf(P.c_re[(g * 16 + h) * 64 + p]);
    ccat[(g * 16 + h) * 128 + 64 + p] = f2bf(-P.c_im[(g * 16 + h) * 64 + p]);
  }
  double pr = ar, pi = ai;
  for (int k = 0; k < 10; ++k) {
    double t = pr * pr - pi * pi;
    pi = 2.0 * pr * pi;
    pr = t;
  }
  lam[0 * 4096 + i] = (float)ar;
  lam[1 * 4096 + i] = (float)ai;
  lam[2 * 4096 + i] = (float)pr;
  lam[3 * 4096 + i] = (float)pi;
}

__device__ void phase0(const Params& P, int bid, int nb, u16* lds) {
  const size_t gtid = (size_t)bid * 256 + tidx(), nth = (size_t)nb * 256;
#define TCONV(wp, KK, NN, OFF) \
  for (int t = bid; t < ((KK) >> 6) * ((NN) >> 6); t += nb) tconv_tile(wp, KK, NN, (u16*)(P.ws + OFF), t, (float*)lds);
  TCONV(P.w_in, 2048, 8192, O_WIN)
  TCONV(P.w_glu, 1024, 1024, O_WGLU)
  TCONV(P.w_au, 1024, 2048, O_WAU)
  TCONV(P.w_su, 1024, 2048, O_WSU)
  TCONV(P.w_out, 2048, 2048, O_WOUT)
  TCONV(P.w_pq, 2048, 2048, O_WPQ)
  TCONV(P.ple_w_gate, 2048, 2048, O_WPG)
  TCONV(P.ple_w_in, 256, 2048, O_WPIN)
  conv_fp8_rows(P.peer_u, (unsigned char*)(P.ws + O_U8), (float*)(P.ws + O_RSU), bid * 4 + (tidx() >> 6), nb * 4);
  conv_fp8_rows(P.peer_v, (unsigned char*)(P.ws + O_V8), (float*)(P.ws + O_RSV), bid * 4 + (tidx() >> 6), nb * 4);
  conv_linear(P.sub_keys, (u16*)(P.ws + O_SK), (size_t)16 * 128 * 128 / 8, gtid, nth);
  conv_linear(P.p, (u16*)(P.ws + O_PB), (size_t)T_ * 256 / 8, gtid, nth);
  for (size_t i = gtid; i < 4096; i += nth) ssm_consts(P, (int)i);
  ln_rows(P.x, P.ln_in_g, P.ln_in_b, (u16*)(P.ws + O_H), bid * 4 + (tidx() >> 6), nb * 4);
}

__device__ void phase1(const Params& P, int bid, int nb, u16* lds) {
  const u16* H = (const u16*)(P.ws + O_H);
  const u16* W = (const u16*)(P.ws + O_WIN);
  u16* Q = (u16*)(P.ws + O_Q);
  u16* Kb = (u16*)(P.ws + O_K);
  u16* Vt = (u16*)(P.ws + O_VT);
  u16* U2 = (u16*)(P.ws + O_U2);
  u16* G = (u16*)(P.ws + O_G);
  EPI_COORDS3
  const int ntiles = 128 * 32;
  for (int t = bid; t < ntiles; t += nb) {
    const int mt = t >> 5, nt = t & 31;
    f32x4 acc[4][8];
    ZERO_ACC8(acc)
    gemm_kloop3(acc, H + (size_t)mt * 256 * D_, D_, W + (size_t)nt * 256 * D_, D_, D_, lds);
    const int region = (nt * 256 + wn * 128) >> 10;
#pragma unroll
    for (int mi = 0; mi < 4; ++mi) {
      const int m = mt * 256 + wm * 64 + mi * 16 + lr;
#pragma unroll
      for (int ni = 0; ni < 8; ++ni) {
        const int n = nt * 256 + wn * 128 + ni * 16 + lq * 4;
        f32x4 a = acc[mi][ni];
        if (region == 0) {
          const float sc = 0.08838834764831845f;
          store_bf4(Q + (size_t)m * 1024 + n, a[0] * sc, a[1] * sc, a[2] * sc, a[3] * sc);
        } else if (region == 1) {
          store_bf4(Kb + (size_t)m * 1024 + (n - 1024), a[0], a[1], a[2], a[3]);
        } else if (region == 2) {
          const int b = m >> 14, tt = m & (S_ - 1);
#pragma unroll
          for (int j = 0; j < 4; ++j) Vt[((size_t)(b * 1024 + (n - 2048 + j))) * S_ + tt] = f2bf(a[j]);
        } else if (region == 3) {
          store_bf4(U2 + (size_t)m * 1024 + (n - 3072), a[0], a[1], a[2], a[3]);
        } else {
          store_bf4(G + (size_t)m * 4096 + (n - 4096), sigmoidf_(a[0]), sigmoidf_(a[1]), sigmoidf_(a[2]), sigmoidf_(a[3]));
        }
      }
    }
  }
}

__device__ void attn_item(const Params& P, int item, u16* lds) {
  const int c = item >> 4, hd = item & 7, b = (item >> 3) & 1;
  const int tid = tidx(), lane = tid & 63, w = tid >> 6, lr = lane & 15, lq = lane >> 4;
  u16* Ks = lds;
  u16* Vs = lds + 64 * 136;
  float* bs = (float*)(lds + 64 * 136 + 128 * 72);
  const u16* Q = (const u16*)(P.ws + O_Q);
  const u16* Kb = (const u16*)(P.ws + O_K);
  const u16* Vt = (const u16*)(P.ws + O_VT);
  u16* ya = (u16*)(P.ws + O_YA);
  __syncthreads();
  for (int i = tid; i < 257; i += 256) bs[i] = P.rel_bias[hd * 257 + i];
  bf16x8 qf[4];
  {
    const u16* qp = Q + (size_t)(b * S_ + c * 64 + w * 16 + lr) * 1024 + hd * 128 + lq * 8;
#pragma unroll
    for (int ks = 0; ks < 4; ++ks) qf[ks] = *(const bf16x8*)(qp + ks * 32);
  }
  f32x4 oacc[8];
#pragma unroll
  for (int d = 0; d < 8; ++d) oacc[d] = f32x4{0.f, 0.f, 0.f, 0.f};
  float m_run = -1e30f, lsum = 0.f;
  const int i0 = (c < 8) ? (8 - c) : 0;
  const int qi = w * 16 + lr;
#define KV_ADDR_K(r, kc_) (Kb + (size_t)(b * S_ + (kc_) * 64 + ((tid + 256 * (r)) >> 4)) * 1024 + hd * 128 + ((tid + 256 * (r)) & 15) * 8)
#define KV_ADDR_V(r, kc_) (Vt + ((size_t)(b * 1024 + hd * 128 + ((tid + 256 * (r)) >> 3))) * S_ + (kc_) * 64 + ((tid + 256 * (r)) & 7) * 8)
#define KV_LOAD(kc_)                                                                   \
  kr0 = *(const uint4*)KV_ADDR_K(0, kc_); kr1 = *(const uint4*)KV_ADDR_K(1, kc_);     \
  kr2 = *(const uint4*)KV_ADDR_K(2, kc_); kr3 = *(const uint4*)KV_ADDR_K(3, kc_);     \
  vr0 = *(const uint4*)KV_ADDR_V(0, kc_); vr1 = *(const uint4*)KV_ADDR_V(1, kc_);     \
  vr2 = *(const uint4*)KV_ADDR_V(2, kc_); vr3 = *(const uint4*)KV_ADDR_V(3, kc_);
#define KS_W(r) (Ks + ((tid + 256 * (r)) >> 4) * 136 + ((tid + 256 * (r)) & 15) * 8)
#define VS_W(r) (Vs + ((tid + 256 * (r)) >> 3) * 72 + ((tid + 256 * (r)) & 7) * 8)
#define KV_LOADS(S, kc_)                                                                \
  S##k0 = *(const uint4*)KV_ADDR_K(0, kc_); S##k1 = *(const uint4*)KV_ADDR_K(1, kc_);   \
  S##k2 = *(const uint4*)KV_ADDR_K(2, kc_); S##k3 = *(const uint4*)KV_ADDR_K(3, kc_);   \
  S##v0 = *(const uint4*)KV_ADDR_V(0, kc_); S##v1 = *(const uint4*)KV_ADDR_V(1, kc_);   \
  S##v2 = *(const uint4*)KV_ADDR_V(2, kc_); S##v3 = *(const uint4*)KV_ADDR_V(3, kc_);
#define KV_WRITES(S)                                                                                   \
  *(uint4*)KS_W(0) = S##k0; *(uint4*)KS_W(1) = S##k1; *(uint4*)KS_W(2) = S##k2; *(uint4*)KS_W(3) = S##k3; \
  *(uint4*)VS_W(0) = S##v0; *(uint4*)VS_W(1) = S##v1; *(uint4*)VS_W(2) = S##v2; *(uint4*)VS_W(3) = S##v3;
  uint4 Ak0, Ak1, Ak2, Ak3, Av0, Av1, Av2, Av3, Bk0, Bk1, Bk2, Bk3, Bv0, Bv1, Bv2, Bv3;
  auto tile_compute = [&](const int i) {
    f32x4 sacc[4];
#pragma unroll
    for (int kt = 0; kt < 4; ++kt) {
      sacc[kt] = f32x4{0.f, 0.f, 0.f, 0.f};
#pragma unroll
      for (int ks = 0; ks < 4; ++ks) {
        bf16x8 kf = *(const bf16x8*)(Ks + (kt * 16 + lr) * 136 + ks * 32 + lq * 8);
        sacc[kt] = __builtin_amdgcn_mfma_f32_16x16x32_bf16(kf, qf[ks], sacc[kt], 0, 0, 0);
      }
    }
    float tmax = -1e30f;
#pragma unroll
    for (int kt = 0; kt < 4; ++kt)
#pragma unroll
      for (int j = 0; j < 4; ++j) {
        int kb = i * 64 + kt * 16 + lq * 4 + j;
        int rel = 512 + qi - kb;
        rel = min(max(rel, -128), 128) + 128;
        float s = sacc[kt][j] + bs[rel];
        sacc[kt][j] = s;
        tmax = fmaxf(tmax, s);
      }
    tmax = fmaxf(tmax, __shfl_xor(tmax, 16));
    tmax = fmaxf(tmax, __shfl_xor(tmax, 32));
    const float m_new = fmaxf(m_run, tmax);
    const float corr = __expf(m_run - m_new);
    m_run = m_new;
    float ps = 0.f;
#pragma unroll
    for (int kt = 0; kt < 4; ++kt)
#pragma unroll
      for (int j = 0; j < 4; ++j) {
        float pv = __expf(sacc[kt][j] - m_new);
        sacc[kt][j] = pv;
        ps += pv;
      }
    lsum = lsum * corr + ps;
#pragma unroll
    for (int d = 0; d < 8; ++d) {
      oacc[d][0] *= corr; oacc[d][1] *= corr; oacc[d][2] *= corr; oacc[d][3] *= corr;
    }
#pragma unroll
    for (int kk = 0; kk < 2; ++kk) {
      union { bf16x8 v; unsigned u[4]; } pf;
      pf.u[0] = pack2(sacc[2 * kk][0], sacc[2 * kk][1]);
      pf.u[1] = pack2(sacc[2 * kk][2], sacc[2 * kk][3]);
      pf.u[2] = pack2(sacc[2 * kk + 1][0], sacc[2 * kk + 1][1]);
      pf.u[3] = pack2(sacc[2 * kk + 1][2], sacc[2 * kk + 1][3]);
#pragma unroll
      for (int d = 0; d < 8; ++d) {
        union { bf16x8 v; uint2 h[2]; } vf;
        vf.h[0] = *(const uint2*)(Vs + (d * 16 + lr) * 72 + kk * 32 + lq * 4);
        vf.h[1] = *(const uint2*)(Vs + (d * 16 + lr) * 72 + kk * 32 + 16 + lq * 4);
        oacc[d] = __builtin_amdgcn_mfma_f32_16x16x32_bf16(vf.v, pf.v, oacc[d], 0, 0, 0);
      }
    }
  };
  KV_LOADS(A, c - 8 + i0)
  if (i0 + 1 <= 8) { KV_LOADS(B, c - 8 + i0 + 1) }
  for (int i = i0; i <= 8; i += 2) {
    __syncthreads();
    KV_WRITES(A)
    __syncthreads();
    if (i + 2 <= 8) { KV_LOADS(A, c - 8 + i + 2) }
    tile_compute(i);
    if (i + 1 > 8) break;
    __syncthreads();
    KV_WRITES(B)
    __syncthreads();
    if (i + 3 <= 8) { KV_LOADS(B, c - 8 + i + 3) }
    tile_compute(i + 1);
  }
  lsum += __shfl_xor(lsum, 16);
  lsum += __shfl_xor(lsum, 32);
  const float inv = 1.f / lsum;
  u16* op = ya + (size_t)(b * S_ + c * 64 + w * 16 + lr) * 1024 + hd * 128 + lq * 4;
#pragma unroll
  for (int d = 0; d < 8; ++d) store_bf4(op + d * 16, oacc[d][0] * inv, oacc[d][1] * inv, oacc[d][2] * inv, oacc[d][3] * inv);
}

template <int PASS>
__device__ void ssm_item(const Params& P, int item, char* ldsw) {
  const int sc = item & 15, seq = item >> 4, g = seq & 63, b = seq >> 6;
  const int lane = tidx() & 63, lr = lane & 15, lq = lane >> 4;
  float* BuS = (float*)ldsw;
  u16* Hs = (u16*)(ldsw + 8448);
  const u16* bcat = (const u16*)(P.ws + O_BCAT);
  const u16* ccat = (const u16*)(P.ws + O_CCAT);
  const float* lam = (const float*)(P.ws + O_LAM);
  const u16* U2 = (const u16*)(P.ws + O_U2);
  float* Sbuf = (float*)(P.ws + O_SBUF);
  u16* ys = (u16*)(P.ws + O_YS);
  const float ar = lam[g * 64 + lane], ai = lam[4096 + g * 64 + lane];
  bf16x8 bfrag[8];
#pragma unroll
  for (int nt = 0; nt < 8; ++nt) bfrag[nt] = *(const bf16x8*)(bcat + (g * 128 + nt * 16 + lr) * 32 + lq * 8);
  float sr = 0.f, si = 0.f;
  bf16x8 cfrag[4];
  float dsk[4];
  if (PASS == 2) {
#pragma unroll
    for (int ks = 0; ks < 4; ++ks) cfrag[ks] = *(const bf16x8*)(ccat + (g * 16 + lr) * 128 + ks * 32 + lq * 8);
#pragma unroll
    for (int j = 0; j < 4; ++j) dsk[j] = P.ssm_d[g * 16 + lq * 4 + j];
    const float aLr = lam[2 * 4096 + g * 64 + lane], aLi = lam[3 * 4096 + g * 64 + lane];
    const float* Sb = Sbuf + (size_t)seq * 16 * 128;
#pragma unroll 4
    for (int cc = 0; cc < sc; ++cc) {
      float xr = Sb[cc * 128 + lane], xi = Sb[cc * 128 + 64 + lane];
      float nr = fmaf(aLr, sr, fmaf(-aLi, si, xr));
      float ni = fmaf(aLr, si, fmaf(aLi, sr, xi));
      sr = nr; si = ni;
    }
  }
#pragma unroll 1
  for (int ci = 0; ci < 8; ++ci) {
  const size_t tok_base = (size_t)b * S_ + (size_t)(sc * 8 + ci) * SSM_L;
  uint4 upre[SSM_L / 16];
  uint2 uepi[SSM_L / 16];
#pragma unroll
  for (int sub = 0; sub < SSM_L / 16; ++sub) {
    upre[sub] = uint4{0u, 0u, 0u, 0u};
    if (lq < 2) upre[sub] = *(const uint4*)(U2 + (tok_base + sub * 16 + lr) * 1024 + g * 16 + lq * 8);
    if (PASS == 2) uepi[sub] = *(const uint2*)(U2 + (tok_base + sub * 16 + lr) * 1024 + g * 16 + lq * 4);
  }
#pragma unroll
  for (int sub = 0; sub < SSM_L / 16; ++sub) {
    const size_t tok0 = tok_base + sub * 16;
    union { bf16x8 v; uint4 u; } uf;
    uf.u = upre[sub];
#pragma unroll
    for (int nt = 0; nt < 8; ++nt) {
      f32x4 d = __builtin_amdgcn_mfma_f32_16x16x32_bf16(bfrag[nt], uf.v, f32x4{0.f, 0.f, 0.f, 0.f}, 0, 0, 0);
      *(f32x4*)(BuS + lr * 132 + nt * 16 + lq * 4) = d;
    }
    asm volatile("s_waitcnt lgkmcnt(0)" ::: "memory");
    float bur[16], bui[16];
#pragma unroll
    for (int t = 0; t < 16; ++t) { bur[t] = BuS[t * 132 + lane]; bui[t] = BuS[t * 132 + 64 + lane]; }
    asm volatile("s_waitcnt lgkmcnt(0)" ::: "memory");
#pragma unroll
    for (int t = 0; t < 16; ++t) {
      float nr = fmaf(ar, sr, fmaf(-ai, si, bur[t]));
      float ni = fmaf(ar, si, fmaf(ai, sr, bui[t]));
      sr = nr; si = ni;
      if (PASS == 2) {
        const unsigned pk = pack2(sr, si);
        Hs[t * 136 + lane] = (u16)(pk & 0xffffu);
        Hs[t * 136 + 64 + lane] = (u16)(pk >> 16);
      }
    }
    asm volatile("s_waitcnt lgkmcnt(0)" ::: "memory");
    if (PASS == 2) {
      f32x4 yacc = f32x4{0.f, 0.f, 0.f, 0.f};
#pragma unroll
      for (int ks = 0; ks < 4; ++ks) {
        bf16x8 hf = *(const bf16x8*)(Hs + lr * 136 + ks * 32 + lq * 8);
        yacc = __builtin_amdgcn_mfma_f32_16x16x32_bf16(cfrag[ks], hf, yacc, 0, 0, 0);
      }
      const uint2 uu = uepi[sub];
      float y0 = gelu_tanh(yacc[0] + dsk[0] * lo2f(uu.x));
      float y1 = gelu_tanh(yacc[1] + dsk[1] * hi2f(uu.x));
      float y2 = gelu_tanh(yacc[2] + dsk[2] * lo2f(uu.y));
      float y3 = gelu_tanh(yacc[3] + dsk[3] * hi2f(uu.y));
      store_bf4(ys + (tok0 + lr) * 1024 + g * 16 + lq * 4, y0, y1, y2, y3);
      asm volatile("s_waitcnt lgkmcnt(0)" ::: "memory");
    }
  }
  }
  if (PASS == 1) {
    Sbuf[((size_t)seq * 16 + sc) * 128 + lane] = sr;
    Sbuf[((size_t)seq * 16 + sc) * 128 + 64 + lane] = si;
  }
}

__device__ void phase2(const Params& P, int bid, int nb, u16* lds) {
  for (int it = bid; it < 4096 + 512; it += nb) {
    if (it < 4096) {
      attn_item(P, it, lds);
    } else {
      __syncthreads();
      const int w = tidx() >> 6;
      ssm_item<1>(P, (it - 4096) * 4 + w, (char*)lds + w * 12800);
    }
  }
}
__device__ void phase3(const Params& P, int bid, int nb, u16* lds) {
  const int w = tidx() >> 6;
  for (int it = bid; it < 512; it += nb) ssm_item<2>(P, it * 4 + w, (char*)lds + w * 12800);
}

__device__ void phase4(const Params& P, int bid, int nb, u16* lds) {
  const u16* ys = (const u16*)(P.ws + O_YS);
  const u16* W = (const u16*)(P.ws + O_WGLU);
  u16* yg = (u16*)(P.ws + O_YG);
  EPI_COORDS3
  FOR_TILES_XCD(t, 128 * 4) {
    const int mt = t >> 2, nt = t & 3;
    f32x4 acc[4][8];
    ZERO_ACC8(acc)
    gemm_kloop3(acc, ys + (size_t)mt * 256 * 1024, 1024, W + (size_t)nt * 256 * 1024, 1024, 1024, lds);
#pragma unroll
    for (int mi = 0; mi < 4; ++mi) {
      const int m = mt * 256 + wm * 64 + mi * 16 + lr;
#pragma unroll
      for (int ni = 0; ni < 8; ++ni) {
        const int n = nt * 256 + wn * 128 + ni * 16 + lq * 4;
        uint2 yy = *(const uint2*)(ys + (size_t)m * 1024 + n);
        f32x4 a = acc[mi][ni];
        store_bf4(yg + (size_t)m * 1024 + n, lo2f(yy.x) * sigmoidf_(a[0]), hi2f(yy.x) * sigmoidf_(a[1]),
                  lo2f(yy.y) * sigmoidf_(a[2]), hi2f(yy.y) * sigmoidf_(a[3]));
      }
    }
  }
}

__device__ void phase5(const Params& P, int bid, int nb, u16* lds) {
  const u16* ya = (const u16*)(P.ws + O_YA);
  const u16* yg = (const u16*)(P.ws + O_YG);
  const u16* Wa = (const u16*)(P.ws + O_WAU);
  const u16* Wsu = (const u16*)(P.ws + O_WSU);
  const u16* G = (const u16*)(P.ws + O_G);
  u16* mg = (u16*)(P.ws + O_MERGED);
  EPI_COORDS3
  FOR_TILES_XCD(t, 128 * 8) {
    const int mt = t >> 3, nt = t & 7;
#pragma unroll 1
    for (int part = 0; part < 2; ++part) {
      f32x4 acc[4][8];
      ZERO_ACC8(acc)
      gemm_kloop3(acc, (part ? yg : ya) + (size_t)mt * 256 * 1024, 1024, (part ? Wsu : Wa) + (size_t)nt * 256 * 1024, 1024,
                  1024, lds);
      const u16* Gp = G + part * 2048;
#pragma unroll
      for (int mi = 0; mi < 4; ++mi) {
        const int m = mt * 256 + wm * 64 + mi * 16 + lr;
#pragma unroll
        for (int ni = 0; ni < 8; ++ni) {
          const int n = nt * 256 + wn * 128 + ni * 16 + lq * 4;
          const uint2 gg = *(const uint2*)(Gp + (size_t)m * 4096 + n);
          f32x4 a = acc[mi][ni];
          float o0 = a[0] * lo2f(gg.x), o1 = a[1] * hi2f(gg.x), o2 = a[2] * lo2f(gg.y), o3 = a[3] * hi2f(gg.y);
          if (part) {
            const uint2 pv = *(const uint2*)(mg + (size_t)m * D_ + n);
            o0 += lo2f(pv.x); o1 += hi2f(pv.x); o2 += lo2f(pv.y); o3 += hi2f(pv.y);
          }
          store_bf4(mg + (size_t)m * D_ + n, o0, o1, o2, o3);
        }
      }
    }
  }
}

__device__ void phase6(const Params& P, int bid, int nb, u16* lds) {
  const u16* mg = (const u16*)(P.ws + O_MERGED);
  const u16* W = (const u16*)(P.ws + O_WOUT);
  const u16* H = (const u16*)(P.ws + O_H);
  float* pre1 = (float*)(P.ws + O_PRE1);
  EPI_COORDS3
  FOR_TILES_XCD(t, 128 * 8) {
    const int mt = t >> 3, nt = t & 7;
    f32x4 acc[4][8];
    ZERO_ACC8(acc)
    gemm_kloop3(acc, mg + (size_t)mt * 256 * D_, D_, W + (size_t)nt * 256 * D_, D_, D_, lds);
#pragma unroll
    for (int mi = 0; mi < 4; ++mi) {
      const int m = mt * 256 + wm * 64 + mi * 16 + lr;
#pragma unroll
      for (int ni = 0; ni < 8; ++ni) {
        const int n = nt * 256 + wn * 128 + ni * 16 + lq * 4;
        uint2 hh = *(const uint2*)(H + (size_t)m * D_ + n);
        f32x4 a = acc[mi][ni];
        float4 o;
        o.x = ALPHA * lo2f(hh.x) + a[0]; o.y = ALPHA * hi2f(hh.x) + a[1];
        o.z = ALPHA * lo2f(hh.y) + a[2]; o.w = ALPHA * hi2f(hh.y) + a[3];
        *(float4*)(pre1 + (size_t)m * D_ + n) = o;
      }
    }
  }
}

__device__ void phase8(const Params& P, int bid, int nb, u16* lds) {
  const u16* H = (const u16*)(P.ws + O_H);
  const u16* Pb = (const u16*)(P.ws + O_PB);
  u16* PQ = (u16*)(P.ws + O_PQ);
  u16* SG = (u16*)(P.ws + O_SG);
  u16* E = (u16*)(P.ws + O_E);
  EPI_COORDS3
  FOR_TILES_XCD(t, 3 * 1024) {
    const int which = t >> 10, tt = t & 1023, mt = tt >> 3, nt = tt & 7;
    f32x4 acc[4][8];
    ZERO_ACC8(acc)
    u16* dst;
    if (which == 0) {
      gemm_kloop3(acc, H + (size_t)mt * 256 * D_, D_, (const u16*)(P.ws + O_WPQ) + (size_t)nt * 256 * D_, D_, D_, lds);
      dst = PQ;
    } else if (which == 1) {
      gemm_kloop3(acc, H + (size_t)mt * 256 * D_, D_, (const u16*)(P.ws + O_WPG) + (size_t)nt * 256 * D_, D_, D_, lds);
      dst = SG;
    } else {
      gemm_kloop3(acc, Pb + (size_t)mt * 256 * 256, 256, (const u16*)(P.ws + O_WPIN) + (size_t)nt * 256 * 256, 256, 256, lds);
      dst = E;
    }
#pragma unroll
    for (int mi = 0; mi < 4; ++mi) {
      const int m = mt * 256 + wm * 64 + mi * 16 + lr;
#pragma unroll
      for (int ni = 0; ni < 8; ++ni) {
        const int n = nt * 256 + wn * 128 + ni * 16 + lq * 4;
        f32x4 a = acc[mi][ni];
        if (which == 1) { a[0] = sigmoidf_(a[0]); a[1] = sigmoidf_(a[1]); a[2] = sigmoidf_(a[2]); a[3] = sigmoidf_(a[3]); }
        store_bf4(dst + (size_t)m * D_ + n, a[0], a[1], a[2], a[3]);
      }
    }
  }
}

struct Top16 { float v[16]; int i[16]; };
__device__ __forceinline__ void top_init(Top16& t) {
#pragma unroll
  for (int k = 0; k < 16; ++k) { t.v[k] = -INFINITY; t.i[k] = 0; }
}
__device__ __forceinline__ void top_insert(Top16& t, float x, int id) {
  const bool c = x > t.v[15];
  t.v[15] = c ? x : t.v[15];
  t.i[15] = c ? id : t.i[15];
#pragma unroll
  for (int k = 15; k >= 1; --k) {
    const bool s = t.v[k] > t.v[k - 1];
    const float a = t.v[k - 1], b = t.v[k];
    const int ia = t.i[k - 1], ib = t.i[k];
    t.v[k - 1] = s ? b : a; t.v[k] = s ? a : b;
    t.i[k - 1] = s ? ib : ia; t.i[k] = s ? ia : ib;
  }
}

__device__ void phase9(const Params& P, int bid, int nb, u16* lds) {
  const u16* PQ = (const u16*)(P.ws + O_PQ);
  const u16* SK = (const u16*)(P.ws + O_SK);
  float* HV = (float*)(P.ws + O_HV);
  int* HI = (int*)(P.ws + O_HI);
  float* Sc = (float*)lds;
  EPI_COORDS
  const int tid = tidx();
  for (int t = bid; t < 256 * 16; t += nb) {
    const int mt = t >> 4, rc = t & 15;
    f32x4 acc[4][4];
    ZERO_ACC(acc)
    gemm_kloop(acc, PQ + (size_t)mt * 128 * D_ + rc * 128, D_, SK + (size_t)rc * 128 * 128, 128, 128, lds);
#pragma unroll
    for (int mi = 0; mi < 4; ++mi) {
      const int m = wm * 64 + mi * 16 + lr;
#pragma unroll
      for (int ni = 0; ni < 4; ++ni) {
        const int n = wn * 64 + ni * 16 + lq * 4;
#pragma unroll
        for (int j = 0; j < 4; ++j) Sc[m * 129 + n + j] = acc[mi][ni][j];
      }
    }
    __syncthreads();
    const int tok = tid & 127, hh = tid >> 7;
    float key[16];
#pragma unroll
    for (int j = 0; j < 16; ++j) key[j] = -INFINITY;
    {
      const float* sp = Sc + tok * 129 + hh * 64;
#pragma unroll 4
      for (int k = 0; k < 64; ++k) {
        const float x = sp[k];
        const float kk = __uint_as_float((__float_as_uint(x) & ~127u) | (unsigned)(127 - (hh * 64 + k)));
#pragma unroll
        for (int j = 15; j >= 1; --j) key[j] = __builtin_amdgcn_fmed3f(key[j - 1], key[j], kk);
        key[0] = fmaxf(key[0], kk);
      }
    }
    __syncthreads();
    float* Lv = (float*)lds;
#pragma unroll
    for (int k = 0; k < 16; ++k) Lv[tid * 17 + k] = key[k];
    __syncthreads();
    if (tid < 128) {
      int ia = 0, ib = 0;
      const float* va = Lv + tid * 17; const float* vb = Lv + (tid + 128) * 17;
      float* ov = HV + ((size_t)(mt * 16 + rc) * 128 + tid) * 16;
      int* oi = HI + ((size_t)(mt * 16 + rc) * 128 + tid) * 16;
      for (int k = 0; k < 16; ++k) {
        const float a = va[ia], b = vb[ib];
        const bool ta = a >= b;
        const unsigned bits = __float_as_uint(ta ? a : b);
        ov[k] = __uint_as_float(bits & ~127u);
        oi[k] = 127 - (int)(bits & 127u);
        ia += ta ? 1 : 0; ib += ta ? 0 : 1;
      }
    }
    __syncthreads();
  }
}

__device__ void phase10(const Params& P, int bid, int nb, u16* lds) {
  int* Lx = (int*)lds + tidx() * 33;
  const float* HV = (const float*)(P.ws + O_HV);
  const int* HI = (const int*)(P.ws + O_HI);
  int* EX = (int*)(P.ws + O_EXP);
  float* GT = (float*)(P.ws + O_GATE);
  for (int i_ = bid * 256 + tidx(); i_ < T_ * 8; i_ += nb * 256) {
    const int r_ = (i_ >> 7) & 7, mt_ = i_ >> 10, tl_ = i_ & 127;
    const int i = (mt_ * 128 + tl_) * 8 + r_;
    const size_t h0 = ((size_t)(mt_ * 16 + r_ * 2) * 128 + tl_) * 16, h1 = h0 + 128 * 16;
    float v0[16], v1[16];
    int i0[16], i1[16];
#pragma unroll
    for (int q = 0; q < 4; ++q) {
      float4 a = *(const float4*)(HV + h0 + q * 4);
      float4 b = *(const float4*)(HV + h1 + q * 4);
      int4 c = *(const int4*)(HI + h0 + q * 4);
      int4 d = *(const int4*)(HI + h1 + q * 4);
      v0[q * 4] = a.x; v0[q * 4 + 1] = a.y; v0[q * 4 + 2] = a.z; v0[q * 4 + 3] = a.w;
      v1[q * 4] = b.x; v1[q * 4 + 1] = b.y; v1[q * 4 + 2] = b.z; v1[q * 4 + 3] = b.w;
      i0[q * 4] = c.x; i0[q * 4 + 1] = c.y; i0[q * 4 + 2] = c.z; i0[q * 4 + 3] = c.w;
      i1[q * 4] = d.x; i1[q * 4 + 1] = d.y; i1[q * 4 + 2] = d.z; i1[q * 4 + 3] = d.w;
    }
    float t[16];
#pragma unroll
    for (int j = 0; j < 16; ++j) t[j] = -INFINITY;
#pragma unroll
    for (int a = 0; a < 16; ++a)
#pragma unroll
      for (int b = 0; b < 16; ++b)
        if ((a + 1) * (b + 1) <= 16) {
          const float sv = v0[a] + v1[b];
#pragma unroll
          for (int j = 15; j >= 1; --j) t[j] = __builtin_amdgcn_fmed3f(t[j - 1], t[j], sv);
          t[0] = fmaxf(t[0], sv);
        }
    const float mx = t[0], thr = t[15];
    float sum = 0.f;
#pragma unroll
    for (int k = 0; k < 16; ++k) sum += __expf(t[k] - mx);
    const float inv = 1.f / sum;
    int cnt = 0;
#pragma unroll
    for (int a = 0; a < 16; ++a)
#pragma unroll
      for (int b = 0; b < 16; ++b)
        if ((a + 1) * (b + 1) <= 16) {
          const float sv = v0[a] + v1[b];
          if (sv >= thr && cnt < 16) {
            Lx[cnt] = i0[a] * 128 + i1[b];
            Lx[16 + cnt] = __float_as_int(__expf(sv - mx) * inv);
            ++cnt;
          }
        }
    asm volatile("s_waitcnt lgkmcnt(0)" ::: "memory");
#pragma unroll
    for (int q = 0; q < 4; ++q) {
      *(int4*)(EX + (size_t)i * 16 + q * 4) = int4{Lx[q * 4], Lx[q * 4 + 1], Lx[q * 4 + 2], Lx[q * 4 + 3]};
      *(float4*)(GT + (size_t)i * 16 + q * 4) =
          float4{__int_as_float(Lx[16 + q * 4]), __int_as_float(Lx[16 + q * 4 + 1]), __int_as_float(Lx[16 + q * 4 + 2]),
                 __int_as_float(Lx[16 + q * 4 + 3])};
    }
    asm volatile("s_waitcnt lgkmcnt(0)" ::: "memory");
  }
}

__device__ __forceinline__ void unpack8(uint4 u, float* f) {
  f[0] = lo2f(u.x); f[1] = hi2f(u.x); f[2] = lo2f(u.y); f[3] = hi2f(u.y);
  f[4] = lo2f(u.z); f[5] = hi2f(u.z); f[6] = lo2f(u.w); f[7] = hi2f(u.w);
}
__device__ __forceinline__ void dec16(uint4 u, float* f) {
  f32x2 a;
  a = __builtin_amdgcn_cvt_pk_f32_fp8((int)u.x, false); f[0] = a.x; f[1] = a.y;
  a = __builtin_amdgcn_cvt_pk_f32_fp8((int)u.x, true);  f[2] = a.x; f[3] = a.y;
  a = __builtin_amdgcn_cvt_pk_f32_fp8((int)u.y, false); f[4] = a.x; f[5] = a.y;
  a = __builtin_amdgcn_cvt_pk_f32_fp8((int)u.y, true);  f[6] = a.x; f[7] = a.y;
  a = __builtin_amdgcn_cvt_pk_f32_fp8((int)u.z, false); f[8] = a.x; f[9] = a.y;
  a = __builtin_amdgcn_cvt_pk_f32_fp8((int)u.z, true);  f[10] = a.x; f[11] = a.y;
  a = __builtin_amdgcn_cvt_pk_f32_fp8((int)u.w, false); f[12] = a.x; f[13] = a.y;
  a = __builtin_amdgcn_cvt_pk_f32_fp8((int)u.w, true);  f[14] = a.x; f[15] = a.y;
}
__device__ __forceinline__ void load_row_bf16(const u16* row, int lane, float* f) {
#pragma unroll
  for (int q = 0; q < 2; ++q) {
    uint4 a = *(const uint4*)(row + q * 1024 + lane * 16);
    uint4 b = *(const uint4*)(row + q * 1024 + lane * 16 + 8);
    unpack8(a, f + q * 16);
    unpack8(b, f + q * 16 + 8);
  }
}
__device__ void phase11(const Params& P, int bid, int nb) {
  const u16* H = (const u16*)(P.ws + O_H);
  const unsigned char* U8 = (const unsigned char*)(P.ws + O_U8);
  const unsigned char* V8 = (const unsigned char*)(P.ws + O_V8);
  const float* RSU = (const float*)(P.ws + O_RSU);
  const float* RSV = (const float*)(P.ws + O_RSV);
  const u16* SG = (const u16*)(P.ws + O_SG);
  const u16* E = (const u16*)(P.ws + O_E);
  const int* EX = (const int*)(P.ws + O_EXP);
  const float* GT = (const float*)(P.ws + O_GATE);
  const int lane = tidx() & 63;
  int sweep = 0;
  for (int tok = bid * 4 + (tidx() >> 6); tok < T_; tok += nb * 4, sweep ^= 1) {
    float hf[32], y[32];
    load_row_bf16(H + (size_t)tok * D_, lane, hf);
#pragma unroll
    for (int k = 0; k < 32; ++k) y[k] = 0.f;
    int ev0 = EX[(size_t)tok * 128 + lane], ev1 = EX[(size_t)tok * 128 + 64 + lane];
    float gv0 = GT[(size_t)tok * 128 + lane], gv1 = GT[(size_t)tok * 128 + 64 + lane];
    {
      int k0 = (ev0 << 7) | lane, k1 = (ev1 << 7) | (64 + lane);
#pragma unroll
      for (int kk = 2; kk <= 128; kk <<= 1) {
#pragma unroll
        for (int j = kk >> 1; j >= 1; j >>= 1) {
          if (j == 64) {
            const int lo_ = min(k0, k1), hi_ = max(k0, k1);
            k0 = lo_; k1 = hi_;
          } else {
            const int p0 = __shfl_xor(k0, j), p1 = __shfl_xor(k1, j);
            const bool lower = (lane & j) == 0;
            const bool up0 = (kk == 128) ? true : ((lane & kk) == 0);
            const bool up1 = (kk == 128) ? true : (kk == 64 ? false : ((lane & kk) == 0));
            k0 = (lower == up0) ? min(k0, p0) : max(k0, p0);
            k1 = (lower == up1) ? min(k1, p1) : max(k1, p1);
          }
        }
      }
      const int s0 = k0 & 127, s1 = k1 & 127;
      const float ga0 = __shfl(gv0, s0 & 63), gb0 = __shfl(gv1, s0 & 63);
      const float ga1 = __shfl(gv0, s1 & 63), gb1 = __shfl(gv1, s1 & 63);
      gv0 = (s0 < 64) ? ga0 : gb0;
      gv1 = (s1 < 64) ? ga1 : gb1;
      ev0 = k0 >> 7;
      ev1 = k1 >> 7;
    }
    const float ru0 = RSU[ev0], ru1 = RSU[ev1], rv0 = RSV[ev0], rv1 = RSV[ev1];
    for (int k4_ = 0; k4_ < 128; k4_ += 4) {
      const int k4 = sweep ? (124 - k4_) : k4_;
      const int src = k4 & 63;
      const bool lo = k4 < 64;
      int ee[4]; float gg[4], su[4], sv[4];
#pragma unroll
      for (int x = 0; x < 4; ++x) {
        ee[x] = __shfl(lo ? ev0 : ev1, src + x);
        gg[x] = __shfl(lo ? gv0 : gv1, src + x);
        su[x] = __shfl(lo ? ru0 : ru1, src + x);
        sv[x] = __shfl(lo ? rv0 : rv1, src + x);
      }
      uint4 uu[4][2], vv[4][2];
#pragma unroll
      for (int x = 0; x < 4; ++x)
#pragma unroll
        for (int q = 0; q < 2; ++q) {
          uu[x][q] = *(const uint4*)(U8 + (size_t)ee[x] * D_ + q * 1024 + lane * 16);
          vv[x][q] = *(const uint4*)(V8 + (size_t)ee[x] * D_ + q * 1024 + lane * 16);
        }
      float dd[4];
#pragma unroll
      for (int x = 0; x < 4; ++x) {
        float d = 0.f;
#pragma unroll
        for (int q = 0; q < 2; ++q) {
          float f[16];
          dec16(uu[x][q], f);
#pragma unroll
          for (int j = 0; j < 16; ++j) d = fmaf(f[j], hf[q * 16 + j], d);
        }
        dd[x] = d;
      }
#pragma unroll
      for (int o = 32; o >= 1; o >>= 1) {
#pragma unroll
        for (int x = 0; x < 4; ++x) dd[x] += __shfl_xor(dd[x], o);
      }
#pragma unroll
      for (int x = 0; x < 4; ++x) {
        const float w = gg[x] * gelu_tanh(dd[x] * su[x]) * sv[x];
#pragma unroll
        for (int q = 0; q < 2; ++q) {
          float f[16];
          dec16(vv[x][q], f);
#pragma unroll
          for (int j = 0; j < 16; ++j) y[q * 16 + j] = fmaf(w, f[j], y[q * 16 + j]);
        }
      }
    }
    float ef[32], sg[32];
    load_row_bf16(E + (size_t)tok * D_, lane, ef);
    load_row_bf16(SG + (size_t)tok * D_, lane, sg);
    float ss = 0.f;
#pragma unroll
    for (int k = 0; k < 32; ++k) ss += ef[k] * ef[k];
    const float rr = rsqrtf(wave_sum(ss) * (1.f / D_) + 1e-5f);
    float s1 = 0.f;
#pragma unroll
    for (int q = 0; q < 2; ++q)
#pragma unroll
      for (int j4 = 0; j4 < 4; ++j4) {
        float4 g = *(const float4*)(P.ple_g + q * 1024 + lane * 16 + j4 * 4);
        const float gq[4] = {g.x, g.y, g.z, g.w};
#pragma unroll
        for (int j = 0; j < 4; ++j) {
          const int k = q * 16 + j4 * 4 + j;
          float v = ALPHA * hf[k] + y[k] + ef[k] * rr * gq[j] * sg[k];
          y[k] = v;
          s1 += v;
        }
      }
    const float mu = wave_sum(s1) * (1.f / D_);
    float s2 = 0.f;
#pragma unroll
    for (int k = 0; k < 32; ++k) { float d = y[k] - mu; s2 += d * d; }
    const float rstd = rsqrtf(wave_sum(s2) * (1.f / D_) + 1e-5f);
#pragma unroll
    for (int q = 0; q < 2; ++q)
#pragma unroll
      for (int j4 = 0; j4 < 4; ++j4) {
        const int col = q * 1024 + lane * 16 + j4 * 4;
        const int k = q * 16 + j4 * 4;
        float4 g = *(const float4*)(P.ln2_g + col), b = *(const float4*)(P.ln2_b + col);
        float4 o;
        o.x = (y[k + 0] - mu) * rstd * g.x + b.x; o.y = (y[k + 1] - mu) * rstd * g.y + b.y;
        o.z = (y[k + 2] - mu) * rstd * g.z + b.z; o.w = (y[k + 3] - mu) * rstd * g.w + b.w;
        *(float4*)(P.out + (size_t)tok * D_ + col) = o;
      }
  }
}

constexpr size_t O_BAR = 1000 * MB;
__device__ __forceinline__ void gbar(unsigned* ctr, unsigned& epoch, unsigned nb) {
  epoch += nb;
  asm volatile("s_waitcnt vmcnt(0)" ::: "memory");
  __syncthreads();
  if (threadIdx.x == 0) {
    __builtin_amdgcn_fence(__ATOMIC_RELEASE, "agent");
    asm volatile("s_waitcnt vmcnt(0)" ::: "memory");
    __hip_atomic_fetch_add(ctr, 1u, __ATOMIC_RELAXED, __HIP_MEMORY_SCOPE_AGENT);
    while (__hip_atomic_load(ctr, __ATOMIC_RELAXED, __HIP_MEMORY_SCOPE_AGENT) < epoch) __builtin_amdgcn_s_sleep(2);
    __builtin_amdgcn_fence(__ATOMIC_ACQUIRE, "agent");
    asm volatile("s_waitcnt vmcnt(0)" ::: "memory");
  }
  __syncthreads();
}

#define XB_TMO      128
#define XB_XCNT(j)  (256  + 64 * (j))
#define XB_XSUB(j)  (1280 + 64 * (j))
#define XB_XGEN(j)  (2304 + 64 * (j))
#define XB_TOP      3328
#define XB_TOPGEN   3392
#define XCD_BAR_WORDS 3456
#define XB_SPIN_CAP (1u << 18)
#define LAS __attribute__((address_space(3)))

__device__ __forceinline__ unsigned xb_ld(unsigned* p)              { return __hip_atomic_load(p, __ATOMIC_RELAXED, __HIP_MEMORY_SCOPE_AGENT); }
__device__ __forceinline__ unsigned xb_add(unsigned* p, unsigned v) { return __hip_atomic_fetch_add(p, v, __ATOMIC_RELAXED, __HIP_MEMORY_SCOPE_AGENT); }
__device__ __forceinline__ unsigned xb_xcc_id() { return (unsigned)__builtin_amdgcn_s_getreg((3 << 11) | 20) & 0xFu; }
#define XB_SPIN(cond, bar) do { unsigned _sp = 0; while (cond) { __builtin_amdgcn_s_sleep(1); \
    if ((++_sp & 255u) == 0u) { if (xb_ld(&(bar)[XB_TMO])) break; if (_sp > XB_SPIN_CAP) { atomicAdd(&(bar)[XB_TMO], 1u); break; } } } } while (0)

struct XcdBarrier {
    unsigned* bar; unsigned x;
    volatile LAS unsigned* st;
};

__device__ __forceinline__ XcdBarrier xcd_barrier_post(unsigned* bar, volatile LAS unsigned* st) {
    XcdBarrier b; b.bar = bar; b.x = xb_xcc_id(); b.st = st;
    if (threadIdx.x == 0) (void)xb_add(&bar[XB_XCNT(b.x)], 1u);
    return b;
}
__device__ __forceinline__ void xcd_barrier_complete(unsigned* bar, unsigned x, unsigned& nloc, unsigned& nx) {
    const unsigned G = gridDim.x * gridDim.y * gridDim.z;
    unsigned sum, cnt, mine, sp = 0u;
    for (;;) {
        sum = 0u; cnt = 0u; mine = 0u;
#pragma unroll
        for (unsigned j = 0; j < 16; ++j) { const unsigned c = xb_ld(&bar[XB_XCNT(j)]); sum += c; cnt += (c > 0u) ? 1u : 0u; mine = (j == x) ? c : mine; }
        if (sum == G) break;
        __builtin_amdgcn_s_sleep(1);
        if ((++sp & 255u) == 0u) { if (xb_ld(&bar[XB_TMO])) break; if (sp > XB_SPIN_CAP) { atomicAdd(&bar[XB_TMO], 1u); break; } }
    }
    nloc = mine > 0u ? mine : 1u; nx = cnt > 0u ? cnt : 1u;
}

__device__ __forceinline__ void xcd_barrier(const XcdBarrier& b) {
    asm volatile("s_waitcnt vmcnt(0)" ::: "memory");
    __syncthreads();
    if (threadIdx.x == 0) {
        unsigned* bar = b.bar;
        __builtin_amdgcn_s_waitcnt(0);
        unsigned nloc = b.st[0], nx = b.st[1];
        if (nloc == 0u) { xcd_barrier_complete(bar, b.x, nloc, nx); b.st[0] = nloc; b.st[1] = nx; }
        const unsigned old = xb_add(&bar[XB_XSUB(b.x)], 1u);
        const unsigned gen = old / nloc;
        if (old + 1u == (gen + 1u) * nloc) {
            __builtin_amdgcn_fence(__ATOMIC_RELEASE, "agent");
            asm volatile("s_waitcnt vmcnt(0)" ::: "memory");
            const unsigned og = xb_add(&bar[XB_TOP], 1u);
            const unsigned tg = og / nx;
            if (og + 1u == (tg + 1u) * nx) xb_add(&bar[XB_TOPGEN], 1u);
            else XB_SPIN(xb_ld(&bar[XB_TOPGEN]) == tg, bar);
            __builtin_amdgcn_fence(__ATOMIC_ACQUIRE, "agent");
            xb_add(&bar[XB_XGEN(b.x)], 1u);
            asm volatile("s_waitcnt vmcnt(0)" ::: "memory");
        } else {
            XB_SPIN(xb_ld(&bar[XB_XGEN(b.x)]) == gen, bar);
            __builtin_amdgcn_fence(__ATOMIC_ACQUIRE, "agent");
            asm volatile("s_waitcnt vmcnt(0)" ::: "memory");
        }
    }
    __syncthreads();
}


constexpr int NPHASE = 12;

__global__ void __launch_bounds__(512, 2) mega_kernel(Params P) {
  extern __shared__ __attribute__((aligned(16))) u16 dlds[];
  cg::grid_group grid = cg::this_grid();
  const int rb = blockIdx.x, rnb = gridDim.x;
  const int half = threadIdx.x >> 8;
  const int bid = rb * 2 + half, nb = rnb * 2;
  u16* lds = dlds + half * 36864;
  volatile LAS unsigned* xst = (volatile LAS unsigned*)(dlds + 73728);
  if (threadIdx.x < 4) xst[threadIdx.x] = 0u;
  __syncthreads();
  XcdBarrier xb = xcd_barrier_post((unsigned*)(P.ws + O_BAR + 4096), xst);
  phase0(P, bid, nb, lds); grid.sync();
  phase1(P, rb, rnb, dlds); xcd_barrier(xb);
  phase2(P, bid, nb, lds); xcd_barrier(xb);
  phase3(P, bid, nb, lds); xcd_barrier(xb);
  phase4(P, rb, rnb, dlds); xcd_barrier(xb);
  phase5(P, rb, rnb, dlds); xcd_barrier(xb);
  phase6(P, rb, rnb, dlds); xcd_barrier(xb);
  ln_rows((const float*)(P.ws + O_PRE1), P.ln1_g, P.ln1_b, (u16*)(P.ws + O_H), bid * 4 + (tidx() >> 6), nb * 4);
  xcd_barrier(xb);
  phase8(P, rb, rnb, dlds); xcd_barrier(xb);
  phase9(P, bid, nb, lds); xcd_barrier(xb);
  phase10(P, bid, nb, lds); xcd_barrier(xb);
  phase11(P, bid, nb);
}

extern "C" void kernel_launch(void* const* d_in, const int* in_sizes, int n_in, void* d_out, int out_size, void* d_ws,
                              size_t ws_size, hipStream_t stream) {
  Params p{};
  const float** pp = (const float**)&p;
  for (int i = 0; i < 29; ++i) pp[i] = (const float*)d_in[i];
  p.out = (float*)d_out;
  p.ws = (char*)d_ws;
  if (ws_size < 1001 * MB) fprintf(stderr, "workspace too small: %zu\n", ws_size);
  constexpr size_t kDynLds = 147456 + 16;
  static int grid_blocks = 0;
  if (!grid_blocks) {
    int dev = 0, cus = 0, per_cu = 0;
    (void)hipGetDevice(&dev);
    (void)hipDeviceGetAttribute(&cus, hipDeviceAttributeMultiprocessorCount, dev);
    (void)hipFuncSetAttribute((const void*)mega_kernel, hipFuncAttributeMaxDynamicSharedMemorySize, (int)kDynLds);
    (void)hipOccupancyMaxActiveBlocksPerMultiprocessor(&per_cu, mega_kernel, 512, kDynLds);
    if (per_cu > 1) per_cu = 1;
    grid_blocks = cus * per_cu;
  }
  (void)hipMemsetAsync((char*)d_ws + O_BAR, 0, 4096 + XCD_BAR_WORDS * 4, stream);
  void* args[] = {&p};
  hipError_t e = hipLaunchCooperativeKernel((void*)mega_kernel, dim3(grid_blocks), dim3(512), args, kDynLds, stream);
  if (e != hipSuccess) fprintf(stderr, "cooperative launch failed: %s (grid %d)\n", hipGetErrorString(e), grid_blocks);
}
```

```cpp
#include <hip/hip_runtime.h>
#include <hip/hip_bf16.h>
#include <hip/hip_cooperative_groups.h>
#include <cstdio>
namespace cg = cooperative_groups;

#ifndef MULTI
#define MULTI 0
#endif

typedef unsigned short u16;
using bf16x8 = __attribute__((ext_vector_type(8))) short;
using f32x4 = __attribute__((ext_vector_type(4))) float;

constexpr int T_ = 32768;
constexpr int S_ = 16384;
constexpr int D_ = 2048;
constexpr int SSM_L = 128;
constexpr int SSM_NC = S_ / SSM_L;
constexpr float ALPHA = 1.189207115002721f;
constexpr size_t MB = 1024ull * 1024ull;

constexpr size_t O_WIN = 0 * MB, O_WGLU = 32 * MB, O_WAU = 34 * MB, O_WSU = 38 * MB, O_WOUT = 42 * MB,
                 O_WPQ = 50 * MB, O_WPG = 58 * MB, O_WPIN = 66 * MB, O_SK = 67 * MB, O_BCAT = 67 * MB + 512 * 1024,
                 O_CCAT = 68 * MB, O_LAM = 68 * MB + 256 * 1024, O_UB = 70 * MB, O_VB = 134 * MB, O_SBUF = 198 * MB,
                 O_H = 206 * MB, O_Q = 334 * MB, O_K = 398 * MB, O_VT = 462 * MB, O_U2 = 526 * MB, O_G = 590 * MB,
                 O_YA = 846 * MB, O_YS = 910 * MB, O_PB = 974 * MB;
constexpr size_t O_YG = O_VT, O_MERGED = O_Q, O_PRE1 = O_G, O_PQ = O_Q, O_SG = O_VT, O_E = O_G,
                 O_HV = O_G + 128 * MB, O_HI = O_G + 160 * MB, O_EXP = O_G + 192 * MB, O_GATE = O_G + 208 * MB;

struct Params {
  const float *x, *p, *ln_in_g, *ln_in_b, *w_in, *rel_bias, *lam_re, *lam_im, *log_dt, *b_re, *b_im, *c_re, *c_im,
      *ssm_d, *w_glu, *w_au, *w_su, *w_out, *ln1_g, *ln1_b, *w_pq, *sub_keys, *peer_u, *peer_v, *ple_w_in, *ple_g,
      *ple_w_gate, *ln2_g, *ln2_b;
  float* out;
  char* ws;
};

__device__ __forceinline__ int tidx() { int t = threadIdx.x & 255; asm volatile("" : "+v"(t)); return t; }
__device__ __forceinline__ int rtid() { int t = threadIdx.x; asm volatile("" : "+v"(t)); return t; }
__device__ __forceinline__ u16 f2bf(float f) {
  unsigned u = __float_as_uint(f);
  u += 0x7fffu + ((u >> 16) & 1u);
  return (u16)(u >> 16);
}
__device__ __forceinline__ float bf2f(u16 h) { return __uint_as_float(((unsigned)h) << 16); }
typedef __bf16 hwbf16x2 __attribute__((ext_vector_type(2)));
typedef float hwf32x2 __attribute__((ext_vector_type(2)));
__device__ __forceinline__ unsigned pack2(float a, float b) {
  hwf32x2 v = {a, b};
  hwbf16x2 r = __builtin_convertvector(v, hwbf16x2);
  return *(unsigned*)&r;
}
__device__ __forceinline__ float lo2f(unsigned u) { return __uint_as_float(u << 16); }
__device__ __forceinline__ float hi2f(unsigned u) { return __uint_as_float(u & 0xffff0000u); }
__device__ __forceinline__ float sigmoidf_(float x) { return __builtin_amdgcn_rcpf(1.f + __expf(-x)); }
__device__ __forceinline__ float gelu_tanh(float x) {
  float u = 0.7978845608028654f * (x + 0.044715f * x * x * x);
  float t = 1.f - 2.f * __builtin_amdgcn_rcpf(1.f + __expf(2.f * u));
  return 0.5f * x * (1.f + t);
}
__device__ __forceinline__ float wave_sum(float v) {
#pragma unroll
  for (int o = 32; o >= 1; o >>= 1) v += __shfl_xor(v, o);
  return v;
}
__device__ __forceinline__ void store_bf4(u16* dst, float a, float b, float c, float d) {
  uint2 v; v.x = pack2(a, b); v.y = pack2(c, d);
  *(uint2*)dst = v;
}

__device__ __forceinline__ void gemm_kloop(f32x4 (&acc)[4][4], const u16* __restrict__ A, int lda,
                                           const u16* __restrict__ Bt, int ldb, int K, u16* lds) {
  const int tid = tidx(), lane = tid & 63, wid = tid >> 6, wm = wid >> 1, wn = wid & 1;
  const int lr = lane & 15, lq = lane >> 4;
  const int nk = K >> 6;
  const int srow = tid >> 3, sc = (tid & 7) ^ (srow & 7);
  const u16* ga = A + (size_t)srow * lda + sc * 8;
  const u16* gb = Bt + (size_t)srow * ldb + sc * 8;
  u16* lw = lds + tid * 8;
#pragma unroll
  for (int i = 0; i < 4; ++i) {
    __builtin_amdgcn_global_load_lds((const unsigned*)(ga + (size_t)(32 * i) * lda), (unsigned*)(lw + i * 2048), 16, 0, 0);
    __builtin_amdgcn_global_load_lds((const unsigned*)(gb + (size_t)(32 * i) * ldb), (unsigned*)(lw + 8192 + i * 2048), 16, 0, 0);
  }
  __syncthreads();
  const int swz = lr & 7;
  for (int kt = 0; kt < nk; ++kt) {
    if (kt + 1 < nk) {
      u16* lw2 = lw + ((kt + 1) & 1) * 16384;
#pragma unroll
      for (int i = 0; i < 4; ++i) {
        __builtin_amdgcn_global_load_lds((const unsigned*)(ga + (size_t)(32 * i) * lda + (kt + 1) * 64), (unsigned*)(lw2 + i * 2048), 16, 0, 0);
        __builtin_amdgcn_global_load_lds((const unsigned*)(gb + (size_t)(32 * i) * ldb + (kt + 1) * 64), (unsigned*)(lw2 + 8192 + i * 2048), 16, 0, 0);
      }
    }
    const u16* sa = lds + (kt & 1) * 16384;
    const u16* sb = sa + 8192;
#pragma unroll
    for (int ks = 0; ks < 2; ++ks) {
      bf16x8 af[4], bfr[4];
      const int co = ((ks * 4 + lq) ^ swz) * 8;
#pragma unroll
      for (int mi = 0; mi < 4; ++mi) af[mi] = *(const bf16x8*)(sa + (wm * 64 + mi * 16 + lr) * 64 + co);
#pragma unroll
      for (int ni = 0; ni < 4; ++ni) bfr[ni] = *(const bf16x8*)(sb + (wn * 64 + ni * 16 + lr) * 64 + co);
#pragma unroll
      for (int mi = 0; mi < 4; ++mi)
#pragma unroll
        for (int ni = 0; ni < 4; ++ni)
          acc[mi][ni] = __builtin_amdgcn_mfma_f32_16x16x32_bf16(bfr[ni], af[mi], acc[mi][ni], 0, 0, 0);
    }
    __syncthreads();
  }
}

#define ZERO_ACC(acc)                                   \
  _Pragma("unroll") for (int _a = 0; _a < 4; ++_a)      \
  _Pragma("unroll") for (int _b = 0; _b < 4; ++_b) acc[_a][_b] = f32x4{0.f, 0.f, 0.f, 0.f};

__device__ __forceinline__ void gemm_kloop2(f32x4 (&acc)[4][8], const u16* __restrict__ A, int lda,
                                            const u16* __restrict__ Bt, int ldb, int K, u16* lds) {
  const int tid = tidx(), lane = tid & 63, wid = tid >> 6;
  const int lr = lane & 15, lq = lane >> 4;
  const int nk = K >> 5;
  const int srow = tid >> 2;
  const int sc = (tid & 3) ^ ((0x78 >> (2 * ((tid >> 4) & 3))) & 3);
  const u16* ga = A + (size_t)srow * lda + sc * 8;
  const u16* gb = Bt + (size_t)srow * ldb + sc * 8;
  u16* lw = lds + tid * 8;
#pragma unroll
  for (int i = 0; i < 4; ++i)
    __builtin_amdgcn_global_load_lds((const unsigned*)(ga + (size_t)(64 * i) * lda), (unsigned*)(lw + i * 2048), 16, 0, 0);
#pragma unroll
  for (int i = 0; i < 2; ++i)
    __builtin_amdgcn_global_load_lds((const unsigned*)(gb + (size_t)(64 * i) * ldb), (unsigned*)(lw + 8192 + i * 2048), 16, 0, 0);
  __syncthreads();
  const int co = (lq ^ ((0x78 >> (2 * ((lr >> 2) & 3))) & 3)) * 8;
  for (int kt = 0; kt < nk; ++kt) {
    if (kt + 1 < nk) {
      u16* lw2 = lw + ((kt + 1) & 1) * 12288;
#pragma unroll
      for (int i = 0; i < 4; ++i)
        __builtin_amdgcn_global_load_lds((const unsigned*)(ga + (size_t)(64 * i) * lda + (kt + 1) * 32), (unsigned*)(lw2 + i * 2048), 16, 0, 0);
#pragma unroll
      for (int i = 0; i < 2; ++i)
        __builtin_amdgcn_global_load_lds((const unsigned*)(gb + (size_t)(64 * i) * ldb + (kt + 1) * 32), (unsigned*)(lw2 + 8192 + i * 2048), 16, 0, 0);
    }
    const u16* sa = lds + (kt & 1) * 12288;
    const u16* sb = sa + 8192;
    bf16x8 af[4];
#pragma unroll
    for (int mi = 0; mi < 4; ++mi) af[mi] = *(const bf16x8*)(sa + (wid * 64 + mi * 16 + lr) * 32 + co);
#pragma unroll
    for (int nh = 0; nh < 2; ++nh) {
      bf16x8 bfr[4];
#pragma unroll
      for (int ni = 0; ni < 4; ++ni) bfr[ni] = *(const bf16x8*)(sb + ((nh * 4 + ni) * 16 + lr) * 32 + co);
#pragma unroll
      for (int mi = 0; mi < 4; ++mi)
#pragma unroll
        for (int ni = 0; ni < 4; ++ni)
          acc[mi][nh * 4 + ni] = __builtin_amdgcn_mfma_f32_16x16x32_bf16(bfr[ni], af[mi], acc[mi][nh * 4 + ni], 0, 0, 0);
    }
    __syncthreads();
  }
}

__device__ __forceinline__ void gemm_kloop3(f32x4 (&acc)[4][8], const u16* __restrict__ A, int lda,
                                            const u16* __restrict__ Bt, int ldb, int K, u16* lds) {
  const int tid = rtid(), lane = tid & 63, wid = tid >> 6, wm = wid >> 1, wn = wid & 1;
  const int lr = lane & 15, lq = lane >> 4;
  const int nk = K >> 6;
  const int srow = tid >> 3, sc = (tid & 7) ^ (srow & 7);
  const u16* ga = A + (size_t)srow * lda + sc * 8;
  const u16* gb = Bt + (size_t)srow * ldb + sc * 8;
  u16* lw = lds + tid * 8;
#pragma unroll
  for (int i = 0; i < 4; ++i) {
    __builtin_amdgcn_global_load_lds((const unsigned*)(ga + (size_t)(64 * i) * lda), (unsigned*)(lw + i * 4096), 16, 0, 0);
    __builtin_amdgcn_global_load_lds((const unsigned*)(gb + (size_t)(64 * i) * ldb), (unsigned*)(lw + 16384 + i * 4096), 16, 0, 0);
  }
  __syncthreads();
  const int swz = lr & 7;
  for (int kt = 0; kt < nk; ++kt) {
    const int ko = min(kt + 1, nk - 1) * 64;
    u16* lw2 = lw + ((kt + 1) & 1) * 32768;
    const u16* sa = lds + (kt & 1) * 32768;
    const u16* sb = sa + 16384;
#pragma unroll
    for (int ks = 0; ks < 2; ++ks) {
      const int co = ((ks * 4 + lq) ^ swz) * 8;
      bf16x8 af[4];
#pragma unroll
      for (int mi = 0; mi < 4; ++mi) af[mi] = *(const bf16x8*)(sa + (wm * 64 + mi * 16 + lr) * 64 + co);
#pragma unroll
      for (int nh = 0; nh < 2; ++nh) {
        bf16x8 bfr[4];
#pragma unroll
        for (int ni = 0; ni < 4; ++ni) bfr[ni] = *(const bf16x8*)(sb + (wn * 128 + (nh * 4 + ni) * 16 + lr) * 64 + co);
        if (ks == 0) __builtin_amdgcn_sched_barrier(0);
#pragma unroll
        for (int mi = 0; mi < 4; ++mi) {
#pragma unroll
          for (int ni = 0; ni < 4; ++ni)
            acc[mi][nh * 4 + ni] = __builtin_amdgcn_mfma_f32_16x16x32_bf16(bfr[ni], af[mi], acc[mi][nh * 4 + ni], 0, 0, 0);
          if (ks == 0) {
            if (nh == 0)
              __builtin_amdgcn_global_load_lds((const unsigned*)(ga + (size_t)(64 * mi) * lda + ko), (unsigned*)(lw2 + mi * 4096), 16, 0, 0);
            else
              __builtin_amdgcn_global_load_lds((const unsigned*)(gb + (size_t)(64 * mi) * ldb + ko), (unsigned*)(lw2 + 16384 + mi * 4096), 16, 0, 0);
            __builtin_amdgcn_sched_barrier(0);
          }
        }
      }
    }
    __syncthreads();
  }
}

#define EPI_COORDS3                                                             \
  const int lane = rtid() & 63, wid = rtid() >> 6, wm = wid >> 1, wn = wid & 1; \
  const int lr = lane & 15, lq = lane >> 4;

#define ZERO_ACC8(acc)                                  \
  _Pragma("unroll") for (int _a = 0; _a < 4; ++_a)      \
  _Pragma("unroll") for (int _b = 0; _b < 8; ++_b) acc[_a][_b] = f32x4{0.f, 0.f, 0.f, 0.f};

#define FOR_TILES_XCD(t, ntiles) \
  for (int _k = 0, t = (bid & 7) * (nb >> 3) + (bid >> 3); t < (ntiles); ++_k, t = ((_k * 8 + (bid & 7)) * (nb >> 3)) + (bid >> 3))

#define EPI_COORDS                                                             \
  const int lane = tidx() & 63, wid = tidx() >> 6, wm = wid >> 1, wn = wid & 1; \
  const int lr = lane & 15, lq = lane >> 4;

__device__ void tconv_tile(const float* __restrict__ W, int K, int N, u16* __restrict__ Wt, int tile, float* lds) {
  const int tid = tidx();
  const int ntn = N >> 6;
  const int kt = tile / ntn, nt = tile % ntn;
  const int c4 = (tid & 15) * 4;
#pragma unroll
  for (int i = 0; i < 4; ++i) {
    int r = (tid >> 4) + 16 * i;
    float4 v = *(const float4*)(W + (size_t)(kt * 64 + r) * N + nt * 64 + c4);
    lds[r * 65 + c4 + 0] = v.x; lds[r * 65 + c4 + 1] = v.y; lds[r * 65 + c4 + 2] = v.z; lds[r * 65 + c4 + 3] = v.w;
  }
  __syncthreads();
  const int n = tid >> 2, kseg = (tid & 3) * 16;
  unsigned o[8];
#pragma unroll
  for (int j = 0; j < 8; ++j) o[j] = pack2(lds[(kseg + 2 * j) * 65 + n], lds[(kseg + 2 * j + 1) * 65 + n]);
  u16* dst = Wt + (size_t)(nt * 64 + n) * K + kt * 64 + kseg;
  *(uint4*)dst = uint4{o[0], o[1], o[2], o[3]};
  *(uint4*)(dst + 8) = uint4{o[4], o[5], o[6], o[7]};
  __syncthreads();
}

__device__ void conv_linear(const float* __restrict__ src, u16* __restrict__ dst, size_t n8, size_t gtid, size_t nth) {
  for (size_t i = gtid; i < n8; i += nth) {
    float4 a = *(const float4*)(src + i * 8), b = *(const float4*)(src + i * 8 + 4);
    *(uint4*)(dst + i * 8) = uint4{pack2(a.x, a.y), pack2(a.z, a.w), pack2(b.x, b.y), pack2(b.z, b.w)};
  }
}

typedef float f32x2 __attribute__((ext_vector_type(2)));
constexpr size_t O_U8 = O_UB, O_V8 = O_UB + 32 * MB, O_RSU = O_VB, O_RSV = O_VB + 64 * 1024;
__device__ void conv_fp8_rows(const float* __restrict__ src, unsigned char* __restrict__ dst, float* __restrict__ rscale,
                              int gw, int nw) {
  const int lane = tidx() & 63;
  for (int row = gw; row < 16384; row += nw) {
    const float* r = src + (size_t)row * D_;
    float4 v[8];
#pragma unroll
    for (int q = 0; q < 8; ++q) v[q] = *(const float4*)(r + q * 256 + lane * 4);
    float am = 0.f;
#pragma unroll
    for (int q = 0; q < 8; ++q) am = fmaxf(am, fmaxf(fmaxf(fabsf(v[q].x), fabsf(v[q].y)), fmaxf(fabsf(v[q].z), fabsf(v[q].w))));
#pragma unroll
    for (int o = 32; o >= 1; o >>= 1) am = fmaxf(am, __shfl_xor(am, o));
    const float sc = am > 0.f ? 416.f / am : 1.f;
#pragma unroll
    for (int q = 0; q < 8; ++q) {
      int w = 0;
      w = __builtin_amdgcn_cvt_pk_fp8_f32(v[q].x * sc, v[q].y * sc, w, false);
      w = __builtin_amdgcn_cvt_pk_fp8_f32(v[q].z * sc, v[q].w * sc, w, true);
      *(int*)(dst + (size_t)row * D_ + q * 256 + lane * 4) = w;
    }
    if (lane == 0) rscale[row] = am > 0.f ? am / 416.f : 1.f;
  }
}

__device__ void ln_rows(const float* __restrict__ src, const float* __restrict__ g, const float* __restrict__ b,
                        u16* __restrict__ dst, int gw, int nw) {
  const int lane = tidx() & 63;
  for (int row = gw; row < T_; row += nw) {
    const float* r = src + (size_t)row * D_;
    float4 v[8];
#pragma unroll
    for (int q = 0; q < 8; ++q) v[q] = *(const float4*)(r + q * 256 + lane * 4);
    float s = 0.f;
#pragma unroll
    for (int q = 0; q < 8; ++q) s += v[q].x + v[q].y + v[q].z + v[q].w;
    float mu = wave_sum(s) * (1.f / D_);
    float ss = 0.f;
#pragma unroll
    for (int q = 0; q < 8; ++q) {
      float a = v[q].x - mu, bb = v[q].y - mu, c = v[q].z - mu, d = v[q].w - mu;
      ss += a * a + bb * bb + c * c + d * d;
    }
    float rstd = rsqrtf(wave_sum(ss) * (1.f / D_) + 1e-5f);
#pragma unroll
    for (int q = 0; q < 8; ++q) {
      int col = q * 256 + lane * 4;
      float4 gg = *(const float4*)(g + col), bb = *(const float4*)(b + col);
      store_bf4(dst + (size_t)row * D_ + col, (v[q].x - mu) * rstd * gg.x + bb.x, (v[q].y - mu) * rstd * gg.y + bb.y,
                (v[q].z - mu) * rstd * gg.z + bb.z, (v[q].w - mu) * rstd * gg.w + bb.w);
    }
  }
}

__device__ __forceinline__ void dsincos(double x, double& s, double& c) {
  double q = rint(x * 0.63661977236758134308);
  double r = x - q * 1.57079632679489661923;
  double r2 = r * r;
  double sp = r * (1.0 + r2 * (-1.0 / 6 + r2 * (1.0 / 120 + r2 * (-1.0 / 5040 + r2 * (1.0 / 362880 + r2 * (-1.0 / 39916800 + r2 * (1.0 / 6227020800.0)))))));
  double cp = 1.0 + r2 * (-0.5 + r2 * (1.0 / 24 + r2 * (-1.0 / 720 + r2 * (1.0 / 40320 + r2 * (-1.0 / 3628800 + r2 * (1.0 / 479001600.0 + r2 * (-1.0 / 87178291200.0)))))));
  int qi = ((int)q) & 3;
  if (qi == 0) { s = sp; c = cp; }
  else if (qi == 1) { s = cp; c = -sp; }
  else if (qi == 2) { s = -sp; c = -cp; }
  else { s = -cp; c = sp; }
}

__device__ void ssm_consts(const Params& P, int i) {
  const int g = i >> 6, p = i & 63;
  double lr = P.lam_re[g * 64 + p], li = P.lam_im[g * 64 + p];
  double dt = exp((double)P.log_dt[g]);
  double mag = exp(lr * dt);
  double sn, cs;
  dsincos(li * dt, sn, cs);
  double ar = mag * cs, ai = mag * sn;
  double nr = ar - 1.0, ni = ai, den = lr * lr + li * li;
  double fr = (nr * lr + ni * li) / den, fi = (ni * lr - nr * li) / den;
  u16* bcat = (u16*)(P.ws + O_BCAT);
  u16* ccat = (u16*)(P.ws + O_CCAT);
  float* lam = (float*)(P.ws + O_LAM);
  for (int h = 0; h < 16; ++h) {
    double br = P.b_re[(g * 64 + p) * 16 + h], bi = P.b_im[(g * 64 + p) * 16 + h];
    bcat[(g * 128 + p) * 32 + h] = f2bf((float)(fr * br - fi * bi));
    bcat[(g * 128 + 64 + p) * 32 + h] = f2bf((float)(fr * bi + fi * br));
    bcat[(g * 128 + p) * 32 + 16 + h] = 0;
    bcat[(g * 128 + 64 + p) * 32 + 16 + h] = 0;
    ccat[(g * 16 + h) * 128 + p] = f2bf(P.c_re[(g * 16 + h) * 64 + p]);
    ccat[(g * 16 + h) * 128 + 64 + p] = f2bf(-P.c_im[(g * 16 + h) * 64 + p]);
  }
  double pr = ar, pi = ai;
  for (int k = 0; k < 10; ++k) {
    double t = pr * pr - pi * pi;
    pi = 2.0 * pr * pi;
    pr = t;
  }
  lam[0 * 4096 + i] = (float)ar;
  lam[1 * 4096 + i] = (float)ai;
  lam[2 * 4096 + i] = (float)pr;
  lam[3 * 4096 + i] = (float)pi;
}

__device__ void phase0(const Params& P, int bid, int nb, u16* lds) {
  const size_t gtid = (size_t)bid * 256 + tidx(), nth = (size_t)nb * 256;
#define TCONV(wp, KK, NN, OFF) \
  for (int t = bid; t < ((KK) >> 6) * ((NN) >> 6); t += nb) tconv_tile(wp, KK, NN, (u16*)(P.ws + OFF), t, (float*)lds);
  TCONV(P.w_in, 2048, 8192, O_WIN)
  TCONV(P.w_glu, 1024, 1024, O_WGLU)
  TCONV(P.w_au, 1024, 2048, O_WAU)
  TCONV(P.w_su, 1024, 2048, O_WSU)
  TCONV(P.w_out, 2048, 2048, O_WOUT)
  TCONV(P.w_pq, 2048, 2048, O_WPQ)
  TCONV(P.ple_w_gate, 2048, 2048, O_WPG)
  TCONV(P.ple_w_in, 256, 2048, O_WPIN)
  conv_fp8_rows(P.peer_u, (unsigned char*)(P.ws + O_U8), (float*)(P.ws + O_RSU), bid * 4 + (tidx() >> 6), nb * 4);
  conv_fp8_rows(P.peer_v, (unsigned char*)(P.ws + O_V8), (float*)(P.ws + O_RSV), bid * 4 + (tidx() >> 6), nb * 4);
  conv_linear(P.sub_keys, (u16*)(P.ws + O_SK), (size_t)16 * 128 * 128 / 8, gtid, nth);
  conv_linear(P.p, (u16*)(P.ws + O_PB), (size_t)T_ * 256 / 8, gtid, nth);
  for (size_t i = gtid; i < 4096; i += nth) ssm_consts(P, (int)i);
  ln_rows(P.x, P.ln_in_g, P.ln_in_b, (u16*)(P.ws + O_H), bid * 4 + (tidx() >> 6), nb * 4);
}

__device__ void phase1(const Params& P, int bid, int nb, u16* lds) {
  const u16* H = (const u16*)(P.ws + O_H);
  const u16* W = (const u16*)(P.ws + O_WIN);
  u16* Q = (u16*)(P.ws + O_Q);
  u16* Kb = (u16*)(P.ws + O_K);
  u16* Vt = (u16*)(P.ws + O_VT);
  u16* U2 = (u16*)(P.ws + O_U2);
  u16* G = (u16*)(P.ws + O_G);
  EPI_COORDS3
  const int ntiles = 128 * 32;
  for (int t = bid; t < ntiles; t += nb) {
    const int mt = t >> 5, nt = t & 31;
    f32x4 acc[4][8];
    ZERO_ACC8(acc)
    gemm_kloop3(acc, H + (size_t)mt * 256 * D_, D_, W + (size_t)nt * 256 * D_, D_, D_, lds);
    const int region = (nt * 256 + wn * 128) >> 10;
#pragma unroll
    for (int mi = 0; mi < 4; ++mi) {
      const int m = mt * 256 + wm * 64 + mi * 16 + lr;
#pragma unroll
      for (int ni = 0; ni < 8; ++ni) {
        const int n = nt * 256 + wn * 128 + ni * 16 + lq * 4;
        f32x4 a = acc[mi][ni];
        if (region == 0) {
          const float sc = 0.08838834764831845f;
          store_bf4(Q + (size_t)m * 1024 + n, a[0] * sc, a[1] * sc, a[2] * sc, a[3] * sc);
        } else if (region == 1) {
          store_bf4(Kb + (size_t)m * 1024 + (n - 1024), a[0], a[1], a[2], a[3]);
        } else if (region == 2) {
          const int b = m >> 14, tt = m & (S_ - 1);
#pragma unroll
          for (int j = 0; j < 4; ++j) Vt[((size_t)(b * 1024 + (n - 2048 + j))) * S_ + tt] = f2bf(a[j]);
        } else if (region == 3) {
          store_bf4(U2 + (size_t)m * 1024 + (n - 3072), a[0], a[1], a[2], a[3]);
        } else {
          store_bf4(G + (size_t)m * 4096 + (n - 4096), sigmoidf_(a[0]), sigmoidf_(a[1]), sigmoidf_(a[2]), sigmoidf_(a[3]));
        }
      }
    }
  }
}

__device__ void attn_item(const Params& P, int item, u16* lds) {
  const int c = item >> 4, hd = item & 7, b = (item >> 3) & 1;
  const int tid = tidx(), lane = tid & 63, w = tid >> 6, lr = lane & 15, lq = lane >> 4;
  u16* Ks = lds;
  u16* Vs = lds + 64 * 136;
  float* bs = (float*)(lds + 64 * 136 + 128 * 72);
  const u16* Q = (const u16*)(P.ws + O_Q);
  const u16* Kb = (const u16*)(P.ws + O_K);
  const u16* Vt = (const u16*)(P.ws + O_VT);
  u16* ya = (u16*)(P.ws + O_YA);
  __syncthreads();
  for (int i = tid; i < 257; i += 256) bs[i] = P.rel_bias[hd * 257 + i];
  bf16x8 qf[4];
  {
    const u16* qp = Q + (size_t)(b * S_ + c * 64 + w * 16 + lr) * 1024 + hd * 128 + lq * 8;
#pragma unroll
    for (int ks = 0; ks < 4; ++ks) qf[ks] = *(const bf16x8*)(qp + ks * 32);
  }
  f32x4 oacc[8];
#pragma unroll
  for (int d = 0; d < 8; ++d) oacc[d] = f32x4{0.f, 0.f, 0.f, 0.f};
  float m_run = -1e30f, lsum = 0.f;
  const int i0 = (c < 8) ? (8 - c) : 0;
  const int qi = w * 16 + lr;
#define KV_ADDR_K(r, kc_) (Kb + (size_t)(b * S_ + (kc_) * 64 + ((tid + 256 * (r)) >> 4)) * 1024 + hd * 128 + ((tid + 256 * (r)) & 15) * 8)
#define KV_ADDR_V(r, kc_) (Vt + ((size_t)(b * 1024 + hd * 128 + ((tid + 256 * (r)) >> 3))) * S_ + (kc_) * 64 + ((tid + 256 * (r)) & 7) * 8)
#define KV_LOAD(kc_)                                                                   \
  kr0 = *(const uint4*)KV_ADDR_K(0, kc_); kr1 = *(const uint4*)KV_ADDR_K(1, kc_);     \
  kr2 = *(const uint4*)KV_ADDR_K(2, kc_); kr3 = *(const uint4*)KV_ADDR_K(3, kc_);     \
  vr0 = *(const uint4*)KV_ADDR_V(0, kc_); vr1 = *(const uint4*)KV_ADDR_V(1, kc_);     \
  vr2 = *(const uint4*)KV_ADDR_V(2, kc_); vr3 = *(const uint4*)KV_ADDR_V(3, kc_);
#define KS_W(r) (Ks + ((tid + 256 * (r)) >> 4) * 136 + ((tid + 256 * (r)) & 15) * 8)
#define VS_W(r) (Vs + ((tid + 256 * (r)) >> 3) * 72 + ((tid + 256 * (r)) & 7) * 8)
#define KV_LOADS(S, kc_)                                                                \
  S##k0 = *(const uint4*)KV_ADDR_K(0, kc_); S##k1 = *(const uint4*)KV_ADDR_K(1, kc_);   \
  S##k2 = *(const uint4*)KV_ADDR_K(2, kc_); S##k3 = *(const uint4*)KV_ADDR_K(3, kc_);   \
  S##v0 = *(const uint4*)KV_ADDR_V(0, kc_); S##v1 = *(const uint4*)KV_ADDR_V(1, kc_);   \
  S##v2 = *(const uint4*)KV_ADDR_V(2, kc_); S##v3 = *(const uint4*)KV_ADDR_V(3, kc_);
#define KV_WRITES(S)                                                                                   \
  *(uint4*)KS_W(0) = S##k0; *(uint4*)KS_W(1) = S##k1; *(uint4*)KS_W(2) = S##k2; *(uint4*)KS_W(3) = S##k3; \
  *(uint4*)VS_W(0) = S##v0; *(uint4*)VS_W(1) = S##v1; *(uint4*)VS_W(2) = S##v2; *(uint4*)VS_W(3) = S##v3;
  uint4 Ak0, Ak1, Ak2, Ak3, Av0, Av1, Av2, Av3, Bk0, Bk1, Bk2, Bk3, Bv0, Bv1, Bv2, Bv3;
  auto tile_compute = [&](const int i) {
    f32x4 sacc[4];
#pragma unroll
    for (int kt = 0; kt < 4; ++kt) {
      sacc[kt] = f32x4{0.f, 0.f, 0.f, 0.f};
#pragma unroll
      for (int ks = 0; ks < 4; ++ks) {
        bf16x8 kf = *(const bf16x8*)(Ks + (kt * 16 + lr) * 136 + ks * 32 + lq * 8);
        sacc[kt] = __builtin_amdgcn_mfma_f32_16x16x32_bf16(kf, qf[ks], sacc[kt], 0, 0, 0);
      }
    }
    float tmax = -1e30f;
#pragma unroll
    for (int kt = 0; kt < 4; ++kt)
#pragma unroll
      for (int j = 0; j < 4; ++j) {
        int kb = i * 64 + kt * 16 + lq * 4 + j;
        int rel = 512 + qi - kb;
        rel = min(max(rel, -128), 128) + 128;
        float s = sacc[kt][j] + bs[rel];
        sacc[kt][j] = s;
        tmax = fmaxf(tmax, s);
      }
    tmax = fmaxf(tmax, __shfl_xor(tmax, 16));
    tmax = fmaxf(tmax, __shfl_xor(tmax, 32));
    const float m_new = fmaxf(m_run, tmax);
    const float corr = __expf(m_run - m_new);
    m_run = m_new;
    float ps = 0.f;
#pragma unroll
    for (int kt = 0; kt < 4; ++kt)
#pragma unroll
      for (int j = 0; j < 4; ++j) {
        float pv = __expf(sacc[kt][j] - m_new);
        sacc[kt][j] = pv;
        ps += pv;
      }
    lsum = lsum * corr + ps;
#pragma unroll
    for (int d = 0; d < 8; ++d) {
      oacc[d][0] *= corr; oacc[d][1] *= corr; oacc[d][2] *= corr; oacc[d][3] *= corr;
    }
#pragma unroll
    for (int kk = 0; kk < 2; ++kk) {
      union { bf16x8 v; unsigned u[4]; } pf;
      pf.u[0] = pack2(sacc[2 * kk][0], sacc[2 * kk][1]);
      pf.u[1] = pack2(sacc[2 * kk][2], sacc[2 * kk][3]);
      pf.u[2] = pack2(sacc[2 * kk + 1][0], sacc[2 * kk + 1][1]);
      pf.u[3] = pack2(sacc[2 * kk + 1][2], sacc[2 * kk + 1][3]);
#pragma unroll
      for (int d = 0; d < 8; ++d) {
        union { bf16x8 v; uint2 h[2]; } vf;
        vf.h[0] = *(const uint2*)(Vs + (d * 16 + lr) * 72 + kk * 32 + lq * 4);
        vf.h[1] = *(const uint2*)(Vs + (d * 16 + lr) * 72 + kk * 32 + 16 + lq * 4);
        oacc[d] = __builtin_amdgcn_mfma_f32_16x16x32_bf16(vf.v, pf.v, oacc[d], 0, 0, 0);
      }
    }
  };
  KV_LOADS(A, c - 8 + i0)
  if (i0 + 1 <= 8) { KV_LOADS(B, c - 8 + i0 + 1) }
  for (int i = i0; i <= 8; i += 2) {
    __syncthreads();
    KV_WRITES(A)
    __syncthreads();
    if (i + 2 <= 8) { KV_LOADS(A, c - 8 + i + 2) }
    tile_compute(i);
    if (i + 1 > 8) break;
    __syncthreads();
    KV_WRITES(B)
    __syncthreads();
    if (i + 3 <= 8) { KV_LOADS(B, c - 8 + i + 3) }
    tile_compute(i + 1);
  }
  lsum += __shfl_xor(lsum, 16);
  lsum += __shfl_xor(lsum, 32);
  const float inv = 1.f / lsum;
  u16* op = ya + (size_t)(b * S_ + c * 64 + w * 16 + lr) * 1024 + hd * 128 + lq * 4;
#pragma unroll
  for (int d = 0; d < 8; ++d) store_bf4(op + d * 16, oacc[d][0] * inv, oacc[d][1] * inv, oacc[d][2] * inv, oacc[d][3] * inv);
}

template <int PASS>
__device__ void ssm_item(const Params& P, int item, char* ldsw) {
  const int sc = item & 15, seq = item >> 4, g = seq & 63, b = seq >> 6;
  const int lane = tidx() & 63, lr = lane & 15, lq = lane >> 4;
  float* BuS = (float*)ldsw;
  u16* Hs = (u16*)(ldsw + 8448);
  const u16* bcat = (const u16*)(P.ws + O_BCAT);
  const u16* ccat = (const u16*)(P.ws + O_CCAT);
  const float* lam = (const float*)(P.ws + O_LAM);
  const u16* U2 = (const u16*)(P.ws + O_U2);
  float* Sbuf = (float*)(P.ws + O_SBUF);
  u16* ys = (u16*)(P.ws + O_YS);
  const float ar = lam[g * 64 + lane], ai = lam[4096 + g * 64 + lane];
  bf16x8 bfrag[8];
#pragma unroll
  for (int nt = 0; nt < 8; ++nt) bfrag[nt] = *(const bf16x8*)(bcat + (g * 128 + nt * 16 + lr) * 32 + lq * 8);
  float sr = 0.f, si = 0.f;
  bf16x8 cfrag[4];
  float dsk[4];
  if (PASS == 2) {
#pragma unroll
    for (int ks = 0; ks < 4; ++ks) cfrag[ks] = *(const bf16x8*)(ccat + (g * 16 + lr) * 128 + ks * 32 + lq * 8);
#pragma unroll
    for (int j = 0; j < 4; ++j) dsk[j] = P.ssm_d[g * 16 + lq * 4 + j];
    const float aLr = lam[2 * 4096 + g * 64 + lane], aLi = lam[3 * 4096 + g * 64 + lane];
    const float* Sb = Sbuf + (size_t)seq * 16 * 128;
#pragma unroll 4
    for (int cc = 0; cc < sc; ++cc) {
      float xr = Sb[cc * 128 + lane], xi = Sb[cc * 128 + 64 + lane];
      float nr = fmaf(aLr, sr, fmaf(-aLi, si, xr));
      float ni = fmaf(aLr, si, fmaf(aLi, sr, xi));
      sr = nr; si = ni;
    }
  }
#pragma unroll 1
  for (int ci = 0; ci < 8; ++ci) {
  const size_t tok_base = (size_t)b * S_ + (size_t)(sc * 8 + ci) * SSM_L;
  uint4 upre[SSM_L / 16];
  uint2 uepi[SSM_L / 16];
#pragma unroll
  for (int sub = 0; sub < SSM_L / 16; ++sub) {
    upre[sub] = uint4{0u, 0u, 0u, 0u};
    if (lq < 2) upre[sub] = *(const uint4*)(U2 + (tok_base + sub * 16 + lr) * 1024 + g * 16 + lq * 8);
    if (PASS == 2) uepi[sub] = *(const uint2*)(U2 + (tok_base + sub * 16 + lr) * 1024 + g * 16 + lq * 4);
  }
#pragma unroll
  for (int sub = 0; sub < SSM_L / 16; ++sub) {
    const size_t tok0 = tok_base + sub * 16;
    union { bf16x8 v; uint4 u; } uf;
    uf.u = upre[sub];
#pragma unroll
    for (int nt = 0; nt < 8; ++nt) {
      f32x4 d = __builtin_amdgcn_mfma_f32_16x16x32_bf16(bfrag[nt], uf.v, f32x4{0.f, 0.f, 0.f, 0.f}, 0, 0, 0);
      *(f32x4*)(BuS + lr * 132 + nt * 16 + lq * 4) = d;
    }
    asm volatile("s_waitcnt lgkmcnt(0)" ::: "memory");
    float bur[16], bui[16];
#pragma unroll
    for (int t = 0; t < 16; ++t) { bur[t] = BuS[t * 132 + lane]; bui[t] = BuS[t * 132 + 64 + lane]; }
    asm volatile("s_waitcnt lgkmcnt(0)" ::: "memory");
#pragma unroll
    for (int t = 0; t < 16; ++t) {
      float nr = fmaf(ar, sr, fmaf(-ai, si, bur[t]));
      float ni = fmaf(ar, si, fmaf(ai, sr, bui[t]));
      sr = nr; si = ni;
      if (PASS == 2) {
        const unsigned pk = pack2(sr, si);
        Hs[t * 136 + lane] = (u16)(pk & 0xffffu);
        Hs[t * 136 + 64 + lane] = (u16)(pk >> 16);
      }
    }
    asm volatile("s_waitcnt lgkmcnt(0)" ::: "memory");
    if (PASS == 2) {
      f32x4 yacc = f32x4{0.f, 0.f, 0.f, 0.f};
#pragma unroll
      for (int ks = 0; ks < 4; ++ks) {
        bf16x8 hf = *(const bf16x8*)(Hs + lr * 136 + ks * 32 + lq * 8);
        yacc = __builtin_amdgcn_mfma_f32_16x16x32_bf16(cfrag[ks], hf, yacc, 0, 0, 0);
      }
      const uint2 uu = uepi[sub];
      float y0 = gelu_tanh(yacc[0] + dsk[0] * lo2f(uu.x));
      float y1 = gelu_tanh(yacc[1] + dsk[1] * hi2f(uu.x));
      float y2 = gelu_tanh(yacc[2] + dsk[2] * lo2f(uu.y));
      float y3 = gelu_tanh(yacc[3] + dsk[3] * hi2f(uu.y));
      store_bf4(ys + (tok0 + lr) * 1024 + g * 16 + lq * 4, y0, y1, y2, y3);
      asm volatile("s_waitcnt lgkmcnt(0)" ::: "memory");
    }
  }
  }
  if (PASS == 1) {
    Sbuf[((size_t)seq * 16 + sc) * 128 + lane] = sr;
    Sbuf[((size_t)seq * 16 + sc) * 128 + 64 + lane] = si;
  }
}

__device__ void phase2(const Params& P, int bid, int nb, u16* lds) {
  for (int it = bid; it < 4096 + 512; it += nb) {
    if (it < 4096) {
      attn_item(P, it, lds);
    } else {
      __syncthreads();
      const int w = tidx() >> 6;
      ssm_item<1>(P, (it - 4096) * 4 + w, (char*)lds + w * 12800);
    }
  }
}
__device__ void phase3(const Params& P, int bid, int nb, u16* lds) {
  const int w = tidx() >> 6;
  for (int it = bid; it < 512; it += nb) ssm_item<2>(P, it * 4 + w, (char*)lds + w * 12800);
}

__device__ void phase4(const Params& P, int bid, int nb, u16* lds) {
  const u16* ys = (const u16*)(P.ws + O_YS);
  const u16* W = (const u16*)(P.ws + O_WGLU);
  u16* yg = (u16*)(P.ws + O_YG);
  EPI_COORDS3
  FOR_TILES_XCD(t, 128 * 4) {
    const int mt = t >> 2, nt = t & 3;
    f32x4 acc[4][8];
    ZERO_ACC8(acc)
    gemm_kloop3(acc, ys + (size_t)mt * 256 * 1024, 1024, W + (size_t)nt * 256 * 1024, 1024, 1024, lds);
#pragma unroll
    for (int mi = 0; mi < 4; ++mi) {
      const int m = mt * 256 + wm * 64 + mi * 16 + lr;
#pragma unroll
      for (int ni = 0; ni < 8; ++ni) {
        const int n = nt * 256 + wn * 128 + ni * 16 + lq * 4;
        uint2 yy = *(const uint2*)(ys + (size_t)m * 1024 + n);
        f32x4 a = acc[mi][ni];
        store_bf4(yg + (size_t)m * 1024 + n, lo2f(yy.x) * sigmoidf_(a[0]), hi2f(yy.x) * sigmoidf_(a[1]),
                  lo2f(yy.y) * sigmoidf_(a[2]), hi2f(yy.y) * sigmoidf_(a[3]));
      }
    }
  }
}

__device__ void phase5(const Params& P, int bid, int nb, u16* lds) {
  const u16* ya = (const u16*)(P.ws + O_YA);
  const u16* yg = (const u16*)(P.ws + O_YG);
  const u16* Wa = (const u16*)(P.ws + O_WAU);
  const u16* Wsu = (const u16*)(P.ws + O_WSU);
  const u16* G = (const u16*)(P.ws + O_G);
  u16* mg = (u16*)(P.ws + O_MERGED);
  EPI_COORDS3
  FOR_TILES_XCD(t, 128 * 8) {
    const int mt = t >> 3, nt = t & 7;
#pragma unroll 1
    for (int part = 0; part < 2; ++part) {
      f32x4 acc[4][8];
      ZERO_ACC8(acc)
      gemm_kloop3(acc, (part ? yg : ya) + (size_t)mt * 256 * 1024, 1024, (part ? Wsu : Wa) + (size_t)nt * 256 * 1024, 1024,
                  1024, lds);
      const u16* Gp = G + part * 2048;
#pragma unroll
      for (int mi = 0; mi < 4; ++mi) {
        const int m = mt * 256 + wm * 64 + mi * 16 + lr;
#pragma unroll
        for (int ni = 0; ni < 8; ++ni) {
          const int n = nt * 256 + wn * 128 + ni * 16 + lq * 4;
          const uint2 gg = *(const uint2*)(Gp + (size_t)m * 4096 + n);
          f32x4 a = acc[mi][ni];
          float o0 = a[0] * lo2f(gg.x), o1 = a[1] * hi2f(gg.x), o2 = a[2] * lo2f(gg.y), o3 = a[3] * hi2f(gg.y);
          if (part) {
            const uint2 pv = *(const uint2*)(mg + (size_t)m * D_ + n);
            o0 += lo2f(pv.x); o1 += hi2f(pv.x); o2 += lo2f(pv.y); o3 += hi2f(pv.y);
          }
          store_bf4(mg + (size_t)m * D_ + n, o0, o1, o2, o3);
        }
      }
    }
  }
}

__device__ void phase6(const Params& P, int bid, int nb, u16* lds) {
  const u16* mg = (const u16*)(P.ws + O_MERGED);
  const u16* W = (const u16*)(P.ws + O_WOUT);
  const u16* H = (const u16*)(P.ws + O_H);
  float* pre1 = (float*)(P.ws + O_PRE1);
  EPI_COORDS3
  FOR_TILES_XCD(t, 128 * 8) {
    const int mt = t >> 3, nt = t & 7;
    f32x4 acc[4][8];
    ZERO_ACC8(acc)
    gemm_kloop3(acc, mg + (size_t)mt * 256 * D_, D_, W + (size_t)nt * 256 * D_, D_, D_, lds);
#pragma unroll
    for (int mi = 0; mi < 4; ++mi) {
      const int m = mt * 256 + wm * 64 + mi * 16 + lr;
#pragma unroll
      for (int ni = 0; ni < 8; ++ni) {
        const int n = nt * 256 + wn * 128 + ni * 16 + lq * 4;
        uint2 hh = *(const uint2*)(H + (size_t)m * D_ + n);
        f32x4 a = acc[mi][ni];
        float4 o;
        o.x = ALPHA * lo2f(hh.x) + a[0]; o.y = ALPHA * hi2f(hh.x) + a[1];
        o.z = ALPHA * lo2f(hh.y) + a[2]; o.w = ALPHA * hi2f(hh.y) + a[3];
        *(float4*)(pre1 + (size_t)m * D_ + n) = o;
      }
    }
  }
}

__device__ void phase8(const Params& P, int bid, int nb, u16* lds) {
  const u16* H = (const u16*)(P.ws + O_H);
  const u16* Pb = (const u16*)(P.ws + O_PB);
  u16* PQ = (u16*)(P.ws + O_PQ);
  u16* SG = (u16*)(P.ws + O_SG);
  u16* E = (u16*)(P.ws + O_E);
  EPI_COORDS3
  FOR_TILES_XCD(t, 3 * 1024) {
    const int which = t >> 10, tt = t & 1023, mt = tt >> 3, nt = tt & 7;
    f32x4 acc[4][8];
    ZERO_ACC8(acc)
    u16* dst;
    if (which == 0) {
      gemm_kloop3(acc, H + (size_t)mt * 256 * D_, D_, (const u16*)(P.ws + O_WPQ) + (size_t)nt * 256 * D_, D_, D_, lds);
      dst = PQ;
    } else if (which == 1) {
      gemm_kloop3(acc, H + (size_t)mt * 256 * D_, D_, (const u16*)(P.ws + O_WPG) + (size_t)nt * 256 * D_, D_, D_, lds);
      dst = SG;
    } else {
      gemm_kloop3(acc, Pb + (size_t)mt * 256 * 256, 256, (const u16*)(P.ws + O_WPIN) + (size_t)nt * 256 * 256, 256, 256, lds);
      dst = E;
    }
#pragma unroll
    for (int mi = 0; mi < 4; ++mi) {
      const int m = mt * 256 + wm * 64 + mi * 16 + lr;
#pragma unroll
      for (int ni = 0; ni < 8; ++ni) {
        const int n = nt * 256 + wn * 128 + ni * 16 + lq * 4;
        f32x4 a = acc[mi][ni];
        if (which == 1) { a[0] = sigmoidf_(a[0]); a[1] = sigmoidf_(a[1]); a[2] = sigmoidf_(a[2]); a[3] = sigmoidf_(a[3]); }
        store_bf4(dst + (size_t)m * D_ + n, a[0], a[1], a[2], a[3]);
      }
    }
  }
}

struct Top16 { float v[16]; int i[16]; };
__device__ __forceinline__ void top_init(Top16& t) {
#pragma unroll
  for (int k = 0; k < 16; ++k) { t.v[k] = -INFINITY; t.i[k] = 0; }
}
__device__ __forceinline__ void top_insert(Top16& t, float x, int id) {
  const bool c = x > t.v[15];
  t.v[15] = c ? x : t.v[15];
  t.i[15] = c ? id : t.i[15];
#pragma unroll
  for (int k = 15; k >= 1; --k) {
    const bool s = t.v[k] > t.v[k - 1];
    const float a = t.v[k - 1], b = t.v[k];
    const int ia = t.i[k - 1], ib = t.i[k];
    t.v[k - 1] = s ? b : a; t.v[k] = s ? a : b;
    t.i[k - 1] = s ? ib : ia; t.i[k] = s ? ia : ib;
  }
}

__device__ void phase9(const Params& P, int bid, int nb, u16* lds) {
  const u16* PQ = (const u16*)(P.ws + O_PQ);
  const u16* SK = (const u16*)(P.ws + O_SK);
  float* HV = (float*)(P.ws + O_HV);
  int* HI = (int*)(P.ws + O_HI);
  float* Sc = (float*)lds;
  EPI_COORDS
  const int tid = tidx();
  for (int t = bid; t < 256 * 16; t += nb) {
    const int mt = t >> 4, rc = t & 15;
    f32x4 acc[4][4];
    ZERO_ACC(acc)
    gemm_kloop(acc, PQ + (size_t)mt * 128 * D_ + rc * 128, D_, SK + (size_t)rc * 128 * 128, 128, 128, lds);
#pragma unroll
    for (int mi = 0; mi < 4; ++mi) {
      const int m = wm * 64 + mi * 16 + lr;
#pragma unroll
      for (int ni = 0; ni < 4; ++ni) {
        const int n = wn * 64 + ni * 16 + lq * 4;
#pragma unroll
        for (int j = 0; j < 4; ++j) Sc[m * 129 + n + j] = acc[mi][ni][j];
      }
    }
    __syncthreads();
    const int tok = tid & 127, hh = tid >> 7;
    float key[16];
#pragma unroll
    for (int j = 0; j < 16; ++j) key[j] = -INFINITY;
    {
      const float* sp = Sc + tok * 129 + hh * 64;
#pragma unroll 4
      for (int k = 0; k < 64; ++k) {
        const float x = sp[k];
        const float kk = __uint_as_float((__float_as_uint(x) & ~127u) | (unsigned)(127 - (hh * 64 + k)));
#pragma unroll
        for (int j = 15; j >= 1; --j) key[j] = __builtin_amdgcn_fmed3f(key[j - 1], key[j], kk);
        key[0] = fmaxf(key[0], kk);
      }
    }
    __syncthreads();
    float* Lv = (float*)lds;
#pragma unroll
    for (int k = 0; k < 16; ++k) Lv[tid * 17 + k] = key[k];
    __syncthreads();
    if (tid < 128) {
      int ia = 0, ib = 0;
      const float* va = Lv + tid * 17; const float* vb = Lv + (tid + 128) * 17;
      float* ov = HV + ((size_t)(mt * 16 + rc) * 128 + tid) * 16;
      int* oi = HI + ((size_t)(mt * 16 + rc) * 128 + tid) * 16;
      for (int k = 0; k < 16; ++k) {
        const float a = va[ia], b = vb[ib];
        const bool ta = a >= b;
        const unsigned bits = __float_as_uint(ta ? a : b);
        ov[k] = __uint_as_float(bits & ~127u);
        oi[k] = 127 - (int)(bits & 127u);
        ia += ta ? 1 : 0; ib += ta ? 0 : 1;
      }
    }
    __syncthreads();
  }
}

__device__ void phase10(const Params& P, int bid, int nb, u16* lds) {
  int* Lx = (int*)lds + tidx() * 33;
  const float* HV = (const float*)(P.ws + O_HV);
  const int* HI = (const int*)(P.ws + O_HI);
  int* EX = (int*)(P.ws + O_EXP);
  float* GT = (float*)(P.ws + O_GATE);
  for (int i_ = bid * 256 + tidx(); i_ < T_ * 8; i_ += nb * 256) {
    const int r_ = (i_ >> 7) & 7, mt_ = i_ >> 10, tl_ = i_ & 127;
    const int i = (mt_ * 128 + tl_) * 8 + r_;
    const size_t h0 = ((size_t)(mt_ * 16 + r_ * 2) * 128 + tl_) * 16, h1 = h0 + 128 * 16;
    float v0[16], v1[16];
    int i0[16], i1[16];
#pragma unroll
    for (int q = 0; q < 4; ++q) {
      float4 a = *(const float4*)(HV + h0 + q * 4);
      float4 b = *(const float4*)(HV + h1 + q * 4);
      int4 c = *(const int4*)(HI + h0 + q * 4);
      int4 d = *(const int4*)(HI + h1 + q * 4);
      v0[q * 4] = a.x; v0[q * 4 + 1] = a.y; v0[q * 4 + 2] = a.z; v0[q * 4 + 3] = a.w;
      v1[q * 4] = b.x; v1[q * 4 + 1] = b.y; v1[q * 4 + 2] = b.z; v1[q * 4 + 3] = b.w;
      i0[q * 4] = c.x; i0[q * 4 + 1] = c.y; i0[q * 4 + 2] = c.z; i0[q * 4 + 3] = c.w;
      i1[q * 4] = d.x; i1[q * 4 + 1] = d.y; i1[q * 4 + 2] = d.z; i1[q * 4 + 3] = d.w;
    }
    float t[16];
#pragma unroll
    for (int j = 0; j < 16; ++j) t[j] = -INFINITY;
#pragma unroll
    for (int a = 0; a < 16; ++a)
#pragma unroll
      for (int b = 0; b < 16; ++b)
        if ((a + 1) * (b + 1) <= 16) {
          const float sv = v0[a] + v1[b];
#pragma unroll
          for (int j = 15; j >= 1; --j) t[j] = __builtin_amdgcn_fmed3f(t[j - 1], t[j], sv);
          t[0] = fmaxf(t[0], sv);
        }
    const float mx = t[0], thr = t[15];
    float sum = 0.f;
#pragma unroll
    for (int k = 0; k < 16; ++k) sum += __expf(t[k] - mx);
    const float inv = 1.f / sum;
    int cnt = 0;
#pragma unroll
    for (int a = 0; a < 16; ++a)
#pragma unroll
      for (int b = 0; b < 16; ++b)
        if ((a + 1) * (b + 1) <= 16) {
          const float sv = v0[a] + v1[b];
          if (sv >= thr && cnt < 16) {
            Lx[cnt] = i0[a] * 128 + i1[b];
            Lx[16 + cnt] = __float_as_int(__expf(sv - mx) * inv);
            ++cnt;
          }
        }
    asm volatile("s_waitcnt lgkmcnt(0)" ::: "memory");
#pragma unroll
    for (int q = 0; q < 4; ++q) {
      *(int4*)(EX + (size_t)i * 16 + q * 4) = int4{Lx[q * 4], Lx[q * 4 + 1], Lx[q * 4 + 2], Lx[q * 4 + 3]};
      *(float4*)(GT + (size_t)i * 16 + q * 4) =
          float4{__int_as_float(Lx[16 + q * 4]), __int_as_float(Lx[16 + q * 4 + 1]), __int_as_float(Lx[16 + q * 4 + 2]),
                 __int_as_float(Lx[16 + q * 4 + 3])};
    }
    asm volatile("s_waitcnt lgkmcnt(0)" ::: "memory");
  }
}

__device__ __forceinline__ void unpack8(uint4 u, float* f) {
  f[0] = lo2f(u.x); f[1] = hi2f(u.x); f[2] = lo2f(u.y); f[3] = hi2f(u.y);
  f[4] = lo2f(u.z); f[5] = hi2f(u.z); f[6] = lo2f(u.w); f[7] = hi2f(u.w);
}
__device__ __forceinline__ void dec16(uint4 u, float* f) {
  f32x2 a;
  a = __builtin_amdgcn_cvt_pk_f32_fp8((int)u.x, false); f[0] = a.x; f[1] = a.y;
  a = __builtin_amdgcn_cvt_pk_f32_fp8((int)u.x, true);  f[2] = a.x; f[3] = a.y;
  a = __builtin_amdgcn_cvt_pk_f32_fp8((int)u.y, false); f[4] = a.x; f[5] = a.y;
  a = __builtin_amdgcn_cvt_pk_f32_fp8((int)u.y, true);  f[6] = a.x; f[7] = a.y;
  a = __builtin_amdgcn_cvt_pk_f32_fp8((int)u.z, false); f[8] = a.x; f[9] = a.y;
  a = __builtin_amdgcn_cvt_pk_f32_fp8((int)u.z, true);  f[10] = a.x; f[11] = a.y;
  a = __builtin_amdgcn_cvt_pk_f32_fp8((int)u.w, false); f[12] = a.x; f[13] = a.y;
  a = __builtin_amdgcn_cvt_pk_f32_fp8((int)u.w, true);  f[14] = a.x; f[15] = a.y;
}
__device__ __forceinline__ void load_row_bf16(const u16* row, int lane, float* f) {
#pragma unroll
  for (int q = 0; q < 2; ++q) {
    uint4 a = *(const uint4*)(row + q * 1024 + lane * 16);
    uint4 b = *(const uint4*)(row + q * 1024 + lane * 16 + 8);
    unpack8(a, f + q * 16);
    unpack8(b, f + q * 16 + 8);
  }
}
__device__ __forceinline__ void pace_xcd(unsigned* ctr, unsigned& epoch, unsigned nloc) {
  epoch += nloc;
  __syncthreads();
  if (threadIdx.x == 0) {
    __hip_atomic_fetch_add(ctr, 1u, __ATOMIC_RELAXED, __HIP_MEMORY_SCOPE_AGENT);
    unsigned sp = 0;
    while (__hip_atomic_load(ctr, __ATOMIC_RELAXED, __HIP_MEMORY_SCOPE_AGENT) < epoch && ++sp < (1u << 16)) __builtin_amdgcn_s_sleep(2);
  }
  __syncthreads();
}
__device__ void phase11(const Params& P, int bid, int nb, unsigned xcc, unsigned nloc) {
  unsigned* pctr = (unsigned*)(P.ws + (1000 * MB + 1024) + xcc * 128);
  unsigned pep = 0;
  const bool do_pace = (T_ % (nb * 4)) == 0 && nloc > 0;
  const u16* H = (const u16*)(P.ws + O_H);
  const unsigned char* U8 = (const unsigned char*)(P.ws + O_U8);
  const unsigned char* V8 = (const unsigned char*)(P.ws + O_V8);
  const float* RSU = (const float*)(P.ws + O_RSU);
  const float* RSV = (const float*)(P.ws + O_RSV);
  const u16* SG = (const u16*)(P.ws + O_SG);
  const u16* E = (const u16*)(P.ws + O_E);
  const int* EX = (const int*)(P.ws + O_EXP);
  const float* GT = (const float*)(P.ws + O_GATE);
  const int lane = tidx() & 63;
  int sweep = 0;
  for (int tok = bid * 4 + (tidx() >> 6); tok < T_; tok += nb * 4, sweep ^= 1) {
    if (do_pace && tok >= nb * 4) pace_xcd(pctr, pep, nloc);
    float hf[32], y[32];
    load_row_bf16(H + (size_t)tok * D_, lane, hf);
#pragma unroll
    for (int k = 0; k < 32; ++k) y[k] = 0.f;
    int ev0 = EX[(size_t)tok * 128 + lane], ev1 = EX[(size_t)tok * 128 + 64 + lane];
    float gv0 = GT[(size_t)tok * 128 + lane], gv1 = GT[(size_t)tok * 128 + 64 + lane];
    {
      int k0 = (ev0 << 7) | lane, k1 = (ev1 << 7) | (64 + lane);
#pragma unroll
      for (int kk = 2; kk <= 128; kk <<= 1) {
#pragma unroll
        for (int j = kk >> 1; j >= 1; j >>= 1) {
          if (j == 64) {
            const int lo_ = min(k0, k1), hi_ = max(k0, k1);
            k0 = lo_; k1 = hi_;
          } else {
            const int p0 = __shfl_xor(k0, j), p1 = __shfl_xor(k1, j);
            const bool lower = (lane & j) == 0;
            const bool up0 = (kk == 128) ? true : ((lane & kk) == 0);
            const bool up1 = (kk == 128) ? true : (kk == 64 ? false : ((lane & kk) == 0));
            k0 = (lower == up0) ? min(k0, p0) : max(k0, p0);
            k1 = (lower == up1) ? min(k1, p1) : max(k1, p1);
          }
        }
      }
      const int s0 = k0 & 127, s1 = k1 & 127;
      const float ga0 = __shfl(gv0, s0 & 63), gb0 = __shfl(gv1, s0 & 63);
      const float ga1 = __shfl(gv0, s1 & 63), gb1 = __shfl(gv1, s1 & 63);
      gv0 = (s0 < 64) ? ga0 : gb0;
      gv1 = (s1 < 64) ? ga1 : gb1;
      ev0 = k0 >> 7;
      ev1 = k1 >> 7;
    }
    const float ru0 = RSU[ev0], ru1 = RSU[ev1], rv0 = RSV[ev0], rv1 = RSV[ev1];
    for (int k4_ = 0; k4_ < 128; k4_ += 4) {
      const int k4 = sweep ? (124 - k4_) : k4_;
      const int src = k4 & 63;
      const bool lo = k4 < 64;
      int ee[4]; float gg[4], su[4], sv[4];
#pragma unroll
      for (int x = 0; x < 4; ++x) {
        ee[x] = __shfl(lo ? ev0 : ev1, src + x);
        gg[x] = __shfl(lo ? gv0 : gv1, src + x);
        su[x] = __shfl(lo ? ru0 : ru1, src + x);
        sv[x] = __shfl(lo ? rv0 : rv1, src + x);
      }
      uint4 uu[4][2], vv[4][2];
#pragma unroll
      for (int x = 0; x < 4; ++x)
#pragma unroll
        for (int q = 0; q < 2; ++q) {
          uu[x][q] = *(const uint4*)(U8 + (size_t)ee[x] * D_ + q * 1024 + lane * 16);
          vv[x][q] = *(const uint4*)(V8 + (size_t)ee[x] * D_ + q * 1024 + lane * 16);
        }
      float dd[4];
#pragma unroll
      for (int x = 0; x < 4; ++x) {
        float d = 0.f;
#pragma unroll
        for (int q = 0; q < 2; ++q) {
          float f[16];
          dec16(uu[x][q], f);
#pragma unroll
          for (int j = 0; j < 16; ++j) d = fmaf(f[j], hf[q * 16 + j], d);
        }
        dd[x] = d;
      }
#pragma unroll
      for (int o = 32; o >= 1; o >>= 1) {
#pragma unroll
        for (int x = 0; x < 4; ++x) dd[x] += __shfl_xor(dd[x], o);
      }
#pragma unroll
      for (int x = 0; x < 4; ++x) {
        const float w = gg[x] * gelu_tanh(dd[x] * su[x]) * sv[x];
#pragma unroll
        for (int q = 0; q < 2; ++q) {
          float f[16];
          dec16(vv[x][q], f);
#pragma unroll
          for (int j = 0; j < 16; ++j) y[q * 16 + j] = fmaf(w, f[j], y[q * 16 + j]);
        }
      }
    }
    float ef[32], sg[32];
    load_row_bf16(E + (size_t)tok * D_, lane, ef);
    load_row_bf16(SG + (size_t)tok * D_, lane, sg);
    float ss = 0.f;
#pragma unroll
    for (int k = 0; k < 32; ++k) ss += ef[k] * ef[k];
    const float rr = rsqrtf(wave_sum(ss) * (1.f / D_) + 1e-5f);
    float s1 = 0.f;
#pragma unroll
    for (int q = 0; q < 2; ++q)
#pragma unroll
      for (int j4 = 0; j4 < 4; ++j4) {
        float4 g = *(const float4*)(P.ple_g + q * 1024 + lane * 16 + j4 * 4);
        const float gq[4] = {g.x, g.y, g.z, g.w};
#pragma unroll
        for (int j = 0; j < 4; ++j) {
          const int k = q * 16 + j4 * 4 + j;
          float v = ALPHA * hf[k] + y[k] + ef[k] * rr * gq[j] * sg[k];
          y[k] = v;
          s1 += v;
        }
      }
    const float mu = wave_sum(s1) * (1.f / D_);
    float s2 = 0.f;
#pragma unroll
    for (int k = 0; k < 32; ++k) { float d = y[k] - mu; s2 += d * d; }
    const float rstd = rsqrtf(wave_sum(s2) * (1.f / D_) + 1e-5f);
#pragma unroll
    for (int q = 0; q < 2; ++q)
#pragma unroll
      for (int j4 = 0; j4 < 4; ++j4) {
        const int col = q * 1024 + lane * 16 + j4 * 4;
        const int k = q * 16 + j4 * 4;
        float4 g = *(const float4*)(P.ln2_g + col), b = *(const float4*)(P.ln2_b + col);
        float4 o;
        o.x = (y[k + 0] - mu) * rstd * g.x + b.x; o.y = (y[k + 1] - mu) * rstd * g.y + b.y;
        o.z = (y[k + 2] - mu) * rstd * g.z + b.z; o.w = (y[k + 3] - mu) * rstd * g.w + b.w;
        *(float4*)(P.out + (size_t)tok * D_ + col) = o;
      }
  }
}

constexpr size_t O_BAR = 1000 * MB;
__device__ __forceinline__ void gbar(unsigned* ctr, unsigned& epoch, unsigned nb) {
  epoch += nb;
  asm volatile("s_waitcnt vmcnt(0)" ::: "memory");
  __syncthreads();
  if (threadIdx.x == 0) {
    __builtin_amdgcn_fence(__ATOMIC_RELEASE, "agent");
    asm volatile("s_waitcnt vmcnt(0)" ::: "memory");
    __hip_atomic_fetch_add(ctr, 1u, __ATOMIC_RELAXED, __HIP_MEMORY_SCOPE_AGENT);
    while (__hip_atomic_load(ctr, __ATOMIC_RELAXED, __HIP_MEMORY_SCOPE_AGENT) < epoch) __builtin_amdgcn_s_sleep(2);
    __builtin_amdgcn_fence(__ATOMIC_ACQUIRE, "agent");
    asm volatile("s_waitcnt vmcnt(0)" ::: "memory");
  }
  __syncthreads();
}

#define XB_TMO      128
#define XB_XCNT(j)  (256  + 64 * (j))
#define XB_XSUB(j)  (1280 + 64 * (j))
#define XB_XGEN(j)  (2304 + 64 * (j))
#define XB_TOP      3328
#define XB_TOPGEN   3392
#define XCD_BAR_WORDS 3456
#define XB_SPIN_CAP (1u << 18)
#define LAS __attribute__((address_space(3)))

__device__ __forceinline__ unsigned xb_ld(unsigned* p)              { return __hip_atomic_load(p, __ATOMIC_RELAXED, __HIP_MEMORY_SCOPE_AGENT); }
__device__ __forceinline__ unsigned xb_add(unsigned* p, unsigned v) { return __hip_atomic_fetch_add(p, v, __ATOMIC_RELAXED, __HIP_MEMORY_SCOPE_AGENT); }
__device__ __forceinline__ unsigned xb_xcc_id() { return (unsigned)__builtin_amdgcn_s_getreg((3 << 11) | 20) & 0xFu; }
#define XB_SPIN(cond, bar) do { unsigned _sp = 0; while (cond) { __builtin_amdgcn_s_sleep(1); \
    if ((++_sp & 255u) == 0u) { if (xb_ld(&(bar)[XB_TMO])) break; if (_sp > XB_SPIN_CAP) { atomicAdd(&(bar)[XB_TMO], 1u); break; } } } } while (0)

struct XcdBarrier {
    unsigned* bar; unsigned x;
    volatile LAS unsigned* st;
};

__device__ __forceinline__ XcdBarrier xcd_barrier_post(unsigned* bar, volatile LAS unsigned* st) {
    XcdBarrier b; b.bar = bar; b.x = xb_xcc_id(); b.st = st;
    if (threadIdx.x == 0) (void)xb_add(&bar[XB_XCNT(b.x)], 1u);
    return b;
}
__device__ __forceinline__ void xcd_barrier_complete(unsigned* bar, unsigned x, unsigned& nloc, unsigned& nx) {
    const unsigned G = gridDim.x * gridDim.y * gridDim.z;
    unsigned sum, cnt, mine, sp = 0u;
    for (;;) {
        sum = 0u; cnt = 0u; mine = 0u;
#pragma unroll
        for (unsigned j = 0; j < 16; ++j) { const unsigned c = xb_ld(&bar[XB_XCNT(j)]); sum += c; cnt += (c > 0u) ? 1u : 0u; mine = (j == x) ? c : mine; }
        if (sum == G) break;
        __builtin_amdgcn_s_sleep(1);
        if ((++sp & 255u) == 0u) { if (xb_ld(&bar[XB_TMO])) break; if (sp > XB_SPIN_CAP) { atomicAdd(&bar[XB_TMO], 1u); break; } }
    }
    nloc = mine > 0u ? mine : 1u; nx = cnt > 0u ? cnt : 1u;
}

__device__ __forceinline__ void xcd_barrier(const XcdBarrier& b) {
    asm volatile("s_waitcnt vmcnt(0)" ::: "memory");
    __syncthreads();
    if (threadIdx.x == 0) {
        unsigned* bar = b.bar;
        __builtin_amdgcn_s_waitcnt(0);
        unsigned nloc = b.st[0], nx = b.st[1];
        if (nloc == 0u) { xcd_barrier_complete(bar, b.x, nloc, nx); b.st[0] = nloc; b.st[1] = nx; }
        const unsigned old = xb_add(&bar[XB_XSUB(b.x)], 1u);
        const unsigned gen = old / nloc;
        if (old + 1u == (gen + 1u) * nloc) {
            __builtin_amdgcn_fence(__ATOMIC_RELEASE, "agent");
            asm volatile("s_waitcnt vmcnt(0)" ::: "memory");
            const unsigned og = xb_add(&bar[XB_TOP], 1u);
            const unsigned tg = og / nx;
            if (og + 1u == (tg + 1u) * nx) xb_add(&bar[XB_TOPGEN], 1u);
            else XB_SPIN(xb_ld(&bar[XB_TOPGEN]) == tg, bar);
            __builtin_amdgcn_fence(__ATOMIC_ACQUIRE, "agent");
            xb_add(&bar[XB_XGEN(b.x)], 1u);
            asm volatile("s_waitcnt vmcnt(0)" ::: "memory");
        } else {
            XB_SPIN(xb_ld(&bar[XB_XGEN(b.x)]) == gen, bar);
            __builtin_amdgcn_fence(__ATOMIC_ACQUIRE, "agent");
            asm volatile("s_waitcnt vmcnt(0)" ::: "memory");
        }
    }
    __syncthreads();
}


constexpr int NPHASE = 12;

__global__ void __launch_bounds__(512, 2) mega_kernel(Params P) {
  extern __shared__ __attribute__((aligned(16))) u16 dlds[];
  cg::grid_group grid = cg::this_grid();
  const int rb = blockIdx.x, rnb = gridDim.x;
  const int half = threadIdx.x >> 8;
  const int bid = rb * 2 + half, nb = rnb * 2;
  u16* lds = dlds + half * 36864;
  volatile LAS unsigned* xst = (volatile LAS unsigned*)(dlds + 73728);
  if (threadIdx.x < 4) xst[threadIdx.x] = 0u;
  __syncthreads();
  XcdBarrier xb = xcd_barrier_post((unsigned*)(P.ws + O_BAR + 4096), xst);
  phase0(P, bid, nb, lds); grid.sync();
  phase1(P, rb, rnb, dlds); xcd_barrier(xb);
  phase2(P, bid, nb, lds); xcd_barrier(xb);
  phase3(P, bid, nb, lds); xcd_barrier(xb);
  phase4(P, rb, rnb, dlds); xcd_barrier(xb);
  phase5(P, rb, rnb, dlds); xcd_barrier(xb);
  phase6(P, rb, rnb, dlds); xcd_barrier(xb);
  ln_rows((const float*)(P.ws + O_PRE1), P.ln1_g, P.ln1_b, (u16*)(P.ws + O_H), bid * 4 + (tidx() >> 6), nb * 4);
  xcd_barrier(xb);
  phase8(P, rb, rnb, dlds); xcd_barrier(xb);
  phase9(P, bid, nb, lds); xcd_barrier(xb);
  phase10(P, bid, nb, lds); xcd_barrier(xb);
  phase11(P, bid, nb, xb.x, xst[0]);
}

extern "C" void kernel_launch(void* const* d_in, const int* in_sizes, int n_in, void* d_out, int out_size, void* d_ws,
                              size_t ws_size, hipStream_t stream) {
  Params p{};
  const float** pp = (const float**)&p;
  for (int i = 0; i < 29; ++i) pp[i] = (const float*)d_in[i];
  p.out = (float*)d_out;
  p.ws = (char*)d_ws;
  if (ws_size < 1001 * MB) fprintf(stderr, "workspace too small: %zu\n", ws_size);
  constexpr size_t kDynLds = 147456 + 16;
  static int grid_blocks = 0;
  if (!grid_blocks) {
    int dev = 0, cus = 0, per_cu = 0;
    (void)hipGetDevice(&dev);
    (void)hipDeviceGetAttribute(&cus, hipDeviceAttributeMultiprocessorCount, dev);
    (void)hipFuncSetAttribute((const void*)mega_kernel, hipFuncAttributeMaxDynamicSharedMemorySize, (int)kDynLds);
    (void)hipOccupancyMaxActiveBlocksPerMultiprocessor(&per_cu, mega_kernel, 512, kDynLds);
    if (per_cu > 1) per_cu = 1;
    grid_blocks = cus * per_cu;
  }
  (void)hipMemsetAsync((char*)d_ws + O_BAR, 0, 4096 + XCD_BAR_WORDS * 4, stream);
  void* args[] = {&p};
  hipError_t e = hipLaunchCooperativeKernel((void*)mega_kernel, dim3(grid_blocks), dim3(512), args, kDynLds, stream);
  if (e != hipSuccess) fprintf(stderr, "cooperative launch failed: %s (grid %d)\n", hipGetErrorString(e), grid_blocks);
}
```

```cpp
#include <hip/hip_runtime.h>
#include <hip/hip_bf16.h>
#include <hip/hip_cooperative_groups.h>
#include <cstdio>
namespace cg = cooperative_groups;

#ifndef MULTI
#define MULTI 0
#endif

typedef unsigned short u16;
using bf16x8 = __attribute__((ext_vector_type(8))) short;
using f32x4 = __attribute__((ext_vector_type(4))) float;

constexpr int T_ = 32768;
constexpr int S_ = 16384;
constexpr int D_ = 2048;
constexpr int SSM_L = 128;
constexpr int SSM_NC = S_ / SSM_L;
constexpr float ALPHA = 1.189207115002721f;
constexpr size_t MB = 1024ull * 1024ull;

constexpr size_t O_WIN = 0 * MB, O_WGLU = 32 * MB, O_WAU = 34 * MB, O_WSU = 38 * MB, O_WOUT = 42 * MB,
                 O_WPQ = 50 * MB, O_WPG = 58 * MB, O_WPIN = 66 * MB, O_SK = 67 * MB, O_BCAT = 67 * MB + 512 * 1024,
                 O_CCAT = 68 * MB, O_LAM = 68 * MB + 256 * 1024, O_UB = 70 * MB, O_VB = 134 * MB, O_SBUF = 198 * MB,
                 O_H = 206 * MB, O_Q = 334 * MB, O_K = 398 * MB, O_VT = 462 * MB, O_U2 = 526 * MB, O_G = 590 * MB,
                 O_YA = 846 * MB, O_YS = 910 * MB, O_PB = 974 * MB;
constexpr size_t O_YG = O_VT, O_MERGED = O_Q, O_PRE1 = O_G, O_PQ = O_Q, O_SG = O_VT, O_E = O_G,
                 O_HV = O_G + 128 * MB, O_HI = O_G + 160 * MB, O_EXP = O_G + 192 * MB, O_GATE = O_G + 208 * MB;

struct Params {
  const float *x, *p, *ln_in_g, *ln_in_b, *w_in, *rel_bias, *lam_re, *lam_im, *log_dt, *b_re, *b_im, *c_re, *c_im,
      *ssm_d, *w_glu, *w_au, *w_su, *w_out, *ln1_g, *ln1_b, *w_pq, *sub_keys, *peer_u, *peer_v, *ple_w_in, *ple_g,
      *ple_w_gate, *ln2_g, *ln2_b;
  float* out;
  char* ws;
};

__device__ __forceinline__ int tidx() { int t = threadIdx.x & 255; asm volatile("" : "+v"(t)); return t; }
__device__ __forceinline__ int rtid() { int t = threadIdx.x; asm volatile("" : "+v"(t)); return t; }
__device__ __forceinline__ u16 f2bf(float f) {
  unsigned u = __float_as_uint(f);
  u += 0x7fffu + ((u >> 16) & 1u);
  return (u16)(u >> 16);
}
__device__ __forceinline__ float bf2f(u16 h) { return __uint_as_float(((unsigned)h) << 16); }
typedef __bf16 hwbf16x2 __attribute__((ext_vector_type(2)));
typedef float hwf32x2 __attribute__((ext_vector_type(2)));
__device__ __forceinline__ unsigned pack2(float a, float b) {
  hwf32x2 v = {a, b};
  hwbf16x2 r = __builtin_convertvector(v, hwbf16x2);
  return *(unsigned*)&r;
}
__device__ __forceinline__ float lo2f(unsigned u) { return __uint_as_float(u << 16); }
__device__ __forceinline__ float hi2f(unsigned u) { return __uint_as_float(u & 0xffff0000u); }
__device__ __forceinline__ float sigmoidf_(float x) { return __builtin_amdgcn_rcpf(1.f + __expf(-x)); }
__device__ __forceinline__ float gelu_tanh(float x) {
  float u = 0.7978845608028654f * (x + 0.044715f * x * x * x);
  float t = 1.f - 2.f * __builtin_amdgcn_rcpf(1.f + __expf(2.f * u));
  return 0.5f * x * (1.f + t);
}
__device__ __forceinline__ float wave_sum(float v) {
#pragma unroll
  for (int o = 32; o >= 1; o >>= 1) v += __shfl_xor(v, o);
  return v;
}
__device__ __forceinline__ void store_bf4(u16* dst, float a, float b, float c, float d) {
  uint2 v; v.x = pack2(a, b); v.y = pack2(c, d);
  *(uint2*)dst = v;
}

__device__ __forceinline__ void gemm_kloop(f32x4 (&acc)[4][4], const u16* __restrict__ A, int lda,
                                           const u16* __restrict__ Bt, int ldb, int K, u16* lds) {
  const int tid = tidx(), lane = tid & 63, wid = tid >> 6, wm = wid >> 1, wn = wid & 1;
  const int lr = lane & 15, lq = lane >> 4;
  const int nk = K >> 6;
  const int srow = tid >> 3, sc = (tid & 7) ^ (srow & 7);
  const u16* ga = A + (size_t)srow * lda + sc * 8;
  const u16* gb = Bt + (size_t)srow * ldb + sc * 8;
  u16* lw = lds + tid * 8;
#pragma unroll
  for (int i = 0; i < 4; ++i) {
    __builtin_amdgcn_global_load_lds((const unsigned*)(ga + (size_t)(32 * i) * lda), (unsigned*)(lw + i * 2048), 16, 0, 0);
    __builtin_amdgcn_global_load_lds((const unsigned*)(gb + (size_t)(32 * i) * ldb), (unsigned*)(lw + 8192 + i * 2048), 16, 0, 0);
  }
  __syncthreads();
  const int swz = lr & 7;
  for (int kt = 0; kt < nk; ++kt) {
    if (kt + 1 < nk) {
      u16* lw2 = lw + ((kt + 1) & 1) * 16384;
#pragma unroll
      for (int i = 0; i < 4; ++i) {
        __builtin_amdgcn_global_load_lds((const unsigned*)(ga + (size_t)(32 * i) * lda + (kt + 1) * 64), (unsigned*)(lw2 + i * 2048), 16, 0, 0);
        __builtin_amdgcn_global_load_lds((const unsigned*)(gb + (size_t)(32 * i) * ldb + (kt + 1) * 64), (unsigned*)(lw2 + 8192 + i * 2048), 16, 0, 0);
      }
    }
    const u16* sa = lds + (kt & 1) * 16384;
    const u16* sb = sa + 8192;
#pragma unroll
    for (int ks = 0; ks < 2; ++ks) {
      bf16x8 af[4], bfr[4];
      const int co = ((ks * 4 + lq) ^ swz) * 8;
#pragma unroll
      for (int mi = 0; mi < 4; ++mi) af[mi] = *(const bf16x8*)(sa + (wm * 64 + mi * 16 + lr) * 64 + co);
#pragma unroll
      for (int ni = 0; ni < 4; ++ni) bfr[ni] = *(const bf16x8*)(sb + (wn * 64 + ni * 16 + lr) * 64 + co);
#pragma unroll
      for (int mi = 0; mi < 4; ++mi)
#pragma unroll
        for (int ni = 0; ni < 4; ++ni)
          acc[mi][ni] = __builtin_amdgcn_mfma_f32_16x16x32_bf16(bfr[ni], af[mi], acc[mi][ni], 0, 0, 0);
    }
    __syncthreads();
  }
}

#define ZERO_ACC(acc)                                   \
  _Pragma("unroll") for (int _a = 0; _a < 4; ++_a)      \
  _Pragma("unroll") for (int _b = 0; _b < 4; ++_b) acc[_a][_b] = f32x4{0.f, 0.f, 0.f, 0.f};

__device__ __forceinline__ void gemm_kloop2(f32x4 (&acc)[4][8], const u16* __restrict__ A, int lda,
                                            const u16* __restrict__ Bt, int ldb, int K, u16* lds) {
  const int tid = tidx(), lane = tid & 63, wid = tid >> 6;
  const int lr = lane & 15, lq = lane >> 4;
  const int nk = K >> 5;
  const int srow = tid >> 2;
  const int sc = (tid & 3) ^ ((0x78 >> (2 * ((tid >> 4) & 3))) & 3);
  const u16* ga = A + (size_t)srow * lda + sc * 8;
  const u16* gb = Bt + (size_t)srow * ldb + sc * 8;
  u16* lw = lds + tid * 8;
#pragma unroll
  for (int i = 0; i < 4; ++i)
    __builtin_amdgcn_global_load_lds((const unsigned*)(ga + (size_t)(64 * i) * lda), (unsigned*)(lw + i * 2048), 16, 0, 0);
#pragma unroll
  for (int i = 0; i < 2; ++i)
    __builtin_amdgcn_global_load_lds((const unsigned*)(gb + (size_t)(64 * i) * ldb), (unsigned*)(lw + 8192 + i * 2048), 16, 0, 0);
  __syncthreads();
  const int co = (lq ^ ((0x78 >> (2 * ((lr >> 2) & 3))) & 3)) * 8;
  for (int kt = 0; kt < nk; ++kt) {
    if (kt + 1 < nk) {
      u16* lw2 = lw + ((kt + 1) & 1) * 12288;
#pragma unroll
      for (int i = 0; i < 4; ++i)
        __builtin_amdgcn_global_load_lds((const unsigned*)(ga + (size_t)(64 * i) * lda + (kt + 1) * 32), (unsigned*)(lw2 + i * 2048), 16, 0, 0);
#pragma unroll
      for (int i = 0; i < 2; ++i)
        __builtin_amdgcn_global_load_lds((const unsigned*)(gb + (size_t)(64 * i) * ldb + (kt + 1) * 32), (unsigned*)(lw2 + 8192 + i * 2048), 16, 0, 0);
    }
    const u16* sa = lds + (kt & 1) * 12288;
    const u16* sb = sa + 8192;
    bf16x8 af[4];
#pragma unroll
    for (int mi = 0; mi < 4; ++mi) af[mi] = *(const bf16x8*)(sa + (wid * 64 + mi * 16 + lr) * 32 + co);
#pragma unroll
    for (int nh = 0; nh < 2; ++nh) {
      bf16x8 bfr[4];
#pragma unroll
      for (int ni = 0; ni < 4; ++ni) bfr[ni] = *(const bf16x8*)(sb + ((nh * 4 + ni) * 16 + lr) * 32 + co);
#pragma unroll
      for (int mi = 0; mi < 4; ++mi)
#pragma unroll
        for (int ni = 0; ni < 4; ++ni)
          acc[mi][nh * 4 + ni] = __builtin_amdgcn_mfma_f32_16x16x32_bf16(bfr[ni], af[mi], acc[mi][nh * 4 + ni], 0, 0, 0);
    }
    __syncthreads();
  }
}

__device__ __forceinline__ void gemm_kloop3(f32x4 (&acc)[4][8], const u16* __restrict__ A, int lda,
                                            const u16* __restrict__ Bt, int ldb, int K, u16* lds) {
  const int tid = rtid(), lane = tid & 63, wid = tid >> 6, wm = wid >> 1, wn = wid & 1;
  const int lr = lane & 15, lq = lane >> 4;
  const int nk = K >> 6;
  const int srow = tid >> 3, sc = (tid & 7) ^ (srow & 7);
  const u16* ga = A + (size_t)srow * lda + sc * 8;
  const u16* gb = Bt + (size_t)srow * ldb + sc * 8;
  u16* lw = lds + tid * 8;
#pragma unroll
  for (int i = 0; i < 4; ++i) {
    __builtin_amdgcn_global_load_lds((const unsigned*)(ga + (size_t)(64 * i) * lda), (unsigned*)(lw + i * 4096), 16, 0, 0);
    __builtin_amdgcn_global_load_lds((const unsigned*)(gb + (size_t)(64 * i) * ldb), (unsigned*)(lw + 16384 + i * 4096), 16, 0, 0);
  }
  __syncthreads();
  const int swz = lr & 7;
  for (int kt = 0; kt < nk; ++kt) {
    const int ko = min(kt + 1, nk - 1) * 64;
    u16* lw2 = lw + ((kt + 1) & 1) * 32768;
    const u16* sa = lds + (kt & 1) * 32768;
    const u16* sb = sa + 16384;
#pragma unroll
    for (int ks = 0; ks < 2; ++ks) {
      const int co = ((ks * 4 + lq) ^ swz) * 8;
      bf16x8 af[4];
#pragma unroll
      for (int mi = 0; mi < 4; ++mi) af[mi] = *(const bf16x8*)(sa + (wm * 64 + mi * 16 + lr) * 64 + co);
#pragma unroll
      for (int nh = 0; nh < 2; ++nh) {
        bf16x8 bfr[4];
#pragma unroll
        for (int ni = 0; ni < 4; ++ni) bfr[ni] = *(const bf16x8*)(sb + (wn * 128 + (nh * 4 + ni) * 16 + lr) * 64 + co);
        if (ks == 0) __builtin_amdgcn_sched_barrier(0);
#pragma unroll
        for (int mi = 0; mi < 4; ++mi) {
#pragma unroll
          for (int ni = 0; ni < 4; ++ni)
            acc[mi][nh * 4 + ni] = __builtin_amdgcn_mfma_f32_16x16x32_bf16(bfr[ni], af[mi], acc[mi][nh * 4 + ni], 0, 0, 0);
          if (ks == 0) {
            if (nh == 0)
              __builtin_amdgcn_global_load_lds((const unsigned*)(ga + (size_t)(64 * mi) * lda + ko), (unsigned*)(lw2 + mi * 4096), 16, 0, 0);
            else
              __builtin_amdgcn_global_load_lds((const unsigned*)(gb + (size_t)(64 * mi) * ldb + ko), (unsigned*)(lw2 + 16384 + mi * 4096), 16, 0, 0);
            __builtin_amdgcn_sched_barrier(0);
          }
        }
      }
    }
    __syncthreads();
  }
}

#define EPI_COORDS3                                                             \
  const int lane = rtid() & 63, wid = rtid() >> 6, wm = wid >> 1, wn = wid & 1; \
  const int lr = lane & 15, lq = lane >> 4;

#define ZERO_ACC8(acc)                                  \
  _Pragma("unroll") for (int _a = 0; _a < 4; ++_a)      \
  _Pragma("unroll") for (int _b = 0; _b < 8; ++_b) acc[_a][_b] = f32x4{0.f, 0.f, 0.f, 0.f};

#define FOR_TILES_XCD(t, ntiles) \
  for (int _k = 0, t = (bid & 7) * (nb >> 3) + (bid >> 3); t < (ntiles); ++_k, t = ((_k * 8 + (bid & 7)) * (nb >> 3)) + (bid >> 3))

#define EPI_COORDS                                                             \
  const int lane = tidx() & 63, wid = tidx() >> 6, wm = wid >> 1, wn = wid & 1; \
  const int lr = lane & 15, lq = lane >> 4;

__device__ void tconv_tile(const float* __restrict__ W, int K, int N, u16* __restrict__ Wt, int tile, float* lds) {
  const int tid = tidx();
  const int ntn = N >> 6;
  const int kt = tile / ntn, nt = tile % ntn;
  const int c4 = (tid & 15) * 4;
#pragma unroll
  for (int i = 0; i < 4; ++i) {
    int r = (tid >> 4) + 16 * i;
    float4 v = *(const float4*)(W + (size_t)(kt * 64 + r) * N + nt * 64 + c4);
    lds[r * 65 + c4 + 0] = v.x; lds[r * 65 + c4 + 1] = v.y; lds[r * 65 + c4 + 2] = v.z; lds[r * 65 + c4 + 3] = v.w;
  }
  __syncthreads();
  const int n = tid >> 2, kseg = (tid & 3) * 16;
  unsigned o[8];
#pragma unroll
  for (int j = 0; j < 8; ++j) o[j] = pack2(lds[(kseg + 2 * j) * 65 + n], lds[(kseg + 2 * j + 1) * 65 + n]);
  u16* dst = Wt + (size_t)(nt * 64 + n) * K + kt * 64 + kseg;
  *(uint4*)dst = uint4{o[0], o[1], o[2], o[3]};
  *(uint4*)(dst + 8) = uint4{o[4], o[5], o[6], o[7]};
  __syncthreads();
}

__device__ void conv_linear(const float* __restrict__ src, u16* __restrict__ dst, size_t n8, size_t gtid, size_t nth) {
  for (size_t i = gtid; i < n8; i += nth) {
    float4 a = *(const float4*)(src + i * 8), b = *(const float4*)(src + i * 8 + 4);
    *(uint4*)(dst + i * 8) = uint4{pack2(a.x, a.y), pack2(a.z, a.w), pack2(b.x, b.y), pack2(b.z, b.w)};
  }
}

typedef float f32x2 __attribute__((ext_vector_type(2)));
constexpr size_t O_U8 = O_UB, O_V8 = O_UB + 32 * MB, O_RSU = O_VB, O_RSV = O_VB + 64 * 1024;
__device__ void conv_fp8_rows(const float* __restrict__ src, unsigned char* __restrict__ dst, float* __restrict__ rscale,
                              int gw, int nw) {
  const int lane = tidx() & 63;
  for (int row = gw; row < 16384; row += nw) {
    const float* r = src + (size_t)row * D_;
    float4 v[8];
#pragma unroll
    for (int q = 0; q < 8; ++q) v[q] = *(const float4*)(r + q * 256 + lane * 4);
    float am = 0.f;
#pragma unroll
    for (int q = 0; q < 8; ++q) am = fmaxf(am, fmaxf(fmaxf(fabsf(v[q].x), fabsf(v[q].y)), fmaxf(fabsf(v[q].z), fabsf(v[q].w))));
#pragma unroll
    for (int o = 32; o >= 1; o >>= 1) am = fmaxf(am, __shfl_xor(am, o));
    const float sc = am > 0.f ? 416.f / am : 1.f;
#pragma unroll
    for (int q = 0; q < 8; ++q) {
      int w = 0;
      w = __builtin_amdgcn_cvt_pk_fp8_f32(v[q].x * sc, v[q].y * sc, w, false);
      w = __builtin_amdgcn_cvt_pk_fp8_f32(v[q].z * sc, v[q].w * sc, w, true);
      *(int*)(dst + (size_t)row * D_ + q * 256 + lane * 4) = w;
    }
    if (lane == 0) rscale[row] = am > 0.f ? am / 416.f : 1.f;
  }
}

__device__ void ln_rows(const float* __restrict__ src, const float* __restrict__ g, const float* __restrict__ b,
                        u16* __restrict__ dst, int gw, int nw) {
  const int lane = tidx() & 63;
  for (int row = gw; row < T_; row += nw) {
    const float* r = src + (size_t)row * D_;
    float4 v[8];
#pragma unroll
    for (int q = 0; q < 8; ++q) v[q] = *(const float4*)(r + q * 256 + lane * 4);
    float s = 0.f;
#pragma unroll
    for (int q = 0; q < 8; ++q) s += v[q].x + v[q].y + v[q].z + v[q].w;
    float mu = wave_sum(s) * (1.f / D_);
    float ss = 0.f;
#pragma unroll
    for (int q = 0; q < 8; ++q) {
      float a = v[q].x - mu, bb = v[q].y - mu, c = v[q].z - mu, d = v[q].w - mu;
      ss += a * a + bb * bb + c * c + d * d;
    }
    float rstd = rsqrtf(wave_sum(ss) * (1.f / D_) + 1e-5f);
#pragma unroll
    for (int q = 0; q < 8; ++q) {
      int col = q * 256 + lane * 4;
      float4 gg = *(const float4*)(g + col), bb = *(const float4*)(b + col);
      store_bf4(dst + (size_t)row * D_ + col, (v[q].x - mu) * rstd * gg.x + bb.x, (v[q].y - mu) * rstd * gg.y + bb.y,
                (v[q].z - mu) * rstd * gg.z + bb.z, (v[q].w - mu) * rstd * gg.w + bb.w);
    }
  }
}

__device__ void ln_rows_bf16(const u16* __restrict__ src, const float* __restrict__ g, const float* __restrict__ b,
                             u16* __restrict__ dst, int gw, int nw) {
  const int lane = tidx() & 63;
  for (int row = gw; row < T_; row += nw) {
    const u16* r = src + (size_t)row * D_;
    float v[32];
#pragma unroll
    for (int q = 0; q < 4; ++q) {
      const uint4 u = *(const uint4*)(r + q * 512 + lane * 8);
      v[q * 8 + 0] = lo2f(u.x); v[q * 8 + 1] = hi2f(u.x); v[q * 8 + 2] = lo2f(u.y); v[q * 8 + 3] = hi2f(u.y);
      v[q * 8 + 4] = lo2f(u.z); v[q * 8 + 5] = hi2f(u.z); v[q * 8 + 6] = lo2f(u.w); v[q * 8 + 7] = hi2f(u.w);
    }
    float s_ = 0.f;
#pragma unroll
    for (int k = 0; k < 32; ++k) s_ += v[k];
    const float mu = wave_sum(s_) * (1.f / D_);
    float ss = 0.f;
#pragma unroll
    for (int k = 0; k < 32; ++k) { const float d = v[k] - mu; ss += d * d; }
    const float rstd = rsqrtf(wave_sum(ss) * (1.f / D_) + 1e-5f);
#pragma unroll
    for (int q = 0; q < 4; ++q) {
      const int col = q * 512 + lane * 8;
      const float4 g0 = *(const float4*)(g + col), g1 = *(const float4*)(g + col + 4);
      const float4 b0 = *(const float4*)(b + col), b1 = *(const float4*)(b + col + 4);
      uint4 o;
      o.x = pack2((v[q * 8 + 0] - mu) * rstd * g0.x + b0.x, (v[q * 8 + 1] - mu) * rstd * g0.y + b0.y);
      o.y = pack2((v[q * 8 + 2] - mu) * rstd * g0.z + b0.z, (v[q * 8 + 3] - mu) * rstd * g0.w + b0.w);
      o.z = pack2((v[q * 8 + 4] - mu) * rstd * g1.x + b1.x, (v[q * 8 + 5] - mu) * rstd * g1.y + b1.y);
      o.w = pack2((v[q * 8 + 6] - mu) * rstd * g1.z + b1.z, (v[q * 8 + 7] - mu) * rstd * g1.w + b1.w);
      *(uint4*)(dst + (size_t)row * D_ + col) = o;
    }
  }
}

__device__ __forceinline__ void dsincos(double x, double& s, double& c) {
  double q = rint(x * 0.63661977236758134308);
  double r = x - q * 1.57079632679489661923;
  double r2 = r * r;
  double sp = r * (1.0 + r2 * (-1.0 / 6 + r2 * (1.0 / 120 + r2 * (-1.0 / 5040 + r2 * (1.0 / 362880 + r2 * (-1.0 / 39916800 + r2 * (1.0 / 6227020800.0)))))));
  double cp = 1.0 + r2 * (-0.5 + r2 * (1.0 / 24 + r2 * (-1.0 / 720 + r2 * (1.0 / 40320 + r2 * (-1.0 / 3628800 + r2 * (1.0 / 479001600.0 + r2 * (-1.0 / 87178291200.0)))))));
  int qi = ((int)q) & 3;
  if (qi == 0) { s = sp; c = cp; }
  else if (qi == 1) { s = cp; c = -sp; }
  else if (qi == 2) { s = -sp; c = -cp; }
  else { s = -cp; c = sp; }
}

__device__ void ssm_consts(const Params& P, int i) {
  const int g = i >> 6, p = i & 63;
  double lr = P.lam_re[g * 64 + p], li = P.lam_im[g * 64 + p];
  double dt = exp((double)P.log_dt[g]);
  double mag = exp(lr * dt);
  double sn, cs;
  dsincos(li * dt, sn, cs);
  double ar = mag * cs, ai = mag * sn;
  double nr = ar - 1.0, ni = ai, den = lr * lr + li * li;
  double fr = (nr * lr + ni * li) / den, fi = (ni * lr - nr * li) / den;
  u16* bcat = (u16*)(P.ws + O_BCAT);
  u16* ccat = (u16*)(P.ws + O_CCAT);
  float* lam = (float*)(P.ws + O_LAM);
  for (int h = 0; h < 16; ++h) {
    double br = P.b_re[(g * 64 + p) * 16 + h], bi = P.b_im[(g * 64 + p) * 16 + h];
    bcat[(g * 128 + p) * 32 + h] = f2bf((float)(fr * br - fi * bi));
    bcat[(g * 128 + 64 + p) * 32 + h] = f2bf((float)(fr * bi + fi * br));
    bcat[(g * 128 + p) * 32 + 16 + h] = 0;
    bcat[(g * 128 + 64 + p) * 32 + 16 + h] = 0;
    ccat[(g * 16 + h) * 128 + p] = f2bf(P.c_re[(g * 16 + h) * 64 + p]);
    ccat[(g * 16 + h) * 128 + 64 + p] = f2bf(-P.c_im[(g * 16 + h) * 64 + p]);
  }
  double pr = ar, pi = ai;
  for (int k = 0; k < 10; ++k) {
    double t = pr * pr - pi * pi;
    pi = 2.0 * pr * pi;
    pr = t;
  }
  lam[0 * 4096 + i] = (float)ar;
  lam[1 * 4096 + i] = (float)ai;
  lam[2 * 4096 + i] = (float)pr;
  lam[3 * 4096 + i] = (float)pi;
}

__device__ void phase0(const Params& P, int bid, int nb, u16* lds) {
  const size_t gtid = (size_t)bid * 256 + tidx(), nth = (size_t)nb * 256;
#define TCONV(wp, KK, NN, OFF) \
  for (int t = bid; t < ((KK) >> 6) * ((NN) >> 6); t += nb) tconv_tile(wp, KK, NN, (u16*)(P.ws + OFF), t, (float*)lds);
  TCONV(P.w_in, 2048, 8192, O_WIN)
  TCONV(P.w_glu, 1024, 1024, O_WGLU)
  TCONV(P.w_au, 1024, 2048, O_WAU)
  TCONV(P.w_su, 1024, 2048, O_WSU)
  TCONV(P.w_out, 2048, 2048, O_WOUT)
  TCONV(P.w_pq, 2048, 2048, O_WPQ)
  TCONV(P.ple_w_gate, 2048, 2048, O_WPG)
  TCONV(P.ple_w_in, 256, 2048, O_WPIN)
  conv_fp8_rows(P.peer_u, (unsigned char*)(P.ws + O_U8), (float*)(P.ws + O_RSU), bid * 4 + (tidx() >> 6), nb * 4);
  conv_fp8_rows(P.peer_v, (unsigned char*)(P.ws + O_V8), (float*)(P.ws + O_RSV), bid * 4 + (tidx() >> 6), nb * 4);
  conv_linear(P.sub_keys, (u16*)(P.ws + O_SK), (size_t)16 * 128 * 128 / 8, gtid, nth);
  conv_linear(P.p, (u16*)(P.ws + O_PB), (size_t)T_ * 256 / 8, gtid, nth);
  for (size_t i = gtid; i < 4096; i += nth) ssm_consts(P, (int)i);
  ln_rows(P.x, P.ln_in_g, P.ln_in_b, (u16*)(P.ws + O_H), bid * 4 + (tidx() >> 6), nb * 4);
}

__device__ void phase1(const Params& P, int bid, int nb, u16* lds) {
  const u16* H = (const u16*)(P.ws + O_H);
  const u16* W = (const u16*)(P.ws + O_WIN);
  u16* Q = (u16*)(P.ws + O_Q);
  u16* Kb = (u16*)(P.ws + O_K);
  u16* Vt = (u16*)(P.ws + O_VT);
  u16* U2 = (u16*)(P.ws + O_U2);
  u16* G = (u16*)(P.ws + O_G);
  EPI_COORDS3
  const int ntiles = 128 * 32;
  for (int t = bid; t < ntiles; t += nb) {
    const int mt = t >> 5, nt = t & 31;
    f32x4 acc[4][8];
    ZERO_ACC8(acc)
    gemm_kloop3(acc, H + (size_t)mt * 256 * D_, D_, W + (size_t)nt * 256 * D_, D_, D_, lds);
    const int region = (nt * 256 + wn * 128) >> 10;
#pragma unroll
    for (int mi = 0; mi < 4; ++mi) {
      const int m = mt * 256 + wm * 64 + mi * 16 + lr;
#pragma unroll
      for (int ni = 0; ni < 8; ++ni) {
        const int n = nt * 256 + wn * 128 + ni * 16 + lq * 4;
        f32x4 a = acc[mi][ni];
        if (region == 0) {
          const float sc = 0.08838834764831845f;
          store_bf4(Q + (size_t)m * 1024 + n, a[0] * sc, a[1] * sc, a[2] * sc, a[3] * sc);
        } else if (region == 1) {
          store_bf4(Kb + (size_t)m * 1024 + (n - 1024), a[0], a[1], a[2], a[3]);
        } else if (region == 2) {
          const int b = m >> 14, tt = m & (S_ - 1);
#pragma unroll
          for (int j = 0; j < 4; ++j) Vt[((size_t)(b * 1024 + (n - 2048 + j))) * S_ + tt] = f2bf(a[j]);
        } else if (region == 3) {
          store_bf4(U2 + (size_t)m * 1024 + (n - 3072), a[0], a[1], a[2], a[3]);
        } else {
          store_bf4(G + (size_t)m * 4096 + (n - 4096), sigmoidf_(a[0]), sigmoidf_(a[1]), sigmoidf_(a[2]), sigmoidf_(a[3]));
        }
      }
    }
  }
}

__device__ void attn_item(const Params& P, int item, u16* lds) {
  const int c = item >> 4, hd = item & 7, b = (item >> 3) & 1;
  const int tid = tidx(), lane = tid & 63, w = tid >> 6, lr = lane & 15, lq = lane >> 4;
  u16* Ks = lds;
  u16* Vs = lds + 64 * 136;
  float* bs = (float*)(lds + 64 * 136 + 128 * 72);
  const u16* Q = (const u16*)(P.ws + O_Q);
  const u16* Kb = (const u16*)(P.ws + O_K);
  const u16* Vt = (const u16*)(P.ws + O_VT);
  u16* ya = (u16*)(P.ws + O_YA);
  __syncthreads();
  for (int i = tid; i < 257; i += 256) bs[i] = P.rel_bias[hd * 257 + i];
  bf16x8 qf[4];
  {
    const u16* qp = Q + (size_t)(b * S_ + c * 64 + w * 16 + lr) * 1024 + hd * 128 + lq * 8;
#pragma unroll
    for (int ks = 0; ks < 4; ++ks) qf[ks] = *(const bf16x8*)(qp + ks * 32);
  }
  f32x4 oacc[8];
#pragma unroll
  for (int d = 0; d < 8; ++d) oacc[d] = f32x4{0.f, 0.f, 0.f, 0.f};
  float m_run = -1e30f, lsum = 0.f;
  const int i0 = (c < 8) ? (8 - c) : 0;
  const int qi = w * 16 + lr;
#define KV_ADDR_K(r, kc_) (Kb + (size_t)(b * S_ + (kc_) * 64 + ((tid + 256 * (r)) >> 4)) * 1024 + hd * 128 + ((tid + 256 * (r)) & 15) * 8)
#define KV_ADDR_V(r, kc_) (Vt + ((size_t)(b * 1024 + hd * 128 + ((tid + 256 * (r)) >> 3))) * S_ + (kc_) * 64 + ((tid + 256 * (r)) & 7) * 8)
#define KV_LOAD(kc_)                                                                   \
  kr0 = *(const uint4*)KV_ADDR_K(0, kc_); kr1 = *(const uint4*)KV_ADDR_K(1, kc_);     \
  kr2 = *(const uint4*)KV_ADDR_K(2, kc_); kr3 = *(const uint4*)KV_ADDR_K(3, kc_);     \
  vr0 = *(const uint4*)KV_ADDR_V(0, kc_); vr1 = *(const uint4*)KV_ADDR_V(1, kc_);     \
  vr2 = *(const uint4*)KV_ADDR_V(2, kc_); vr3 = *(const uint4*)KV_ADDR_V(3, kc_);
#define KS_W(r) (Ks + ((tid + 256 * (r)) >> 4) * 136 + ((tid + 256 * (r)) & 15) * 8)
#define VS_W(r) (Vs + ((tid + 256 * (r)) >> 3) * 72 + ((tid + 256 * (r)) & 7) * 8)
#define KV_LOADS(S, kc_)                                                                \
  S##k0 = *(const uint4*)KV_ADDR_K(0, kc_); S##k1 = *(const uint4*)KV_ADDR_K(1, kc_);   \
  S##k2 = *(const uint4*)KV_ADDR_K(2, kc_); S##k3 = *(const uint4*)KV_ADDR_K(3, kc_);   \
  S##v0 = *(const uint4*)KV_ADDR_V(0, kc_); S##v1 = *(const uint4*)KV_ADDR_V(1, kc_);   \
  S##v2 = *(const uint4*)KV_ADDR_V(2, kc_); S##v3 = *(const uint4*)KV_ADDR_V(3, kc_);
#define KV_WRITES(S)                                                                                   \
  *(uint4*)KS_W(0) = S##k0; *(uint4*)KS_W(1) = S##k1; *(uint4*)KS_W(2) = S##k2; *(uint4*)KS_W(3) = S##k3; \
  *(uint4*)VS_W(0) = S##v0; *(uint4*)VS_W(1) = S##v1; *(uint4*)VS_W(2) = S##v2; *(uint4*)VS_W(3) = S##v3;
  uint4 Ak0, Ak1, Ak2, Ak3, Av0, Av1, Av2, Av3, Bk0, Bk1, Bk2, Bk3, Bv0, Bv1, Bv2, Bv3;
  auto tile_compute = [&](const int i) {
    f32x4 sacc[4];
#pragma unroll
    for (int kt = 0; kt < 4; ++kt) {
      sacc[kt] = f32x4{0.f, 0.f, 0.f, 0.f};
#pragma unroll
      for (int ks = 0; ks < 4; ++ks) {
        bf16x8 kf = *(const bf16x8*)(Ks + (kt * 16 + lr) * 136 + ks * 32 + lq * 8);
        sacc[kt] = __builtin_amdgcn_mfma_f32_16x16x32_bf16(kf, qf[ks], sacc[kt], 0, 0, 0);
      }
    }
    float tmax = -1e30f;
#pragma unroll
    for (int kt = 0; kt < 4; ++kt)
#pragma unroll
      for (int j = 0; j < 4; ++j) {
        int kb = i * 64 + kt * 16 + lq * 4 + j;
        int rel = 512 + qi - kb;
        rel = min(max(rel, -128), 128) + 128;
        float s = sacc[kt][j] + bs[rel];
        sacc[kt][j] = s;
        tmax = fmaxf(tmax, s);
      }
    tmax = fmaxf(tmax, __shfl_xor(tmax, 16));
    tmax = fmaxf(tmax, __shfl_xor(tmax, 32));
    const float m_new = fmaxf(m_run, tmax);
    const float corr = __expf(m_run - m_new);
    m_run = m_new;
    float ps = 0.f;
#pragma unroll
    for (int kt = 0; kt < 4; ++kt)
#pragma unroll
      for (int j = 0; j < 4; ++j) {
        float pv = __expf(sacc[kt][j] - m_new);
        sacc[kt][j] = pv;
        ps += pv;
      }
    lsum = lsum * corr + ps;
#pragma unroll
    for (int d = 0; d < 8; ++d) {
      oacc[d][0] *= corr; oacc[d][1] *= corr; oacc[d][2] *= corr; oacc[d][3] *= corr;
    }
#pragma unroll
    for (int kk = 0; kk < 2; ++kk) {
      union { bf16x8 v; unsigned u[4]; } pf;
      pf.u[0] = pack2(sacc[2 * kk][0], sacc[2 * kk][1]);
      pf.u[1] = pack2(sacc[2 * kk][2], sacc[2 * kk][3]);
      pf.u[2] = pack2(sacc[2 * kk + 1][0], sacc[2 * kk + 1][1]);
      pf.u[3] = pack2(sacc[2 * kk + 1][2], sacc[2 * kk + 1][3]);
#pragma unroll
      for (int d = 0; d < 8; ++d) {
        union { bf16x8 v; uint2 h[2]; } vf;
        vf.h[0] = *(const uint2*)(Vs + (d * 16 + lr) * 72 + kk * 32 + lq * 4);
        vf.h[1] = *(const uint2*)(Vs + (d * 16 + lr) * 72 + kk * 32 + 16 + lq * 4);
        oacc[d] = __builtin_amdgcn_mfma_f32_16x16x32_bf16(vf.v, pf.v, oacc[d], 0, 0, 0);
      }
    }
  };
  KV_LOADS(A, c - 8 + i0)
  if (i0 + 1 <= 8) { KV_LOADS(B, c - 8 + i0 + 1) }
  for (int i = i0; i <= 8; i += 2) {
    __syncthreads();
    KV_WRITES(A)
    __syncthreads();
    if (i + 2 <= 8) { KV_LOADS(A, c - 8 + i + 2) }
    tile_compute(i);
    if (i + 1 > 8) break;
    __syncthreads();
    KV_WRITES(B)
    __syncthreads();
    if (i + 3 <= 8) { KV_LOADS(B, c - 8 + i + 3) }
    tile_compute(i + 1);
  }
  lsum += __shfl_xor(lsum, 16);
  lsum += __shfl_xor(lsum, 32);
  const float inv = 1.f / lsum;
  u16* op = ya + (size_t)(b * S_ + c * 64 + w * 16 + lr) * 1024 + hd * 128 + lq * 4;
#pragma unroll
  for (int d = 0; d < 8; ++d) store_bf4(op + d * 16, oacc[d][0] * inv, oacc[d][1] * inv, oacc[d][2] * inv, oacc[d][3] * inv);
}

template <int PASS>
__device__ void ssm_item(const Params& P, int item, char* ldsw) {
  const int sc = item & 15, seq = item >> 4, g = seq & 63, b = seq >> 6;
  const int lane = tidx() & 63, lr = lane & 15, lq = lane >> 4;
  float* BuS = (float*)ldsw;
  u16* Hs = (u16*)(ldsw + 8448);
  const u16* bcat = (const u16*)(P.ws + O_BCAT);
  const u16* ccat = (const u16*)(P.ws + O_CCAT);
  const float* lam = (const float*)(P.ws + O_LAM);
  const u16* U2 = (const u16*)(P.ws + O_U2);
  float* Sbuf = (float*)(P.ws + O_SBUF);
  u16* ys = (u16*)(P.ws + O_YS);
  const float ar = lam[g * 64 + lane], ai = lam[4096 + g * 64 + lane];
  bf16x8 bfrag[8];
#pragma unroll
  for (int nt = 0; nt < 8; ++nt) bfrag[nt] = *(const bf16x8*)(bcat + (g * 128 + nt * 16 + lr) * 32 + lq * 8);
  float sr = 0.f, si = 0.f;
  bf16x8 cfrag[4];
  float dsk[4];
  if (PASS == 2) {
#pragma unroll
    for (int ks = 0; ks < 4; ++ks) cfrag[ks] = *(const bf16x8*)(ccat + (g * 16 + lr) * 128 + ks * 32 + lq * 8);
#pragma unroll
    for (int j = 0; j < 4; ++j) dsk[j] = P.ssm_d[g * 16 + lq * 4 + j];
    const float aLr = lam[2 * 4096 + g * 64 + lane], aLi = lam[3 * 4096 + g * 64 + lane];
    const float* Sb = Sbuf + (size_t)seq * 16 * 128;
#pragma unroll 4
    for (int cc = 0; cc < sc; ++cc) {
      float xr = Sb[cc * 128 + lane], xi = Sb[cc * 128 + 64 + lane];
      float nr = fmaf(aLr, sr, fmaf(-aLi, si, xr));
      float ni = fmaf(aLr, si, fmaf(aLi, sr, xi));
      sr = nr; si = ni;
    }
  }
#pragma unroll 1
  for (int ci = 0; ci < 8; ++ci) {
  const size_t tok_base = (size_t)b * S_ + (size_t)(sc * 8 + ci) * SSM_L;
  uint4 upre[SSM_L / 16];
  uint2 uepi[SSM_L / 16];
#pragma unroll
  for (int sub = 0; sub < SSM_L / 16; ++sub) {
    upre[sub] = uint4{0u, 0u, 0u, 0u};
    if (lq < 2) upre[sub] = *(const uint4*)(U2 + (tok_base + sub * 16 + lr) * 1024 + g * 16 + lq * 8);
    if (PASS == 2) uepi[sub] = *(const uint2*)(U2 + (tok_base + sub * 16 + lr) * 1024 + g * 16 + lq * 4);
  }
#pragma unroll
  for (int sub = 0; sub < SSM_L / 16; ++sub) {
    const size_t tok0 = tok_base + sub * 16;
    union { bf16x8 v; uint4 u; } uf;
    uf.u = upre[sub];
#pragma unroll
    for (int nt = 0; nt < 8; ++nt) {
      f32x4 d = __builtin_amdgcn_mfma_f32_16x16x32_bf16(bfrag[nt], uf.v, f32x4{0.f, 0.f, 0.f, 0.f}, 0, 0, 0);
      *(f32x4*)(BuS + lr * 132 + nt * 16 + lq * 4) = d;
    }
    asm volatile("s_waitcnt lgkmcnt(0)" ::: "memory");
    float bur[16], bui[16];
#pragma unroll
    for (int t = 0; t < 16; ++t) { bur[t] = BuS[t * 132 + lane]; bui[t] = BuS[t * 132 + 64 + lane]; }
    asm volatile("s_waitcnt lgkmcnt(0)" ::: "memory");
#pragma unroll
    for (int t = 0; t < 16; ++t) {
      float nr = fmaf(ar, sr, fmaf(-ai, si, bur[t]));
      float ni = fmaf(ar, si, fmaf(ai, sr, bui[t]));
      sr = nr; si = ni;
      if (PASS == 2) {
        const unsigned pk = pack2(sr, si);
        Hs[t * 136 + lane] = (u16)(pk & 0xffffu);
        Hs[t * 136 + 64 + lane] = (u16)(pk >> 16);
      }
    }
    asm volatile("s_waitcnt lgkmcnt(0)" ::: "memory");
    if (PASS == 2) {
      f32x4 yacc = f32x4{0.f, 0.f, 0.f, 0.f};
#pragma unroll
      for (int ks = 0; ks < 4; ++ks) {
        bf16x8 hf = *(const bf16x8*)(Hs + lr * 136 + ks * 32 + lq * 8);
        yacc = __builtin_amdgcn_mfma_f32_16x16x32_bf16(cfrag[ks], hf, yacc, 0, 0, 0);
      }
      const uint2 uu = uepi[sub];
      float y0 = gelu_tanh(yacc[0] + dsk[0] * lo2f(uu.x));
      float y1 = gelu_tanh(yacc[1] + dsk[1] * hi2f(uu.x));
      float y2 = gelu_tanh(yacc[2] + dsk[2] * lo2f(uu.y));
      float y3 = gelu_tanh(yacc[3] + dsk[3] * hi2f(uu.y));
      store_bf4(ys + (tok0 + lr) * 1024 + g * 16 + lq * 4, y0, y1, y2, y3);
      asm volatile("s_waitcnt lgkmcnt(0)" ::: "memory");
    }
  }
  }
  if (PASS == 1) {
    Sbuf[((size_t)seq * 16 + sc) * 128 + lane] = sr;
    Sbuf[((size_t)seq * 16 + sc) * 128 + 64 + lane] = si;
  }
}

__device__ void phase2(const Params& P, int bid, int nb, u16* lds) {
  for (int it = bid; it < 4096 + 512; it += nb) {
    if (it < 4096) {
      attn_item(P, it, lds);
    } else {
      __syncthreads();
      const int w = tidx() >> 6;
      ssm_item<1>(P, (it - 4096) * 4 + w, (char*)lds + w * 12800);
    }
  }
}
__device__ void phase3(const Params& P, int bid, int nb, u16* lds) {
  const int w = tidx() >> 6;
  for (int it = bid; it < 512; it += nb) ssm_item<2>(P, it * 4 + w, (char*)lds + w * 12800);
}

__device__ void phase4(const Params& P, int bid, int nb, u16* lds) {
  const u16* ys = (const u16*)(P.ws + O_YS);
  const u16* W = (const u16*)(P.ws + O_WGLU);
  u16* yg = (u16*)(P.ws + O_YG);
  EPI_COORDS3
  FOR_TILES_XCD(t, 128 * 4) {
    const int mt = t >> 2, nt = t & 3;
    f32x4 acc[4][8];
    ZERO_ACC8(acc)
    gemm_kloop3(acc, ys + (size_t)mt * 256 * 1024, 1024, W + (size_t)nt * 256 * 1024, 1024, 1024, lds);
#pragma unroll
    for (int mi = 0; mi < 4; ++mi) {
      const int m = mt * 256 + wm * 64 + mi * 16 + lr;
#pragma unroll
      for (int ni = 0; ni < 8; ++ni) {
        const int n = nt * 256 + wn * 128 + ni * 16 + lq * 4;
        uint2 yy = *(const uint2*)(ys + (size_t)m * 1024 + n);
        f32x4 a = acc[mi][ni];
        store_bf4(yg + (size_t)m * 1024 + n, lo2f(yy.x) * sigmoidf_(a[0]), hi2f(yy.x) * sigmoidf_(a[1]),
                  lo2f(yy.y) * sigmoidf_(a[2]), hi2f(yy.y) * sigmoidf_(a[3]));
      }
    }
  }
}

__device__ void phase5(const Params& P, int bid, int nb, u16* lds) {
  const u16* ya = (const u16*)(P.ws + O_YA);
  const u16* yg = (const u16*)(P.ws + O_YG);
  const u16* Wa = (const u16*)(P.ws + O_WAU);
  const u16* Wsu = (const u16*)(P.ws + O_WSU);
  const u16* G = (const u16*)(P.ws + O_G);
  u16* mg = (u16*)(P.ws + O_MERGED);
  EPI_COORDS3
  FOR_TILES_XCD(t, 128 * 8) {
    const int mt = t >> 3, nt = t & 7;
#pragma unroll 1
    for (int part = 0; part < 2; ++part) {
      f32x4 acc[4][8];
      ZERO_ACC8(acc)
      gemm_kloop3(acc, (part ? yg : ya) + (size_t)mt * 256 * 1024, 1024, (part ? Wsu : Wa) + (size_t)nt * 256 * 1024, 1024,
                  1024, lds);
      const u16* Gp = G + part * 2048;
#pragma unroll
      for (int mi = 0; mi < 4; ++mi) {
        const int m = mt * 256 + wm * 64 + mi * 16 + lr;
#pragma unroll
        for (int ni = 0; ni < 8; ++ni) {
          const int n = nt * 256 + wn * 128 + ni * 16 + lq * 4;
          const uint2 gg = *(const uint2*)(Gp + (size_t)m * 4096 + n);
          f32x4 a = acc[mi][ni];
          float o0 = a[0] * lo2f(gg.x), o1 = a[1] * hi2f(gg.x), o2 = a[2] * lo2f(gg.y), o3 = a[3] * hi2f(gg.y);
          if (part) {
            const uint2 pv = *(const uint2*)(mg + (size_t)m * D_ + n);
            o0 += lo2f(pv.x); o1 += hi2f(pv.x); o2 += lo2f(pv.y); o3 += hi2f(pv.y);
          }
          store_bf4(mg + (size_t)m * D_ + n, o0, o1, o2, o3);
        }
      }
    }
  }
}

__device__ void phase6(const Params& P, int bid, int nb, u16* lds) {
  const u16* mg = (const u16*)(P.ws + O_MERGED);
  const u16* W = (const u16*)(P.ws + O_WOUT);
  const u16* H = (const u16*)(P.ws + O_H);
  u16* pre1 = (u16*)(P.ws + O_PRE1);
  EPI_COORDS3
  FOR_TILES_XCD(t, 128 * 8) {
    const int mt = t >> 3, nt = t & 7;
    f32x4 acc[4][8];
    ZERO_ACC8(acc)
    gemm_kloop3(acc, mg + (size_t)mt * 256 * D_, D_, W + (size_t)nt * 256 * D_, D_, D_, lds);
#pragma unroll
    for (int mi = 0; mi < 4; ++mi) {
      const int m = mt * 256 + wm * 64 + mi * 16 + lr;
#pragma unroll
      for (int ni = 0; ni < 8; ++ni) {
        const int n = nt * 256 + wn * 128 + ni * 16 + lq * 4;
        uint2 hh = *(const uint2*)(H + (size_t)m * D_ + n);
        f32x4 a = acc[mi][ni];
        store_bf4(pre1 + (size_t)m * D_ + n, ALPHA * lo2f(hh.x) + a[0], ALPHA * hi2f(hh.x) + a[1],
                  ALPHA * lo2f(hh.y) + a[2], ALPHA * hi2f(hh.y) + a[3]);
      }
    }
  }
}

__device__ void phase8(const Params& P, int bid, int nb, u16* lds) {
  const u16* H = (const u16*)(P.ws + O_H);
  const u16* Pb = (const u16*)(P.ws + O_PB);
  u16* PQ = (u16*)(P.ws + O_PQ);
  u16* SG = (u16*)(P.ws + O_SG);
  u16* E = (u16*)(P.ws + O_E);
  EPI_COORDS3
  FOR_TILES_XCD(t, 3 * 1024) {
    const int which = t >> 10, tt = t & 1023, mt = tt >> 3, nt = tt & 7;
    f32x4 acc[4][8];
    ZERO_ACC8(acc)
    u16* dst;
    if (which == 0) {
      gemm_kloop3(acc, H + (size_t)mt * 256 * D_, D_, (const u16*)(P.ws + O_WPQ) + (size_t)nt * 256 * D_, D_, D_, lds);
      dst = PQ;
    } else if (which == 1) {
      gemm_kloop3(acc, H + (size_t)mt * 256 * D_, D_, (const u16*)(P.ws + O_WPG) + (size_t)nt * 256 * D_, D_, D_, lds);
      dst = SG;
    } else {
      gemm_kloop3(acc, Pb + (size_t)mt * 256 * 256, 256, (const u16*)(P.ws + O_WPIN) + (size_t)nt * 256 * 256, 256, 256, lds);
      dst = E;
    }
#pragma unroll
    for (int mi = 0; mi < 4; ++mi) {
      const int m = mt * 256 + wm * 64 + mi * 16 + lr;
#pragma unroll
      for (int ni = 0; ni < 8; ++ni) {
        const int n = nt * 256 + wn * 128 + ni * 16 + lq * 4;
        f32x4 a = acc[mi][ni];
        if (which == 1) { a[0] = sigmoidf_(a[0]); a[1] = sigmoidf_(a[1]); a[2] = sigmoidf_(a[2]); a[3] = sigmoidf_(a[3]); }
        store_bf4(dst + (size_t)m * D_ + n, a[0], a[1], a[2], a[3]);
      }
    }
  }
}

struct Top16 { float v[16]; int i[16]; };
__device__ __forceinline__ void top_init(Top16& t) {
#pragma unroll
  for (int k = 0; k < 16; ++k) { t.v[k] = -INFINITY; t.i[k] = 0; }
}
__device__ __forceinline__ void top_insert(Top16& t, float x, int id) {
  const bool c = x > t.v[15];
  t.v[15] = c ? x : t.v[15];
  t.i[15] = c ? id : t.i[15];
#pragma unroll
  for (int k = 15; k >= 1; --k) {
    const bool s = t.v[k] > t.v[k - 1];
    const float a = t.v[k - 1], b = t.v[k];
    const int ia = t.i[k - 1], ib = t.i[k];
    t.v[k - 1] = s ? b : a; t.v[k] = s ? a : b;
    t.i[k - 1] = s ? ib : ia; t.i[k] = s ? ia : ib;
  }
}

__device__ void phase9(const Params& P, int bid, int nb, u16* lds) {
  const u16* PQ = (const u16*)(P.ws + O_PQ);
  const u16* SK = (const u16*)(P.ws + O_SK);
  float* HV = (float*)(P.ws + O_HV);
  int* HI = (int*)(P.ws + O_HI);
  float* Sc = (float*)lds;
  EPI_COORDS
  const int tid = tidx();
  for (int t = bid; t < 256 * 16; t += nb) {
    const int mt = t >> 4, rc = t & 15;
    f32x4 acc[4][4];
    ZERO_ACC(acc)
    gemm_kloop(acc, PQ + (size_t)mt * 128 * D_ + rc * 128, D_, SK + (size_t)rc * 128 * 128, 128, 128, lds);
#pragma unroll
    for (int mi = 0; mi < 4; ++mi) {
      const int m = wm * 64 + mi * 16 + lr;
#pragma unroll
      for (int ni = 0; ni < 4; ++ni) {
        const int n = wn * 64 + ni * 16 + lq * 4;
#pragma unroll
        for (int j = 0; j < 4; ++j) Sc[m * 129 + n + j] = acc[mi][ni][j];
      }
    }
    __syncthreads();
    const int tok = tid & 127, hh = tid >> 7;
    float key[16];
#pragma unroll
    for (int j = 0; j < 16; ++j) key[j] = -INFINITY;
    {
      const float* sp = Sc + tok * 129 + hh * 64;
#pragma unroll 4
      for (int k = 0; k < 64; ++k) {
        const float x = sp[k];
        const float kk = __uint_as_float((__float_as_uint(x) & ~127u) | (unsigned)(127 - (hh * 64 + k)));
#pragma unroll
        for (int j = 15; j >= 1; --j) key[j] = __builtin_amdgcn_fmed3f(key[j - 1], key[j], kk);
        key[0] = fmaxf(key[0], kk);
      }
    }
    __syncthreads();
    float* Lv = (float*)lds;
#pragma unroll
    for (int k = 0; k < 16; ++k) Lv[tid * 17 + k] = key[k];
    __syncthreads();
    if (tid < 128) {
      int ia = 0, ib = 0;
      const float* va = Lv + tid * 17; const float* vb = Lv + (tid + 128) * 17;
      float* ov = HV + ((size_t)(mt * 16 + rc) * 128 + tid) * 16;
      int* oi = HI + ((size_t)(mt * 16 + rc) * 128 + tid) * 16;
      for (int k = 0; k < 16; ++k) {
        const float a = va[ia], b = vb[ib];
        const bool ta = a >= b;
        const unsigned bits = __float_as_uint(ta ? a : b);
        ov[k] = __uint_as_float(bits & ~127u);
        oi[k] = 127 - (int)(bits & 127u);
        ia += ta ? 1 : 0; ib += ta ? 0 : 1;
      }
    }
    __syncthreads();
  }
}

__device__ void phase10(const Params& P, int bid, int nb, u16* lds) {
  int* Lx = (int*)lds + tidx() * 33;
  const float* HV = (const float*)(P.ws + O_HV);
  const int* HI = (const int*)(P.ws + O_HI);
  int* EX = (int*)(P.ws + O_EXP);
  float* GT = (float*)(P.ws + O_GATE);
  for (int i_ = bid * 256 + tidx(); i_ < T_ * 8; i_ += nb * 256) {
    const int r_ = (i_ >> 7) & 7, mt_ = i_ >> 10, tl_ = i_ & 127;
    const int i = (mt_ * 128 + tl_) * 8 + r_;
    const size_t h0 = ((size_t)(mt_ * 16 + r_ * 2) * 128 + tl_) * 16, h1 = h0 + 128 * 16;
    float v0[16], v1[16];
    int i0[16], i1[16];
#pragma unroll
    for (int q = 0; q < 4; ++q) {
      float4 a = *(const float4*)(HV + h0 + q * 4);
      float4 b = *(const float4*)(HV + h1 + q * 4);
      int4 c = *(const int4*)(HI + h0 + q * 4);
      int4 d = *(const int4*)(HI + h1 + q * 4);
      v0[q * 4] = a.x; v0[q * 4 + 1] = a.y; v0[q * 4 + 2] = a.z; v0[q * 4 + 3] = a.w;
      v1[q * 4] = b.x; v1[q * 4 + 1] = b.y; v1[q * 4 + 2] = b.z; v1[q * 4 + 3] = b.w;
      i0[q * 4] = c.x; i0[q * 4 + 1] = c.y; i0[q * 4 + 2] = c.z; i0[q * 4 + 3] = c.w;
      i1[q * 4] = d.x; i1[q * 4 + 1] = d.y; i1[q * 4 + 2] = d.z; i1[q * 4 + 3] = d.w;
    }
    float t[16];
#pragma unroll
    for (int j = 0; j < 16; ++j) t[j] = -INFINITY;
#pragma unroll
    for (int a = 0; a < 16; ++a)
#pragma unroll
      for (int b = 0; b < 16; ++b)
        if ((a + 1) * (b + 1) <= 16) {
          const float sv = v0[a] + v1[b];
#pragma unroll
          for (int j = 15; j >= 1; --j) t[j] = __builtin_amdgcn_fmed3f(t[j - 1], t[j], sv);
          t[0] = fmaxf(t[0], sv);
        }
    const float mx = t[0], thr = t[15];
    float sum = 0.f;
#pragma unroll
    for (int k = 0; k < 16; ++k) sum += __expf(t[k] - mx);
    const float inv = 1.f / sum;
    int cnt = 0;
#pragma unroll
    for (int a = 0; a < 16; ++a)
#pragma unroll
      for (int b = 0; b < 16; ++b)
        if ((a + 1) * (b + 1) <= 16) {
          const float sv = v0[a] + v1[b];
          if (sv >= thr && cnt < 16) {
            Lx[cnt] = i0[a] * 128 + i1[b];
            Lx[16 + cnt] = __float_as_int(__expf(sv - mx) * inv);
            ++cnt;
          }
        }
    asm volatile("s_waitcnt lgkmcnt(0)" ::: "memory");
#pragma unroll
    for (int q = 0; q < 4; ++q) {
      *(int4*)(EX + (size_t)i * 16 + q * 4) = int4{Lx[q * 4], Lx[q * 4 + 1], Lx[q * 4 + 2], Lx[q * 4 + 3]};
      *(float4*)(GT + (size_t)i * 16 + q * 4) =
          float4{__int_as_float(Lx[16 + q * 4]), __int_as_float(Lx[16 + q * 4 + 1]), __int_as_float(Lx[16 + q * 4 + 2]),
                 __int_as_float(Lx[16 + q * 4 + 3])};
    }
    asm volatile("s_waitcnt lgkmcnt(0)" ::: "memory");
  }
}

__device__ __forceinline__ void unpack8(uint4 u, float* f) {
  f[0] = lo2f(u.x); f[1] = hi2f(u.x); f[2] = lo2f(u.y); f[3] = hi2f(u.y);
  f[4] = lo2f(u.z); f[5] = hi2f(u.z); f[6] = lo2f(u.w); f[7] = hi2f(u.w);
}
__device__ __forceinline__ void dec16(uint4 u, float* f) {
  f32x2 a;
  a = __builtin_amdgcn_cvt_pk_f32_fp8((int)u.x, false); f[0] = a.x; f[1] = a.y;
  a = __builtin_amdgcn_cvt_pk_f32_fp8((int)u.x, true);  f[2] = a.x; f[3] = a.y;
  a = __builtin_amdgcn_cvt_pk_f32_fp8((int)u.y, false); f[4] = a.x; f[5] = a.y;
  a = __builtin_amdgcn_cvt_pk_f32_fp8((int)u.y, true);  f[6] = a.x; f[7] = a.y;
  a = __builtin_amdgcn_cvt_pk_f32_fp8((int)u.z, false); f[8] = a.x; f[9] = a.y;
  a = __builtin_amdgcn_cvt_pk_f32_fp8((int)u.z, true);  f[10] = a.x; f[11] = a.y;
  a = __builtin_amdgcn_cvt_pk_f32_fp8((int)u.w, false); f[12] = a.x; f[13] = a.y;
  a = __builtin_amdgcn_cvt_pk_f32_fp8((int)u.w, true);  f[14] = a.x; f[15] = a.y;
}
__device__ __forceinline__ void load_row_bf16(const u16* row, int lane, float* f) {
#pragma unroll
  for (int q = 0; q < 2; ++q) {
    uint4 a = *(const uint4*)(row + q * 1024 + lane * 16);
    uint4 b = *(const uint4*)(row + q * 1024 + lane * 16 + 8);
    unpack8(a, f + q * 16);
    unpack8(b, f + q * 16 + 8);
  }
}
__device__ __forceinline__ void pace_xcd(unsigned* ctr, unsigned& epoch, unsigned nloc) {
  epoch += nloc;
  __syncthreads();
  if (threadIdx.x == 0) {
    __hip_atomic_fetch_add(ctr, 1u, __ATOMIC_RELAXED, __HIP_MEMORY_SCOPE_AGENT);
    unsigned sp = 0;
    while (__hip_atomic_load(ctr, __ATOMIC_RELAXED, __HIP_MEMORY_SCOPE_AGENT) < epoch && ++sp < (1u << 16)) __builtin_amdgcn_s_sleep(2);
  }
  __syncthreads();
}
__device__ void phase11(const Params& P, int bid, int nb, unsigned xcc, unsigned nloc) {
  unsigned* pctr = (unsigned*)(P.ws + (1000 * MB + 1024) + xcc * 128);
  unsigned pep = 0;
  const bool do_pace = (T_ % (nb * 4)) == 0 && nloc > 0;
  const u16* H = (const u16*)(P.ws + O_H);
  const unsigned char* U8 = (const unsigned char*)(P.ws + O_U8);
  const unsigned char* V8 = (const unsigned char*)(P.ws + O_V8);
  const float* RSU = (const float*)(P.ws + O_RSU);
  const float* RSV = (const float*)(P.ws + O_RSV);
  const u16* SG = (const u16*)(P.ws + O_SG);
  const u16* E = (const u16*)(P.ws + O_E);
  const int* EX = (const int*)(P.ws + O_EXP);
  const float* GT = (const float*)(P.ws + O_GATE);
  const int lane = tidx() & 63;
  int sweep = 0;
  for (int tok = bid * 4 + (tidx() >> 6); tok < T_; tok += nb * 4, sweep ^= 1) {
    if (do_pace && tok >= nb * 4) pace_xcd(pctr, pep, nloc);
    float hf[32], y[32];
    load_row_bf16(H + (size_t)tok * D_, lane, hf);
#pragma unroll
    for (int k = 0; k < 32; ++k) y[k] = 0.f;
    int ev0 = EX[(size_t)tok * 128 + lane], ev1 = EX[(size_t)tok * 128 + 64 + lane];
    float gv0 = GT[(size_t)tok * 128 + lane], gv1 = GT[(size_t)tok * 128 + 64 + lane];
    {
      int k0 = (ev0 << 7) | lane, k1 = (ev1 << 7) | (64 + lane);
#pragma unroll
      for (int kk = 2; kk <= 128; kk <<= 1) {
#pragma unroll
        for (int j = kk >> 1; j >= 1; j >>= 1) {
          if (j == 64) {
            const int lo_ = min(k0, k1), hi_ = max(k0, k1);
            k0 = lo_; k1 = hi_;
          } else {
            const int p0 = __shfl_xor(k0, j), p1 = __shfl_xor(k1, j);
            const bool lower = (lane & j) == 0;
            const bool up0 = (kk == 128) ? true : ((lane & kk) == 0);
            const bool up1 = (kk == 128) ? true : (kk == 64 ? false : ((lane & kk) == 0));
            k0 = (lower == up0) ? min(k0, p0) : max(k0, p0);
            k1 = (lower == up1) ? min(k1, p1) : max(k1, p1);
          }
        }
      }
      const int s0 = k0 & 127, s1 = k1 & 127;
      const float ga0 = __shfl(gv0, s0 & 63), gb0 = __shfl(gv1, s0 & 63);
      const float ga1 = __shfl(gv0, s1 & 63), gb1 = __shfl(gv1, s1 & 63);
      gv0 = (s0 < 64) ? ga0 : gb0;
      gv1 = (s1 < 64) ? ga1 : gb1;
      ev0 = k0 >> 7;
      ev1 = k1 >> 7;
    }
    const float ru0 = RSU[ev0], ru1 = RSU[ev1], rv0 = RSV[ev0], rv1 = RSV[ev1];
    for (int k4_ = 0; k4_ < 128; k4_ += 4) {
      const int k4 = sweep ? (124 - k4_) : k4_;
      const int src = k4 & 63;
      const bool lo = k4 < 64;
      int ee[4]; float gg[4], su[4], sv[4];
#pragma unroll
      for (int x = 0; x < 4; ++x) {
        ee[x] = __shfl(lo ? ev0 : ev1, src + x);
        gg[x] = __shfl(lo ? gv0 : gv1, src + x);
        su[x] = __shfl(lo ? ru0 : ru1, src + x);
        sv[x] = __shfl(lo ? rv0 : rv1, src + x);
      }
      uint4 uu[4][2], vv[4][2];
#pragma unroll
      for (int x = 0; x < 4; ++x)
#pragma unroll
        for (int q = 0; q < 2; ++q) {
          uu[x][q] = *(const uint4*)(U8 + (size_t)ee[x] * D_ + q * 1024 + lane * 16);
          vv[x][q] = *(const uint4*)(V8 + (size_t)ee[x] * D_ + q * 1024 + lane * 16);
        }
      float dd[4];
#pragma unroll
      for (int x = 0; x < 4; ++x) {
        float d = 0.f;
#pragma unroll
        for (int q = 0; q < 2; ++q) {
          float f[16];
          dec16(uu[x][q], f);
#pragma unroll
          for (int j = 0; j < 16; ++j) d = fmaf(f[j], hf[q * 16 + j], d);
        }
        dd[x] = d;
      }
#pragma unroll
      for (int o = 32; o >= 1; o >>= 1) {
#pragma unroll
        for (int x = 0; x < 4; ++x) dd[x] += __shfl_xor(dd[x], o);
      }
#pragma unroll
      for (int x = 0; x < 4; ++x) {
        const float w = gg[x] * gelu_tanh(dd[x] * su[x]) * sv[x];
#pragma unroll
        for (int q = 0; q < 2; ++q) {
          float f[16];
          dec16(vv[x][q], f);
#pragma unroll
          for (int j = 0; j < 16; ++j) y[q * 16 + j] = fmaf(w, f[j], y[q * 16 + j]);
        }
      }
    }
    float ef[32], sg[32];
    load_row_bf16(E + (size_t)tok * D_, lane, ef);
    load_row_bf16(SG + (size_t)tok * D_, lane, sg);
    float ss = 0.f;
#pragma unroll
    for (int k = 0; k < 32; ++k) ss += ef[k] * ef[k];
    const float rr = rsqrtf(wave_sum(ss) * (1.f / D_) + 1e-5f);
    float s1 = 0.f;
#pragma unroll
    for (int q = 0; q < 2; ++q)
#pragma unroll
      for (int j4 = 0; j4 < 4; ++j4) {
        float4 g = *(const float4*)(P.ple_g + q * 1024 + lane * 16 + j4 * 4);
        const float gq[4] = {g.x, g.y, g.z, g.w};
#pragma unroll
        for (int j = 0; j < 4; ++j) {
          const int k = q * 16 + j4 * 4 + j;
          float v = ALPHA * hf[k] + y[k] + ef[k] * rr * gq[j] * sg[k];
          y[k] = v;
          s1 += v;
        }
      }
    const float mu = wave_sum(s1) * (1.f / D_);
    float s2 = 0.f;
#pragma unroll
    for (int k = 0; k < 32; ++k) { float d = y[k] - mu; s2 += d * d; }
    const float rstd = rsqrtf(wave_sum(s2) * (1.f / D_) + 1e-5f);
#pragma unroll
    for (int q = 0; q < 2; ++q)
#pragma unroll
      for (int j4 = 0; j4 < 4; ++j4) {
        const int col = q * 1024 + lane * 16 + j4 * 4;
        const int k = q * 16 + j4 * 4;
        float4 g = *(const float4*)(P.ln2_g + col), b = *(const float4*)(P.ln2_b + col);
        float4 o;
        o.x = (y[k + 0] - mu) * rstd * g.x + b.x; o.y = (y[k + 1] - mu) * rstd * g.y + b.y;
        o.z = (y[k + 2] - mu) * rstd * g.z + b.z; o.w = (y[k + 3] - mu) * rstd * g.w + b.w;
        *(float4*)(P.out + (size_t)tok * D_ + col) = o;
      }
  }
}

constexpr size_t O_BAR = 1000 * MB;
__device__ __forceinline__ void gbar(unsigned* ctr, unsigned& epoch, unsigned nb) {
  epoch += nb;
  asm volatile("s_waitcnt vmcnt(0)" ::: "memory");
  __syncthreads();
  if (threadIdx.x == 0) {
    __builtin_amdgcn_fence(__ATOMIC_RELEASE, "agent");
    asm volatile("s_waitcnt vmcnt(0)" ::: "memory");
    __hip_atomic_fetch_add(ctr, 1u, __ATOMIC_RELAXED, __HIP_MEMORY_SCOPE_AGENT);
    while (__hip_atomic_load(ctr, __ATOMIC_RELAXED, __HIP_MEMORY_SCOPE_AGENT) < epoch) __builtin_amdgcn_s_sleep(2);
    __builtin_amdgcn_fence(__ATOMIC_ACQUIRE, "agent");
    asm volatile("s_waitcnt vmcnt(0)" ::: "memory");
  }
  __syncthreads();
}

#define XB_TMO      128
#define XB_XCNT(j)  (256  + 64 * (j))
#define XB_XSUB(j)  (1280 + 64 * (j))
#define XB_XGEN(j)  (2304 + 64 * (j))
#define XB_TOP      3328
#define XB_TOPGEN   3392
#define XCD_BAR_WORDS 3456
#define XB_SPIN_CAP (1u << 18)
#define LAS __attribute__((address_space(3)))

__device__ __forceinline__ unsigned xb_ld(unsigned* p)              { return __hip_atomic_load(p, __ATOMIC_RELAXED, __HIP_MEMORY_SCOPE_AGENT); }
__device__ __forceinline__ unsigned xb_add(unsigned* p, unsigned v) { return __hip_atomic_fetch_add(p, v, __ATOMIC_RELAXED, __HIP_MEMORY_SCOPE_AGENT); }
__device__ __forceinline__ unsigned xb_xcc_id() { return (unsigned)__builtin_amdgcn_s_getreg((3 << 11) | 20) & 0xFu; }
#define XB_SPIN(cond, bar) do { unsigned _sp = 0; while (cond) { __builtin_amdgcn_s_sleep(1); \
    if ((++_sp & 255u) == 0u) { if (xb_ld(&(bar)[XB_TMO])) break; if (_sp > XB_SPIN_CAP) { atomicAdd(&(bar)[XB_TMO], 1u); break; } } } } while (0)

struct XcdBarrier {
    unsigned* bar; unsigned x;
    volatile LAS unsigned* st;
};

__device__ __forceinline__ XcdBarrier xcd_barrier_post(unsigned* bar, volatile LAS unsigned* st) {
    XcdBarrier b; b.bar = bar; b.x = xb_xcc_id(); b.st = st;
    if (threadIdx.x == 0) (void)xb_add(&bar[XB_XCNT(b.x)], 1u);
    return b;
}
__device__ __forceinline__ void xcd_barrier_complete(unsigned* bar, unsigned x, unsigned& nloc, unsigned& nx) {
    const unsigned G = gridDim.x * gridDim.y * gridDim.z;
    unsigned sum, cnt, mine, sp = 0u;
    for (;;) {
        sum = 0u; cnt = 0u; mine = 0u;
#pragma unroll
        for (unsigned j = 0; j < 16; ++j) { const unsigned c = xb_ld(&bar[XB_XCNT(j)]); sum += c; cnt += (c > 0u) ? 1u : 0u; mine = (j == x) ? c : mine; }
        if (sum == G) break;
        __builtin_amdgcn_s_sleep(1);
        if ((++sp & 255u) == 0u) { if (xb_ld(&bar[XB_TMO])) break; if (sp > XB_SPIN_CAP) { atomicAdd(&bar[XB_TMO], 1u); break; } }
    }
    nloc = mine > 0u ? mine : 1u; nx = cnt > 0u ? cnt : 1u;
}

__device__ __forceinline__ void xcd_barrier(const XcdBarrier& b) {
    asm volatile("s_waitcnt vmcnt(0)" ::: "memory");
    __syncthreads();
    if (threadIdx.x == 0) {
        unsigned* bar = b.bar;
        __builtin_amdgcn_s_waitcnt(0);
        unsigned nloc = b.st[0], nx = b.st[1];
        if (nloc == 0u) { xcd_barrier_complete(bar, b.x, nloc, nx); b.st[0] = nloc; b.st[1] = nx; }
        const unsigned old = xb_add(&bar[XB_XSUB(b.x)], 1u);
        const unsigned gen = old / nloc;
        if (old + 1u == (gen + 1u) * nloc) {
            __builtin_amdgcn_fence(__ATOMIC_RELEASE, "agent");
            asm volatile("s_waitcnt vmcnt(0)" ::: "memory");
            const unsigned og = xb_add(&bar[XB_TOP], 1u);
            const unsigned tg = og / nx;
            if (og + 1u == (tg + 1u) * nx) xb_add(&bar[XB_TOPGEN], 1u);
            else XB_SPIN(xb_ld(&bar[XB_TOPGEN]) == tg, bar);
            __builtin_amdgcn_fence(__ATOMIC_ACQUIRE, "agent");
            xb_add(&bar[XB_XGEN(b.x)], 1u);
            asm volatile("s_waitcnt vmcnt(0)" ::: "memory");
        } else {
            XB_SPIN(xb_ld(&bar[XB_XGEN(b.x)]) == gen, bar);
            __builtin_amdgcn_fence(__ATOMIC_ACQUIRE, "agent");
            asm volatile("s_waitcnt vmcnt(0)" ::: "memory");
        }
    }
    __syncthreads();
}


constexpr int NPHASE = 12;

__global__ void __launch_bounds__(512, 2) mega_kernel(Params P) {
  extern __shared__ __attribute__((aligned(16))) u16 dlds[];
  cg::grid_group grid = cg::this_grid();
  const int rb = blockIdx.x, rnb = gridDim.x;
  const int half = threadIdx.x >> 8;
  const int bid = rb * 2 + half, nb = rnb * 2;
  u16* lds = dlds + half * 36864;
  volatile LAS unsigned* xst = (volatile LAS unsigned*)(dlds + 73728);
  if (threadIdx.x < 4) xst[threadIdx.x] = 0u;
  __syncthreads();
  XcdBarrier xb = xcd_barrier_post((unsigned*)(P.ws + O_BAR + 4096), xst);
  phase0(P, bid, nb, lds); grid.sync();
  phase1(P, rb, rnb, dlds); xcd_barrier(xb);
  phase2(P, bid, nb, lds); xcd_barrier(xb);
  phase3(P, bid, nb, lds); xcd_barrier(xb);
  phase4(P, rb, rnb, dlds); xcd_barrier(xb);
  phase5(P, rb, rnb, dlds); xcd_barrier(xb);
  phase6(P, rb, rnb, dlds); xcd_barrier(xb);
  ln_rows_bf16((const u16*)(P.ws + O_PRE1), P.ln1_g, P.ln1_b, (u16*)(P.ws + O_H), bid * 4 + (tidx() >> 6), nb * 4);
  xcd_barrier(xb);
  phase8(P, rb, rnb, dlds); xcd_barrier(xb);
  phase9(P, bid, nb, lds); xcd_barrier(xb);
  phase10(P, bid, nb, lds); xcd_barrier(xb);
  phase11(P, bid, nb, xb.x, xst[0]);
}

extern "C" void kernel_launch(void* const* d_in, const int* in_sizes, int n_in, void* d_out, int out_size, void* d_ws,
                              size_t ws_size, hipStream_t stream) {
  Params p{};
  const float** pp = (const float**)&p;
  for (int i = 0; i < 29; ++i) pp[i] = (const float*)d_in[i];
  p.out = (float*)d_out;
  p.ws = (char*)d_ws;
  if (ws_size < 1001 * MB) fprintf(stderr, "workspace too small: %zu\n", ws_size);
  constexpr size_t kDynLds = 147456 + 16;
  static int grid_blocks = 0;
  if (!grid_blocks) {
    int dev = 0, cus = 0, per_cu = 0;
    (void)hipGetDevice(&dev);
    (void)hipDeviceGetAttribute(&cus, hipDeviceAttributeMultiprocessorCount, dev);
    (void)hipFuncSetAttribute((const void*)mega_kernel, hipFuncAttributeMaxDynamicSharedMemorySize, (int)kDynLds);
    (void)hipOccupancyMaxActiveBlocksPerMultiprocessor(&per_cu, mega_kernel, 512, kDynLds);
    if (per_cu > 1) per_cu = 1;
    grid_blocks = cus * per_cu;
  }
  (void)hipMemsetAsync((char*)d_ws + O_BAR, 0, 4096 + XCD_BAR_WORDS * 4, stream);
  void* args[] = {&p};
  hipError_t e = hipLaunchCooperativeKernel((void*)mega_kernel, dim3(grid_blocks), dim3(512), args, kDynLds, stream);
  if (e != hipSuccess) fprintf(stderr, "cooperative launch failed: %s (grid %d)\n", hipGetErrorString(e), grid_blocks);
}
```

```cpp
#include <hip/hip_runtime.h>
#include <hip/hip_bf16.h>
#include <hip/hip_cooperative_groups.h>
#include <cstdio>
namespace cg = cooperative_groups;

#ifndef MULTI
#define MULTI 0
#endif

typedef unsigned short u16;
using bf16x8 = __attribute__((ext_vector_type(8))) short;
using f32x4 = __attribute__((ext_vector_type(4))) float;

constexpr int T_ = 32768;
constexpr int S_ = 16384;
constexpr int D_ = 2048;
constexpr int SSM_L = 128;
constexpr int SSM_NC = S_ / SSM_L;
constexpr float ALPHA = 1.189207115002721f;
constexpr size_t MB = 1024ull * 1024ull;

constexpr size_t O_WIN = 0 * MB, O_WGLU = 32 * MB, O_WAU = 34 * MB, O_WSU = 38 * MB, O_WOUT = 42 * MB,
                 O_WPQ = 50 * MB, O_WPG = 58 * MB, O_WPIN = 66 * MB, O_SK = 67 * MB, O_BCAT = 67 * MB + 512 * 1024,
                 O_CCAT = 68 * MB, O_LAM = 68 * MB + 256 * 1024, O_UB = 70 * MB, O_VB = 134 * MB, O_SBUF = 198 * MB,
                 O_H = 206 * MB, O_Q = 334 * MB, O_K = 398 * MB, O_VT = 462 * MB, O_U2 = 526 * MB, O_G = 590 * MB,
                 O_YA = 846 * MB, O_YS = 910 * MB, O_PB = 974 * MB;
constexpr size_t O_YG = O_VT, O_MERGED = O_Q, O_PRE1 = O_G, O_PQ = O_Q, O_SG = O_VT, O_E = O_G,
                 O_HV = O_G + 128 * MB, O_HI = O_G + 160 * MB, O_EXP = O_G + 192 * MB, O_GATE = O_G + 208 * MB;

struct Params {
  const float *x, *p, *ln_in_g, *ln_in_b, *w_in, *rel_bias, *lam_re, *lam_im, *log_dt, *b_re, *b_im, *c_re, *c_im,
      *ssm_d, *w_glu, *w_au, *w_su, *w_out, *ln1_g, *ln1_b, *w_pq, *sub_keys, *peer_u, *peer_v, *ple_w_in, *ple_g,
      *ple_w_gate, *ln2_g, *ln2_b;
  float* out;
  char* ws;
};

__device__ __forceinline__ int tidx() { int t = threadIdx.x & 255; asm volatile("" : "+v"(t)); return t; }
__device__ __forceinline__ int rtid() { int t = threadIdx.x; asm volatile("" : "+v"(t)); return t; }
__device__ __forceinline__ u16 f2bf(float f) {
  unsigned u = __float_as_uint(f);
  u += 0x7fffu + ((u >> 16) & 1u);
  return (u16)(u >> 16);
}
__device__ __forceinline__ float bf2f(u16 h) { return __uint_as_float(((unsigned)h) << 16); }
typedef __bf16 hwbf16x2 __attribute__((ext_vector_type(2)));
typedef float hwf32x2 __attribute__((ext_vector_type(2)));
__device__ __forceinline__ unsigned pack2(float a, float b) {
  hwf32x2 v = {a, b};
  hwbf16x2 r = __builtin_convertvector(v, hwbf16x2);
  return *(unsigned*)&r;
}
__device__ __forceinline__ float lo2f(unsigned u) { return __uint_as_float(u << 16); }
__device__ __forceinline__ float hi2f(unsigned u) { return __uint_as_float(u & 0xffff0000u); }
__device__ __forceinline__ float sigmoidf_(float x) { return __builtin_amdgcn_rcpf(1.f + __expf(-x)); }
__device__ __forceinline__ float gelu_tanh(float x) {
  float u = 0.7978845608028654f * (x + 0.044715f * x * x * x);
  float t = 1.f - 2.f * __builtin_amdgcn_rcpf(1.f + __expf(2.f * u));
  return 0.5f * x * (1.f + t);
}
__device__ __forceinline__ float wave_sum(float v) {
#pragma unroll
  for (int o = 32; o >= 1; o >>= 1) v += __shfl_xor(v, o);
  return v;
}
__device__ __forceinline__ void store_bf4(u16* dst, float a, float b, float c, float d) {
  uint2 v; v.x = pack2(a, b); v.y = pack2(c, d);
  *(uint2*)dst = v;
}

__device__ __forceinline__ void gemm_kloop(f32x4 (&acc)[4][4], const u16* __restrict__ A, int lda,
                                           const u16* __restrict__ Bt, int ldb, int K, u16* lds) {
  const int tid = tidx(), lane = tid & 63, wid = tid >> 6, wm = wid >> 1, wn = wid & 1;
  const int lr = lane & 15, lq = lane >> 4;
  const int nk = K >> 6;
  const int srow = tid >> 3, sc = (tid & 7) ^ (srow & 7);
  const u16* ga = A + (size_t)srow * lda + sc * 8;
  const u16* gb = Bt + (size_t)srow * ldb + sc * 8;
  u16* lw = lds + tid * 8;
#pragma unroll
  for (int i = 0; i < 4; ++i) {
    __builtin_amdgcn_global_load_lds((const unsigned*)(ga + (size_t)(32 * i) * lda), (unsigned*)(lw + i * 2048), 16, 0, 0);
    __builtin_amdgcn_global_load_lds((const unsigned*)(gb + (size_t)(32 * i) * ldb), (unsigned*)(lw + 8192 + i * 2048), 16, 0, 0);
  }
  __syncthreads();
  const int swz = lr & 7;
  for (int kt = 0; kt < nk; ++kt) {
    if (kt + 1 < nk) {
      u16* lw2 = lw + ((kt + 1) & 1) * 16384;
#pragma unroll
      for (int i = 0; i < 4; ++i) {
        __builtin_amdgcn_global_load_lds((const unsigned*)(ga + (size_t)(32 * i) * lda + (kt + 1) * 64), (unsigned*)(lw2 + i * 2048), 16, 0, 0);
        __builtin_amdgcn_global_load_lds((const unsigned*)(gb + (size_t)(32 * i) * ldb + (kt + 1) * 64), (unsigned*)(lw2 + 8192 + i * 2048), 16, 0, 0);
      }
    }
    const u16* sa = lds + (kt & 1) * 16384;
    const u16* sb = sa + 8192;
#pragma unroll
    for (int ks = 0; ks < 2; ++ks) {
      bf16x8 af[4], bfr[4];
      const int co = ((ks * 4 + lq) ^ swz) * 8;
#pragma unroll
      for (int mi = 0; mi < 4; ++mi) af[mi] = *(const bf16x8*)(sa + (wm * 64 + mi * 16 + lr) * 64 + co);
#pragma unroll
      for (int ni = 0; ni < 4; ++ni) bfr[ni] = *(const bf16x8*)(sb + (wn * 64 + ni * 16 + lr) * 64 + co);
#pragma unroll
      for (int mi = 0; mi < 4; ++mi)
#pragma unroll
        for (int ni = 0; ni < 4; ++ni)
          acc[mi][ni] = __builtin_amdgcn_mfma_f32_16x16x32_bf16(bfr[ni], af[mi], acc[mi][ni], 0, 0, 0);
    }
    __syncthreads();
  }
}

#define ZERO_ACC(acc)                                   \
  _Pragma("unroll") for (int _a = 0; _a < 4; ++_a)      \
  _Pragma("unroll") for (int _b = 0; _b < 4; ++_b) acc[_a][_b] = f32x4{0.f, 0.f, 0.f, 0.f};

__device__ __forceinline__ void gemm_kloop2(f32x4 (&acc)[4][8], const u16* __restrict__ A, int lda,
                                            const u16* __restrict__ Bt, int ldb, int K, u16* lds) {
  const int tid = tidx(), lane = tid & 63, wid = tid >> 6;
  const int lr = lane & 15, lq = lane >> 4;
  const int nk = K >> 5;
  const int srow = tid >> 2;
  const int sc = (tid & 3) ^ ((0x78 >> (2 * ((tid >> 4) & 3))) & 3);
  const u16* ga = A + (size_t)srow * lda + sc * 8;
  const u16* gb = Bt + (size_t)srow * ldb + sc * 8;
  u16* lw = lds + tid * 8;
#pragma unroll
  for (int i = 0; i < 4; ++i)
    __builtin_amdgcn_global_load_lds((const unsigned*)(ga + (size_t)(64 * i) * lda), (unsigned*)(lw + i * 2048), 16, 0, 0);
#pragma unroll
  for (int i = 0; i < 2; ++i)
    __builtin_amdgcn_global_load_lds((const unsigned*)(gb + (size_t)(64 * i) * ldb), (unsigned*)(lw + 8192 + i * 2048), 16, 0, 0);
  __syncthreads();
  const int co = (lq ^ ((0x78 >> (2 * ((lr >> 2) & 3))) & 3)) * 8;
  for (int kt = 0; kt < nk; ++kt) {
    if (kt + 1 < nk) {
      u16* lw2 = lw + ((kt + 1) & 1) * 12288;
#pragma unroll
      for (int i = 0; i < 4; ++i)
        __builtin_amdgcn_global_load_lds((const unsigned*)(ga + (size_t)(64 * i) * lda + (kt + 1) * 32), (unsigned*)(lw2 + i * 2048), 16, 0, 0);
#pragma unroll
      for (int i = 0; i < 2; ++i)
        __builtin_amdgcn_global_load_lds((const unsigned*)(gb + (size_t)(64 * i) * ldb + (kt + 1) * 32), (unsigned*)(lw2 + 8192 + i * 2048), 16, 0, 0);
    }
    const u16* sa = lds + (kt & 1) * 12288;
    const u16* sb = sa + 8192;
    bf16x8 af[4];
#pragma unroll
    for (int mi = 0; mi < 4; ++mi) af[mi] = *(const bf16x8*)(sa + (wid * 64 + mi * 16 + lr) * 32 + co);
#pragma unroll
    for (int nh = 0; nh < 2; ++nh) {
      bf16x8 bfr[4];
#pragma unroll
      for (int ni = 0; ni < 4; ++ni) bfr[ni] = *(const bf16x8*)(sb + ((nh * 4 + ni) * 16 + lr) * 32 + co);
#pragma unroll
      for (int mi = 0; mi < 4; ++mi)
#pragma unroll
        for (int ni = 0; ni < 4; ++ni)
          acc[mi][nh * 4 + ni] = __builtin_amdgcn_mfma_f32_16x16x32_bf16(bfr[ni], af[mi], acc[mi][nh * 4 + ni], 0, 0, 0);
    }
    __syncthreads();
  }
}

__device__ __forceinline__ void gemm_kloop3(f32x4 (&acc)[4][8], const u16* __restrict__ A, int lda,
                                            const u16* __restrict__ Bt, int ldb, int K, u16* lds) {
  const int tid = rtid(), lane = tid & 63, wid = tid >> 6, wm = wid >> 1, wn = wid & 1;
  const int lr = lane & 15, lq = lane >> 4;
  const int nk = K >> 6;
  const int srow = tid >> 3, sc = (tid & 7) ^ (srow & 7);
  const u16* ga = A + (size_t)srow * lda + sc * 8;
  const u16* gb = Bt + (size_t)srow * ldb + sc * 8;
  u16* lw = lds + tid * 8;
#pragma unroll
  for (int i = 0; i < 4; ++i) {
    __builtin_amdgcn_global_load_lds((const unsigned*)(ga + (size_t)(64 * i) * lda), (unsigned*)(lw + i * 4096), 16, 0, 0);
    __builtin_amdgcn_global_load_lds((const unsigned*)(gb + (size_t)(64 * i) * ldb), (unsigned*)(lw + 16384 + i * 4096), 16, 0, 0);
  }
  __syncthreads();
  const int swz = lr & 7;
  for (int kt = 0; kt < nk; ++kt) {
    const int ko = min(kt + 1, nk - 1) * 64;
    u16* lw2 = lw + ((kt + 1) & 1) * 32768;
    const u16* sa = lds + (kt & 1) * 32768;
    const u16* sb = sa + 16384;
#pragma unroll
    for (int ks = 0; ks < 2; ++ks) {
      const int co = ((ks * 4 + lq) ^ swz) * 8;
      bf16x8 af[4];
#pragma unroll
      for (int mi = 0; mi < 4; ++mi) af[mi] = *(const bf16x8*)(sa + (wm * 64 + mi * 16 + lr) * 64 + co);
#pragma unroll
      for (int nh = 0; nh < 2; ++nh) {
        bf16x8 bfr[4];
#pragma unroll
        for (int ni = 0; ni < 4; ++ni) bfr[ni] = *(const bf16x8*)(sb + (wn * 128 + (nh * 4 + ni) * 16 + lr) * 64 + co);
        if (ks == 0) __builtin_amdgcn_sched_barrier(0);
#pragma unroll
        for (int mi = 0; mi < 4; ++mi) {
#pragma unroll
          for (int ni = 0; ni < 4; ++ni)
            acc[mi][nh * 4 + ni] = __builtin_amdgcn_mfma_f32_16x16x32_bf16(bfr[ni], af[mi], acc[mi][nh * 4 + ni], 0, 0, 0);
          if (ks == 0) {
            if (nh == 0)
              __builtin_amdgcn_global_load_lds((const unsigned*)(ga + (size_t)(64 * mi) * lda + ko), (unsigned*)(lw2 + mi * 4096), 16, 0, 0);
            else
              __builtin_amdgcn_global_load_lds((const unsigned*)(gb + (size_t)(64 * mi) * ldb + ko), (unsigned*)(lw2 + 16384 + mi * 4096), 16, 0, 0);
            __builtin_amdgcn_sched_barrier(0);
          }
        }
      }
    }
    __syncthreads();
  }
}

#define EPI_COORDS3                                                             \
  const int lane = rtid() & 63, wid = rtid() >> 6, wm = wid >> 1, wn = wid & 1; \
  const int lr = lane & 15, lq = lane >> 4;

#define ZERO_ACC8(acc)                                  \
  _Pragma("unroll") for (int _a = 0; _a < 4; ++_a)      \
  _Pragma("unroll") for (int _b = 0; _b < 8; ++_b) acc[_a][_b] = f32x4{0.f, 0.f, 0.f, 0.f};

#define FOR_TILES_XCD(t, ntiles) \
  for (int _k = 0, t = (bid & 7) * (nb >> 3) + (bid >> 3); t < (ntiles); ++_k, t = ((_k * 8 + (bid & 7)) * (nb >> 3)) + (bid >> 3))

#define EPI_COORDS                                                             \
  const int lane = tidx() & 63, wid = tidx() >> 6, wm = wid >> 1, wn = wid & 1; \
  const int lr = lane & 15, lq = lane >> 4;

__device__ void tconv_tile(const float* __restrict__ W, int K, int N, u16* __restrict__ Wt, int tile, float* lds) {
  const int tid = tidx();
  const int ntn = N >> 6;
  const int kt = tile / ntn, nt = tile % ntn;
  const int c4 = (tid & 15) * 4;
#pragma unroll
  for (int i = 0; i < 4; ++i) {
    int r = (tid >> 4) + 16 * i;
    float4 v = *(const float4*)(W + (size_t)(kt * 64 + r) * N + nt * 64 + c4);
    lds[r * 65 + c4 + 0] = v.x; lds[r * 65 + c4 + 1] = v.y; lds[r * 65 + c4 + 2] = v.z; lds[r * 65 + c4 + 3] = v.w;
  }
  __syncthreads();
  const int n = tid >> 2, kseg = (tid & 3) * 16;
  unsigned o[8];
#pragma unroll
  for (int j = 0; j < 8; ++j) o[j] = pack2(lds[(kseg + 2 * j) * 65 + n], lds[(kseg + 2 * j + 1) * 65 + n]);
  u16* dst = Wt + (size_t)(nt * 64 + n) * K + kt * 64 + kseg;
  *(uint4*)dst = uint4{o[0], o[1], o[2], o[3]};
  *(uint4*)(dst + 8) = uint4{o[4], o[5], o[6], o[7]};
  __syncthreads();
}

__device__ void conv_linear(const float* __restrict__ src, u16* __restrict__ dst, size_t n8, size_t gtid, size_t nth) {
  for (size_t i = gtid; i < n8; i += nth) {
    float4 a = *(const float4*)(src + i * 8), b = *(const float4*)(src + i * 8 + 4);
    *(uint4*)(dst + i * 8) = uint4{pack2(a.x, a.y), pack2(a.z, a.w), pack2(b.x, b.y), pack2(b.z, b.w)};
  }
}

typedef float f32x2 __attribute__((ext_vector_type(2)));
constexpr size_t O_U8 = O_UB, O_V8 = O_UB + 32 * MB, O_RSU = O_VB, O_RSV = O_VB + 64 * 1024;
__device__ void conv_fp8_rows(const float* __restrict__ src, unsigned char* __restrict__ dst, float* __restrict__ rscale,
                              int gw, int nw) {
  const int lane = tidx() & 63;
  for (int row = gw; row < 16384; row += nw) {
    const float* r = src + (size_t)row * D_;
    float4 v[8];
#pragma unroll
    for (int q = 0; q < 8; ++q) v[q] = *(const float4*)(r + q * 256 + lane * 4);
    float am = 0.f;
#pragma unroll
    for (int q = 0; q < 8; ++q) am = fmaxf(am, fmaxf(fmaxf(fabsf(v[q].x), fabsf(v[q].y)), fmaxf(fabsf(v[q].z), fabsf(v[q].w))));
#pragma unroll
    for (int o = 32; o >= 1; o >>= 1) am = fmaxf(am, __shfl_xor(am, o));
    const float sc = am > 0.f ? 416.f / am : 1.f;
#pragma unroll
    for (int q = 0; q < 8; ++q) {
      int w = 0;
      w = __builtin_amdgcn_cvt_pk_fp8_f32(v[q].x * sc, v[q].y * sc, w, false);
      w = __builtin_amdgcn_cvt_pk_fp8_f32(v[q].z * sc, v[q].w * sc, w, true);
      *(int*)(dst + (size_t)row * D_ + q * 256 + lane * 4) = w;
    }
    if (lane == 0) rscale[row] = am > 0.f ? am / 416.f : 1.f;
  }
}

__device__ void ln_rows(const float* __restrict__ src, const float* __restrict__ g, const float* __restrict__ b,
                        u16* __restrict__ dst, int gw, int nw) {
  const int lane = tidx() & 63;
  for (int row = gw; row < T_; row += nw) {
    const float* r = src + (size_t)row * D_;
    float4 v[8];
#pragma unroll
    for (int q = 0; q < 8; ++q) v[q] = *(const float4*)(r + q * 256 + lane * 4);
    float s = 0.f;
#pragma unroll
    for (int q = 0; q < 8; ++q) s += v[q].x + v[q].y + v[q].z + v[q].w;
    float mu = wave_sum(s) * (1.f / D_);
    float ss = 0.f;
#pragma unroll
    for (int q = 0; q < 8; ++q) {
      float a = v[q].x - mu, bb = v[q].y - mu, c = v[q].z - mu, d = v[q].w - mu;
      ss += a * a + bb * bb + c * c + d * d;
    }
    float rstd = rsqrtf(wave_sum(ss) * (1.f / D_) + 1e-5f);
#pragma unroll
    for (int q = 0; q < 8; ++q) {
      int col = q * 256 + lane * 4;
      float4 gg = *(const float4*)(g + col), bb = *(const float4*)(b + col);
      store_bf4(dst + (size_t)row * D_ + col, (v[q].x - mu) * rstd * gg.x + bb.x, (v[q].y - mu) * rstd * gg.y + bb.y,
                (v[q].z - mu) * rstd * gg.z + bb.z, (v[q].w - mu) * rstd * gg.w + bb.w);
    }
  }
}

__device__ void ln_rows_bf16(const u16* __restrict__ src, const float* __restrict__ g, const float* __restrict__ b,
                             u16* __restrict__ dst, int gw, int nw) {
  const int lane = tidx() & 63;
  for (int row = gw; row < T_; row += nw) {
    const u16* r = src + (size_t)row * D_;
    float v[32];
#pragma unroll
    for (int q = 0; q < 4; ++q) {
      const uint4 u = *(const uint4*)(r + q * 512 + lane * 8);
      v[q * 8 + 0] = lo2f(u.x); v[q * 8 + 1] = hi2f(u.x); v[q * 8 + 2] = lo2f(u.y); v[q * 8 + 3] = hi2f(u.y);
      v[q * 8 + 4] = lo2f(u.z); v[q * 8 + 5] = hi2f(u.z); v[q * 8 + 6] = lo2f(u.w); v[q * 8 + 7] = hi2f(u.w);
    }
    float s_ = 0.f;
#pragma unroll
    for (int k = 0; k < 32; ++k) s_ += v[k];
    const float mu = wave_sum(s_) * (1.f / D_);
    float ss = 0.f;
#pragma unroll
    for (int k = 0; k < 32; ++k) { const float d = v[k] - mu; ss += d * d; }
    const float rstd = rsqrtf(wave_sum(ss) * (1.f / D_) + 1e-5f);
#pragma unroll
    for (int q = 0; q < 4; ++q) {
      const int col = q * 512 + lane * 8;
      const float4 g0 = *(const float4*)(g + col), g1 = *(const float4*)(g + col + 4);
      const float4 b0 = *(const float4*)(b + col), b1 = *(const float4*)(b + col + 4);
      uint4 o;
      o.x = pack2((v[q * 8 + 0] - mu) * rstd * g0.x + b0.x, (v[q * 8 + 1] - mu) * rstd * g0.y + b0.y);
      o.y = pack2((v[q * 8 + 2] - mu) * rstd * g0.z + b0.z, (v[q * 8 + 3] - mu) * rstd * g0.w + b0.w);
      o.z = pack2((v[q * 8 + 4] - mu) * rstd * g1.x + b1.x, (v[q * 8 + 5] - mu) * rstd * g1.y + b1.y);
      o.w = pack2((v[q * 8 + 6] - mu) * rstd * g1.z + b1.z, (v[q * 8 + 7] - mu) * rstd * g1.w + b1.w);
      *(uint4*)(dst + (size_t)row * D_ + col) = o;
    }
  }
}

__device__ __forceinline__ void dsincos(double x, double& s, double& c) {
  double q = rint(x * 0.63661977236758134308);
  double r = x - q * 1.57079632679489661923;
  double r2 = r * r;
  double sp = r * (1.0 + r2 * (-1.0 / 6 + r2 * (1.0 / 120 + r2 * (-1.0 / 5040 + r2 * (1.0 / 362880 + r2 * (-1.0 / 39916800 + r2 * (1.0 / 6227020800.0)))))));
  double cp = 1.0 + r2 * (-0.5 + r2 * (1.0 / 24 + r2 * (-1.0 / 720 + r2 * (1.0 / 40320 + r2 * (-1.0 / 3628800 + r2 * (1.0 / 479001600.0 + r2 * (-1.0 / 87178291200.0)))))));
  int qi = ((int)q) & 3;
  if (qi == 0) { s = sp; c = cp; }
  else if (qi == 1) { s = cp; c = -sp; }
  else if (qi == 2) { s = -sp; c = -cp; }
  else { s = -cp; c = sp; }
}

__device__ void ssm_consts(const Params& P, int i) {
  const int g = i >> 6, p = i & 63;
  double lr = P.lam_re[g * 64 + p], li = P.lam_im[g * 64 + p];
  double dt = exp((double)P.log_dt[g]);
  double mag = exp(lr * dt);
  double sn, cs;
  dsincos(li * dt, sn, cs);
  double ar = mag * cs, ai = mag * sn;
  double nr = ar - 1.0, ni = ai, den = lr * lr + li * li;
  double fr = (nr * lr + ni * li) / den, fi = (ni * lr - nr * li) / den;
  u16* bcat = (u16*)(P.ws + O_BCAT);
  u16* ccat = (u16*)(P.ws + O_CCAT);
  float* lam = (float*)(P.ws + O_LAM);
  for (int h = 0; h < 16; ++h) {
    double br = P.b_re[(g * 64 + p) * 16 + h], bi = P.b_im[(g * 64 + p) * 16 + h];
    bcat[(g * 128 + p) * 32 + h] = f2bf((float)(fr * br - fi * bi));
    bcat[(g * 128 + 64 + p) * 32 + h] = f2bf((float)(fr * bi + fi * br));
    bcat[(g * 128 + p) * 32 + 16 + h] = 0;
    bcat[(g * 128 + 64 + p) * 32 + 16 + h] = 0;
    ccat[(g * 16 + h) * 128 + p] = f2bf(P.c_re[(g * 16 + h) * 64 + p]);
    ccat[(g * 16 + h) * 128 + 64 + p] = f2bf(-P.c_im[(g * 16 + h) * 64 + p]);
  }
  double pr = ar, pi = ai;
  for (int k = 0; k < 10; ++k) {
    double t = pr * pr - pi * pi;
    pi = 2.0 * pr * pi;
    pr = t;
  }
  lam[0 * 4096 + i] = (float)ar;
  lam[1 * 4096 + i] = (float)ai;
  lam[2 * 4096 + i] = (float)pr;
  lam[3 * 4096 + i] = (float)pi;
}

__device__ void phase0(const Params& P, int bid, int nb, u16* lds) {
  const size_t gtid = (size_t)bid * 256 + tidx(), nth = (size_t)nb * 256;
#define TCONV(wp, KK, NN, OFF) \
  for (int t = bid; t < ((KK) >> 6) * ((NN) >> 6); t += nb) tconv_tile(wp, KK, NN, (u16*)(P.ws + OFF), t, (float*)lds);
  TCONV(P.w_in, 2048, 8192, O_WIN)
  TCONV(P.w_glu, 1024, 1024, O_WGLU)
  TCONV(P.w_au, 1024, 2048, O_WAU)
  TCONV(P.w_su, 1024, 2048, O_WSU)
  TCONV(P.w_out, 2048, 2048, O_WOUT)
  TCONV(P.w_pq, 2048, 2048, O_WPQ)
  TCONV(P.ple_w_gate, 2048, 2048, O_WPG)
  TCONV(P.ple_w_in, 256, 2048, O_WPIN)
  conv_fp8_rows(P.peer_u, (unsigned char*)(P.ws + O_U8), (float*)(P.ws + O_RSU), bid * 4 + (tidx() >> 6), nb * 4);
  conv_fp8_rows(P.peer_v, (unsigned char*)(P.ws + O_V8), (float*)(P.ws + O_RSV), bid * 4 + (tidx() >> 6), nb * 4);
  conv_linear(P.sub_keys, (u16*)(P.ws + O_SK), (size_t)16 * 128 * 128 / 8, gtid, nth);
  conv_linear(P.p, (u16*)(P.ws + O_PB), (size_t)T_ * 256 / 8, gtid, nth);
  for (size_t i = gtid; i < 4096; i += nth) ssm_consts(P, (int)i);
  ln_rows(P.x, P.ln_in_g, P.ln_in_b, (u16*)(P.ws + O_H), bid * 4 + (tidx() >> 6), nb * 4);
}

__device__ void phase1(const Params& P, int bid, int nb, u16* lds) {
  const u16* H = (const u16*)(P.ws + O_H);
  const u16* W = (const u16*)(P.ws + O_WIN);
  u16* Q = (u16*)(P.ws + O_Q);
  u16* Kb = (u16*)(P.ws + O_K);
  u16* Vt = (u16*)(P.ws + O_VT);
  u16* U2 = (u16*)(P.ws + O_U2);
  u16* G = (u16*)(P.ws + O_G);
  EPI_COORDS3
  const int ntiles = 128 * 32;
  for (int t = bid; t < ntiles; t += nb) {
    const int mt = t >> 5, nt = t & 31;
    f32x4 acc[4][8];
    ZERO_ACC8(acc)
    gemm_kloop3(acc, H + (size_t)mt * 256 * D_, D_, W + (size_t)nt * 256 * D_, D_, D_, lds);
    const int region = (nt * 256 + wn * 128) >> 10;
#pragma unroll
    for (int mi = 0; mi < 4; ++mi) {
      const int m = mt * 256 + wm * 64 + mi * 16 + lr;
#pragma unroll
      for (int ni = 0; ni < 8; ++ni) {
        const int n = nt * 256 + wn * 128 + ni * 16 + lq * 4;
        f32x4 a = acc[mi][ni];
        if (region == 0) {
          const float sc = 0.08838834764831845f;
          store_bf4(Q + (size_t)m * 1024 + n, a[0] * sc, a[1] * sc, a[2] * sc, a[3] * sc);
        } else if (region == 1) {
          store_bf4(Kb + (size_t)m * 1024 + (n - 1024), a[0], a[1], a[2], a[3]);
        } else if (region == 2) {
          const int b = m >> 14, tt = m & (S_ - 1);
#pragma unroll
          for (int j = 0; j < 4; ++j) Vt[((size_t)(b * 1024 + (n - 2048 + j))) * S_ + tt] = f2bf(a[j]);
        } else if (region == 3) {
          store_bf4(U2 + (size_t)m * 1024 + (n - 3072), a[0], a[1], a[2], a[3]);
        } else {
          store_bf4(G + (size_t)m * 4096 + (n - 4096), sigmoidf_(a[0]), sigmoidf_(a[1]), sigmoidf_(a[2]), sigmoidf_(a[3]));
        }
      }
    }
  }
}

__device__ void attn_item(const Params& P, int item, u16* lds) {
  const int c = item >> 4, hd = item & 7, b = (item >> 3) & 1;
  const int tid = tidx(), lane = tid & 63, w = tid >> 6, lr = lane & 15, lq = lane >> 4;
  u16* Ks = lds;
  u16* Vs = lds + 64 * 136;
  float* bs = (float*)(lds + 64 * 136 + 128 * 72);
  const u16* Q = (const u16*)(P.ws + O_Q);
  const u16* Kb = (const u16*)(P.ws + O_K);
  const u16* Vt = (const u16*)(P.ws + O_VT);
  u16* ya = (u16*)(P.ws + O_YA);
  __syncthreads();
  for (int i = tid; i < 257; i += 256) bs[i] = P.rel_bias[hd * 257 + i];
  bf16x8 qf[4];
  {
    const u16* qp = Q + (size_t)(b * S_ + c * 64 + w * 16 + lr) * 1024 + hd * 128 + lq * 8;
#pragma unroll
    for (int ks = 0; ks < 4; ++ks) qf[ks] = *(const bf16x8*)(qp + ks * 32);
  }
  f32x4 oacc[8];
#pragma unroll
  for (int d = 0; d < 8; ++d) oacc[d] = f32x4{0.f, 0.f, 0.f, 0.f};
  float m_run = -1e30f, lsum = 0.f;
  const int i0 = (c < 8) ? (8 - c) : 0;
  const int qi = w * 16 + lr;
#define KV_ADDR_K(r, kc_) (Kb + (size_t)(b * S_ + (kc_) * 64 + ((tid + 256 * (r)) >> 4)) * 1024 + hd * 128 + ((tid + 256 * (r)) & 15) * 8)
#define KV_ADDR_V(r, kc_) (Vt + ((size_t)(b * 1024 + hd * 128 + ((tid + 256 * (r)) >> 3))) * S_ + (kc_) * 64 + ((tid + 256 * (r)) & 7) * 8)
#define KV_LOAD(kc_)                                                                   \
  kr0 = *(const uint4*)KV_ADDR_K(0, kc_); kr1 = *(const uint4*)KV_ADDR_K(1, kc_);     \
  kr2 = *(const uint4*)KV_ADDR_K(2, kc_); kr3 = *(const uint4*)KV_ADDR_K(3, kc_);     \
  vr0 = *(const uint4*)KV_ADDR_V(0, kc_); vr1 = *(const uint4*)KV_ADDR_V(1, kc_);     \
  vr2 = *(const uint4*)KV_ADDR_V(2, kc_); vr3 = *(const uint4*)KV_ADDR_V(3, kc_);
#define KS_W(r) (Ks + ((tid + 256 * (r)) >> 4) * 136 + ((tid + 256 * (r)) & 15) * 8)
#define VS_W(r) (Vs + ((tid + 256 * (r)) >> 3) * 72 + ((tid + 256 * (r)) & 7) * 8)
#define KV_LOADS(S, kc_)                                                                \
  S##k0 = *(const uint4*)KV_ADDR_K(0, kc_); S##k1 = *(const uint4*)KV_ADDR_K(1, kc_);   \
  S##k2 = *(const uint4*)KV_ADDR_K(2, kc_); S##k3 = *(const uint4*)KV_ADDR_K(3, kc_);   \
  S##v0 = *(const uint4*)KV_ADDR_V(0, kc_); S##v1 = *(const uint4*)KV_ADDR_V(1, kc_);   \
  S##v2 = *(const uint4*)KV_ADDR_V(2, kc_); S##v3 = *(const uint4*)KV_ADDR_V(3, kc_);
#define KV_WRITES(S)                                                                                   \
  *(uint4*)KS_W(0) = S##k0; *(uint4*)KS_W(1) = S##k1; *(uint4*)KS_W(2) = S##k2; *(uint4*)KS_W(3) = S##k3; \
  *(uint4*)VS_W(0) = S##v0; *(uint4*)VS_W(1) = S##v1; *(uint4*)VS_W(2) = S##v2; *(uint4*)VS_W(3) = S##v3;
  uint4 Ak0, Ak1, Ak2, Ak3, Av0, Av1, Av2, Av3, Bk0, Bk1, Bk2, Bk3, Bv0, Bv1, Bv2, Bv3;
  auto tile_compute = [&](const int i) {
    f32x4 sacc[4];
#pragma unroll
    for (int kt = 0; kt < 4; ++kt) {
      sacc[kt] = f32x4{0.f, 0.f, 0.f, 0.f};
#pragma unroll
      for (int ks = 0; ks < 4; ++ks) {
        bf16x8 kf = *(const bf16x8*)(Ks + (kt * 16 + lr) * 136 + ks * 32 + lq * 8);
        sacc[kt] = __builtin_amdgcn_mfma_f32_16x16x32_bf16(kf, qf[ks], sacc[kt], 0, 0, 0);
      }
    }
    float tmax = -1e30f;
#pragma unroll
    for (int kt = 0; kt < 4; ++kt)
#pragma unroll
      for (int j = 0; j < 4; ++j) {
        int kb = i * 64 + kt * 16 + lq * 4 + j;
        int rel = 512 + qi - kb;
        rel = min(max(rel, -128), 128) + 128;
        float s = sacc[kt][j] + bs[rel];
        sacc[kt][j] = s;
        tmax = fmaxf(tmax, s);
      }
    tmax = fmaxf(tmax, __shfl_xor(tmax, 16));
    tmax = fmaxf(tmax, __shfl_xor(tmax, 32));
    const float m_new = fmaxf(m_run, tmax);
    const float corr = __expf(m_run - m_new);
    m_run = m_new;
    float ps = 0.f;
#pragma unroll
    for (int kt = 0; kt < 4; ++kt)
#pragma unroll
      for (int j = 0; j < 4; ++j) {
        float pv = __expf(sacc[kt][j] - m_new);
        sacc[kt][j] = pv;
        ps += pv;
      }
    lsum = lsum * corr + ps;
#pragma unroll
    for (int d = 0; d < 8; ++d) {
      oacc[d][0] *= corr; oacc[d][1] *= corr; oacc[d][2] *= corr; oacc[d][3] *= corr;
    }
#pragma unroll
    for (int kk = 0; kk < 2; ++kk) {
      union { bf16x8 v; unsigned u[4]; } pf;
      pf.u[0] = pack2(sacc[2 * kk][0], sacc[2 * kk][1]);
      pf.u[1] = pack2(sacc[2 * kk][2], sacc[2 * kk][3]);
      pf.u[2] = pack2(sacc[2 * kk + 1][0], sacc[2 * kk + 1][1]);
      pf.u[3] = pack2(sacc[2 * kk + 1][2], sacc[2 * kk + 1][3]);
#pragma unroll
      for (int d = 0; d < 8; ++d) {
        union { bf16x8 v; uint2 h[2]; } vf;
        vf.h[0] = *(const uint2*)(Vs + (d * 16 + lr) * 72 + kk * 32 + lq * 4);
        vf.h[1] = *(const uint2*)(Vs + (d * 16 + lr) * 72 + kk * 32 + 16 + lq * 4);
        oacc[d] = __builtin_amdgcn_mfma_f32_16x16x32_bf16(vf.v, pf.v, oacc[d], 0, 0, 0);
      }
    }
  };
  KV_LOADS(A, c - 8 + i0)
  if (i0 + 1 <= 8) { KV_LOADS(B, c - 8 + i0 + 1) }
  for (int i = i0; i <= 8; i += 2) {
    __syncthreads();
    KV_WRITES(A)
    __syncthreads();
    if (i + 2 <= 8) { KV_LOADS(A, c - 8 + i + 2) }
    tile_compute(i);
    if (i + 1 > 8) break;
    __syncthreads();
    KV_WRITES(B)
    __syncthreads();
    if (i + 3 <= 8) { KV_LOADS(B, c - 8 + i + 3) }
    tile_compute(i + 1);
  }
  lsum += __shfl_xor(lsum, 16);
  lsum += __shfl_xor(lsum, 32);
  const float inv = 1.f / lsum;
  u16* op = ya + (size_t)(b * S_ + c * 64 + w * 16 + lr) * 1024 + hd * 128 + lq * 4;
#pragma unroll
  for (int d = 0; d < 8; ++d) store_bf4(op + d * 16, oacc[d][0] * inv, oacc[d][1] * inv, oacc[d][2] * inv, oacc[d][3] * inv);
}

template <int PASS>
__device__ void ssm_item(const Params& P, int item, char* ldsw) {
  const int sc = item & 15, seq = item >> 4, g = seq & 63, b = seq >> 6;
  const int lane = tidx() & 63, lr = lane & 15, lq = lane >> 4;
  float* BuS = (float*)ldsw;
  u16* Hs = (u16*)(ldsw + 8448);
  const u16* bcat = (const u16*)(P.ws + O_BCAT);
  const u16* ccat = (const u16*)(P.ws + O_CCAT);
  const float* lam = (const float*)(P.ws + O_LAM);
  const u16* U2 = (const u16*)(P.ws + O_U2);
  float* Sbuf = (float*)(P.ws + O_SBUF);
  u16* ys = (u16*)(P.ws + O_YS);
  const float ar = lam[g * 64 + lane], ai = lam[4096 + g * 64 + lane];
  bf16x8 bfrag[8];
#pragma unroll
  for (int nt = 0; nt < 8; ++nt) bfrag[nt] = *(const bf16x8*)(bcat + (g * 128 + nt * 16 + lr) * 32 + lq * 8);
  float sr = 0.f, si = 0.f;
  bf16x8 cfrag[4];
  float dsk[4];
  if (PASS == 2) {
#pragma unroll
    for (int ks = 0; ks < 4; ++ks) cfrag[ks] = *(const bf16x8*)(ccat + (g * 16 + lr) * 128 + ks * 32 + lq * 8);
#pragma unroll
    for (int j = 0; j < 4; ++j) dsk[j] = P.ssm_d[g * 16 + lq * 4 + j];
    const float aLr = lam[2 * 4096 + g * 64 + lane], aLi = lam[3 * 4096 + g * 64 + lane];
    const float* Sb = Sbuf + (size_t)seq * 16 * 128;
#pragma unroll 4
    for (int cc = 0; cc < sc; ++cc) {
      float xr = Sb[cc * 128 + lane], xi = Sb[cc * 128 + 64 + lane];
      float nr = fmaf(aLr, sr, fmaf(-aLi, si, xr));
      float ni = fmaf(aLr, si, fmaf(aLi, sr, xi));
      sr = nr; si = ni;
    }
  }
#pragma unroll 1
  for (int ci = 0; ci < 8; ++ci) {
  const size_t tok_base = (size_t)b * S_ + (size_t)(sc * 8 + ci) * SSM_L;
  uint4 upre[SSM_L / 16];
  uint2 uepi[SSM_L / 16];
#pragma unroll
  for (int sub = 0; sub < SSM_L / 16; ++sub) {
    upre[sub] = uint4{0u, 0u, 0u, 0u};
    if (lq < 2) upre[sub] = *(const uint4*)(U2 + (tok_base + sub * 16 + lr) * 1024 + g * 16 + lq * 8);
    if (PASS == 2) uepi[sub] = *(const uint2*)(U2 + (tok_base + sub * 16 + lr) * 1024 + g * 16 + lq * 4);
  }
#pragma unroll
  for (int sub = 0; sub < SSM_L / 16; ++sub) {
    const size_t tok0 = tok_base + sub * 16;
    union { bf16x8 v; uint4 u; } uf;
    uf.u = upre[sub];
#pragma unroll
    for (int nt = 0; nt < 8; ++nt) {
      f32x4 d = __builtin_amdgcn_mfma_f32_16x16x32_bf16(bfrag[nt], uf.v, f32x4{0.f, 0.f, 0.f, 0.f}, 0, 0, 0);
      *(f32x4*)(BuS + lr * 132 + nt * 16 + lq * 4) = d;
    }
    asm volatile("s_waitcnt lgkmcnt(0)" ::: "memory");
    float bur[16], bui[16];
#pragma unroll
    for (int t = 0; t < 16; ++t) { bur[t] = BuS[t * 132 + lane]; bui[t] = BuS[t * 132 + 64 + lane]; }
    asm volatile("s_waitcnt lgkmcnt(0)" ::: "memory");
#pragma unroll
    for (int t = 0; t < 16; ++t) {
      float nr = fmaf(ar, sr, fmaf(-ai, si, bur[t]));
      float ni = fmaf(ar, si, fmaf(ai, sr, bui[t]));
      sr = nr; si = ni;
      if (PASS == 2) {
        const unsigned pk = pack2(sr, si);
        Hs[t * 136 + lane] = (u16)(pk & 0xffffu);
        Hs[t * 136 + 64 + lane] = (u16)(pk >> 16);
      }
    }
    asm volatile("s_waitcnt lgkmcnt(0)" ::: "memory");
    if (PASS == 2) {
      f32x4 yacc = f32x4{0.f, 0.f, 0.f, 0.f};
#pragma unroll
      for (int ks = 0; ks < 4; ++ks) {
        bf16x8 hf = *(const bf16x8*)(Hs + lr * 136 + ks * 32 + lq * 8);
        yacc = __builtin_amdgcn_mfma_f32_16x16x32_bf16(cfrag[ks], hf, yacc, 0, 0, 0);
      }
      const uint2 uu = uepi[sub];
      float y0 = gelu_tanh(yacc[0] + dsk[0] * lo2f(uu.x));
      float y1 = gelu_tanh(yacc[1] + dsk[1] * hi2f(uu.x));
      float y2 = gelu_tanh(yacc[2] + dsk[2] * lo2f(uu.y));
      float y3 = gelu_tanh(yacc[3] + dsk[3] * hi2f(uu.y));
      store_bf4(ys + (tok0 + lr) * 1024 + g * 16 + lq * 4, y0, y1, y2, y3);
      asm volatile("s_waitcnt lgkmcnt(0)" ::: "memory");
    }
  }
  }
  if (PASS == 1) {
    Sbuf[((size_t)seq * 16 + sc) * 128 + lane] = sr;
    Sbuf[((size_t)seq * 16 + sc) * 128 + 64 + lane] = si;
  }
}

__device__ void phase2(const Params& P, int bid, int nb, u16* lds) {
  for (int it = bid; it < 4096 + 512; it += nb) {
    if (it < 4096) {
      attn_item(P, it, lds);
    } else {
      __syncthreads();
      const int w = tidx() >> 6;
      ssm_item<1>(P, (it - 4096) * 4 + w, (char*)lds + w * 12800);
    }
  }
}
__device__ void phase3(const Params& P, int bid, int nb, u16* lds) {
  const int w = tidx() >> 6;
  for (int it = bid; it < 512; it += nb) ssm_item<2>(P, it * 4 + w, (char*)lds + w * 12800);
}

__device__ void phase4(const Params& P, int bid, int nb, u16* lds) {
  const u16* ys = (const u16*)(P.ws + O_YS);
  const u16* W = (const u16*)(P.ws + O_WGLU);
  u16* yg = (u16*)(P.ws + O_YG);
  EPI_COORDS3
  FOR_TILES_XCD(t, 128 * 4) {
    const int mt = t >> 2, nt = t & 3;
    f32x4 acc[4][8];
    ZERO_ACC8(acc)
    gemm_kloop3(acc, ys + (size_t)mt * 256 * 1024, 1024, W + (size_t)nt * 256 * 1024, 1024, 1024, lds);
#pragma unroll
    for (int mi = 0; mi < 4; ++mi) {
      const int m = mt * 256 + wm * 64 + mi * 16 + lr;
#pragma unroll
      for (int ni = 0; ni < 8; ++ni) {
        const int n = nt * 256 + wn * 128 + ni * 16 + lq * 4;
        uint2 yy = *(const uint2*)(ys + (size_t)m * 1024 + n);
        f32x4 a = acc[mi][ni];
        store_bf4(yg + (size_t)m * 1024 + n, lo2f(yy.x) * sigmoidf_(a[0]), hi2f(yy.x) * sigmoidf_(a[1]),
                  lo2f(yy.y) * sigmoidf_(a[2]), hi2f(yy.y) * sigmoidf_(a[3]));
      }
    }
  }
}

__device__ void phase5(const Params& P, int bid, int nb, u16* lds) {
  const u16* ya = (const u16*)(P.ws + O_YA);
  const u16* yg = (const u16*)(P.ws + O_YG);
  const u16* Wa = (const u16*)(P.ws + O_WAU);
  const u16* Wsu = (const u16*)(P.ws + O_WSU);
  const u16* G = (const u16*)(P.ws + O_G);
  u16* mg = (u16*)(P.ws + O_MERGED);
  EPI_COORDS3
  FOR_TILES_XCD(t, 128 * 8) {
    const int mt = t >> 3, nt = t & 7;
#pragma unroll 1
    for (int part = 0; part < 2; ++part) {
      f32x4 acc[4][8];
      ZERO_ACC8(acc)
      gemm_kloop3(acc, (part ? yg : ya) + (size_t)mt * 256 * 1024, 1024, (part ? Wsu : Wa) + (size_t)nt * 256 * 1024, 1024,
                  1024, lds);
      const u16* Gp = G + part * 2048;
#pragma unroll
      for (int mi = 0; mi < 4; ++mi) {
        const int m = mt * 256 + wm * 64 + mi * 16 + lr;
#pragma unroll
        for (int ni = 0; ni < 8; ++ni) {
          const int n = nt * 256 + wn * 128 + ni * 16 + lq * 4;
          const uint2 gg = *(const uint2*)(Gp + (size_t)m * 4096 + n);
          f32x4 a = acc[mi][ni];
          float o0 = a[0] * lo2f(gg.x), o1 = a[1] * hi2f(gg.x), o2 = a[2] * lo2f(gg.y), o3 = a[3] * hi2f(gg.y);
          if (part) {
            const uint2 pv = *(const uint2*)(mg + (size_t)m * D_ + n);
            o0 += lo2f(pv.x); o1 += hi2f(pv.x); o2 += lo2f(pv.y); o3 += hi2f(pv.y);
          }
          store_bf4(mg + (size_t)m * D_ + n, o0, o1, o2, o3);
        }
      }
    }
  }
}

__device__ void phase6(const Params& P, int bid, int nb, u16* lds) {
  const u16* mg = (const u16*)(P.ws + O_MERGED);
  const u16* W = (const u16*)(P.ws + O_WOUT);
  const u16* H = (const u16*)(P.ws + O_H);
  u16* pre1 = (u16*)(P.ws + O_PRE1);
  EPI_COORDS3
  FOR_TILES_XCD(t, 128 * 8) {
    const int mt = t >> 3, nt = t & 7;
    f32x4 acc[4][8];
    ZERO_ACC8(acc)
    gemm_kloop3(acc, mg + (size_t)mt * 256 * D_, D_, W + (size_t)nt * 256 * D_, D_, D_, lds);
#pragma unroll
    for (int mi = 0; mi < 4; ++mi) {
      const int m = mt * 256 + wm * 64 + mi * 16 + lr;
#pragma unroll
      for (int ni = 0; ni < 8; ++ni) {
        const int n = nt * 256 + wn * 128 + ni * 16 + lq * 4;
        uint2 hh = *(const uint2*)(H + (size_t)m * D_ + n);
        f32x4 a = acc[mi][ni];
        store_bf4(pre1 + (size_t)m * D_ + n, ALPHA * lo2f(hh.x) + a[0], ALPHA * hi2f(hh.x) + a[1],
                  ALPHA * lo2f(hh.y) + a[2], ALPHA * hi2f(hh.y) + a[3]);
      }
    }
  }
}

__device__ void phase8(const Params& P, int bid, int nb, u16* lds) {
  const u16* H = (const u16*)(P.ws + O_H);
  const u16* Pb = (const u16*)(P.ws + O_PB);
  u16* PQ = (u16*)(P.ws + O_PQ);
  u16* SG = (u16*)(P.ws + O_SG);
  u16* E = (u16*)(P.ws + O_E);
  EPI_COORDS3
  FOR_TILES_XCD(t, 3 * 1024) {
    const int which = t >> 10, tt = t & 1023, mt = tt >> 3, nt = tt & 7;
    f32x4 acc[4][8];
    ZERO_ACC8(acc)
    u16* dst;
    if (which == 0) {
      gemm_kloop3(acc, H + (size_t)mt * 256 * D_, D_, (const u16*)(P.ws + O_WPQ) + (size_t)nt * 256 * D_, D_, D_, lds);
      dst = PQ;
    } else if (which == 1) {
      gemm_kloop3(acc, H + (size_t)mt * 256 * D_, D_, (const u16*)(P.ws + O_WPG) + (size_t)nt * 256 * D_, D_, D_, lds);
      dst = SG;
    } else {
      gemm_kloop3(acc, Pb + (size_t)mt * 256 * 256, 256, (const u16*)(P.ws + O_WPIN) + (size_t)nt * 256 * 256, 256, 256, lds);
      dst = E;
    }
#pragma unroll
    for (int mi = 0; mi < 4; ++mi) {
      const int m = mt * 256 + wm * 64 + mi * 16 + lr;
#pragma unroll
      for (int ni = 0; ni < 8; ++ni) {
        const int n = nt * 256 + wn * 128 + ni * 16 + lq * 4;
        f32x4 a = acc[mi][ni];
        if (which == 1) { a[0] = sigmoidf_(a[0]); a[1] = sigmoidf_(a[1]); a[2] = sigmoidf_(a[2]); a[3] = sigmoidf_(a[3]); }
        store_bf4(dst + (size_t)m * D_ + n, a[0], a[1], a[2], a[3]);
      }
    }
  }
}

struct Top16 { float v[16]; int i[16]; };
__device__ __forceinline__ void top_init(Top16& t) {
#pragma unroll
  for (int k = 0; k < 16; ++k) { t.v[k] = -INFINITY; t.i[k] = 0; }
}
__device__ __forceinline__ void top_insert(Top16& t, float x, int id) {
  const bool c = x > t.v[15];
  t.v[15] = c ? x : t.v[15];
  t.i[15] = c ? id : t.i[15];
#pragma unroll
  for (int k = 15; k >= 1; --k) {
    const bool s = t.v[k] > t.v[k - 1];
    const float a = t.v[k - 1], b = t.v[k];
    const int ia = t.i[k - 1], ib = t.i[k];
    t.v[k - 1] = s ? b : a; t.v[k] = s ? a : b;
    t.i[k - 1] = s ? ib : ia; t.i[k] = s ? ia : ib;
  }
}

__device__ void phase9(const Params& P, int bid, int nb, u16* lds) {
  const u16* PQ = (const u16*)(P.ws + O_PQ);
  const u16* SK = (const u16*)(P.ws + O_SK);
  float* HV = (float*)(P.ws + O_HV);
  int* HI = (int*)(P.ws + O_HI);
  float* Sc = (float*)lds;
  EPI_COORDS
  const int tid = tidx();
  for (int t = bid; t < 256 * 16; t += nb) {
    const int mt = t >> 4, rc = t & 15;
    f32x4 acc[4][4];
    ZERO_ACC(acc)
    gemm_kloop(acc, PQ + (size_t)mt * 128 * D_ + rc * 128, D_, SK + (size_t)rc * 128 * 128, 128, 128, lds);
#pragma unroll
    for (int mi = 0; mi < 4; ++mi) {
      const int m = wm * 64 + mi * 16 + lr;
#pragma unroll
      for (int ni = 0; ni < 4; ++ni) {
        const int n = wn * 64 + ni * 16 + lq * 4;
#pragma unroll
        for (int j = 0; j < 4; ++j) Sc[m * 129 + n + j] = acc[mi][ni][j];
      }
    }
    __syncthreads();
    const int tok = tid & 127, hh = tid >> 7;
    float key[16];
#pragma unroll
    for (int j = 0; j < 16; ++j) key[j] = -INFINITY;
    {
      const float* sp = Sc + tok * 129 + hh * 64;
#pragma unroll 4
      for (int k = 0; k < 64; ++k) {
        const float x = sp[k];
        const float kk = __uint_as_float((__float_as_uint(x) & ~127u) | (unsigned)(127 - (hh * 64 + k)));
#pragma unroll
        for (int j = 15; j >= 1; --j) key[j] = __builtin_amdgcn_fmed3f(key[j - 1], key[j], kk);
        key[0] = fmaxf(key[0], kk);
      }
    }
    __syncthreads();
    float* Lv = (float*)lds;
#pragma unroll
    for (int k = 0; k < 16; ++k) Lv[tid * 17 + k] = key[k];
    __syncthreads();
    if (tid < 128) {
      int ia = 0, ib = 0;
      const float* va = Lv + tid * 17; const float* vb = Lv + (tid + 128) * 17;
      float* ov = HV + ((size_t)(mt * 16 + rc) * 128 + tid) * 16;
      int* oi = HI + ((size_t)(mt * 16 + rc) * 128 + tid) * 16;
      for (int k = 0; k < 16; ++k) {
        const float a = va[ia], b = vb[ib];
        const bool ta = a >= b;
        const unsigned bits = __float_as_uint(ta ? a : b);
        ov[k] = __uint_as_float(bits & ~127u);
        oi[k] = 127 - (int)(bits & 127u);
        ia += ta ? 1 : 0; ib += ta ? 0 : 1;
      }
    }
    __syncthreads();
  }
}

__device__ void phase10(const Params& P, int bid, int nb, u16* lds) {
  int* Lx = (int*)lds + tidx() * 33;
  const float* HV = (const float*)(P.ws + O_HV);
  const int* HI = (const int*)(P.ws + O_HI);
  int* EX = (int*)(P.ws + O_EXP);
  float* GT = (float*)(P.ws + O_GATE);
  for (int i_ = bid * 256 + tidx(); i_ < T_ * 8; i_ += nb * 256) {
    const int r_ = (i_ >> 7) & 7, mt_ = i_ >> 10, tl_ = i_ & 127;
    const int i = (mt_ * 128 + tl_) * 8 + r_;
    const size_t h0 = ((size_t)(mt_ * 16 + r_ * 2) * 128 + tl_) * 16, h1 = h0 + 128 * 16;
    float v0[16], v1[16];
    int i0[16], i1[16];
#pragma unroll
    for (int q = 0; q < 4; ++q) {
      float4 a = *(const float4*)(HV + h0 + q * 4);
      float4 b = *(const float4*)(HV + h1 + q * 4);
      int4 c = *(const int4*)(HI + h0 + q * 4);
      int4 d = *(const int4*)(HI + h1 + q * 4);
      v0[q * 4] = a.x; v0[q * 4 + 1] = a.y; v0[q * 4 + 2] = a.z; v0[q * 4 + 3] = a.w;
      v1[q * 4] = b.x; v1[q * 4 + 1] = b.y; v1[q * 4 + 2] = b.z; v1[q * 4 + 3] = b.w;
      i0[q * 4] = c.x; i0[q * 4 + 1] = c.y; i0[q * 4 + 2] = c.z; i0[q * 4 + 3] = c.w;
      i1[q * 4] = d.x; i1[q * 4 + 1] = d.y; i1[q * 4 + 2] = d.z; i1[q * 4 + 3] = d.w;
    }
    float t[16];
#pragma unroll
    for (int j = 0; j < 16; ++j) t[j] = -INFINITY;
#pragma unroll
    for (int a = 0; a < 16; ++a)
#pragma unroll
      for (int b = 0; b < 16; ++b)
        if ((a + 1) * (b + 1) <= 16) {
          const float sv = v0[a] + v1[b];
#pragma unroll
          for (int j = 15; j >= 1; --j) t[j] = __builtin_amdgcn_fmed3f(t[j - 1], t[j], sv);
          t[0] = fmaxf(t[0], sv);
        }
    const float mx = t[0], thr = t[15];
    float sum = 0.f;
#pragma unroll
    for (int k = 0; k < 16; ++k) sum += __expf(t[k] - mx);
    const float inv = 1.f / sum;
    int cnt = 0;
#pragma unroll
    for (int a = 0; a < 16; ++a)
#pragma unroll
      for (int b = 0; b < 16; ++b)
        if ((a + 1) * (b + 1) <= 16) {
          const float sv = v0[a] + v1[b];
          if (sv >= thr && cnt < 16) {
            Lx[cnt] = i0[a] * 128 + i1[b];
            Lx[16 + cnt] = __float_as_int(__expf(sv - mx) * inv);
            ++cnt;
          }
        }
    asm volatile("s_waitcnt lgkmcnt(0)" ::: "memory");
#pragma unroll
    for (int q = 0; q < 4; ++q) {
      *(int4*)(EX + (size_t)i * 16 + q * 4) = int4{Lx[q * 4], Lx[q * 4 + 1], Lx[q * 4 + 2], Lx[q * 4 + 3]};
      *(float4*)(GT + (size_t)i * 16 + q * 4) =
          float4{__int_as_float(Lx[16 + q * 4]), __int_as_float(Lx[16 + q * 4 + 1]), __int_as_float(Lx[16 + q * 4 + 2]),
                 __int_as_float(Lx[16 + q * 4 + 3])};
    }
    asm volatile("s_waitcnt lgkmcnt(0)" ::: "memory");
  }
}

__device__ __forceinline__ void unpack8(uint4 u, float* f) {
  f[0] = lo2f(u.x); f[1] = hi2f(u.x); f[2] = lo2f(u.y); f[3] = hi2f(u.y);
  f[4] = lo2f(u.z); f[5] = hi2f(u.z); f[6] = lo2f(u.w); f[7] = hi2f(u.w);
}
__device__ __forceinline__ void dec16(uint4 u, float* f) {
  f32x2 a;
  a = __builtin_amdgcn_cvt_pk_f32_fp8((int)u.x, false); f[0] = a.x; f[1] = a.y;
  a = __builtin_amdgcn_cvt_pk_f32_fp8((int)u.x, true);  f[2] = a.x; f[3] = a.y;
  a = __builtin_amdgcn_cvt_pk_f32_fp8((int)u.y, false); f[4] = a.x; f[5] = a.y;
  a = __builtin_amdgcn_cvt_pk_f32_fp8((int)u.y, true);  f[6] = a.x; f[7] = a.y;
  a = __builtin_amdgcn_cvt_pk_f32_fp8((int)u.z, false); f[8] = a.x; f[9] = a.y;
  a = __builtin_amdgcn_cvt_pk_f32_fp8((int)u.z, true);  f[10] = a.x; f[11] = a.y;
  a = __builtin_amdgcn_cvt_pk_f32_fp8((int)u.w, false); f[12] = a.x; f[13] = a.y;
  a = __builtin_amdgcn_cvt_pk_f32_fp8((int)u.w, true);  f[14] = a.x; f[15] = a.y;
}
__device__ __forceinline__ void load_row_bf16(const u16* row, int lane, float* f) {
#pragma unroll
  for (int q = 0; q < 2; ++q) {
    uint4 a = *(const uint4*)(row + q * 1024 + lane * 16);
    uint4 b = *(const uint4*)(row + q * 1024 + lane * 16 + 8);
    unpack8(a, f + q * 16);
    unpack8(b, f + q * 16 + 8);
  }
}
__device__ __forceinline__ void pace_xcd(unsigned* ctr, unsigned& epoch, unsigned nloc) {
  epoch += nloc;
  __syncthreads();
  if (threadIdx.x == 0) {
    __hip_atomic_fetch_add(ctr, 1u, __ATOMIC_RELAXED, __HIP_MEMORY_SCOPE_AGENT);
    unsigned sp = 0;
    while (__hip_atomic_load(ctr, __ATOMIC_RELAXED, __HIP_MEMORY_SCOPE_AGENT) < epoch && ++sp < (1u << 16)) __builtin_amdgcn_s_sleep(2);
  }
  __syncthreads();
}
__device__ void phase11(const Params& P, int bid, int nb, unsigned xcc, unsigned nloc) {
  unsigned* pctr = (unsigned*)(P.ws + (1000 * MB + 1024) + xcc * 128);
  unsigned pep = 0;
  const bool do_pace = (T_ % (nb * 4)) == 0 && nloc > 0;
  const u16* H = (const u16*)(P.ws + O_H);
  const unsigned char* U8 = (const unsigned char*)(P.ws + O_U8);
  const unsigned char* V8 = (const unsigned char*)(P.ws + O_V8);
  const float* RSU = (const float*)(P.ws + O_RSU);
  const float* RSV = (const float*)(P.ws + O_RSV);
  const u16* SG = (const u16*)(P.ws + O_SG);
  const u16* E = (const u16*)(P.ws + O_E);
  const int* EX = (const int*)(P.ws + O_EXP);
  const float* GT = (const float*)(P.ws + O_GATE);
  const int lane = tidx() & 63;
  int sweep = 0;
  for (int tok = bid * 4 + (tidx() >> 6); tok < T_; tok += nb * 4, sweep ^= 1) {
    if (do_pace && tok >= nb * 4) pace_xcd(pctr, pep, nloc);
    float hf[32], y[32];
    load_row_bf16(H + (size_t)tok * D_, lane, hf);
#pragma unroll
    for (int k = 0; k < 32; ++k) y[k] = 0.f;
    int ev0 = EX[(size_t)tok * 128 + lane], ev1 = EX[(size_t)tok * 128 + 64 + lane];
    float gv0 = GT[(size_t)tok * 128 + lane], gv1 = GT[(size_t)tok * 128 + 64 + lane];
    {
      int k0 = (ev0 << 7) | lane, k1 = (ev1 << 7) | (64 + lane);
#pragma unroll
      for (int kk = 2; kk <= 128; kk <<= 1) {
#pragma unroll
        for (int j = kk >> 1; j >= 1; j >>= 1) {
          if (j == 64) {
            const int lo_ = min(k0, k1), hi_ = max(k0, k1);
            k0 = lo_; k1 = hi_;
          } else {
            const int p0 = __shfl_xor(k0, j), p1 = __shfl_xor(k1, j);
            const bool lower = (lane & j) == 0;
            const bool up0 = (kk == 128) ? true : ((lane & kk) == 0);
            const bool up1 = (kk == 128) ? true : (kk == 64 ? false : ((lane & kk) == 0));
            k0 = (lower == up0) ? min(k0, p0) : max(k0, p0);
            k1 = (lower == up1) ? min(k1, p1) : max(k1, p1);
          }
        }
      }
      const int s0 = k0 & 127, s1 = k1 & 127;
      const float ga0 = __shfl(gv0, s0 & 63), gb0 = __shfl(gv1, s0 & 63);
      const float ga1 = __shfl(gv0, s1 & 63), gb1 = __shfl(gv1, s1 & 63);
      gv0 = (s0 < 64) ? ga0 : gb0;
      gv1 = (s1 < 64) ? ga1 : gb1;
      ev0 = k0 >> 7;
      ev1 = k1 >> 7;
    }
    const float ru0 = RSU[ev0], ru1 = RSU[ev1], rv0 = RSV[ev0], rv1 = RSV[ev1];
    for (int k4_ = 0; k4_ < 128; k4_ += 4) {
      const int k4 = sweep ? (124 - k4_) : k4_;
      const int src = k4 & 63;
      const bool lo = k4 < 64;
      int ee[4]; float gg[4], su[4], sv[4];
#pragma unroll
      for (int x = 0; x < 4; ++x) {
        ee[x] = __shfl(lo ? ev0 : ev1, src + x);
        gg[x] = __shfl(lo ? gv0 : gv1, src + x);
        su[x] = __shfl(lo ? ru0 : ru1, src + x);
        sv[x] = __shfl(lo ? rv0 : rv1, src + x);
      }
      uint4 uu[4][2], vv[4][2];
#pragma unroll
      for (int x = 0; x < 4; ++x)
#pragma unroll
        for (int q = 0; q < 2; ++q) {
          uu[x][q] = *(const uint4*)(U8 + (size_t)ee[x] * D_ + q * 1024 + lane * 16);
          vv[x][q] = *(const uint4*)(V8 + (size_t)ee[x] * D_ + q * 1024 + lane * 16);
        }
      float dd[4];
#pragma unroll
      for (int x = 0; x < 4; ++x) {
        float d = 0.f;
#pragma unroll
        for (int q = 0; q < 2; ++q) {
          float f[16];
          dec16(uu[x][q], f);
#pragma unroll
          for (int j = 0; j < 16; ++j) d = fmaf(f[j], hf[q * 16 + j], d);
        }
        dd[x] = d;
      }
#pragma unroll
      for (int o = 32; o >= 1; o >>= 1) {
#pragma unroll
        for (int x = 0; x < 4; ++x) dd[x] += __shfl_xor(dd[x], o);
      }
#pragma unroll
      for (int x = 0; x < 4; ++x) {
        const float w = gg[x] * gelu_tanh(dd[x] * su[x]) * sv[x];
#pragma unroll
        for (int q = 0; q < 2; ++q) {
          float f[16];
          dec16(vv[x][q], f);
#pragma unroll
          for (int j = 0; j < 16; ++j) y[q * 16 + j] = fmaf(w, f[j], y[q * 16 + j]);
        }
      }
    }
    float ef[32], sg[32];
    load_row_bf16(E + (size_t)tok * D_, lane, ef);
    load_row_bf16(SG + (size_t)tok * D_, lane, sg);
    float ss = 0.f;
#pragma unroll
    for (int k = 0; k < 32; ++k) ss += ef[k] * ef[k];
    const float rr = rsqrtf(wave_sum(ss) * (1.f / D_) + 1e-5f);
    float s1 = 0.f;
#pragma unroll
    for (int q = 0; q < 2; ++q)
#pragma unroll
      for (int j4 = 0; j4 < 4; ++j4) {
        float4 g = *(const float4*)(P.ple_g + q * 1024 + lane * 16 + j4 * 4);
        const float gq[4] = {g.x, g.y, g.z, g.w};
#pragma unroll
        for (int j = 0; j < 4; ++j) {
          const int k = q * 16 + j4 * 4 + j;
          float v = ALPHA * hf[k] + y[k] + ef[k] * rr * gq[j] * sg[k];
          y[k] = v;
          s1 += v;
        }
      }
    const float mu = wave_sum(s1) * (1.f / D_);
    float s2 = 0.f;
#pragma unroll
    for (int k = 0; k < 32; ++k) { float d = y[k] - mu; s2 += d * d; }
    const float rstd = rsqrtf(wave_sum(s2) * (1.f / D_) + 1e-5f);
#pragma unroll
    for (int q = 0; q < 2; ++q)
#pragma unroll
      for (int j4 = 0; j4 < 4; ++j4) {
        const int col = q * 1024 + lane * 16 + j4 * 4;
        const int k = q * 16 + j4 * 4;
        float4 g = *(const float4*)(P.ln2_g + col), b = *(const float4*)(P.ln2_b + col);
        float4 o;
        o.x = (y[k + 0] - mu) * rstd * g.x + b.x; o.y = (y[k + 1] - mu) * rstd * g.y + b.y;
        o.z = (y[k + 2] - mu) * rstd * g.z + b.z; o.w = (y[k + 3] - mu) * rstd * g.w + b.w;
        *(float4*)(P.out + (size_t)tok * D_ + col) = o;
      }
  }
}

constexpr size_t O_BAR = 1000 * MB;
__device__ __forceinline__ void gbar(unsigned* ctr, unsigned& epoch, unsigned nb) {
  epoch += nb;
  asm volatile("s_waitcnt vmcnt(0)" ::: "memory");
  __syncthreads();
  if (threadIdx.x == 0) {
    __builtin_amdgcn_fence(__ATOMIC_RELEASE, "agent");
    asm volatile("s_waitcnt vmcnt(0)" ::: "memory");
    __hip_atomic_fetch_add(ctr, 1u, __ATOMIC_RELAXED, __HIP_MEMORY_SCOPE_AGENT);
    while (__hip_atomic_load(ctr, __ATOMIC_RELAXED, __HIP_MEMORY_SCOPE_AGENT) < epoch) __builtin_amdgcn_s_sleep(2);
    __builtin_amdgcn_fence(__ATOMIC_ACQUIRE, "agent");
    asm volatile("s_waitcnt vmcnt(0)" ::: "memory");
  }
  __syncthreads();
}

#define XB_TMO      128
#define XB_XCNT(j)  (256  + 64 * (j))
#define XB_XSUB(j)  (1280 + 64 * (j))
#define XB_XGEN(j)  (2304 + 64 * (j))
#define XB_TOP      3328
#define XB_TOPGEN   3392
#define XCD_BAR_WORDS 3456
#define XB_SPIN_CAP (1u << 18)
#define LAS __attribute__((address_space(3)))

__device__ __forceinline__ unsigned xb_ld(unsigned* p)              { return __hip_atomic_load(p, __ATOMIC_RELAXED, __HIP_MEMORY_SCOPE_AGENT); }
__device__ __forceinline__ unsigned xb_add(unsigned* p, unsigned v) { return __hip_atomic_fetch_add(p, v, __ATOMIC_RELAXED, __HIP_MEMORY_SCOPE_AGENT); }
__device__ __forceinline__ unsigned xb_xcc_id() { return (unsigned)__builtin_amdgcn_s_getreg((3 << 11) | 20) & 0xFu; }
#define XB_SPIN(cond, bar) do { unsigned _sp = 0; while (cond) { __builtin_amdgcn_s_sleep(1); \
    if ((++_sp & 255u) == 0u) { if (xb_ld(&(bar)[XB_TMO])) break; if (_sp > XB_SPIN_CAP) { atomicAdd(&(bar)[XB_TMO], 1u); break; } } } } while (0)

struct XcdBarrier {
    unsigned* bar; unsigned x;
    volatile LAS unsigned* st;
};

__device__ __forceinline__ XcdBarrier xcd_barrier_post(unsigned* bar, volatile LAS unsigned* st) {
    XcdBarrier b; b.bar = bar; b.x = xb_xcc_id(); b.st = st;
    if (threadIdx.x == 0) (void)xb_add(&bar[XB_XCNT(b.x)], 1u);
    return b;
}
__device__ __forceinline__ void xcd_barrier_complete(unsigned* bar, unsigned x, unsigned& nloc, unsigned& nx) {
    const unsigned G = gridDim.x * gridDim.y * gridDim.z;
    unsigned sum, cnt, mine, sp = 0u;
    for (;;) {
        sum = 0u; cnt = 0u; mine = 0u;
#pragma unroll
        for (unsigned j = 0; j < 16; ++j) { const unsigned c = xb_ld(&bar[XB_XCNT(j)]); sum += c; cnt += (c > 0u) ? 1u : 0u; mine = (j == x) ? c : mine; }
        if (sum == G) break;
        __builtin_amdgcn_s_sleep(1);
        if ((++sp & 255u) == 0u) { if (xb_ld(&bar[XB_TMO])) break; if (sp > XB_SPIN_CAP) { atomicAdd(&bar[XB_TMO], 1u); break; } }
    }
    nloc = mine > 0u ? mine : 1u; nx = cnt > 0u ? cnt : 1u;
}

__device__ __forceinline__ void xcd_barrier(const XcdBarrier& b) {
    asm volatile("s_waitcnt vmcnt(0)" ::: "memory");
    __syncthreads();
    if (threadIdx.x == 0) {
        unsigned* bar = b.bar;
        __builtin_amdgcn_s_waitcnt(0);
        unsigned nloc = b.st[0], nx = b.st[1];
        if (nloc == 0u) { xcd_barrier_complete(bar, b.x, nloc, nx); b.st[0] = nloc; b.st[1] = nx; }
        const unsigned old = xb_add(&bar[XB_XSUB(b.x)], 1u);
        const unsigned gen = old / nloc;
        if (old + 1u == (gen + 1u) * nloc) {
            __builtin_amdgcn_fence(__ATOMIC_RELEASE, "agent");
            asm volatile("s_waitcnt vmcnt(0)" ::: "memory");
            const unsigned og = xb_add(&bar[XB_TOP], 1u);
            const unsigned tg = og / nx;
            if (og + 1u == (tg + 1u) * nx) xb_add(&bar[XB_TOPGEN], 1u);
            else XB_SPIN(xb_ld(&bar[XB_TOPGEN]) == tg, bar);
            __builtin_amdgcn_fence(__ATOMIC_ACQUIRE, "agent");
            xb_add(&bar[XB_XGEN(b.x)], 1u);
            asm volatile("s_waitcnt vmcnt(0)" ::: "memory");
        } else {
            XB_SPIN(xb_ld(&bar[XB_XGEN(b.x)]) == gen, bar);
            __builtin_amdgcn_fence(__ATOMIC_ACQUIRE, "agent");
            asm volatile("s_waitcnt vmcnt(0)" ::: "memory");
        }
    }
    __syncthreads();
}


constexpr int NPHASE = 12;

__global__ void __launch_bounds__(512, 2) mega_kernel(Params P) {
  extern __shared__ __attribute__((aligned(16))) u16 dlds[];
  cg::grid_group grid = cg::this_grid();
  const int rb = blockIdx.x, rnb = gridDim.x;
  const int half = threadIdx.x >> 8;
  const int bid = rb * 2 + half, nb = rnb * 2;
  u16* lds = dlds + half * 36864;
  volatile LAS unsigned* xst = (volatile LAS unsigned*)(dlds + 73728);
  if (threadIdx.x < 4) xst[threadIdx.x] = 0u;
  __syncthreads();
  XcdBarrier xb = xcd_barrier_post((unsigned*)(P.ws + O_BAR + 4096), xst);
  phase0(P, bid, nb, lds);
  if (P.ws == nullptr) grid.sync();
  xcd_barrier(xb);
  phase1(P, rb, rnb, dlds); xcd_barrier(xb);
  phase2(P, bid, nb, lds); xcd_barrier(xb);
  phase3(P, bid, nb, lds); xcd_barrier(xb);
  phase4(P, rb, rnb, dlds); xcd_barrier(xb);
  phase5(P, rb, rnb, dlds); xcd_barrier(xb);
  phase6(P, rb, rnb, dlds); xcd_barrier(xb);
  ln_rows_bf16((const u16*)(P.ws + O_PRE1), P.ln1_g, P.ln1_b, (u16*)(P.ws + O_H), bid * 4 + (tidx() >> 6), nb * 4);
  xcd_barrier(xb);
  phase8(P, rb, rnb, dlds); xcd_barrier(xb);
  phase9(P, bid, nb, lds); xcd_barrier(xb);
  phase10(P, bid, nb, lds); xcd_barrier(xb);
  phase11(P, bid, nb, xb.x, xst[0]);
}

extern "C" void kernel_launch(void* const* d_in, const int* in_sizes, int n_in, void* d_out, int out_size, void* d_ws,
                              size_t ws_size, hipStream_t stream) {
  Params p{};
  const float** pp = (const float**)&p;
  for (int i = 0; i < 29; ++i) pp[i] = (const float*)d_in[i];
  p.out = (float*)d_out;
  p.ws = (char*)d_ws;
  if (ws_size < 1001 * MB) fprintf(stderr, "workspace too small: %zu\n", ws_size);
  constexpr size_t kDynLds = 147456 + 16;
  static int grid_blocks = 0;
  if (!grid_blocks) {
    int dev = 0, cus = 0, per_cu = 0;
    (void)hipGetDevice(&dev);
    (void)hipDeviceGetAttribute(&cus, hipDeviceAttributeMultiprocessorCount, dev);
    (void)hipFuncSetAttribute((const void*)mega_kernel, hipFuncAttributeMaxDynamicSharedMemorySize, (int)kDynLds);
    (void)hipOccupancyMaxActiveBlocksPerMultiprocessor(&per_cu, mega_kernel, 512, kDynLds);
    if (per_cu > 1) per_cu = 1;
    grid_blocks = cus * per_cu;
  }
  (void)hipMemsetAsync((char*)d_ws + O_BAR, 0, 4096 + XCD_BAR_WORDS * 4, stream);
  void* args[] = {&p};
  hipError_t e = hipLaunchCooperativeKernel((void*)mega_kernel, dim3(grid_blocks), dim3(512), args, kDynLds, stream);
  if (e != hipSuccess) fprintf(stderr, "cooperative launch failed: %s (grid %d)\n", hipGetErrorString(e), grid_blocks);
}
```

```cpp
#include <hip/hip_runtime.h>
#include <hip/hip_bf16.h>
#include <hip/hip_cooperative_groups.h>
#include <cstdio>
namespace cg = cooperative_groups;

#ifndef MULTI
#define MULTI 0
#endif

typedef unsigned short u16;
using bf16x8 = __attribute__((ext_vector_type(8))) short;
using f32x4 = __attribute__((ext_vector_type(4))) float;

constexpr int T_ = 32768;
constexpr int S_ = 16384;
constexpr int D_ = 2048;
constexpr int SSM_L = 128;
constexpr int SSM_NC = S_ / SSM_L;
constexpr float ALPHA = 1.189207115002721f;
constexpr size_t MB = 1024ull * 1024ull;

constexpr size_t O_WIN = 0 * MB, O_WGLU = 32 * MB, O_WAU = 34 * MB, O_WSU = 38 * MB, O_WOUT = 42 * MB,
                 O_WPQ = 50 * MB, O_WPG = 58 * MB, O_WPIN = 66 * MB, O_SK = 67 * MB, O_BCAT = 67 * MB + 512 * 1024,
                 O_CCAT = 68 * MB, O_LAM = 68 * MB + 256 * 1024, O_UB = 70 * MB, O_VB = 134 * MB, O_SBUF = 198 * MB,
                 O_H = 206 * MB, O_Q = 334 * MB, O_K = 398 * MB, O_VT = 462 * MB, O_U2 = 526 * MB, O_G = 590 * MB,
                 O_YA = 846 * MB, O_YS = 910 * MB, O_PB = 974 * MB;
constexpr size_t O_YG = O_VT, O_MERGED = O_Q, O_PRE1 = O_G, O_PQ = O_Q, O_SG = O_VT, O_E = O_G,
                 O_HV = O_G + 128 * MB, O_HI = O_G + 160 * MB, O_EXP = O_G + 192 * MB, O_GATE = O_G + 208 * MB;

struct Params {
  const float *x, *p, *ln_in_g, *ln_in_b, *w_in, *rel_bias, *lam_re, *lam_im, *log_dt, *b_re, *b_im, *c_re, *c_im,
      *ssm_d, *w_glu, *w_au, *w_su, *w_out, *ln1_g, *ln1_b, *w_pq, *sub_keys, *peer_u, *peer_v, *ple_w_in, *ple_g,
      *ple_w_gate, *ln2_g, *ln2_b;
  float* out;
  char* ws;
};

__device__ __forceinline__ int tidx() { int t = threadIdx.x & 255; asm volatile("" : "+v"(t)); return t; }
__device__ __forceinline__ int rtid() { int t = threadIdx.x; asm volatile("" : "+v"(t)); return t; }
__device__ __forceinline__ u16 f2bf(float f) {
  unsigned u = __float_as_uint(f);
  u += 0x7fffu + ((u >> 16) & 1u);
  return (u16)(u >> 16);
}
__device__ __forceinline__ float bf2f(u16 h) { return __uint_as_float(((unsigned)h) << 16); }
typedef __bf16 hwbf16x2 __attribute__((ext_vector_type(2)));
typedef float hwf32x2 __attribute__((ext_vector_type(2)));
__device__ __forceinline__ unsigned pack2(float a, float b) {
  hwf32x2 v = {a, b};
  hwbf16x2 r = __builtin_convertvector(v, hwbf16x2);
  return *(unsigned*)&r;
}
__device__ __forceinline__ float lo2f(unsigned u) { return __uint_as_float(u << 16); }
__device__ __forceinline__ float hi2f(unsigned u) { return __uint_as_float(u & 0xffff0000u); }
__device__ __forceinline__ float sigmoidf_(float x) { return __builtin_amdgcn_rcpf(1.f + __expf(-x)); }
__device__ __forceinline__ float gelu_tanh(float x) {
  float u = 0.7978845608028654f * (x + 0.044715f * x * x * x);
  float t = 1.f - 2.f * __builtin_amdgcn_rcpf(1.f + __expf(2.f * u));
  return 0.5f * x * (1.f + t);
}
__device__ __forceinline__ float wave_sum(float v) {
#pragma unroll
  for (int o = 32; o >= 1; o >>= 1) v += __shfl_xor(v, o);
  return v;
}
__device__ __forceinline__ void store_bf4(u16* dst, float a, float b, float c, float d) {
  uint2 v; v.x = pack2(a, b); v.y = pack2(c, d);
  *(uint2*)dst = v;
}

__device__ __forceinline__ void gemm_kloop(f32x4 (&acc)[4][4], const u16* __restrict__ A, int lda,
                                           const u16* __restrict__ Bt, int ldb, int K, u16* lds) {
  const int tid = tidx(), lane = tid & 63, wid = tid >> 6, wm = wid >> 1, wn = wid & 1;
  const int lr = lane & 15, lq = lane >> 4;
  const int nk = K >> 6;
  const int srow = tid >> 3, sc = (tid & 7) ^ (srow & 7);
  const u16* ga = A + (size_t)srow * lda + sc * 8;
  const u16* gb = Bt + (size_t)srow * ldb + sc * 8;
  u16* lw = lds + tid * 8;
#pragma unroll
  for (int i = 0; i < 4; ++i) {
    __builtin_amdgcn_global_load_lds((const unsigned*)(ga + (size_t)(32 * i) * lda), (unsigned*)(lw + i * 2048), 16, 0, 0);
    __builtin_amdgcn_global_load_lds((const unsigned*)(gb + (size_t)(32 * i) * ldb), (unsigned*)(lw + 8192 + i * 2048), 16, 0, 0);
  }
  __syncthreads();
  const int swz = lr & 7;
  for (int kt = 0; kt < nk; ++kt) {
    if (kt + 1 < nk) {
      u16* lw2 = lw + ((kt + 1) & 1) * 16384;
#pragma unroll
      for (int i = 0; i < 4; ++i) {
        __builtin_amdgcn_global_load_lds((const unsigned*)(ga + (size_t)(32 * i) * lda + (kt + 1) * 64), (unsigned*)(lw2 + i * 2048), 16, 0, 0);
        __builtin_amdgcn_global_load_lds((const unsigned*)(gb + (size_t)(32 * i) * ldb + (kt + 1) * 64), (unsigned*)(lw2 + 8192 + i * 2048), 16, 0, 0);
      }
    }
    const u16* sa = lds + (kt & 1) * 16384;
    const u16* sb = sa + 8192;
#pragma unroll
    for (int ks = 0; ks < 2; ++ks) {
      bf16x8 af[4], bfr[4];
      const int co = ((ks * 4 + lq) ^ swz) * 8;
#pragma unroll
      for (int mi = 0; mi < 4; ++mi) af[mi] = *(const bf16x8*)(sa + (wm * 64 + mi * 16 + lr) * 64 + co);
#pragma unroll
      for (int ni = 0; ni < 4; ++ni) bfr[ni] = *(const bf16x8*)(sb + (wn * 64 + ni * 16 + lr) * 64 + co);
#pragma unroll
      for (int mi = 0; mi < 4; ++mi)
#pragma unroll
        for (int ni = 0; ni < 4; ++ni)
          acc[mi][ni] = __builtin_amdgcn_mfma_f32_16x16x32_bf16(bfr[ni], af[mi], acc[mi][ni], 0, 0, 0);
    }
    __syncthreads();
  }
}

#define ZERO_ACC(acc)                                   \
  _Pragma("unroll") for (int _a = 0; _a < 4; ++_a)      \
  _Pragma("unroll") for (int _b = 0; _b < 4; ++_b) acc[_a][_b] = f32x4{0.f, 0.f, 0.f, 0.f};

__device__ __forceinline__ void gemm_kloop2(f32x4 (&acc)[4][8], const u16* __restrict__ A, int lda,
                                            const u16* __restrict__ Bt, int ldb, int K, u16* lds) {
  const int tid = tidx(), lane = tid & 63, wid = tid >> 6;
  const int lr = lane & 15, lq = lane >> 4;
  const int nk = K >> 5;
  const int srow = tid >> 2;
  const int sc = (tid & 3) ^ ((0x78 >> (2 * ((tid >> 4) & 3))) & 3);
  const u16* ga = A + (size_t)srow * lda + sc * 8;
  const u16* gb = Bt + (size_t)srow * ldb + sc * 8;
  u16* lw = lds + tid * 8;
#pragma unroll
  for (int i = 0; i < 4; ++i)
    __builtin_amdgcn_global_load_lds((const unsigned*)(ga + (size_t)(64 * i) * lda), (unsigned*)(lw + i * 2048), 16, 0, 0);
#pragma unroll
  for (int i = 0; i < 2; ++i)
    __builtin_amdgcn_global_load_lds((const unsigned*)(gb + (size_t)(64 * i) * ldb), (unsigned*)(lw + 8192 + i * 2048), 16, 0, 0);
  __syncthreads();
  const int co = (lq ^ ((0x78 >> (2 * ((lr >> 2) & 3))) & 3)) * 8;
  for (int kt = 0; kt < nk; ++kt) {
    if (kt + 1 < nk) {
      u16* lw2 = lw + ((kt + 1) & 1) * 12288;
#pragma unroll
      for (int i = 0; i < 4; ++i)
        __builtin_amdgcn_global_load_lds((const unsigned*)(ga + (size_t)(64 * i) * lda + (kt + 1) * 32), (unsigned*)(lw2 + i * 2048), 16, 0, 0);
#pragma unroll
      for (int i = 0; i < 2; ++i)
        __builtin_amdgcn_global_load_lds((const unsigned*)(gb + (size_t)(64 * i) * ldb + (kt + 1) * 32), (unsigned*)(lw2 + 8192 + i * 2048), 16, 0, 0);
    }
    const u16* sa = lds + (kt & 1) * 12288;
    const u16* sb = sa + 8192;
    bf16x8 af[4];
#pragma unroll
    for (int mi = 0; mi < 4; ++mi) af[mi] = *(const bf16x8*)(sa + (wid * 64 + mi * 16 + lr) * 32 + co);
#pragma unroll
    for (int nh = 0; nh < 2; ++nh) {
      bf16x8 bfr[4];
#pragma unroll
      for (int ni = 0; ni < 4; ++ni) bfr[ni] = *(const bf16x8*)(sb + ((nh * 4 + ni) * 16 + lr) * 32 + co);
#pragma unroll
      for (int mi = 0; mi < 4; ++mi)
#pragma unroll
        for (int ni = 0; ni < 4; ++ni)
          acc[mi][nh * 4 + ni] = __builtin_amdgcn_mfma_f32_16x16x32_bf16(bfr[ni], af[mi], acc[mi][nh * 4 + ni], 0, 0, 0);
    }
    __syncthreads();
  }
}

__device__ __forceinline__ void gemm_kloop3(f32x4 (&acc)[4][8], const u16* __restrict__ A, int lda,
                                            const u16* __restrict__ Bt, int ldb, int K, u16* lds) {
  const int tid = rtid(), lane = tid & 63, wid = tid >> 6, wm = wid >> 1, wn = wid & 1;
  const int lr = lane & 15, lq = lane >> 4;
  const int nk = K >> 6;
  const int srow = tid >> 3, sc = (tid & 7) ^ (srow & 7);
  const u16* ga = A + (size_t)srow * lda + sc * 8;
  const u16* gb = Bt + (size_t)srow * ldb + sc * 8;
  u16* lw = lds + tid * 8;
#pragma unroll
  for (int i = 0; i < 4; ++i) {
    __builtin_amdgcn_global_load_lds((const unsigned*)(ga + (size_t)(64 * i) * lda), (unsigned*)(lw + i * 4096), 16, 0, 0);
    __builtin_amdgcn_global_load_lds((const unsigned*)(gb + (size_t)(64 * i) * ldb), (unsigned*)(lw + 16384 + i * 4096), 16, 0, 0);
  }
  __syncthreads();
  const int swz = lr & 7;
  for (int kt = 0; kt < nk; ++kt) {
    const int ko = min(kt + 1, nk - 1) * 64;
    u16* lw2 = lw + ((kt + 1) & 1) * 32768;
    const u16* sa = lds + (kt & 1) * 32768;
    const u16* sb = sa + 16384;
#pragma unroll
    for (int ks = 0; ks < 2; ++ks) {
      const int co = ((ks * 4 + lq) ^ swz) * 8;
      bf16x8 af[4];
#pragma unroll
      for (int mi = 0; mi < 4; ++mi) af[mi] = *(const bf16x8*)(sa + (wm * 64 + mi * 16 + lr) * 64 + co);
#pragma unroll
      for (int nh = 0; nh < 2; ++nh) {
        bf16x8 bfr[4];
#pragma unroll
        for (int ni = 0; ni < 4; ++ni) bfr[ni] = *(const bf16x8*)(sb + (wn * 128 + (nh * 4 + ni) * 16 + lr) * 64 + co);
        if (ks == 0) __builtin_amdgcn_sched_barrier(0);
#pragma unroll
        for (int mi = 0; mi < 4; ++mi) {
#pragma unroll
          for (int ni = 0; ni < 4; ++ni)
            acc[mi][nh * 4 + ni] = __builtin_amdgcn_mfma_f32_16x16x32_bf16(bfr[ni], af[mi], acc[mi][nh * 4 + ni], 0, 0, 0);
          if (ks == 0) {
            if (nh == 0)
              __builtin_amdgcn_global_load_lds((const unsigned*)(ga + (size_t)(64 * mi) * lda + ko), (unsigned*)(lw2 + mi * 4096), 16, 0, 0);
            else
              __builtin_amdgcn_global_load_lds((const unsigned*)(gb + (size_t)(64 * mi) * ldb + ko), (unsigned*)(lw2 + 16384 + mi * 4096), 16, 0, 0);
            __builtin_amdgcn_sched_barrier(0);
          }
        }
      }
    }
    __syncthreads();
  }
}

#define EPI_COORDS3                                                             \
  const int lane = rtid() & 63, wid = rtid() >> 6, wm = wid >> 1, wn = wid & 1; \
  const int lr = lane & 15, lq = lane >> 4;

#define ZERO_ACC8(acc)                                  \
  _Pragma("unroll") for (int _a = 0; _a < 4; ++_a)      \
  _Pragma("unroll") for (int _b = 0; _b < 8; ++_b) acc[_a][_b] = f32x4{0.f, 0.f, 0.f, 0.f};

#define FOR_TILES_XCD(t, ntiles) \
  for (int _k = 0, t = (bid & 7) * (nb >> 3) + (bid >> 3); t < (ntiles); ++_k, t = ((_k * 8 + (bid & 7)) * (nb >> 3)) + (bid >> 3))

#define EPI_COORDS                                                             \
  const int lane = tidx() & 63, wid = tidx() >> 6, wm = wid >> 1, wn = wid & 1; \
  const int lr = lane & 15, lq = lane >> 4;

__device__ void tconv_tile(const float* __restrict__ W, int K, int N, u16* __restrict__ Wt, int tile, float* lds) {
  const int tid = tidx();
  const int ntn = N >> 6;
  const int kt = tile / ntn, nt = tile % ntn;
  const int c4 = (tid & 15) * 4;
#pragma unroll
  for (int i = 0; i < 4; ++i) {
    int r = (tid >> 4) + 16 * i;
    float4 v = *(const float4*)(W + (size_t)(kt * 64 + r) * N + nt * 64 + c4);
    lds[r * 65 + c4 + 0] = v.x; lds[r * 65 + c4 + 1] = v.y; lds[r * 65 + c4 + 2] = v.z; lds[r * 65 + c4 + 3] = v.w;
  }
  __syncthreads();
  const int n = tid >> 2, kseg = (tid & 3) * 16;
  unsigned o[8];
#pragma unroll
  for (int j = 0; j < 8; ++j) o[j] = pack2(lds[(kseg + 2 * j) * 65 + n], lds[(kseg + 2 * j + 1) * 65 + n]);
  u16* dst = Wt + (size_t)(nt * 64 + n) * K + kt * 64 + kseg;
  *(uint4*)dst = uint4{o[0], o[1], o[2], o[3]};
  *(uint4*)(dst + 8) = uint4{o[4], o[5], o[6], o[7]};
  __syncthreads();
}

__device__ void conv_linear(const float* __restrict__ src, u16* __restrict__ dst, size_t n8, size_t gtid, size_t nth) {
  for (size_t i = gtid; i < n8; i += nth) {
    float4 a = *(const float4*)(src + i * 8), b = *(const float4*)(src + i * 8 + 4);
    *(uint4*)(dst + i * 8) = uint4{pack2(a.x, a.y), pack2(a.z, a.w), pack2(b.x, b.y), pack2(b.z, b.w)};
  }
}

typedef float f32x2 __attribute__((ext_vector_type(2)));
constexpr size_t O_U8 = O_UB, O_V8 = O_UB + 32 * MB, O_RSU = O_VB, O_RSV = O_VB + 64 * 1024;
__device__ void conv_fp8_rows(const float* __restrict__ src, unsigned char* __restrict__ dst, float* __restrict__ rscale,
                              int gw, int nw) {
  const int lane = tidx() & 63;
  for (int row = gw; row < 16384; row += nw) {
    const float* r = src + (size_t)row * D_;
    float4 v[8];
#pragma unroll
    for (int q = 0; q < 8; ++q) v[q] = *(const float4*)(r + q * 256 + lane * 4);
    float am = 0.f;
#pragma unroll
    for (int q = 0; q < 8; ++q) am = fmaxf(am, fmaxf(fmaxf(fabsf(v[q].x), fabsf(v[q].y)), fmaxf(fabsf(v[q].z), fabsf(v[q].w))));
#pragma unroll
    for (int o = 32; o >= 1; o >>= 1) am = fmaxf(am, __shfl_xor(am, o));
    const float sc = am > 0.f ? 416.f / am : 1.f;
#pragma unroll
    for (int q = 0; q < 8; ++q) {
      int w = 0;
      w = __builtin_amdgcn_cvt_pk_fp8_f32(v[q].x * sc, v[q].y * sc, w, false);
      w = __builtin_amdgcn_cvt_pk_fp8_f32(v[q].z * sc, v[q].w * sc, w, true);
      *(int*)(dst + (size_t)row * D_ + q * 256 + lane * 4) = w;
    }
    if (lane == 0) rscale[row] = am > 0.f ? am / 416.f : 1.f;
  }
}

__device__ void ln_rows(const float* __restrict__ src, const float* __restrict__ g, const float* __restrict__ b,
                        u16* __restrict__ dst, int gw, int nw) {
  const int lane = tidx() & 63;
  for (int row = gw; row < T_; row += nw) {
    const float* r = src + (size_t)row * D_;
    float4 v[8];
#pragma unroll
    for (int q = 0; q < 8; ++q) v[q] = *(const float4*)(r + q * 256 + lane * 4);
    float s = 0.f;
#pragma unroll
    for (int q = 0; q < 8; ++q) s += v[q].x + v[q].y + v[q].z + v[q].w;
    float mu = wave_sum(s) * (1.f / D_);
    float ss = 0.f;
#pragma unroll
    for (int q = 0; q < 8; ++q) {
      float a = v[q].x - mu, bb = v[q].y - mu, c = v[q].z - mu, d = v[q].w - mu;
      ss += a * a + bb * bb + c * c + d * d;
    }
    float rstd = rsqrtf(wave_sum(ss) * (1.f / D_) + 1e-5f);
#pragma unroll
    for (int q = 0; q < 8; ++q) {
      int col = q * 256 + lane * 4;
      float4 gg = *(const float4*)(g + col), bb = *(const float4*)(b + col);
      store_bf4(dst + (size_t)row * D_ + col, (v[q].x - mu) * rstd * gg.x + bb.x, (v[q].y - mu) * rstd * gg.y + bb.y,
                (v[q].z - mu) * rstd * gg.z + bb.z, (v[q].w - mu) * rstd * gg.w + bb.w);
    }
  }
}

__device__ void ln_rows_bf16(const u16* __restrict__ src, const float* __restrict__ g, const float* __restrict__ b,
                             u16* __restrict__ dst, int gw, int nw) {
  const int lane = tidx() & 63;
  for (int row = gw; row < T_; row += nw) {
    const u16* r = src + (size_t)row * D_;
    float v[32];
#pragma unroll
    for (int q = 0; q < 4; ++q) {
      const uint4 u = *(const uint4*)(r + q * 512 + lane * 8);
      v[q * 8 + 0] = lo2f(u.x); v[q * 8 + 1] = hi2f(u.x); v[q * 8 + 2] = lo2f(u.y); v[q * 8 + 3] = hi2f(u.y);
      v[q * 8 + 4] = lo2f(u.z); v[q * 8 + 5] = hi2f(u.z); v[q * 8 + 6] = lo2f(u.w); v[q * 8 + 7] = hi2f(u.w);
    }
    float s_ = 0.f;
#pragma unroll
    for (int k = 0; k < 32; ++k) s_ += v[k];
    const float mu = wave_sum(s_) * (1.f / D_);
    float ss = 0.f;
#pragma unroll
    for (int k = 0; k < 32; ++k) { const float d = v[k] - mu; ss += d * d; }
    const float rstd = rsqrtf(wave_sum(ss) * (1.f / D_) + 1e-5f);
#pragma unroll
    for (int q = 0; q < 4; ++q) {
      const int col = q * 512 + lane * 8;
      const float4 g0 = *(const float4*)(g + col), g1 = *(const float4*)(g + col + 4);
      const float4 b0 = *(const float4*)(b + col), b1 = *(const float4*)(b + col + 4);
      uint4 o;
      o.x = pack2((v[q * 8 + 0] - mu) * rstd * g0.x + b0.x, (v[q * 8 + 1] - mu) * rstd * g0.y + b0.y);
      o.y = pack2((v[q * 8 + 2] - mu) * rstd * g0.z + b0.z, (v[q * 8 + 3] - mu) * rstd * g0.w + b0.w);
      o.z = pack2((v[q * 8 + 4] - mu) * rstd * g1.x + b1.x, (v[q * 8 + 5] - mu) * rstd * g1.y + b1.y);
      o.w = pack2((v[q * 8 + 6] - mu) * rstd * g1.z + b1.z, (v[q * 8 + 7] - mu) * rstd * g1.w + b1.w);
      *(uint4*)(dst + (size_t)row * D_ + col) = o;
    }
  }
}

__device__ __forceinline__ void dsincos(double x, double& s, double& c) {
  double q = rint(x * 0.63661977236758134308);
  double r = x - q * 1.57079632679489661923;
  double r2 = r * r;
  double sp = r * (1.0 + r2 * (-1.0 / 6 + r2 * (1.0 / 120 + r2 * (-1.0 / 5040 + r2 * (1.0 / 362880 + r2 * (-1.0 / 39916800 + r2 * (1.0 / 6227020800.0)))))));
  double cp = 1.0 + r2 * (-0.5 + r2 * (1.0 / 24 + r2 * (-1.0 / 720 + r2 * (1.0 / 40320 + r2 * (-1.0 / 3628800 + r2 * (1.0 / 479001600.0 + r2 * (-1.0 / 87178291200.0)))))));
  int qi = ((int)q) & 3;
  if (qi == 0) { s = sp; c = cp; }
  else if (qi == 1) { s = cp; c = -sp; }
  else if (qi == 2) { s = -sp; c = -cp; }
  else { s = -cp; c = sp; }
}

__device__ void ssm_consts(const Params& P, int i) {
  const int g = i >> 6, p = i & 63;
  double lr = P.lam_re[g * 64 + p], li = P.lam_im[g * 64 + p];
  double dt = exp((double)P.log_dt[g]);
  double mag = exp(lr * dt);
  double sn, cs;
  dsincos(li * dt, sn, cs);
  double ar = mag * cs, ai = mag * sn;
  double nr = ar - 1.0, ni = ai, den = lr * lr + li * li;
  double fr = (nr * lr + ni * li) / den, fi = (ni * lr - nr * li) / den;
  u16* bcat = (u16*)(P.ws + O_BCAT);
  u16* ccat = (u16*)(P.ws + O_CCAT);
  float* lam = (float*)(P.ws + O_LAM);
  for (int h = 0; h < 16; ++h) {
    double br = P.b_re[(g * 64 + p) * 16 + h], bi = P.b_im[(g * 64 + p) * 16 + h];
    bcat[(g * 128 + p) * 32 + h] = f2bf((float)(fr * br - fi * bi));
    bcat[(g * 128 + 64 + p) * 32 + h] = f2bf((float)(fr * bi + fi * br));
    bcat[(g * 128 + p) * 32 + 16 + h] = 0;
    bcat[(g * 128 + 64 + p) * 32 + 16 + h] = 0;
    ccat[(g * 16 + h) * 128 + p] = f2bf(P.c_re[(g * 16 + h) * 64 + p]);
    ccat[(g * 16 + h) * 128 + 64 + p] = f2bf(-P.c_im[(g * 16 + h) * 64 + p]);
  }
  double pr = ar, pi = ai;
  for (int k = 0; k < 10; ++k) {
    double t = pr * pr - pi * pi;
    pi = 2.0 * pr * pi;
    pr = t;
  }
  lam[0 * 4096 + i] = (float)ar;
  lam[1 * 4096 + i] = (float)ai;
  lam[2 * 4096 + i] = (float)pr;
  lam[3 * 4096 + i] = (float)pi;
}

__device__ void phase0(const Params& P, int bid, int nb, u16* lds) {
  const size_t gtid = (size_t)bid * 256 + tidx(), nth = (size_t)nb * 256;
#define TCONV(wp, KK, NN, OFF) \
  for (int t = bid; t < ((KK) >> 6) * ((NN) >> 6); t += nb) tconv_tile(wp, KK, NN, (u16*)(P.ws + OFF), t, (float*)lds);
  TCONV(P.w_in, 2048, 8192, O_WIN)
  TCONV(P.w_glu, 1024, 1024, O_WGLU)
  TCONV(P.w_au, 1024, 2048, O_WAU)
  TCONV(P.w_su, 1024, 2048, O_WSU)
  TCONV(P.w_out, 2048, 2048, O_WOUT)
  TCONV(P.w_pq, 2048, 2048, O_WPQ)
  TCONV(P.ple_w_gate, 2048, 2048, O_WPG)
  TCONV(P.ple_w_in, 256, 2048, O_WPIN)
  conv_fp8_rows(P.peer_u, (unsigned char*)(P.ws + O_U8), (float*)(P.ws + O_RSU), bid * 4 + (tidx() >> 6), nb * 4);
  conv_fp8_rows(P.peer_v, (unsigned char*)(P.ws + O_V8), (float*)(P.ws + O_RSV), bid * 4 + (tidx() >> 6), nb * 4);
  conv_linear(P.sub_keys, (u16*)(P.ws + O_SK), (size_t)16 * 128 * 128 / 8, gtid, nth);
  conv_linear(P.p, (u16*)(P.ws + O_PB), (size_t)T_ * 256 / 8, gtid, nth);
  for (size_t i = gtid; i < 4096; i += nth) ssm_consts(P, (int)i);
  ln_rows(P.x, P.ln_in_g, P.ln_in_b, (u16*)(P.ws + O_H), bid * 4 + (tidx() >> 6), nb * 4);
}

__device__ void phase1(const Params& P, int bid, int nb, u16* lds) {
  const u16* H = (const u16*)(P.ws + O_H);
  const u16* W = (const u16*)(P.ws + O_WIN);
  u16* Q = (u16*)(P.ws + O_Q);
  u16* Kb = (u16*)(P.ws + O_K);
  u16* Vt = (u16*)(P.ws + O_VT);
  u16* U2 = (u16*)(P.ws + O_U2);
  u16* G = (u16*)(P.ws + O_G);
  EPI_COORDS3
  const int ntiles = 128 * 32;
  for (int t = bid; t < ntiles; t += nb) {
    const int mt = t >> 5, nt = t & 31;
    f32x4 acc[4][8];
    ZERO_ACC8(acc)
    gemm_kloop3(acc, H + (size_t)mt * 256 * D_, D_, W + (size_t)nt * 256 * D_, D_, D_, lds);
    const int region = (nt * 256 + wn * 128) >> 10;
#pragma unroll
    for (int mi = 0; mi < 4; ++mi) {
      const int m = mt * 256 + wm * 64 + mi * 16 + lr;
#pragma unroll
      for (int ni = 0; ni < 8; ++ni) {
        const int n = nt * 256 + wn * 128 + ni * 16 + lq * 4;
        f32x4 a = acc[mi][ni];
        if (region == 0) {
          const float sc = 0.08838834764831845f;
          store_bf4(Q + (size_t)m * 1024 + n, a[0] * sc, a[1] * sc, a[2] * sc, a[3] * sc);
        } else if (region == 1) {
          store_bf4(Kb + (size_t)m * 1024 + (n - 1024), a[0], a[1], a[2], a[3]);
        } else if (region == 2) {
          const int b = m >> 14, tt = m & (S_ - 1);
#pragma unroll
          for (int j = 0; j < 4; ++j) Vt[((size_t)(b * 1024 + (n - 2048 + j))) * S_ + tt] = f2bf(a[j]);
        } else if (region == 3) {
          store_bf4(U2 + (size_t)m * 1024 + (n - 3072), a[0], a[1], a[2], a[3]);
        } else {
          store_bf4(G + (size_t)m * 4096 + (n - 4096), sigmoidf_(a[0]), sigmoidf_(a[1]), sigmoidf_(a[2]), sigmoidf_(a[3]));
        }
      }
    }
  }
}

__device__ void attn_item(const Params& P, int item, u16* lds) {
  const int c = item >> 4, hd = item & 7, b = (item >> 3) & 1;
  const int tid = tidx(), lane = tid & 63, w = tid >> 6, lr = lane & 15, lq = lane >> 4;
  u16* Ks = lds;
  u16* Vs = lds + 64 * 136;
  float* bs = (float*)(lds + 64 * 136 + 128 * 72);
  const u16* Q = (const u16*)(P.ws + O_Q);
  const u16* Kb = (const u16*)(P.ws + O_K);
  const u16* Vt = (const u16*)(P.ws + O_VT);
  u16* ya = (u16*)(P.ws + O_YA);
  __syncthreads();
  for (int i = tid; i < 257; i += 256) bs[i] = P.rel_bias[hd * 257 + i];
  bf16x8 qf[4];
  {
    const u16* qp = Q + (size_t)(b * S_ + c * 64 + w * 16 + lr) * 1024 + hd * 128 + lq * 8;
#pragma unroll
    for (int ks = 0; ks < 4; ++ks) qf[ks] = *(const bf16x8*)(qp + ks * 32);
  }
  f32x4 oacc[8];
#pragma unroll
  for (int d = 0; d < 8; ++d) oacc[d] = f32x4{0.f, 0.f, 0.f, 0.f};
  float m_run = -1e30f, lsum = 0.f;
  const int i0 = (c < 8) ? (8 - c) : 0;
  const int qi = w * 16 + lr;
#define KV_ADDR_K(r, kc_) (Kb + (size_t)(b * S_ + (kc_) * 64 + ((tid + 256 * (r)) >> 4)) * 1024 + hd * 128 + ((tid + 256 * (r)) & 15) * 8)
#define KV_ADDR_V(r, kc_) (Vt + ((size_t)(b * 1024 + hd * 128 + ((tid + 256 * (r)) >> 3))) * S_ + (kc_) * 64 + ((tid + 256 * (r)) & 7) * 8)
#define KV_LOAD(kc_)                                                                   \
  kr0 = *(const uint4*)KV_ADDR_K(0, kc_); kr1 = *(const uint4*)KV_ADDR_K(1, kc_);     \
  kr2 = *(const uint4*)KV_ADDR_K(2, kc_); kr3 = *(const uint4*)KV_ADDR_K(3, kc_);     \
  vr0 = *(const uint4*)KV_ADDR_V(0, kc_); vr1 = *(const uint4*)KV_ADDR_V(1, kc_);     \
  vr2 = *(const uint4*)KV_ADDR_V(2, kc_); vr3 = *(const uint4*)KV_ADDR_V(3, kc_);
#define KS_W(r) (Ks + ((tid + 256 * (r)) >> 4) * 136 + ((tid + 256 * (r)) & 15) * 8)
#define VS_W(r) (Vs + ((tid + 256 * (r)) >> 3) * 72 + ((tid + 256 * (r)) & 7) * 8)
#define KV_LOADS(S, kc_)                                                                \
  S##k0 = *(const uint4*)KV_ADDR_K(0, kc_); S##k1 = *(const uint4*)KV_ADDR_K(1, kc_);   \
  S##k2 = *(const uint4*)KV_ADDR_K(2, kc_); S##k3 = *(const uint4*)KV_ADDR_K(3, kc_);   \
  S##v0 = *(const uint4*)KV_ADDR_V(0, kc_); S##v1 = *(const uint4*)KV_ADDR_V(1, kc_);   \
  S##v2 = *(const uint4*)KV_ADDR_V(2, kc_); S##v3 = *(const uint4*)KV_ADDR_V(3, kc_);
#define KV_WRITES(S)                                                                                   \
  *(uint4*)KS_W(0) = S##k0; *(uint4*)KS_W(1) = S##k1; *(uint4*)KS_W(2) = S##k2; *(uint4*)KS_W(3) = S##k3; \
  *(uint4*)VS_W(0) = S##v0; *(uint4*)VS_W(1) = S##v1; *(uint4*)VS_W(2) = S##v2; *(uint4*)VS_W(3) = S##v3;
  uint4 Ak0, Ak1, Ak2, Ak3, Av0, Av1, Av2, Av3, Bk0, Bk1, Bk2, Bk3, Bv0, Bv1, Bv2, Bv3;
  auto tile_compute = [&](const int i) {
    f32x4 sacc[4];
#pragma unroll
    for (int kt = 0; kt < 4; ++kt) {
      sacc[kt] = f32x4{0.f, 0.f, 0.f, 0.f};
#pragma unroll
      for (int ks = 0; ks < 4; ++ks) {
        bf16x8 kf = *(const bf16x8*)(Ks + (kt * 16 + lr) * 136 + ks * 32 + lq * 8);
        sacc[kt] = __builtin_amdgcn_mfma_f32_16x16x32_bf16(kf, qf[ks], sacc[kt], 0, 0, 0);
      }
    }
    float tmax = -1e30f;
#pragma unroll
    for (int kt = 0; kt < 4; ++kt)
#pragma unroll
      for (int j = 0; j < 4; ++j) {
        int kb = i * 64 + kt * 16 + lq * 4 + j;
        int rel = 512 + qi - kb;
        rel = min(max(rel, -128), 128) + 128;
        float s = sacc[kt][j] + bs[rel];
        sacc[kt][j] = s;
        tmax = fmaxf(tmax, s);
      }
    tmax = fmaxf(tmax, __shfl_xor(tmax, 16));
    tmax = fmaxf(tmax, __shfl_xor(tmax, 32));
    const float m_new = fmaxf(m_run, tmax);
    const float corr = __expf(m_run - m_new);
    m_run = m_new;
    float ps = 0.f;
#pragma unroll
    for (int kt = 0; kt < 4; ++kt)
#pragma unroll
      for (int j = 0; j < 4; ++j) {
        float pv = __expf(sacc[kt][j] - m_new);
        sacc[kt][j] = pv;
        ps += pv;
      }
    lsum = lsum * corr + ps;
#pragma unroll
    for (int d = 0; d < 8; ++d) {
      oacc[d][0] *= corr; oacc[d][1] *= corr; oacc[d][2] *= corr; oacc[d][3] *= corr;
    }
#pragma unroll
    for (int kk = 0; kk < 2; ++kk) {
      union { bf16x8 v; unsigned u[4]; } pf;
      pf.u[0] = pack2(sacc[2 * kk][0], sacc[2 * kk][1]);
      pf.u[1] = pack2(sacc[2 * kk][2], sacc[2 * kk][3]);
      pf.u[2] = pack2(sacc[2 * kk + 1][0], sacc[2 * kk + 1][1]);
      pf.u[3] = pack2(sacc[2 * kk + 1][2], sacc[2 * kk + 1][3]);
#pragma unroll
      for (int d = 0; d < 8; ++d) {
        union { bf16x8 v; uint2 h[2]; } vf;
        vf.h[0] = *(const uint2*)(Vs + (d * 16 + lr) * 72 + kk * 32 + lq * 4);
        vf.h[1] = *(const uint2*)(Vs + (d * 16 + lr) * 72 + kk * 32 + 16 + lq * 4);
        oacc[d] = __builtin_amdgcn_mfma_f32_16x16x32_bf16(vf.v, pf.v, oacc[d], 0, 0, 0);
      }
    }
  };
  KV_LOADS(A, c - 8 + i0)
  if (i0 + 1 <= 8) { KV_LOADS(B, c - 8 + i0 + 1) }
  for (int i = i0; i <= 8; i += 2) {
    __syncthreads();
    KV_WRITES(A)
    __syncthreads();
    if (i + 2 <= 8) { KV_LOADS(A, c - 8 + i + 2) }
    tile_compute(i);
    if (i + 1 > 8) break;
    __syncthreads();
    KV_WRITES(B)
    __syncthreads();
    if (i + 3 <= 8) { KV_LOADS(B, c - 8 + i + 3) }
    tile_compute(i + 1);
  }
  lsum += __shfl_xor(lsum, 16);
  lsum += __shfl_xor(lsum, 32);
  const float inv = 1.f / lsum;
  u16* op = ya + (size_t)(b * S_ + c * 64 + w * 16 + lr) * 1024 + hd * 128 + lq * 4;
#pragma unroll
  for (int d = 0; d < 8; ++d) store_bf4(op + d * 16, oacc[d][0] * inv, oacc[d][1] * inv, oacc[d][2] * inv, oacc[d][3] * inv);
}

template <int PASS>
__device__ void ssm_item(const Params& P, int item, char* ldsw) {
  const int sc = item & 15, seq = item >> 4, g = seq & 63, b = seq >> 6;
  const int lane = tidx() & 63, lr = lane & 15, lq = lane >> 4;
  float* BuS = (float*)ldsw;
  u16* Hs = (u16*)(ldsw + 8448);
  const u16* bcat = (const u16*)(P.ws + O_BCAT);
  const u16* ccat = (const u16*)(P.ws + O_CCAT);
  const float* lam = (const float*)(P.ws + O_LAM);
  const u16* U2 = (const u16*)(P.ws + O_U2);
  float* Sbuf = (float*)(P.ws + O_SBUF);
  u16* ys = (u16*)(P.ws + O_YS);
  const float ar = lam[g * 64 + lane], ai = lam[4096 + g * 64 + lane];
  bf16x8 bfrag[8];
#pragma unroll
  for (int nt = 0; nt < 8; ++nt) bfrag[nt] = *(const bf16x8*)(bcat + (g * 128 + nt * 16 + lr) * 32 + lq * 8);
  float sr = 0.f, si = 0.f;
  bf16x8 cfrag[4];
  float dsk[4];
  if (PASS == 2) {
#pragma unroll
    for (int ks = 0; ks < 4; ++ks) cfrag[ks] = *(const bf16x8*)(ccat + (g * 16 + lr) * 128 + ks * 32 + lq * 8);
#pragma unroll
    for (int j = 0; j < 4; ++j) dsk[j] = P.ssm_d[g * 16 + lq * 4 + j];
    const float aLr = lam[2 * 4096 + g * 64 + lane], aLi = lam[3 * 4096 + g * 64 + lane];
    const float* Sb = Sbuf + (size_t)seq * 16 * 128;
#pragma unroll 4
    for (int cc = 0; cc < sc; ++cc) {
      float xr = Sb[cc * 128 + lane], xi = Sb[cc * 128 + 64 + lane];
      float nr = fmaf(aLr, sr, fmaf(-aLi, si, xr));
      float ni = fmaf(aLr, si, fmaf(aLi, sr, xi));
      sr = nr; si = ni;
    }
  }
#pragma unroll 1
  for (int ci = 0; ci < 8; ++ci) {
  const size_t tok_base = (size_t)b * S_ + (size_t)(sc * 8 + ci) * SSM_L;
  uint4 upre[SSM_L / 16];
  uint2 uepi[SSM_L / 16];
#pragma unroll
  for (int sub = 0; sub < SSM_L / 16; ++sub) {
    upre[sub] = uint4{0u, 0u, 0u, 0u};
    if (lq < 2) upre[sub] = *(const uint4*)(U2 + (tok_base + sub * 16 + lr) * 1024 + g * 16 + lq * 8);
    if (PASS == 2) uepi[sub] = *(const uint2*)(U2 + (tok_base + sub * 16 + lr) * 1024 + g * 16 + lq * 4);
  }
#pragma unroll
  for (int sub = 0; sub < SSM_L / 16; ++sub) {
    const size_t tok0 = tok_base + sub * 16;
    union { bf16x8 v; uint4 u; } uf;
    uf.u = upre[sub];
#pragma unroll
    for (int nt = 0; nt < 8; ++nt) {
      f32x4 d = __builtin_amdgcn_mfma_f32_16x16x32_bf16(bfrag[nt], uf.v, f32x4{0.f, 0.f, 0.f, 0.f}, 0, 0, 0);
      *(f32x4*)(BuS + lr * 132 + nt * 16 + lq * 4) = d;
    }
    asm volatile("s_waitcnt lgkmcnt(0)" ::: "memory");
    float bur[16], bui[16];
#pragma unroll
    for (int t = 0; t < 16; ++t) { bur[t] = BuS[t * 132 + lane]; bui[t] = BuS[t * 132 + 64 + lane]; }
    asm volatile("s_waitcnt lgkmcnt(0)" ::: "memory");
#pragma unroll
    for (int t = 0; t < 16; ++t) {
      float nr = fmaf(ar, sr, fmaf(-ai, si, bur[t]));
      float ni = fmaf(ar, si, fmaf(ai, sr, bui[t]));
      sr = nr; si = ni;
      if (PASS == 2) {
        const unsigned pk = pack2(sr, si);
        Hs[t * 136 + lane] = (u16)(pk & 0xffffu);
        Hs[t * 136 + 64 + lane] = (u16)(pk >> 16);
      }
    }
    asm volatile("s_waitcnt lgkmcnt(0)" ::: "memory");
    if (PASS == 2) {
      f32x4 yacc = f32x4{0.f, 0.f, 0.f, 0.f};
#pragma unroll
      for (int ks = 0; ks < 4; ++ks) {
        bf16x8 hf = *(const bf16x8*)(Hs + lr * 136 + ks * 32 + lq * 8);
        yacc = __builtin_amdgcn_mfma_f32_16x16x32_bf16(cfrag[ks], hf, yacc, 0, 0, 0);
      }
      const uint2 uu = uepi[sub];
      float y0 = gelu_tanh(yacc[0] + dsk[0] * lo2f(uu.x));
      float y1 = gelu_tanh(yacc[1] + dsk[1] * hi2f(uu.x));
      float y2 = gelu_tanh(yacc[2] + dsk[2] * lo2f(uu.y));
      float y3 = gelu_tanh(yacc[3] + dsk[3] * hi2f(uu.y));
      store_bf4(ys + (tok0 + lr) * 1024 + g * 16 + lq * 4, y0, y1, y2, y3);
      asm volatile("s_waitcnt lgkmcnt(0)" ::: "memory");
    }
  }
  }
  if (PASS == 1) {
    Sbuf[((size_t)seq * 16 + sc) * 128 + lane] = sr;
    Sbuf[((size_t)seq * 16 + sc) * 128 + 64 + lane] = si;
  }
}

__device__ void phase2(const Params& P, int bid, int nb, u16* lds) {
  for (int it = bid; it < 4096 + 512; it += nb) {
    if (it < 4096) {
      attn_item(P, it, lds);
    } else {
      __syncthreads();
      const int w = tidx() >> 6;
      ssm_item<1>(P, (it - 4096) * 4 + w, (char*)lds + w * 12800);
    }
  }
}
__device__ void phase3(const Params& P, int bid, int nb, u16* lds) {
  const int w = tidx() >> 6;
  for (int it = bid; it < 512; it += nb) ssm_item<2>(P, it * 4 + w, (char*)lds + w * 12800);
}

__device__ void phase4(const Params& P, int bid, int nb, u16* lds) {
  const u16* ys = (const u16*)(P.ws + O_YS);
  const u16* W = (const u16*)(P.ws + O_WGLU);
  u16* yg = (u16*)(P.ws + O_YG);
  EPI_COORDS3
  FOR_TILES_XCD(t, 128 * 4) {
    const int mt = t >> 2, nt = t & 3;
    f32x4 acc[4][8];
    ZERO_ACC8(acc)
    gemm_kloop3(acc, ys + (size_t)mt * 256 * 1024, 1024, W + (size_t)nt * 256 * 1024, 1024, 1024, lds);
#pragma unroll
    for (int mi = 0; mi < 4; ++mi) {
      const int m = mt * 256 + wm * 64 + mi * 16 + lr;
#pragma unroll
      for (int ni = 0; ni < 8; ++ni) {
        const int n = nt * 256 + wn * 128 + ni * 16 + lq * 4;
        uint2 yy = *(const uint2*)(ys + (size_t)m * 1024 + n);
        f32x4 a = acc[mi][ni];
        store_bf4(yg + (size_t)m * 1024 + n, lo2f(yy.x) * sigmoidf_(a[0]), hi2f(yy.x) * sigmoidf_(a[1]),
                  lo2f(yy.y) * sigmoidf_(a[2]), hi2f(yy.y) * sigmoidf_(a[3]));
      }
    }
  }
}

__device__ void phase5(const Params& P, int bid, int nb, u16* lds) {
  const u16* ya = (const u16*)(P.ws + O_YA);
  const u16* yg = (const u16*)(P.ws + O_YG);
  const u16* Wa = (const u16*)(P.ws + O_WAU);
  const u16* Wsu = (const u16*)(P.ws + O_WSU);
  const u16* G = (const u16*)(P.ws + O_G);
  u16* mg = (u16*)(P.ws + O_MERGED);
  EPI_COORDS3
  FOR_TILES_XCD(t, 128 * 8) {
    const int mt = t >> 3, nt = t & 7;
#pragma unroll 1
    for (int part = 0; part < 2; ++part) {
      f32x4 acc[4][8];
      ZERO_ACC8(acc)
      gemm_kloop3(acc, (part ? yg : ya) + (size_t)mt * 256 * 1024, 1024, (part ? Wsu : Wa) + (size_t)nt * 256 * 1024, 1024,
                  1024, lds);
      const u16* Gp = G + part * 2048;
#pragma unroll
      for (int mi = 0; mi < 4; ++mi) {
        const int m = mt * 256 + wm * 64 + mi * 16 + lr;
#pragma unroll
        for (int ni = 0; ni < 8; ++ni) {
          const int n = nt * 256 + wn * 128 + ni * 16 + lq * 4;
          const uint2 gg = *(const uint2*)(Gp + (size_t)m * 4096 + n);
          f32x4 a = acc[mi][ni];
          float o0 = a[0] * lo2f(gg.x), o1 = a[1] * hi2f(gg.x), o2 = a[2] * lo2f(gg.y), o3 = a[3] * hi2f(gg.y);
          if (part) {
            const uint2 pv = *(const uint2*)(mg + (size_t)m * D_ + n);
            o0 += lo2f(pv.x); o1 += hi2f(pv.x); o2 += lo2f(pv.y); o3 += hi2f(pv.y);
          }
          store_bf4(mg + (size_t)m * D_ + n, o0, o1, o2, o3);
        }
      }
    }
  }
}

__device__ void phase6(const Params& P, int bid, int nb, u16* lds) {
  const u16* mg = (const u16*)(P.ws + O_MERGED);
  const u16* W = (const u16*)(P.ws + O_WOUT);
  const u16* H = (const u16*)(P.ws + O_H);
  u16* pre1 = (u16*)(P.ws + O_PRE1);
  EPI_COORDS3
  FOR_TILES_XCD(t, 128 * 8) {
    const int mt = t >> 3, nt = t & 7;
    f32x4 acc[4][8];
    ZERO_ACC8(acc)
    gemm_kloop3(acc, mg + (size_t)mt * 256 * D_, D_, W + (size_t)nt * 256 * D_, D_, D_, lds);
#pragma unroll
    for (int mi = 0; mi < 4; ++mi) {
      const int m = mt * 256 + wm * 64 + mi * 16 + lr;
#pragma unroll
      for (int ni = 0; ni < 8; ++ni) {
        const int n = nt * 256 + wn * 128 + ni * 16 + lq * 4;
        uint2 hh = *(const uint2*)(H + (size_t)m * D_ + n);
        f32x4 a = acc[mi][ni];
        store_bf4(pre1 + (size_t)m * D_ + n, ALPHA * lo2f(hh.x) + a[0], ALPHA * hi2f(hh.x) + a[1],
                  ALPHA * lo2f(hh.y) + a[2], ALPHA * hi2f(hh.y) + a[3]);
      }
    }
  }
}

__device__ void phase8(const Params& P, int bid, int nb, u16* lds) {
  const u16* H = (const u16*)(P.ws + O_H);
  const u16* Pb = (const u16*)(P.ws + O_PB);
  u16* PQ = (u16*)(P.ws + O_PQ);
  u16* SG = (u16*)(P.ws + O_SG);
  u16* E = (u16*)(P.ws + O_E);
  EPI_COORDS3
  FOR_TILES_XCD(t, 3 * 1024) {
    const int which = t >> 10, tt = t & 1023, mt = tt >> 3, nt = tt & 7;
    f32x4 acc[4][8];
    ZERO_ACC8(acc)
    u16* dst;
    if (which == 0) {
      gemm_kloop3(acc, H + (size_t)mt * 256 * D_, D_, (const u16*)(P.ws + O_WPQ) + (size_t)nt * 256 * D_, D_, D_, lds);
      dst = PQ;
    } else if (which == 1) {
      gemm_kloop3(acc, H + (size_t)mt * 256 * D_, D_, (const u16*)(P.ws + O_WPG) + (size_t)nt * 256 * D_, D_, D_, lds);
      dst = SG;
    } else {
      gemm_kloop3(acc, Pb + (size_t)mt * 256 * 256, 256, (const u16*)(P.ws + O_WPIN) + (size_t)nt * 256 * 256, 256, 256, lds);
      dst = E;
    }
#pragma unroll
    for (int mi = 0; mi < 4; ++mi) {
      const int m = mt * 256 + wm * 64 + mi * 16 + lr;
#pragma unroll
      for (int ni = 0; ni < 8; ++ni) {
        const int n = nt * 256 + wn * 128 + ni * 16 + lq * 4;
        f32x4 a = acc[mi][ni];
        if (which == 1) { a[0] = sigmoidf_(a[0]); a[1] = sigmoidf_(a[1]); a[2] = sigmoidf_(a[2]); a[3] = sigmoidf_(a[3]); }
        store_bf4(dst + (size_t)m * D_ + n, a[0], a[1], a[2], a[3]);
      }
    }
  }
}

struct Top16 { float v[16]; int i[16]; };
__device__ __forceinline__ void top_init(Top16& t) {
#pragma unroll
  for (int k = 0; k < 16; ++k) { t.v[k] = -INFINITY; t.i[k] = 0; }
}
__device__ __forceinline__ void top_insert(Top16& t, float x, int id) {
  const bool c = x > t.v[15];
  t.v[15] = c ? x : t.v[15];
  t.i[15] = c ? id : t.i[15];
#pragma unroll
  for (int k = 15; k >= 1; --k) {
    const bool s = t.v[k] > t.v[k - 1];
    const float a = t.v[k - 1], b = t.v[k];
    const int ia = t.i[k - 1], ib = t.i[k];
    t.v[k - 1] = s ? b : a; t.v[k] = s ? a : b;
    t.i[k - 1] = s ? ib : ia; t.i[k] = s ? ia : ib;
  }
}

__device__ void phase9(const Params& P, int bid, int nb, u16* lds) {
  const u16* PQ = (const u16*)(P.ws + O_PQ);
  const u16* SK = (const u16*)(P.ws + O_SK);
  float* HV = (float*)(P.ws + O_HV);
  int* HI = (int*)(P.ws + O_HI);
  float* Sc = (float*)lds;
  EPI_COORDS
  const int tid = tidx();
  for (int t = bid; t < 256 * 16; t += nb) {
    const int mt = t >> 4, rc = t & 15;
    f32x4 acc[4][4];
    ZERO_ACC(acc)
    gemm_kloop(acc, PQ + (size_t)mt * 128 * D_ + rc * 128, D_, SK + (size_t)rc * 128 * 128, 128, 128, lds);
#pragma unroll
    for (int mi = 0; mi < 4; ++mi) {
      const int m = wm * 64 + mi * 16 + lr;
#pragma unroll
      for (int ni = 0; ni < 4; ++ni) {
        const int n = wn * 64 + ni * 16 + lq * 4;
#pragma unroll
        for (int j = 0; j < 4; ++j) Sc[m * 129 + n + j] = acc[mi][ni][j];
      }
    }
    __syncthreads();
    const int tok = tid & 127, hh = tid >> 7;
    float key[16];
#pragma unroll
    for (int j = 0; j < 16; ++j) key[j] = -INFINITY;
    {
      const float* sp = Sc + tok * 129 + hh * 64;
#pragma unroll 4
      for (int k = 0; k < 64; ++k) {
        const float x = sp[k];
        const float kk = __uint_as_float((__float_as_uint(x) & ~127u) | (unsigned)(127 - (hh * 64 + k)));
#pragma unroll
        for (int j = 15; j >= 1; --j) key[j] = __builtin_amdgcn_fmed3f(key[j - 1], key[j], kk);
        key[0] = fmaxf(key[0], kk);
      }
    }
    __syncthreads();
    float* Lv = (float*)lds;
#pragma unroll
    for (int k = 0; k < 16; ++k) Lv[tid * 17 + k] = key[k];
    __syncthreads();
    if (tid < 128) {
      int ia = 0, ib = 0;
      const float* va = Lv + tid * 17; const float* vb = Lv + (tid + 128) * 17;
      float* ov = HV + ((size_t)(mt * 16 + rc) * 128 + tid) * 16;
      int* oi = HI + ((size_t)(mt * 16 + rc) * 128 + tid) * 16;
      for (int k = 0; k < 16; ++k) {
        const float a = va[ia], b = vb[ib];
        const bool ta = a >= b;
        const unsigned bits = __float_as_uint(ta ? a : b);
        ov[k] = __uint_as_float(bits & ~127u);
        oi[k] = 127 - (int)(bits & 127u);
        ia += ta ? 1 : 0; ib += ta ? 0 : 1;
      }
    }
    __syncthreads();
  }
}

__device__ void phase10(const Params& P, int bid, int nb, u16* lds) {
  int* Lx = (int*)lds + tidx() * 33;
  const float* HV = (const float*)(P.ws + O_HV);
  const int* HI = (const int*)(P.ws + O_HI);
  int* EX = (int*)(P.ws + O_EXP);
  float* GT = (float*)(P.ws + O_GATE);
  for (int i_ = bid * 256 + tidx(); i_ < T_ * 8; i_ += nb * 256) {
    const int r_ = (i_ >> 7) & 7, mt_ = i_ >> 10, tl_ = i_ & 127;
    const int i = (mt_ * 128 + tl_) * 8 + r_;
    const size_t h0 = ((size_t)(mt_ * 16 + r_ * 2) * 128 + tl_) * 16, h1 = h0 + 128 * 16;
    float v0[16], v1[16];
    int i0[16], i1[16];
#pragma unroll
    for (int q = 0; q < 4; ++q) {
      float4 a = *(const float4*)(HV + h0 + q * 4);
      float4 b = *(const float4*)(HV + h1 + q * 4);
      int4 c = *(const int4*)(HI + h0 + q * 4);
      int4 d = *(const int4*)(HI + h1 + q * 4);
      v0[q * 4] = a.x; v0[q * 4 + 1] = a.y; v0[q * 4 + 2] = a.z; v0[q * 4 + 3] = a.w;
      v1[q * 4] = b.x; v1[q * 4 + 1] = b.y; v1[q * 4 + 2] = b.z; v1[q * 4 + 3] = b.w;
      i0[q * 4] = c.x; i0[q * 4 + 1] = c.y; i0[q * 4 + 2] = c.z; i0[q * 4 + 3] = c.w;
      i1[q * 4] = d.x; i1[q * 4 + 1] = d.y; i1[q * 4 + 2] = d.z; i1[q * 4 + 3] = d.w;
    }
    float t[16];
#pragma unroll
    for (int j = 0; j < 16; ++j) t[j] = -INFINITY;
#pragma unroll
    for (int a = 0; a < 16; ++a)
#pragma unroll
      for (int b = 0; b < 16; ++b)
        if ((a + 1) * (b + 1) <= 16) {
          const float sv = v0[a] + v1[b];
#pragma unroll
          for (int j = 15; j >= 1; --j) t[j] = __builtin_amdgcn_fmed3f(t[j - 1], t[j], sv);
          t[0] = fmaxf(t[0], sv);
        }
    const float mx = t[0], thr = t[15];
    float sum = 0.f;
#pragma unroll
    for (int k = 0; k < 16; ++k) sum += __expf(t[k] - mx);
    const float inv = 1.f / sum;
    int cnt = 0;
#pragma unroll
    for (int a = 0; a < 16; ++a)
#pragma unroll
      for (int b = 0; b < 16; ++b)
        if ((a + 1) * (b + 1) <= 16) {
          const float sv = v0[a] + v1[b];
          if (sv >= thr && cnt < 16) {
            Lx[cnt] = i0[a] * 128 + i1[b];
            Lx[16 + cnt] = __float_as_int(__expf(sv - mx) * inv);
            ++cnt;
          }
        }
    asm volatile("s_waitcnt lgkmcnt(0)" ::: "memory");
#pragma unroll
    for (int q = 0; q < 4; ++q) {
      *(int4*)(EX + (size_t)i * 16 + q * 4) = int4{Lx[q * 4], Lx[q * 4 + 1], Lx[q * 4 + 2], Lx[q * 4 + 3]};
      *(float4*)(GT + (size_t)i * 16 + q * 4) =
          float4{__int_as_float(Lx[16 + q * 4]), __int_as_float(Lx[16 + q * 4 + 1]), __int_as_float(Lx[16 + q * 4 + 2]),
                 __int_as_float(Lx[16 + q * 4 + 3])};
    }
    asm volatile("s_waitcnt lgkmcnt(0)" ::: "memory");
  }
}

__device__ __forceinline__ void unpack8(uint4 u, float* f) {
  f[0] = lo2f(u.x); f[1] = hi2f(u.x); f[2] = lo2f(u.y); f[3] = hi2f(u.y);
  f[4] = lo2f(u.z); f[5] = hi2f(u.z); f[6] = lo2f(u.w); f[7] = hi2f(u.w);
}
__device__ __forceinline__ void dec16(uint4 u, float* f) {
  f32x2 a;
  a = __builtin_amdgcn_cvt_pk_f32_fp8((int)u.x, false); f[0] = a.x; f[1] = a.y;
  a = __builtin_amdgcn_cvt_pk_f32_fp8((int)u.x, true);  f[2] = a.x; f[3] = a.y;
  a = __builtin_amdgcn_cvt_pk_f32_fp8((int)u.y, false); f[4] = a.x; f[5] = a.y;
  a = __builtin_amdgcn_cvt_pk_f32_fp8((int)u.y, true);  f[6] = a.x; f[7] = a.y;
  a = __builtin_amdgcn_cvt_pk_f32_fp8((int)u.z, false); f[8] = a.x; f[9] = a.y;
  a = __builtin_amdgcn_cvt_pk_f32_fp8((int)u.z, true);  f[10] = a.x; f[11] = a.y;
  a = __builtin_amdgcn_cvt_pk_f32_fp8((int)u.w, false); f[12] = a.x; f[13] = a.y;
  a = __builtin_amdgcn_cvt_pk_f32_fp8((int)u.w, true);  f[14] = a.x; f[15] = a.y;
}
__device__ __forceinline__ void load_row_bf16(const u16* row, int lane, float* f) {
#pragma unroll
  for (int q = 0; q < 2; ++q) {
    uint4 a = *(const uint4*)(row + q * 1024 + lane * 16);
    uint4 b = *(const uint4*)(row + q * 1024 + lane * 16 + 8);
    unpack8(a, f + q * 16);
    unpack8(b, f + q * 16 + 8);
  }
}
__device__ __forceinline__ void pace_xcd(unsigned* ctr, unsigned& epoch, unsigned nloc) {
  epoch += nloc;
  __syncthreads();
  if (threadIdx.x == 0) {
    __hip_atomic_fetch_add(ctr, 1u, __ATOMIC_RELAXED, __HIP_MEMORY_SCOPE_AGENT);
    unsigned sp = 0;
    while (__hip_atomic_load(ctr, __ATOMIC_RELAXED, __HIP_MEMORY_SCOPE_AGENT) < epoch && ++sp < (1u << 16)) __builtin_amdgcn_s_sleep(2);
  }
  __syncthreads();
}
__device__ void phase11(const Params& P, int bid, int nb, unsigned xcc, unsigned nloc) {
  unsigned* pctr = (unsigned*)(P.ws + (1000 * MB + 1024) + xcc * 128);
  unsigned pep = 0;
  const bool do_pace = (T_ % (nb * 4)) == 0 && nloc > 0;
  const u16* H = (const u16*)(P.ws + O_H);
  const unsigned char* U8 = (const unsigned char*)(P.ws + O_U8);
  const unsigned char* V8 = (const unsigned char*)(P.ws + O_V8);
  const float* RSU = (const float*)(P.ws + O_RSU);
  const float* RSV = (const float*)(P.ws + O_RSV);
  const u16* SG = (const u16*)(P.ws + O_SG);
  const u16* E = (const u16*)(P.ws + O_E);
  const int* EX = (const int*)(P.ws + O_EXP);
  const float* GT = (const float*)(P.ws + O_GATE);
  const int lane = tidx() & 63;
  int sweep = 0;
  for (int tok = bid * 4 + (tidx() >> 6); tok < T_; tok += nb * 4, sweep ^= 1) {
    float hf[32], y[32];
    load_row_bf16(H + (size_t)tok * D_, lane, hf);
#pragma unroll
    for (int k = 0; k < 32; ++k) y[k] = 0.f;
    int ev0 = EX[(size_t)tok * 128 + lane], ev1 = EX[(size_t)tok * 128 + 64 + lane];
    float gv0 = GT[(size_t)tok * 128 + lane], gv1 = GT[(size_t)tok * 128 + 64 + lane];
    {
      int k0 = (ev0 << 7) | lane, k1 = (ev1 << 7) | (64 + lane);
#pragma unroll
      for (int kk = 2; kk <= 128; kk <<= 1) {
#pragma unroll
        for (int j = kk >> 1; j >= 1; j >>= 1) {
          if (j == 64) {
            const int lo_ = min(k0, k1), hi_ = max(k0, k1);
            k0 = lo_; k1 = hi_;
          } else {
            const int p0 = __shfl_xor(k0, j), p1 = __shfl_xor(k1, j);
            const bool lower = (lane & j) == 0;
            const bool up0 = (kk == 128) ? true : ((lane & kk) == 0);
            const bool up1 = (kk == 128) ? true : (kk == 64 ? false : ((lane & kk) == 0));
            k0 = (lower == up0) ? min(k0, p0) : max(k0, p0);
            k1 = (lower == up1) ? min(k1, p1) : max(k1, p1);
          }
        }
      }
      const int s0 = k0 & 127, s1 = k1 & 127;
      const float ga0 = __shfl(gv0, s0 & 63), gb0 = __shfl(gv1, s0 & 63);
      const float ga1 = __shfl(gv0, s1 & 63), gb1 = __shfl(gv1, s1 & 63);
      gv0 = (s0 < 64) ? ga0 : gb0;
      gv1 = (s1 < 64) ? ga1 : gb1;
      ev0 = k0 >> 7;
      ev1 = k1 >> 7;
    }
    const float ru0 = RSU[ev0], ru1 = RSU[ev1], rv0 = RSV[ev0], rv1 = RSV[ev1];
    for (int k4_ = 0; k4_ < 128; k4_ += 4) {
      if (do_pace && k4_ == 64) pace_xcd(pctr, pep, nloc);
      const int k4 = sweep ? (124 - k4_) : k4_;
      const int src = k4 & 63;
      const bool lo = k4 < 64;
      int ee[4]; float gg[4], su[4], sv[4];
#pragma unroll
      for (int x = 0; x < 4; ++x) {
        ee[x] = __shfl(lo ? ev0 : ev1, src + x);
        gg[x] = __shfl(lo ? gv0 : gv1, src + x);
        su[x] = __shfl(lo ? ru0 : ru1, src + x);
        sv[x] = __shfl(lo ? rv0 : rv1, src + x);
      }
      uint4 uu[4][2], vv[4][2];
#pragma unroll
      for (int x = 0; x < 4; ++x)
#pragma unroll
        for (int q = 0; q < 2; ++q) {
          uu[x][q] = *(const uint4*)(U8 + (size_t)ee[x] * D_ + q * 1024 + lane * 16);
          vv[x][q] = *(const uint4*)(V8 + (size_t)ee[x] * D_ + q * 1024 + lane * 16);
        }
      float dd[4];
#pragma unroll
      for (int x = 0; x < 4; ++x) {
        float d = 0.f;
#pragma unroll
        for (int q = 0; q < 2; ++q) {
          float f[16];
          dec16(uu[x][q], f);
#pragma unroll
          for (int j = 0; j < 16; ++j) d = fmaf(f[j], hf[q * 16 + j], d);
        }
        dd[x] = d;
      }
#pragma unroll
      for (int o = 32; o >= 1; o >>= 1) {
#pragma unroll
        for (int x = 0; x < 4; ++x) dd[x] += __shfl_xor(dd[x], o);
      }
#pragma unroll
      for (int x = 0; x < 4; ++x) {
        const float w = gg[x] * gelu_tanh(dd[x] * su[x]) * sv[x];
#pragma unroll
        for (int q = 0; q < 2; ++q) {
          float f[16];
          dec16(vv[x][q], f);
#pragma unroll
          for (int j = 0; j < 16; ++j) y[q * 16 + j] = fmaf(w, f[j], y[q * 16 + j]);
        }
      }
    }
    float ef[32], sg[32];
    load_row_bf16(E + (size_t)tok * D_, lane, ef);
    load_row_bf16(SG + (size_t)tok * D_, lane, sg);
    float ss = 0.f;
#pragma unroll
    for (int k = 0; k < 32; ++k) ss += ef[k] * ef[k];
    const float rr = rsqrtf(wave_sum(ss) * (1.f / D_) + 1e-5f);
    float s1 = 0.f;
#pragma unroll
    for (int q = 0; q < 2; ++q)
#pragma unroll
      for (int j4 = 0; j4 < 4; ++j4) {
        float4 g = *(const float4*)(P.ple_g + q * 1024 + lane * 16 + j4 * 4);
        const float gq[4] = {g.x, g.y, g.z, g.w};
#pragma unroll
        for (int j = 0; j < 4; ++j) {
          const int k = q * 16 + j4 * 4 + j;
          float v = ALPHA * hf[k] + y[k] + ef[k] * rr * gq[j] * sg[k];
          y[k] = v;
          s1 += v;
        }
      }
    const float mu = wave_sum(s1) * (1.f / D_);
    float s2 = 0.f;
#pragma unroll
    for (int k = 0; k < 32; ++k) { float d = y[k] - mu; s2 += d * d; }
    const float rstd = rsqrtf(wave_sum(s2) * (1.f / D_) + 1e-5f);
#pragma unroll
    for (int q = 0; q < 2; ++q)
#pragma unroll
      for (int j4 = 0; j4 < 4; ++j4) {
        const int col = q * 1024 + lane * 16 + j4 * 4;
        const int k = q * 16 + j4 * 4;
        float4 g = *(const float4*)(P.ln2_g + col), b = *(const float4*)(P.ln2_b + col);
        float4 o;
        o.x = (y[k + 0] - mu) * rstd * g.x + b.x; o.y = (y[k + 1] - mu) * rstd * g.y + b.y;
        o.z = (y[k + 2] - mu) * rstd * g.z + b.z; o.w = (y[k + 3] - mu) * rstd * g.w + b.w;
        *(float4*)(P.out + (size_t)tok * D_ + col) = o;
      }
  }
}

constexpr size_t O_BAR = 1000 * MB;
__device__ __forceinline__ void gbar(unsigned* ctr, unsigned& epoch, unsigned nb) {
  epoch += nb;
  asm volatile("s_waitcnt vmcnt(0)" ::: "memory");
  __syncthreads();
  if (threadIdx.x == 0) {
    __builtin_amdgcn_fence(__ATOMIC_RELEASE, "agent");
    asm volatile("s_waitcnt vmcnt(0)" ::: "memory");
    __hip_atomic_fetch_add(ctr, 1u, __ATOMIC_RELAXED, __HIP_MEMORY_SCOPE_AGENT);
    while (__hip_atomic_load(ctr, __ATOMIC_RELAXED, __HIP_MEMORY_SCOPE_AGENT) < epoch) __builtin_amdgcn_s_sleep(2);
    __builtin_amdgcn_fence(__ATOMIC_ACQUIRE, "agent");
    asm volatile("s_waitcnt vmcnt(0)" ::: "memory");
  }
  __syncthreads();
}

#define XB_TMO      128
#define XB_XCNT(j)  (256  + 64 * (j))
#define XB_XSUB(j)  (1280 + 64 * (j))
#define XB_XGEN(j)  (2304 + 64 * (j))
#define XB_TOP      3328
#define XB_TOPGEN   3392
#define XCD_BAR_WORDS 3456
#define XB_SPIN_CAP (1u << 18)
#define LAS __attribute__((address_space(3)))

__device__ __forceinline__ unsigned xb_ld(unsigned* p)              { return __hip_atomic_load(p, __ATOMIC_RELAXED, __HIP_MEMORY_SCOPE_AGENT); }
__device__ __forceinline__ unsigned xb_add(unsigned* p, unsigned v) { return __hip_atomic_fetch_add(p, v, __ATOMIC_RELAXED, __HIP_MEMORY_SCOPE_AGENT); }
__device__ __forceinline__ unsigned xb_xcc_id() { return (unsigned)__builtin_amdgcn_s_getreg((3 << 11) | 20) & 0xFu; }
#define XB_SPIN(cond, bar) do { unsigned _sp = 0; while (cond) { __builtin_amdgcn_s_sleep(1); \
    if ((++_sp & 255u) == 0u) { if (xb_ld(&(bar)[XB_TMO])) break; if (_sp > XB_SPIN_CAP) { atomicAdd(&(bar)[XB_TMO], 1u); break; } } } } while (0)

struct XcdBarrier {
    unsigned* bar; unsigned x;
    volatile LAS unsigned* st;
};

__device__ __forceinline__ XcdBarrier xcd_barrier_post(unsigned* bar, volatile LAS unsigned* st) {
    XcdBarrier b; b.bar = bar; b.x = xb_xcc_id(); b.st = st;
    if (threadIdx.x == 0) (void)xb_add(&bar[XB_XCNT(b.x)], 1u);
    return b;
}
__device__ __forceinline__ void xcd_barrier_complete(unsigned* bar, unsigned x, unsigned& nloc, unsigned& nx) {
    const unsigned G = gridDim.x * gridDim.y * gridDim.z;
    unsigned sum, cnt, mine, sp = 0u;
    for (;;) {
        sum = 0u; cnt = 0u; mine = 0u;
#pragma unroll
        for (unsigned j = 0; j < 16; ++j) { const unsigned c = xb_ld(&bar[XB_XCNT(j)]); sum += c; cnt += (c > 0u) ? 1u : 0u; mine = (j == x) ? c : mine; }
        if (sum == G) break;
        __builtin_amdgcn_s_sleep(1);
        if ((++sp & 255u) == 0u) { if (xb_ld(&bar[XB_TMO])) break; if (sp > XB_SPIN_CAP) { atomicAdd(&bar[XB_TMO], 1u); break; } }
    }
    nloc = mine > 0u ? mine : 1u; nx = cnt > 0u ? cnt : 1u;
}

__device__ __forceinline__ void xcd_barrier(const XcdBarrier& b) {
    asm volatile("s_waitcnt vmcnt(0)" ::: "memory");
    __syncthreads();
    if (threadIdx.x == 0) {
        unsigned* bar = b.bar;
        __builtin_amdgcn_s_waitcnt(0);
        unsigned nloc = b.st[0], nx = b.st[1];
        if (nloc == 0u) { xcd_barrier_complete(bar, b.x, nloc, nx); b.st[0] = nloc; b.st[1] = nx; }
        const unsigned old = xb_add(&bar[XB_XSUB(b.x)], 1u);
        const unsigned gen = old / nloc;
        if (old + 1u == (gen + 1u) * nloc) {
            __builtin_amdgcn_fence(__ATOMIC_RELEASE, "agent");
            asm volatile("s_waitcnt vmcnt(0)" ::: "memory");
            const unsigned og = xb_add(&bar[XB_TOP], 1u);
            const unsigned tg = og / nx;
            if (og + 1u == (tg + 1u) * nx) xb_add(&bar[XB_TOPGEN], 1u);
            else XB_SPIN(xb_ld(&bar[XB_TOPGEN]) == tg, bar);
            __builtin_amdgcn_fence(__ATOMIC_ACQUIRE, "agent");
            xb_add(&bar[XB_XGEN(b.x)], 1u);
            asm volatile("s_waitcnt vmcnt(0)" ::: "memory");
        } else {
            XB_SPIN(xb_ld(&bar[XB_XGEN(b.x)]) == gen, bar);
            __builtin_amdgcn_fence(__ATOMIC_ACQUIRE, "agent");
            asm volatile("s_waitcnt vmcnt(0)" ::: "memory");
        }
    }
    __syncthreads();
}


constexpr int NPHASE = 12;

__global__ void __launch_bounds__(512, 2) mega_kernel(Params P) {
  extern __shared__ __attribute__((aligned(16))) u16 dlds[];
  cg::grid_group grid = cg::this_grid();
  const int rb = blockIdx.x, rnb = gridDim.x;
  const int half = threadIdx.x >> 8;
  const int bid = rb * 2 + half, nb = rnb * 2;
  u16* lds = dlds + half * 36864;
  volatile LAS unsigned* xst = (volatile LAS unsigned*)(dlds + 73728);
  if (threadIdx.x < 4) xst[threadIdx.x] = 0u;
  __syncthreads();
  XcdBarrier xb = xcd_barrier_post((unsigned*)(P.ws + O_BAR + 4096), xst);
  phase0(P, bid, nb, lds);
  if (P.ws == nullptr) grid.sync();
  xcd_barrier(xb);
  phase1(P, rb, rnb, dlds); xcd_barrier(xb);
  phase2(P, bid, nb, lds); xcd_barrier(xb);
  phase3(P, bid, nb, lds); xcd_barrier(xb);
  phase4(P, rb, rnb, dlds); xcd_barrier(xb);
  phase5(P, rb, rnb, dlds); xcd_barrier(xb);
  phase6(P, rb, rnb, dlds); xcd_barrier(xb);
  ln_rows_bf16((const u16*)(P.ws + O_PRE1), P.ln1_g, P.ln1_b, (u16*)(P.ws + O_H), bid * 4 + (tidx() >> 6), nb * 4);
  xcd_barrier(xb);
  phase8(P, rb, rnb, dlds); xcd_barrier(xb);
  phase9(P, bid, nb, lds); xcd_barrier(xb);
  phase10(P, bid, nb, lds); xcd_barrier(xb);
  phase11(P, bid, nb, xb.x, xst[0]);
}

extern "C" void kernel_launch(void* const* d_in, const int* in_sizes, int n_in, void* d_out, int out_size, void* d_ws,
                              size_t ws_size, hipStream_t stream) {
  Params p{};
  const float** pp = (const float**)&p;
  for (int i = 0; i < 29; ++i) pp[i] = (const float*)d_in[i];
  p.out = (float*)d_out;
  p.ws = (char*)d_ws;
  if (ws_size < 1001 * MB) fprintf(stderr, "workspace too small: %zu\n", ws_size);
  constexpr size_t kDynLds = 147456 + 16;
  static int grid_blocks = 0;
  if (!grid_blocks) {
    int dev = 0, cus = 0, per_cu = 0;
    (void)hipGetDevice(&dev);
    (void)hipDeviceGetAttribute(&cus, hipDeviceAttributeMultiprocessorCount, dev);
    (void)hipFuncSetAttribute((const void*)mega_kernel, hipFuncAttributeMaxDynamicSharedMemorySize, (int)kDynLds);
    (void)hipOccupancyMaxActiveBlocksPerMultiprocessor(&per_cu, mega_kernel, 512, kDynLds);
    if (per_cu > 1) per_cu = 1;
    grid_blocks = cus * per_cu;
  }
  (void)hipMemsetAsync((char*)d_ws + O_BAR, 0, 4096 + XCD_BAR_WORDS * 4, stream);
  void* args[] = {&p};
  hipError_t e = hipLaunchCooperativeKernel((void*)mega_kernel, dim3(grid_blocks), dim3(512), args, kDynLds, stream);
  if (e != hipSuccess) fprintf(stderr, "cooperative launch failed: %s (grid %d)\n", hipGetErrorString(e), grid_blocks);
}
```
